# Optimizing an MI355X kernel written in HIP

```python
import jax, jax.numpy as jnp
from jax import lax
import numpy as np

D_MODEL = 1024
BATCH = 4
SEQ = 8192
DEPTH = 2

CHUNK = 64
N_META = 16
LEAD_PAD = CHUNK - N_META
EPS = 1e-6
MIX_WIDTH = D_MODEL
M_HEADS = 4
M_WIDTH = MIX_WIDTH // 2
M_HEAD_DIM = M_WIDTH // M_HEADS
CONV_K = 4
G_HEADS = 4
G_WIDTH = MIX_WIDTH - M_WIDTH
G_V_DIM = G_WIDTH // G_HEADS
G_K_DIM = G_V_DIM // 2
G_K_WIDTH = G_HEADS * G_K_DIM
G_RANK = 16
G_TAU = 16.0
N_GROUPS = 4
EXPERTS_PER_GROUP = 8
N_EXPERTS = N_GROUPS * EXPERTS_PER_GROUP
TOP_K = 2
D_EXPERT = D_MODEL // 4
EXPERT_BLOCK = 128
IN_SPLITS = (2 * M_WIDTH, M_WIDTH, M_WIDTH, M_HEADS, M_HEADS, G_K_WIDTH, G_K_WIDTH, G_WIDTH, G_WIDTH, G_RANK)
IN_WIDTH = sum(IN_SPLITS)
F32 = jnp.float32

kernel_name = "hybrid_mlstm_gla_hiermoe"


def rmsnorm(x, g):
    xf = x.astype(F32)
    y = xf * lax.rsqrt(jnp.mean(xf * xf, axis=-1, keepdims=True) + EPS)
    return (y * g.astype(F32)).astype(x.dtype)


def head_rmsnorm(h, g):
    y = h * lax.rsqrt(jnp.mean(h * h, axis=-1, keepdims=True) + EPS)
    return y.reshape(h.shape[0], h.shape[1], -1) * g.astype(F32)


def causal_depthwise_conv(x, w, b):
    c = x.shape[-1]
    y = lax.conv_general_dilated(x, w[:, None, :], window_strides=(1,), padding=[(CONV_K - 1, 0)],
                                 dimension_numbers=('NWC', 'WIO', 'NWC'), feature_group_count=c)
    return y + b


def to_chunks(t, fill):
    pad = [(0, 0), (LEAD_PAD, 0)] + [(0, 0)] * (t.ndim - 2)
    t = jnp.pad(t, pad, constant_values=fill)
    bn, lp = t.shape[0], t.shape[1]
    t = t.reshape(bn, lp // CHUNK, CHUNK, *t.shape[2:])
    return jnp.moveaxis(t, (1, 3), (0, 2))


def from_chunks(h):
    h = jnp.moveaxis(h, (0, 2), (1, 3))
    bn, nc, c, nh, d = h.shape
    return h.reshape(bn, nc * c, nh, d)[:, LEAD_PAD:]


def mlstm_heads(q, k, v, ig, lf):
    bn, _, nh, d = q.shape
    causal = jnp.tril(jnp.ones((CHUNK, CHUNK), dtype=bool))
    xs = (to_chunks(q, 0.0), to_chunks(k, 0.0), to_chunks(v, 0.0),
          to_chunks(ig, -jnp.inf), to_chunks(lf, 0.0))

    def step(carry, inp):
        c_state, n_state, m_state = carry
        qc, kc, vc, igc, lfc = inp
        b = jnp.cumsum(lfc, axis=-1)
        dmat = jnp.where(causal, b[..., :, None] - b[..., None, :] + igc[..., None, :], -jnp.inf)
        m_inter = b + m_state[..., None]
        m_t = jnp.maximum(m_inter, jnp.max(dmat, axis=-1))
        s = jnp.einsum('bhtd,bhsd->bhts', qc, kc) * jnp.exp(dmat - m_t[..., None])
        w_inter = jnp.exp(m_inter - m_t)
        num = jnp.einsum('bhts,bhsv->bhtv', s, vc) + w_inter[..., None] * jnp.einsum('bhvk,bhtk->bhtv', c_state, qc)
        den = jnp.sum(s, axis=-1) + w_inter * jnp.einsum('bhk,bhtk->bht', n_state, qc)
        h = num / jnp.maximum(jnp.abs(den), jnp.exp(-m_t))[..., None]
        b_end = b[..., -1]
        g = b_end[..., None] - b + igc
        m_new = jnp.maximum(b_end + m_state, jnp.max(g, axis=-1))
        wk = jnp.exp(g - m_new[..., None])
        decay = jnp.exp(b_end + m_state - m_new)
        c_state = decay[..., None, None] * c_state + jnp.einsum('bhs,bhsv,bhsk->bhvk', wk, vc, kc)
        n_state = decay[..., None] * n_state + jnp.einsum('bhs,bhsk->bhk', wk, kc)
        return (c_state, n_state, m_new), h

    init = (jnp.zeros((bn, nh, d, d), F32), jnp.zeros((bn, nh, d), F32), jnp.zeros((bn, nh), F32))
    _, h = lax.scan(step, init, xs)
    return from_chunks(h)


def gla_heads(q, k, v, la):
    bn, _, nh, dk = q.shape
    dv = v.shape[-1]
    causal = jnp.tril(jnp.ones((CHUNK, CHUNK), dtype=bool))
    xs = (to_chunks(q, 0.0), to_chunks(k, 0.0), to_chunks(v, 0.0), to_chunks(la, 0.0))

    def step(s_state, inp):
        qc, kc, vc, lac = inp
        b = jnp.cumsum(lac, axis=2)
        pair = jnp.where(causal[:, :, None], b[:, :, :, None, :] - b[:, :, None, :, :], -jnp.inf)
        a = jnp.einsum('bhtj,bhsj,bhtsj->bhts', qc, kc, jnp.exp(pair))
        o = jnp.einsum('bhts,bhsv->bhtv', a, vc) + jnp.einsum('bhtj,bhjv->bhtv', qc * jnp.exp(b), s_state)
        b_end = b[:, :, -1]
        s_state = jnp.exp(b_end)[..., None] * s_state + jnp.einsum(
            'bhsj,bhsv->bhjv', kc * jnp.exp(b_end[:, :, None] - b), vc)
        return s_state, o

    _, o = lax.scan(step, jnp.zeros((bn, nh, dk, dv), F32), xs)
    return from_chunks(o)


def hybrid_mixer(xn, w_in, conv_w, conv_b, gate_b, m_norm_g, a_w2, a_b, g_norm_g, w_out):
    bn, seq_len, _ = xn.shape
    z = (xn @ w_in).astype(F32)
    qk_m, v_m, o_m, ig, fg, q_g, k_g, v_g, gate_g, code_g = jnp.split(
        z, np.cumsum(IN_SPLITS)[:-1].tolist(), axis=-1)
    heads = lambda t, d: t.reshape(bn, seq_len, -1, d)
    qk_m = jax.nn.silu(causal_depthwise_conv(qk_m, conv_w.astype(F32), conv_b.astype(F32)))
    q_m, k_m = jnp.split(qk_m, 2, axis=-1)
    h_m = mlstm_heads(heads(q_m, M_HEAD_DIM), heads(k_m, M_HEAD_DIM) * (M_HEAD_DIM ** -0.5),
                      heads(v_m, M_HEAD_DIM), ig + gate_b[0].astype(F32),
                      jax.nn.log_sigmoid(fg + gate_b[1].astype(F32)))
    y_m = head_rmsnorm(h_m, m_norm_g) * jax.nn.sigmoid(o_m)
    la = jax.nn.log_sigmoid(code_g @ a_w2.astype(F32) + a_b.astype(F32)) / G_TAU
    h_g = gla_heads(heads(q_g, G_K_DIM) * (G_K_DIM ** -0.5), heads(k_g, G_K_DIM),
                    heads(v_g, G_V_DIM), heads(la, G_K_DIM))
    y_g = head_rmsnorm(h_g, g_norm_g) * jax.nn.silu(gate_g)
    y = jnp.concatenate([y_m, y_g], axis=-1).astype(xn.dtype)
    return y @ w_out


def hierarchical_moe(xn, wr_g, br_g, wr_e, br_e, w_gate, w_up, w_down):
    bn, seq_len, dm = xn.shape
    xt = xn.reshape(-1, dm)
    n_tok = xt.shape[0]
    p_group = jax.nn.softmax((xt @ wr_g).astype(F32) + br_g.astype(F32), axis=-1)
    g_sel = jnp.argmax(p_group, axis=-1)
    p_sel = jnp.take_along_axis(p_group, g_sel[:, None], axis=-1)
    e_logits = ((xt @ wr_e).astype(F32) + br_e.astype(F32)).reshape(n_tok, N_GROUPS, EXPERTS_PER_GROUP)
    e_logits = jnp.take_along_axis(e_logits, g_sel[:, None, None], axis=1)[:, 0]
    top_v, top_i = lax.top_k(e_logits, TOP_K)
    gate = jax.nn.softmax(top_v, axis=-1) * p_sel
    expert = (g_sel[:, None] * EXPERTS_PER_GROUP + top_i).reshape(-1).astype(jnp.int32)
    token = jnp.repeat(jnp.arange(n_tok, dtype=jnp.int32), TOP_K)
    weight = gate.reshape(-1)
    n_asg = n_tok * TOP_K
    order = jnp.argsort(expert)
    s_exp, s_tok, s_w = expert[order], token[order], weight[order]
    counts = jnp.bincount(expert, length=N_EXPERTS)
    padded = (counts + EXPERT_BLOCK - 1) // EXPERT_BLOCK * EXPERT_BLOCK
    pad_end = jnp.cumsum(padded)
    slot = (pad_end - padded)[s_exp] + jnp.arange(n_asg, dtype=jnp.int32) - (jnp.cumsum(counts) - counts)[s_exp]
    n_blocks = -(-(n_asg + N_EXPERTS * (EXPERT_BLOCK - 1)) // EXPERT_BLOCK)
    slot_tok = jnp.full((n_blocks * EXPERT_BLOCK,), n_tok, jnp.int32).at[slot].set(s_tok)
    block_exp = jnp.minimum(jnp.searchsorted(pad_end, jnp.arange(n_blocks, dtype=jnp.int32) * EXPERT_BLOCK,
                                             side='right'), N_EXPERTS - 1)
    x_pad = jnp.concatenate([xt, jnp.zeros((1, dm), xt.dtype)], axis=0)

    def run_block(args):
        tok, e = args
        xb = x_pad[tok]
        hb = jax.nn.silu(xb @ w_gate[e]) * (xb @ w_up[e])
        return hb @ w_down[e]

    y_blocks = lax.map(run_block, (slot_tok.reshape(n_blocks, EXPERT_BLOCK), block_exp))
    y_slots = y_blocks.reshape(-1, dm)[slot].astype(F32)
    y = jax.ops.segment_sum(y_slots * s_w[:, None], s_tok, num_segments=n_tok)
    return y.astype(xn.dtype).reshape(bn, seq_len, dm)


def setup_inputs(seed: int = 0) -> dict:
    key = jax.random.key(seed)
    ks = jax.random.split(key, 24)
    nrm = lambda k, shape, scale: jax.random.normal(k, shape, F32) * scale
    gains = lambda k, shape: 1.0 + nrm(k, shape, 0.02)
    gate_b = jnp.stack([nrm(ks[6], (DEPTH, M_HEADS), 0.1),
                        jnp.linspace(3.0, 6.0, M_HEADS, dtype=F32) + nrm(ks[7], (DEPTH, M_HEADS), 0.1)], axis=1)
    return {
        "x": nrm(ks[0], (BATCH, SEQ, D_MODEL), 1.0),
        "meta_tokens": nrm(ks[1], (N_META, D_MODEL), 1.0),
        "norm1_g": gains(ks[2], (DEPTH, D_MODEL)),
        "w_in": nrm(ks[3], (DEPTH, D_MODEL, IN_WIDTH), D_MODEL ** -0.5),
        "conv_w": nrm(ks[4], (DEPTH, CONV_K, 2 * M_WIDTH), CONV_K ** -0.5),
        "conv_b": nrm(ks[5], (DEPTH, 2 * M_WIDTH), 0.02),
        "gate_b": gate_b,
        "m_norm_g": gains(ks[8], (DEPTH, M_WIDTH)),
        "a_w2": nrm(ks[9], (DEPTH, G_RANK, G_K_WIDTH), G_RANK ** -0.5),
        "a_b": nrm(ks[10], (DEPTH, G_K_WIDTH), 0.1),
        "g_norm_g": gains(ks[11], (DEPTH, G_WIDTH)),
        "w_out": nrm(ks[12], (DEPTH, MIX_WIDTH, D_MODEL), MIX_WIDTH ** -0.5),
        "norm2_g": gains(ks[13], (DEPTH, D_MODEL)),
        "wr_g": nrm(ks[14], (DEPTH, D_MODEL, N_GROUPS), D_MODEL ** -0.5),
        "br_g": nrm(ks[15], (DEPTH, N_GROUPS), 0.01),
        "wr_e": nrm(ks[16], (DEPTH, D_MODEL, N_EXPERTS), D_MODEL ** -0.5),
        "br_e": nrm(ks[17], (DEPTH, N_EXPERTS), 0.01),
        "w_gate": nrm(ks[18], (DEPTH, N_EXPERTS, D_MODEL, D_EXPERT), D_MODEL ** -0.5),
        "w_up": nrm(ks[19], (DEPTH, N_EXPERTS, D_MODEL, D_EXPERT), D_MODEL ** -0.5),
        "w_down": nrm(ks[20], (DEPTH, N_EXPERTS, D_EXPERT, D_MODEL), D_EXPERT ** -0.5),
        "final_norm_g": gains(ks[21], (D_MODEL,)),
    }


def reference(x, meta_tokens, norm1_g, w_in, conv_w, conv_b, gate_b, m_norm_g, a_w2, a_b, g_norm_g, w_out,
              norm2_g, wr_g, br_g, wr_e, br_e, w_gate, w_up, w_down, final_norm_g):
    bn = x.shape[0]
    meta = jnp.broadcast_to(meta_tokens[None].astype(x.dtype), (bn, N_META, x.shape[-1]))
    h = jnp.concatenate([meta, x], axis=1)
    for l in range(DEPTH):
        h = h + hybrid_mixer(rmsnorm(h, norm1_g[l]), w_in[l], conv_w[l], conv_b[l], gate_b[l], m_norm_g[l],
                             a_w2[l], a_b[l], g_norm_g[l], w_out[l])
        h = h + hierarchical_moe(rmsnorm(h, norm2_g[l]), wr_g[l], br_g[l], wr_e[l], br_e[l],
                                 w_gate[l], w_up[l], w_down[l])
    return rmsnorm(h, final_norm_g)[:, N_META:]
```

```cpp
#include <hip/hip_runtime.h>
#include <cstdio>
#include <cstdint>

typedef unsigned short bf16_t;
typedef float f32x4 __attribute__((ext_vector_type(4)));

namespace cfg {
constexpr int B = 4, SEQ = 8192, D = 1024, DEPTH = 2;
constexpr int CH = 64, NMETA = 16, LEAD = 48;
constexpr int TP = LEAD + NMETA + SEQ;
constexpr int NCH = TP / CH;
constexpr int MP = B * TP;
constexpr int NIN = 3608, NZP = 3840;
constexpr int ZO_OM = 0, ZO_GG = 512, ZO_QM = 1024, ZO_KM = 1536, ZO_VM = 2048, ZO_QG = 2560, ZO_KG = 2816, ZO_VG = 3072, ZO_IG = 3584, ZO_FG = 3588, ZO_CODE = 3592;
constexpr int NE = 32, DE = 256, NR = 40;
constexpr float EPS = 1e-6f;
constexpr int NU = B * 4 * NCH;

constexpr size_t al(size_t x) { return (x + 255) & ~(size_t)255; }
constexpr size_t WS_CTL = 0, CTL_BYTES = 4u << 20;
constexpr size_t WS_WIN = WS_CTL + CTL_BYTES;
constexpr size_t WS_WOUT = WS_WIN + al((size_t)DEPTH * NZP * D * 2);
constexpr size_t WS_WGU = WS_WOUT + al((size_t)DEPTH * D * D * 2);
constexpr size_t WS_WD = WS_WGU + al((size_t)DEPTH * NE * 512 * D * 2);
constexpr size_t WS_WR = WS_WD + al((size_t)DEPTH * NE * D * DE * 2);
constexpr size_t WS_H = WS_WR + al((size_t)DEPTH * NR * D * 4);
constexpr size_t WS_Z = WS_H + al((size_t)MP * D * 2);
constexpr size_t WS_SS1 = WS_Z + al((size_t)MP * NIN * 2);
constexpr size_t WS_SS2 = WS_SS1 + al((size_t)MP * 16);
constexpr size_t WS_TOKE = WS_SS2 + al((size_t)MP * 16);
constexpr size_t WS_TOKW = WS_TOKE + al((size_t)MP * 8);
constexpr size_t WS_END = WS_TOKW + al((size_t)MP * 8);
constexpr size_t ST_MC = 0;
constexpr size_t ST_GS = ST_MC + al((size_t)NU * 16384 * 2);
constexpr size_t ST_MN = ST_GS + al((size_t)NU * 8192 * 2);
constexpr size_t ST_MSC = ST_MN + al((size_t)NU * 128 * 4);
constexpr size_t ST_GB = ST_MSC + al((size_t)NU * 16);
constexpr size_t ST_END = ST_GB + al((size_t)NU * 64 * 4);
static_assert(ST_END <= (size_t)B * SEQ * D * 4, "state scratch fits d_out");
}
using namespace cfg;

__device__ __forceinline__ float bf2f(bf16_t v) { return __uint_as_float(((unsigned)v) << 16); }
__device__ __forceinline__ bf16_t f2bf(float f) { unsigned u = __float_as_uint(f); u += 0x7fffu + ((u >> 16) & 1u); return (bf16_t)(u >> 16); }
__device__ __forceinline__ float wave_sum(float v) {
#pragma unroll
    for (int o = 1; o < 64; o <<= 1) v += __shfl_xor(v, o);
    return v;
}
__device__ __forceinline__ float logsig(float x) { return fminf(x, 0.f) - log1pf(__expf(-fabsf(x))); }
__device__ __forceinline__ float sigm(float x) { return 1.f / (1.f + __expf(-x)); }
__device__ __forceinline__ float silu(float x) { return x * sigm(x); }

__host__ __device__ __forceinline__ int zsrc(int n) {
    if (n < 512) return 1536 + n;
    if (n < 1024) return 3080 + (n - 512);
    if (n < 2048) return n - 1024;
    if (n < 2560) return 1024 + (n - 2048);
    if (n < 2816) return 2056 + (n - 2560);
    if (n < 3072) return 2312 + (n - 2816);
    if (n < 3584) return 2568 + (n - 3072);
    if (n < 3588) return 2048 + (n - 3584);
    if (n < 3592) return 2052 + (n - 3588);
    return n;
}

struct P {
    const float *x, *meta, *norm1_g, *w_in, *conv_w, *conv_b, *gate_b, *m_norm_g, *a_w2, *a_b, *g_norm_g, *w_out, *norm2_g, *wr_g, *br_g, *wr_e, *br_e, *w_gate, *w_up, *w_down, *final_g;
    float* out; unsigned char* ws;
    __device__ __forceinline__ bf16_t* Win() const { return (bf16_t*)(ws + WS_WIN); }
    __device__ __forceinline__ bf16_t* Wout() const { return (bf16_t*)(ws + WS_WOUT); }
    __device__ __forceinline__ bf16_t* Wgu() const { return (bf16_t*)(ws + WS_WGU); }
    __device__ __forceinline__ bf16_t* Wd() const { return (bf16_t*)(ws + WS_WD); }
    __device__ __forceinline__ float* Wr() const { return (float*)(ws + WS_WR); }
    __device__ __forceinline__ bf16_t* H() const { return (bf16_t*)(ws + WS_H); }
    __device__ __forceinline__ bf16_t* Z() const { return (bf16_t*)(ws + WS_Z); }
    __device__ __forceinline__ float* SS1() const { return (float*)(ws + WS_SS1); }
    __device__ __forceinline__ float* SS2() const { return (float*)(ws + WS_SS2); }
    __device__ __forceinline__ int* TokE() const { return (int*)(ws + WS_TOKE); }
    __device__ __forceinline__ float* TokW() const { return (float*)(ws + WS_TOKW); }
    __device__ __forceinline__ bf16_t* MC() const { return (bf16_t*)((unsigned char*)out + ST_MC); }
    __device__ __forceinline__ bf16_t* GS() const { return (bf16_t*)((unsigned char*)out + ST_GS); }
    __device__ __forceinline__ float* MN() const { return (float*)((unsigned char*)out + ST_MN); }
    __device__ __forceinline__ float* MSC() const { return (float*)((unsigned char*)out + ST_MSC); }
    __device__ __forceinline__ float* GB() const { return (float*)((unsigned char*)out + ST_GB); }
};

template <class F> __global__ void __launch_bounds__(256) k_transpose(F f) {
    __shared__ float t[32][33];
    const int n0 = blockIdx.x * 32, k0 = blockIdx.y * 32, bz = blockIdx.z, tx = threadIdx.x & 31, ty = threadIdx.x >> 5;
    for (int i = ty; i < 32; i += 8) t[i][tx] = f.load(bz, k0 + i, n0 + tx);
    __syncthreads();
    for (int i = ty; i < 32; i += 8) f.store(bz, n0 + i, k0 + tx, t[tx][i]);
}
struct TWin { const float* w; const float* g; bf16_t* o;
    __device__ float load(int l, int k, int n) const { return n < NIN ? w[((size_t)l * D + k) * NIN + zsrc(n)] * g[l * D + k] : 0.f; }
    __device__ void store(int l, int n, int k, float v) const { o[((size_t)l * NZP + n) * D + k] = f2bf(v); } };
struct TWout { const float* w; bf16_t* o;
    __device__ float load(int l, int k, int n) const { return w[((size_t)l * D + k) * D + n]; }
    __device__ void store(int l, int n, int k, float v) const { o[((size_t)l * D + n) * D + k] = f2bf(v); } };
struct TWgu { const float* wg; const float* wu; const float* g; bf16_t* o;
    __device__ float load(int bz, int k, int n) const { const int gq = n >> 5, i = n & 31, col = 16 * gq + (i & 15); const float* s = (i < 16) ? wg : wu;
        return s[((size_t)bz * D + k) * DE + col] * g[(bz >> 5) * D + k]; }
    __device__ void store(int bz, int n, int k, float v) const { o[((size_t)bz * 512 + n) * D + k] = f2bf(v); } };
struct TWd { const float* w; bf16_t* o;
    __device__ float load(int bz, int k, int n) const { return w[((size_t)bz * DE + k) * D + n]; }
    __device__ void store(int bz, int n, int k, float v) const { o[((size_t)bz * D + n) * DE + k] = f2bf(v); } };
__global__ void k_prep_wr(P p) {
    const int idx = blockIdx.x * 256 + threadIdx.x; if (idx >= DEPTH * NR * D) return;
    const int k = idx % D, o = (idx / D) % NR, l = idx / (D * NR);
    float v = 0.f;
    if (o < 4) v = p.wr_g[((size_t)l * D + k) * 4 + o]; else if (o < 36) v = p.wr_e[((size_t)l * D + k) * 32 + (o - 4)];
    p.Wr()[idx] = v * p.norm2_g[l * D + k];
}
__global__ void __launch_bounds__(256) k_prep_h(P p) {
    const int r = blockIdx.x * 4 + (threadIdx.x >> 6), lane = threadIdx.x & 63;
    const int b = r / TP, pp = r % TP;
    const float* src = nullptr;
    if (pp >= 64) src = p.x + ((size_t)b * SEQ + (pp - 64)) * D; else if (pp >= LEAD) src = p.meta + (size_t)(pp - LEAD) * D;
    float s = 0.f; bf16_t* hr = p.H() + (size_t)r * D;
#pragma unroll
    for (int j = 0; j < 4; ++j) { f32x4 v = {0.f, 0.f, 0.f, 0.f}; if (src) v = ((const f32x4*)src)[lane + 64 * j];
        s += v.x * v.x + v.y * v.y + v.z * v.z + v.w * v.w;
        ushort4 o; o.x = f2bf(v.x); o.y = f2bf(v.y); o.z = f2bf(v.z); o.w = f2bf(v.w); ((ushort4*)hr)[lane + 64 * j] = o; }
    s = wave_sum(s);
    if (lane == 0) { float* q = p.SS1() + (size_t)r * 4; q[0] = s; q[1] = 0.f; q[2] = 0.f; q[3] = 0.f; }
}
__device__ __forceinline__ float row_rs(const float* ss, int r) {
    if ((r % TP) < LEAD) return 0.f;
    const f32x4 v = *(const f32x4*)(ss + (size_t)r * 4);
    return rsqrtf((v.x + v.y + v.z + v.w) * (1.f / D) + EPS);
}
template <class Epi> __global__ void __launch_bounds__(256) k_gemm_ref(const bf16_t* A, int lda, const bf16_t* Bt, int K, int N, Epi E) {
    __shared__ __attribute__((aligned(16))) float As[32][68]; __shared__ __attribute__((aligned(16))) float Bs[32][68];
    const int tx = threadIdx.x & 15, ty = threadIdx.x >> 4, m0 = blockIdx.y * 64, n0 = blockIdx.x * 64;
    float acc[4][4];
#pragma unroll
    for (int i = 0; i < 4; ++i)
#pragma unroll
        for (int j = 0; j < 4; ++j) acc[i][j] = 0.f;
    for (int k0 = 0; k0 < K; k0 += 32) {
        for (int i = threadIdx.x; i < 2048; i += 256) { const int r = i >> 5, c = i & 31;
            As[c][r] = bf2f(A[(size_t)(m0 + r) * lda + k0 + c]);
            Bs[c][r] = (n0 + r < N) ? bf2f(Bt[(size_t)(n0 + r) * K + k0 + c]) : 0.f; }
        __syncthreads();
#pragma unroll 8
        for (int kk = 0; kk < 32; ++kk) { const f32x4 a = *(const f32x4*)&As[kk][ty * 4], b = *(const f32x4*)&Bs[kk][tx * 4];
            const float av[4] = {a.x, a.y, a.z, a.w}, bv[4] = {b.x, b.y, b.z, b.w};
#pragma unroll
            for (int i = 0; i < 4; ++i)
#pragma unroll
                for (int j = 0; j < 4; ++j) acc[i][j] += av[i] * bv[j]; }
        __syncthreads();
    }
#pragma unroll
    for (int i = 0; i < 4; ++i)
#pragma unroll
        for (int j = 0; j < 4; ++j) { const int r = m0 + ty * 4 + i, c = n0 + tx * 4 + j; if (c < N) E(r, c, acc[i][j]); }
}
struct EZ { bf16_t* z; const float* ss; __device__ void operator()(int r, int c, float v) const { z[(size_t)r * NIN + c] = f2bf(v * row_rs(ss, r)); } };
struct EO { bf16_t* h; __device__ void operator()(int r, int c, float v) const { bf16_t* q = h + (size_t)r * D + c; *q = f2bf(bf2f(*q) + v); } };
__global__ void __launch_bounds__(256) k_rowss(const bf16_t* h, float* ss) {
    const int r = blockIdx.x * 4 + (threadIdx.x >> 6), lane = threadIdx.x & 63; float s = 0.f;
    for (int j = lane; j < D; j += 64) { const float v = bf2f(h[(size_t)r * D + j]); s += v * v; }
    s = wave_sum(s); if (lane == 0) { float* q = ss + (size_t)r * 4; q[0] = s; q[1] = 0.f; q[2] = 0.f; q[3] = 0.f; }
}

__device__ __forceinline__ float conv_qk(const P& p, int l, const bf16_t* z, int r0, int c, int s, int zcol, int cch) {
    float acc = p.conv_b[l * D + cch];
#pragma unroll
    for (int j = 0; j < 4; ++j) { const int pp = c * 64 + s - 3 + j; if (pp >= LEAD) acc += p.conv_w[(l * 4 + j) * D + cch] * bf2f(z[(size_t)(r0 + s - 3 + j) * NIN + zcol]); }
    return silu(acc);
}
__global__ void __launch_bounds__(256) k_mix_local_ref(P p, int l) {
    extern __shared__ float sm[];
    const int tid = threadIdx.x, type = blockIdx.x / NU, u = blockIdx.x % NU, c = u % NCH, hd = (u / NCH) & 3, b = u / (NCH * 4);
    const int r0 = b * TP + c * 64; const bf16_t* z = p.Z();
    if (type == 0) {
        float* ks = sm; float* vs = ks + 64 * 129; float* wv = vs + 64 * 129; float* lfs = wv + 64; float* igs = lfs + 64;
        if (tid < 64) { const int s = tid; const bool valid = (c > 0) || (s >= LEAD); const size_t zr = (size_t)(r0 + s) * NIN;
            lfs[s] = valid ? logsig(bf2f(z[zr + ZO_FG + hd]) + p.gate_b[(l * 2 + 1) * 4 + hd]) : 0.f;
            igs[s] = valid ? bf2f(z[zr + ZO_IG + hd]) + p.gate_b[(l * 2 + 0) * 4 + hd] : -INFINITY; }
        for (int i = tid; i < 64 * 128; i += 256) { const int s = i >> 7, ch = i & 127; const bool valid = (c > 0) || (s >= LEAD);
            ks[s * 129 + ch] = valid ? conv_qk(p, l, z, r0, c, s, ZO_KM + hd * 128 + ch, 512 + hd * 128 + ch) * 0.08838834764831845f : 0.f;
            vs[s * 129 + ch] = valid ? bf2f(z[(size_t)(r0 + s) * NIN + ZO_VM + hd * 128 + ch]) : 0.f; }
        __syncthreads();
        if (tid == 0) { float run = 0.f; for (int s = 0; s < 64; ++s) { run += lfs[s]; lfs[s] = run; }
            const float be = run; float mg = -INFINITY; for (int s = 0; s < 64; ++s) { const float g = be - lfs[s] + igs[s]; igs[s] = g; mg = fmaxf(mg, g); }
            for (int s = 0; s < 64; ++s) wv[s] = __expf(igs[s] - mg);
            float* sc = p.MSC() + (size_t)u * 4; sc[0] = mg; sc[1] = be; }
        __syncthreads();
        bf16_t* Cd = p.MC() + (size_t)u * 16384; const int k = tid & 127;
        for (int i = 0; i < 64; ++i) { const int v = (tid >> 7) + 2 * i; float a = 0.f;
            for (int s = 0; s < 64; ++s) a += wv[s] * vs[s * 129 + v] * ks[s * 129 + k];
            Cd[v * 128 + k] = f2bf(a); }
        if (tid < 128) { float a = 0.f; for (int s = 0; s < 64; ++s) a += wv[s] * ks[s * 129 + tid]; p.MN()[(size_t)u * 128 + tid] = a; }
    } else {
        float* kh = sm; float* vs = kh + 64 * 65; float* bs = vs + 64 * 129; float* cod = bs + 64 * 65;
        for (int i = tid; i < 64 * 16; i += 256) { const int s = i >> 4, q = i & 15; cod[i] = bf2f(z[(size_t)(r0 + s) * NIN + ZO_CODE + q]); }
        __syncthreads();
        for (int i = tid; i < 64 * 64; i += 256) { const int s = i >> 6, j = i & 63; const bool valid = (c > 0) || (s >= LEAD);
            float a = p.a_b[l * 256 + hd * 64 + j];
#pragma unroll
            for (int q = 0; q < 16; ++q) a += cod[s * 16 + q] * p.a_w2[(l * 16 + q) * 256 + hd * 64 + j];
            bs[s * 65 + j] = valid ? logsig(a) * (1.f / 16.f) : 0.f; }
        for (int i = tid; i < 64 * 128; i += 256) { const int s = i >> 7, d = i & 127; const bool valid = (c > 0) || (s >= LEAD);
            vs[s * 129 + d] = valid ? bf2f(z[(size_t)(r0 + s) * NIN + ZO_VG + hd * 128 + d]) : 0.f; }
        __syncthreads();
        if (tid < 64) { float run = 0.f; for (int s = 0; s < 64; ++s) { run += bs[s * 65 + tid]; bs[s * 65 + tid] = run; } p.GB()[(size_t)u * 64 + tid] = run; }
        __syncthreads();
        for (int i = tid; i < 64 * 64; i += 256) { const int s = i >> 6, j = i & 63; const bool valid = (c > 0) || (s >= LEAD);
            kh[s * 65 + j] = valid ? bf2f(z[(size_t)(r0 + s) * NIN + ZO_KG + hd * 64 + j]) * __expf(bs[63 * 65 + j] - bs[s * 65 + j]) : 0.f; }
        __syncthreads();
        bf16_t* Sd = p.GS() + (size_t)u * 8192; const int j = tid & 63;
        for (int i = 0; i < 32; ++i) { const int d = (tid >> 6) + 4 * i; float a = 0.f;
            for (int s = 0; s < 64; ++s) a += vs[s * 129 + d] * kh[s * 65 + j];
            Sd[d * 64 + j] = f2bf(a); }
    }
}
__global__ void __launch_bounds__(256) k_scan_ref(P p) {
    const int nbm = 16 * 65;
    if ((int)blockIdx.x < nbm) {
        const int bh = blockIdx.x / 65, e = (blockIdx.x % 65) * 256 + threadIdx.x; if (e >= 16384 + 128) return;
        float m = 0.f, C = 0.f;
        for (int c = 0; c < NCH; ++c) { const size_t u = (size_t)bh * NCH + c; float* sc = p.MSC() + u * 4; const float mg = sc[0], be = sc[1];
            float dl;
            if (e < 16384) { bf16_t* q = p.MC() + u * 16384 + e; dl = bf2f(*q); *q = f2bf(C); } else { float* q = p.MN() + u * 128 + (e - 16384); dl = *q; *q = C; }
            if (e == 0) sc[2] = m;
            const float mn = fmaxf(be + m, mg), dec = __expf(be + m - mn), wg = __expf(mg - mn);
            C = dec * C + wg * dl; m = mn; }
    } else {
        const int bi = blockIdx.x - nbm, bh = bi / 32, e = (bi % 32) * 256 + threadIdx.x, j = e & 63;
        float S = 0.f;
        for (int c = 0; c < NCH; ++c) { const size_t u = (size_t)bh * NCH + c; bf16_t* q = p.GS() + u * 8192 + e; const float dl = bf2f(*q); *q = f2bf(S);
            S = S * __expf(p.GB()[u * 64 + j]) + dl; }
    }
}
__global__ void __launch_bounds__(256) k_mix_out_ref(P p, int l) {
    extern __shared__ float sm[];
    const int tid = threadIdx.x, type = blockIdx.x / NU, u = blockIdx.x % NU, c = u % NCH, hd = (u / NCH) & 3, b = u / (NCH * 4);
    const int r0 = b * TP + c * 64; bf16_t* z = p.Z();
    if (type == 0) {
        float* qs = sm; float* ks = qs + 64 * 129; float* vs = ks + 64 * 129; float* Ss = vs + 64 * 129; float* bb = Ss + 64 * 65; float* igs = bb + 64; float* mt = igs + 64; float* wi = mt + 64; float* den = wi + 64; float* hn = den + 64;
        if (tid < 64) { const int s = tid; const bool valid = (c > 0) || (s >= LEAD); const size_t zr = (size_t)(r0 + s) * NIN;
            bb[s] = valid ? logsig(bf2f(z[zr + ZO_FG + hd]) + p.gate_b[(l * 2 + 1) * 4 + hd]) : 0.f;
            igs[s] = valid ? bf2f(z[zr + ZO_IG + hd]) + p.gate_b[(l * 2 + 0) * 4 + hd] : -INFINITY; }
        for (int i = tid; i < 64 * 128; i += 256) { const int s = i >> 7, ch = i & 127; const bool valid = (c > 0) || (s >= LEAD);
            qs[s * 129 + ch] = valid ? conv_qk(p, l, z, r0, c, s, ZO_QM + hd * 128 + ch, hd * 128 + ch) : 0.f;
            ks[s * 129 + ch] = valid ? conv_qk(p, l, z, r0, c, s, ZO_KM + hd * 128 + ch, 512 + hd * 128 + ch) * 0.08838834764831845f : 0.f;
            vs[s * 129 + ch] = valid ? bf2f(z[(size_t)(r0 + s) * NIN + ZO_VM + hd * 128 + ch]) : 0.f; }
        __syncthreads();
        if (tid == 0) { float run = 0.f; for (int s = 0; s < 64; ++s) { run += bb[s]; bb[s] = run; } }
        for (int i = tid; i < 4096; i += 256) { const int t = i >> 6, s = i & 63; float a = 0.f;
            for (int d = 0; d < 128; ++d) a += qs[t * 129 + d] * ks[s * 129 + d];
            Ss[t * 65 + s] = a; }
        __syncthreads();
        const float m0 = p.MSC()[(size_t)u * 4 + 2];
        if (tid < 64) { const int t = tid; float dmax = -INFINITY;
            for (int s = 0; s <= t; ++s) dmax = fmaxf(dmax, bb[t] - bb[s] + igs[s]);
            const float mint = bb[t] + m0, m = fmaxf(mint, dmax), w = __expf(mint - m); float dsum = 0.f;
            for (int s = 0; s < 64; ++s) { const float v = (s <= t) ? Ss[t * 65 + s] * __expf(bb[t] - bb[s] + igs[s] - m) : 0.f; Ss[t * 65 + s] = v; dsum += v; }
            float nq = 0.f; const float* nn = p.MN() + (size_t)u * 128;
            for (int k = 0; k < 128; ++k) nq += nn[k] * qs[t * 129 + k];
            mt[t] = m; wi[t] = w; den[t] = dsum + w * nq; }
        __syncthreads();
        { const int v = tid & 127; const bf16_t* Cr = p.MC() + (size_t)u * 16384 + v * 128;
          for (int i = 0; i < 32; ++i) { const int t = (tid >> 7) + 2 * i; float a = 0.f, cq = 0.f;
              for (int s = 0; s < 64; ++s) a += Ss[t * 65 + s] * vs[s * 129 + v];
              for (int k = 0; k < 128; ++k) cq += bf2f(Cr[k]) * qs[t * 129 + k];
              ks[t * 129 + v] = (a + wi[t] * cq) / fmaxf(fabsf(den[t]), __expf(-mt[t])); } }
        __syncthreads();
        if (tid < 64) { float s2 = 0.f; for (int v = 0; v < 128; ++v) { const float x = ks[tid * 129 + v]; s2 += x * x; } hn[tid] = rsqrtf(s2 * (1.f / 128.f) + EPS); }
        __syncthreads();
        for (int i = tid; i < 64 * 128; i += 256) { const int s = i >> 7, v = i & 127; const bool valid = (c > 0) || (s >= LEAD);
            bf16_t* q = z + (size_t)(r0 + s) * NIN + ZO_OM + hd * 128 + v;
            const float y = ks[s * 129 + v] * hn[s] * p.m_norm_g[l * 512 + hd * 128 + v] * sigm(bf2f(*q));
            *q = f2bf(valid ? y : 0.f); }
    } else {
        float* qt = sm; float* kt = qt + 64 * 65; float* vs = kt + 64 * 65; float* As = vs + 64 * 129; float* bs = As + 64 * 65; float* cod = bs + 64 * 65; float* ob = cod + 64 * 16; float* hn = ob + 64 * 129;
        for (int i = tid; i < 64 * 16; i += 256) { const int s = i >> 4, q = i & 15; cod[i] = bf2f(z[(size_t)(r0 + s) * NIN + ZO_CODE + q]); }
        __syncthreads();
        for (int i = tid; i < 64 * 64; i += 256) { const int s = i >> 6, j = i & 63; const bool valid = (c > 0) || (s >= LEAD);
            float a = p.a_b[l * 256 + hd * 64 + j];
#pragma unroll
            for (int q = 0; q < 16; ++q) a += cod[s * 16 + q] * p.a_w2[(l * 16 + q) * 256 + hd * 64 + j];
            bs[s * 65 + j] = valid ? logsig(a) * (1.f / 16.f) : 0.f; }
        for (int i = tid; i < 64 * 128; i += 256) { const int s = i >> 7, d = i & 127; const bool valid = (c > 0) || (s >= LEAD);
            vs[s * 129 + d] = valid ? bf2f(z[(size_t)(r0 + s) * NIN + ZO_VG + hd * 128 + d]) : 0.f; }
        __syncthreads();
        if (tid < 64) { float run = 0.f; for (int s = 0; s < 64; ++s) { run += bs[s * 65 + tid]; bs[s * 65 + tid] = run; } }
        __syncthreads();
        for (int i = tid; i < 64 * 64; i += 256) { const int s = i >> 6, j = i & 63; const bool valid = (c > 0) || (s >= LEAD); const size_t zr = (size_t)(r0 + s) * NIN;
            qt[s * 65 + j] = valid ? bf2f(z[zr + ZO_QG + hd * 64 + j]) * 0.125f * __expf(bs[s * 65 + j]) : 0.f;
            kt[s * 65 + j] = valid ? bf2f(z[zr + ZO_KG + hd * 64 + j]) * __expf(-bs[s * 65 + j]) : 0.f; }
        __syncthreads();
        for (int i = tid; i < 4096; i += 256) { const int t = i >> 6, s = i & 63; float a = 0.f;
            if (s <= t) for (int j = 0; j < 64; ++j) a += qt[t * 65 + j] * kt[s * 65 + j];
            As[t * 65 + s] = a; }
        __syncthreads();
        { const int d = tid & 127; const bf16_t* Sr = p.GS() + (size_t)u * 8192 + d * 64;
          for (int i = 0; i < 32; ++i) { const int t = (tid >> 7) + 2 * i; float a = 0.f;
              for (int s = 0; s < 64; ++s) a += As[t * 65 + s] * vs[s * 129 + d];
              for (int j = 0; j < 64; ++j) a += qt[t * 65 + j] * bf2f(Sr[j]);
              ob[t * 129 + d] = a; } }
        __syncthreads();
        if (tid < 64) { float s2 = 0.f; for (int d = 0; d < 128; ++d) { const float x = ob[tid * 129 + d]; s2 += x * x; } hn[tid] = rsqrtf(s2 * (1.f / 128.f) + EPS); }
        __syncthreads();
        for (int i = tid; i < 64 * 128; i += 256) { const int s = i >> 7, d = i & 127; const bool valid = (c > 0) || (s >= LEAD);
            bf16_t* q = z + (size_t)(r0 + s) * NIN + ZO_GG + hd * 128 + d;
            const float y = ob[s * 129 + d] * hn[s] * p.g_norm_g[l * 512 + hd * 128 + d] * silu(bf2f(*q));
            *q = f2bf(valid ? y : 0.f); }
    }
}
__global__ void __launch_bounds__(256) k_route_ref(P p, int l) {
    __shared__ float lg[4][40];
    const int w = threadIdx.x >> 6, lane = threadIdx.x & 63, r = blockIdx.x * 4 + w;
    int* tokE = p.TokE(); float* tokW = p.TokW();
    if ((r % TP) < LEAD) { if (lane == 0) { tokE[r * 2] = -1; tokE[r * 2 + 1] = -1; tokW[r * 2] = 0.f; tokW[r * 2 + 1] = 0.f; } return; }
    const float rs = row_rs(p.SS2(), r); float xv[16];
#pragma unroll
    for (int i = 0; i < 16; ++i) xv[i] = bf2f(p.H()[(size_t)r * D + lane * 16 + i]) * rs;
    const float* W = p.Wr() + (size_t)l * NR * D;
    for (int o = 0; o < 36; ++o) { float a = 0.f;
#pragma unroll
        for (int i = 0; i < 16; ++i) a += xv[i] * W[o * D + lane * 16 + i];
        a = wave_sum(a); if (lane == 0) lg[w][o] = a + (o < 4 ? p.br_g[l * 4 + o] : p.br_e[l * 32 + o - 4]); }
    if (lane == 0) {
        int g = 0; float gm = lg[w][0];
        for (int i = 1; i < 4; ++i) if (lg[w][i] > gm) { gm = lg[w][i]; g = i; }
        float se = 0.f; for (int i = 0; i < 4; ++i) se += __expf(lg[w][i] - gm);
        const float psel = 1.f / se;
        int i0 = 0; float v0 = lg[w][4 + g * 8];
        for (int i = 1; i < 8; ++i) if (lg[w][4 + g * 8 + i] > v0) { v0 = lg[w][4 + g * 8 + i]; i0 = i; }
        int i1 = -1; float v1 = -INFINITY;
        for (int i = 0; i < 8; ++i) if (i != i0 && lg[w][4 + g * 8 + i] > v1) { v1 = lg[w][4 + g * 8 + i]; i1 = i; }
        const float w0 = 1.f / (1.f + __expf(v1 - v0));
        tokE[r * 2] = g * 8 + i0; tokE[r * 2 + 1] = g * 8 + i1; tokW[r * 2] = w0 * psel; tokW[r * 2 + 1] = (1.f - w0) * psel;
    }
}
__global__ void __launch_bounds__(256) k_moe_ref(P p, int l) {
    __shared__ float xn[1024], pre[512], hid[256], outv[1024], red[4];
    const int r = blockIdx.x, tid = threadIdx.x, w = tid >> 6, lane = tid & 63;
    if ((r % TP) < LEAD) return;
    const float rs = row_rs(p.SS2(), r); bf16_t* hr = p.H() + (size_t)r * D;
    for (int i = tid; i < D; i += 256) { xn[i] = bf2f(hr[i]) * rs; outv[i] = 0.f; }
    __syncthreads();
    for (int rank = 0; rank < 2; ++rank) {
        const int e = p.TokE()[r * 2 + rank]; const float gw = p.TokW()[r * 2 + rank];
        const bf16_t* Wg = p.Wgu() + ((size_t)(l * NE + e) * 512) * D;
        for (int row = w; row < 512; row += 4) { float a = 0.f;
            for (int k = lane; k < D; k += 64) a += bf2f(Wg[(size_t)row * D + k]) * xn[k];
            a = wave_sum(a); if (lane == 0) pre[row] = a; }
        __syncthreads();
        { const int j = tid, gq = j >> 4, i = j & 15; hid[j] = silu(pre[32 * gq + i]) * pre[32 * gq + 16 + i]; }
        __syncthreads();
        const bf16_t* Wd = p.Wd() + ((size_t)(l * NE + e) * D) * DE;
        for (int n = w; n < D; n += 4) { float a = 0.f;
            for (int k = lane; k < DE; k += 64) a += bf2f(Wd[(size_t)n * DE + k]) * hid[k];
            a = wave_sum(a); if (lane == 0) outv[n] += gw * a; }
        __syncthreads();
    }
    float s = 0.f;
    for (int i = tid; i < D; i += 256) { const float v = bf2f(hr[i]) + outv[i]; hr[i] = f2bf(v); s += v * v; }
    s = wave_sum(s); if (lane == 0) red[w] = s;
    __syncthreads();
    if (tid == 0) { float* q = p.SS1() + (size_t)r * 4; q[0] = red[0] + red[1] + red[2] + red[3]; q[1] = 0.f; q[2] = 0.f; q[3] = 0.f; }
}
__global__ void __launch_bounds__(256) k_final_ref(P p) {
    const int t = blockIdx.x * 4 + (threadIdx.x >> 6), lane = threadIdx.x & 63, b = t / SEQ, s = t % SEQ, r = b * TP + 64 + s;
    const float rs = row_rs(p.SS1(), r); const bf16_t* hr = p.H() + (size_t)r * D; float* o = p.out + (size_t)t * D;
#pragma unroll
    for (int j = 0; j < 4; ++j) { const ushort4 hv = ((const ushort4*)hr)[lane + 64 * j]; const f32x4 g = ((const f32x4*)p.final_g)[lane + 64 * j];
        f32x4 v; v.x = bf2f(hv.x) * rs * g.x; v.y = bf2f(hv.y) * rs * g.y; v.z = bf2f(hv.z) * rs * g.z; v.w = bf2f(hv.w) * rs * g.w;
        ((f32x4*)o)[lane + 64 * j] = v; }
}

extern "C" void kernel_launch(void* const* d_in, const int* in_sizes, int n_in, void* d_out, int out_size, void* d_ws, size_t ws_size, hipStream_t stream) {
    if (n_in != 21 || ws_size < WS_END || out_size != B * SEQ * D) { fprintf(stderr, "kernel_launch: unexpected sizes n_in %d ws %zu (need %zu) out %d\n", n_in, ws_size, (size_t)WS_END, out_size); return; }
    P p{};
    const float** f = (const float**)&p.x;
    for (int i = 0; i < 21; ++i) f[i] = (const float*)d_in[i];
    p.out = (float*)d_out; p.ws = (unsigned char*)d_ws;
    static bool attr = false;
    constexpr int LDS_LOCAL = 18000 * 4, LDS_OUT = 35000 * 4;
    if (!attr) { attr = true;
        (void)hipFuncSetAttribute((const void*)k_mix_local_ref, hipFuncAttributeMaxDynamicSharedMemorySize, LDS_LOCAL);
        (void)hipFuncSetAttribute((const void*)k_mix_out_ref, hipFuncAttributeMaxDynamicSharedMemorySize, LDS_OUT); }
    (void)hipMemsetAsync(d_ws, 0, CTL_BYTES, stream);
    hipLaunchKernelGGL(k_transpose<TWin>, dim3(NZP / 32, D / 32, DEPTH), dim3(256), 0, stream, TWin{p.w_in, p.norm1_g, (bf16_t*)(p.ws + WS_WIN)});
    hipLaunchKernelGGL(k_transpose<TWout>, dim3(D / 32, D / 32, DEPTH), dim3(256), 0, stream, TWout{p.w_out, (bf16_t*)(p.ws + WS_WOUT)});
    hipLaunchKernelGGL(k_transpose<TWgu>, dim3(512 / 32, D / 32, DEPTH * NE), dim3(256), 0, stream, TWgu{p.w_gate, p.w_up, p.norm2_g, (bf16_t*)(p.ws + WS_WGU)});
    hipLaunchKernelGGL(k_transpose<TWd>, dim3(D / 32, DE / 32, DEPTH * NE), dim3(256), 0, stream, TWd{p.w_down, (bf16_t*)(p.ws + WS_WD)});
    hipLaunchKernelGGL(k_prep_wr, dim3((DEPTH * NR * D + 255) / 256), dim3(256), 0, stream, p);
    hipLaunchKernelGGL(k_prep_h, dim3(MP / 4), dim3(256), 0, stream, p);
    bf16_t* H = (bf16_t*)(p.ws + WS_H); bf16_t* Z = (bf16_t*)(p.ws + WS_Z);
    for (int l = 0; l < DEPTH; ++l) {
        hipLaunchKernelGGL(k_gemm_ref<EZ>, dim3((NIN + 63) / 64, MP / 64), dim3(256), 0, stream, H, D, (const bf16_t*)(p.ws + WS_WIN) + (size_t)l * NZP * D, D, NIN, EZ{Z, (const float*)(p.ws + WS_SS1)});
        hipLaunchKernelGGL(k_mix_local_ref, dim3(2 * NU), dim3(256), LDS_LOCAL, stream, p, l);
        hipLaunchKernelGGL(k_scan_ref, dim3(16 * 65 + 16 * 32), dim3(256), 0, stream, p);
        hipLaunchKernelGGL(k_mix_out_ref, dim3(2 * NU), dim3(256), LDS_OUT, stream, p, l);
        hipLaunchKernelGGL(k_gemm_ref<EO>, dim3(D / 64, MP / 64), dim3(256), 0, stream, Z, NIN, (const bf16_t*)(p.ws + WS_WOUT) + (size_t)l * D * D, D, D, EO{H});
        hipLaunchKernelGGL(k_rowss, dim3(MP / 4), dim3(256), 0, stream, H, (float*)(p.ws + WS_SS2));
        hipLaunchKernelGGL(k_route_ref, dim3(MP / 4), dim3(256), 0, stream, p, l);
        hipLaunchKernelGGL(k_moe_ref, dim3(MP), dim3(256), 0, stream, p, l);
    }
    hipLaunchKernelGGL(k_final_ref, dim3(B * SEQ / 4), dim3(256), 0, stream, p);
}
```

```cpp
#include <hip/hip_runtime.h>
#include <cstdio>
#include <cstdint>

typedef unsigned short bf16_t;
typedef float f32x4 __attribute__((ext_vector_type(4)));

namespace cfg {
constexpr int B = 4, SEQ = 8192, D = 1024, DEPTH = 2;
constexpr int CH = 64, NMETA = 16, LEAD = 48;
constexpr int TP = LEAD + NMETA + SEQ;
constexpr int NCH = TP / CH;
constexpr int MP = B * TP;
constexpr int NIN = 3608, NZP = 3840;
constexpr int ZO_OM = 0, ZO_GG = 512, ZO_QM = 1024, ZO_KM = 1536, ZO_VM = 2048, ZO_QG = 2560, ZO_KG = 2816, ZO_VG = 3072, ZO_IG = 3584, ZO_FG = 3588, ZO_CODE = 3592;
constexpr int NE = 32, DE = 256, NR = 40;
constexpr float EPS = 1e-6f;
constexpr int NU = B * 4 * NCH;

constexpr size_t al(size_t x) { return (x + 255) & ~(size_t)255; }
constexpr size_t WS_CTL = 0, CTL_BYTES = 4u << 20;
constexpr size_t WS_WIN = WS_CTL + CTL_BYTES;
constexpr size_t WS_WOUT = WS_WIN + al((size_t)DEPTH * NZP * D * 2);
constexpr size_t WS_WGU = WS_WOUT + al((size_t)DEPTH * D * D * 2);
constexpr size_t WS_WD = WS_WGU + al((size_t)DEPTH * NE * 512 * D * 2);
constexpr size_t WS_WR = WS_WD + al((size_t)DEPTH * NE * D * DE * 2);
constexpr size_t WS_H = WS_WR + al((size_t)DEPTH * NR * D * 4);
constexpr size_t WS_Z = WS_H + al((size_t)MP * D * 2);
constexpr size_t WS_SS1 = WS_Z + al((size_t)MP * NIN * 2);
constexpr size_t WS_SS2 = WS_SS1 + al((size_t)MP * 16);
constexpr size_t WS_TOKE = WS_SS2 + al((size_t)MP * 16);
constexpr size_t WS_TOKW = WS_TOKE + al((size_t)MP * 8);
constexpr int CAPL = MP, NBMAX = 352;
constexpr size_t WS_LTOK = WS_TOKW + al((size_t)MP * 8);
constexpr size_t WS_LRS = WS_LTOK + al((size_t)64 * CAPL * 4);
constexpr size_t WS_LW = WS_LRS + al((size_t)64 * CAPL * 4);
constexpr size_t WS_END = WS_LW + al((size_t)64 * CAPL * 4);
constexpr size_t WS_HID = WS_Z;
static_assert((size_t)NBMAX * 256 * 256 * 2 <= (size_t)MP * NIN * 2, "hid fits in z");
constexpr size_t ST_MC = 0;
constexpr size_t ST_GS = ST_MC + al((size_t)NU * 16384 * 2);
constexpr size_t ST_MN = ST_GS + al((size_t)NU * 8192 * 2);
constexpr size_t ST_MSC = ST_MN + al((size_t)NU * 128 * 4);
constexpr size_t ST_GB = ST_MSC + al((size_t)NU * 16);
constexpr size_t ST_END = ST_GB + al((size_t)NU * 64 * 4);
static_assert(ST_END <= (size_t)B * SEQ * D * 4, "state scratch fits d_out");
}
using namespace cfg;

__device__ __forceinline__ float bf2f(bf16_t v) { return __uint_as_float(((unsigned)v) << 16); }
__device__ __forceinline__ bf16_t f2bf(float f) { unsigned u = __float_as_uint(f); u += 0x7fffu + ((u >> 16) & 1u); return (bf16_t)(u >> 16); }
__device__ __forceinline__ float wave_sum(float v) {
#pragma unroll
    for (int o = 1; o < 64; o <<= 1) v += __shfl_xor(v, o);
    return v;
}
__device__ __forceinline__ float logsig(float x) { return fminf(x, 0.f) - log1pf(__expf(-fabsf(x))); }
__device__ __forceinline__ float sigm(float x) { return 1.f / (1.f + __expf(-x)); }
__device__ __forceinline__ float silu(float x) { return x * sigm(x); }

__host__ __device__ __forceinline__ int zsrc(int n) {
    if (n < 512) return 1536 + n;
    if (n < 1024) return 3080 + (n - 512);
    if (n < 2048) return n - 1024;
    if (n < 2560) return 1024 + (n - 2048);
    if (n < 2816) return 2056 + (n - 2560);
    if (n < 3072) return 2312 + (n - 2816);
    if (n < 3584) return 2568 + (n - 3072);
    if (n < 3588) return 2048 + (n - 3584);
    if (n < 3592) return 2052 + (n - 3588);
    return n;
}

struct P {
    const float *x, *meta, *norm1_g, *w_in, *conv_w, *conv_b, *gate_b, *m_norm_g, *a_w2, *a_b, *g_norm_g, *w_out, *norm2_g, *wr_g, *br_g, *wr_e, *br_e, *w_gate, *w_up, *w_down, *final_g;
    float* out; unsigned char* ws;
    __device__ __forceinline__ bf16_t* Win() const { return (bf16_t*)(ws + WS_WIN); }
    __device__ __forceinline__ bf16_t* Wout() const { return (bf16_t*)(ws + WS_WOUT); }
    __device__ __forceinline__ bf16_t* Wgu() const { return (bf16_t*)(ws + WS_WGU); }
    __device__ __forceinline__ bf16_t* Wd() const { return (bf16_t*)(ws + WS_WD); }
    __device__ __forceinline__ float* Wr() const { return (float*)(ws + WS_WR); }
    __device__ __forceinline__ bf16_t* H() const { return (bf16_t*)(ws + WS_H); }
    __device__ __forceinline__ bf16_t* Z() const { return (bf16_t*)(ws + WS_Z); }
    __device__ __forceinline__ float* SS1() const { return (float*)(ws + WS_SS1); }
    __device__ __forceinline__ float* SS2() const { return (float*)(ws + WS_SS2); }
    __device__ __forceinline__ int* TokE() const { return (int*)(ws + WS_TOKE); }
    __device__ __forceinline__ float* TokW() const { return (float*)(ws + WS_TOKW); }
    __device__ __forceinline__ bf16_t* MC() const { return (bf16_t*)((unsigned char*)out + ST_MC); }
    __device__ __forceinline__ bf16_t* GS() const { return (bf16_t*)((unsigned char*)out + ST_GS); }
    __device__ __forceinline__ float* MN() const { return (float*)((unsigned char*)out + ST_MN); }
    __device__ __forceinline__ float* MSC() const { return (float*)((unsigned char*)out + ST_MSC); }
    __device__ __forceinline__ float* GB() const { return (float*)((unsigned char*)out + ST_GB); }
};

template <class F> __global__ void __launch_bounds__(256) k_transpose(F f) {
    __shared__ float t[32][33];
    const int n0 = blockIdx.x * 32, k0 = blockIdx.y * 32, bz = blockIdx.z, tx = threadIdx.x & 31, ty = threadIdx.x >> 5;
    for (int i = ty; i < 32; i += 8) t[i][tx] = f.load(bz, k0 + i, n0 + tx);
    __syncthreads();
    for (int i = ty; i < 32; i += 8) f.store(bz, n0 + i, k0 + tx, t[tx][i]);
}
struct TWin { const float* w; const float* g; bf16_t* o;
    __device__ float load(int l, int k, int n) const { return n < NIN ? w[((size_t)l * D + k) * NIN + zsrc(n)] * g[l * D + k] : 0.f; }
    __device__ void store(int l, int n, int k, float v) const { o[((size_t)l * NZP + n) * D + k] = f2bf(v); } };
struct TWout { const float* w; bf16_t* o;
    __device__ float load(int l, int k, int n) const { return w[((size_t)l * D + k) * D + n]; }
    __device__ void store(int l, int n, int k, float v) const { o[((size_t)l * D + n) * D + k] = f2bf(v); } };
struct TWgu { const float* wg; const float* wu; const float* g; bf16_t* o;
    __device__ float load(int bz, int k, int n) const { const int gq = n >> 5, i = n & 31, col = 16 * gq + (i & 15); const float* s = (i < 16) ? wg : wu;
        return s[((size_t)bz * D + k) * DE + col] * g[(bz >> 5) * D + k]; }
    __device__ void store(int bz, int n, int k, float v) const { o[((size_t)bz * 512 + n) * D + k] = f2bf(v); } };
struct TWd { const float* w; bf16_t* o;
    __device__ float load(int bz, int k, int n) const { return w[((size_t)bz * DE + k) * D + n]; }
    __device__ void store(int bz, int n, int k, float v) const { o[((size_t)bz * D + n) * DE + k] = f2bf(v); } };
__global__ void k_prep_wr(P p) {
    const int idx = blockIdx.x * 256 + threadIdx.x; if (idx >= DEPTH * NR * D) return;
    const int k = idx % D, o = (idx / D) % NR, l = idx / (D * NR);
    float v = 0.f;
    if (o < 4) v = p.wr_g[((size_t)l * D + k) * 4 + o]; else if (o < 36) v = p.wr_e[((size_t)l * D + k) * 32 + (o - 4)];
    p.Wr()[idx] = v * p.norm2_g[l * D + k];
}
__global__ void __launch_bounds__(256) k_prep_h(P p) {
    const int r = blockIdx.x * 4 + (threadIdx.x >> 6), lane = threadIdx.x & 63;
    const int b = r / TP, pp = r % TP;
    const float* src = nullptr;
    if (pp >= 64) src = p.x + ((size_t)b * SEQ + (pp - 64)) * D; else if (pp >= LEAD) src = p.meta + (size_t)(pp - LEAD) * D;
    float s = 0.f; bf16_t* hr = p.H() + (size_t)r * D;
#pragma unroll
    for (int j = 0; j < 4; ++j) { f32x4 v = {0.f, 0.f, 0.f, 0.f}; if (src) v = ((const f32x4*)src)[lane + 64 * j];
        s += v.x * v.x + v.y * v.y + v.z * v.z + v.w * v.w;
        ushort4 o; o.x = f2bf(v.x); o.y = f2bf(v.y); o.z = f2bf(v.z); o.w = f2bf(v.w); ((ushort4*)hr)[lane + 64 * j] = o; }
    s = wave_sum(s);
    if (lane == 0) { float* q = p.SS1() + (size_t)r * 4; q[0] = s; q[1] = 0.f; q[2] = 0.f; q[3] = 0.f; }
}
__device__ __forceinline__ float row_rs(const float* ss, int r) {
    if ((r % TP) < LEAD) return 0.f;
    const f32x4 v = *(const f32x4*)(ss + (size_t)r * 4);
    return rsqrtf((v.x + v.y + v.z + v.w) * (1.f / D) + EPS);
}
template <class Epi> __global__ void __launch_bounds__(256) k_gemm_ref(const bf16_t* A, int lda, const bf16_t* Bt, int K, int N, Epi E) {
    __shared__ __attribute__((aligned(16))) float As[32][68]; __shared__ __attribute__((aligned(16))) float Bs[32][68];
    const int tx = threadIdx.x & 15, ty = threadIdx.x >> 4, m0 = blockIdx.y * 64, n0 = blockIdx.x * 64;
    float acc[4][4];
#pragma unroll
    for (int i = 0; i < 4; ++i)
#pragma unroll
        for (int j = 0; j < 4; ++j) acc[i][j] = 0.f;
    for (int k0 = 0; k0 < K; k0 += 32) {
        for (int i = threadIdx.x; i < 2048; i += 256) { const int r = i >> 5, c = i & 31;
            As[c][r] = bf2f(A[(size_t)(m0 + r) * lda + k0 + c]);
            Bs[c][r] = (n0 + r < N) ? bf2f(Bt[(size_t)(n0 + r) * K + k0 + c]) : 0.f; }
        __syncthreads();
#pragma unroll 8
        for (int kk = 0; kk < 32; ++kk) { const f32x4 a = *(const f32x4*)&As[kk][ty * 4], b = *(const f32x4*)&Bs[kk][tx * 4];
            const float av[4] = {a.x, a.y, a.z, a.w}, bv[4] = {b.x, b.y, b.z, b.w};
#pragma unroll
            for (int i = 0; i < 4; ++i)
#pragma unroll
                for (int j = 0; j < 4; ++j) acc[i][j] += av[i] * bv[j]; }
        __syncthreads();
    }
#pragma unroll
    for (int i = 0; i < 4; ++i)
#pragma unroll
        for (int j = 0; j < 4; ++j) { const int r = m0 + ty * 4 + i, c = n0 + tx * 4 + j; if (c < N) E(r, c, acc[i][j]); }
}
struct EZ { bf16_t* z; const float* ss; __device__ void operator()(int r, int c, float v) const { z[(size_t)r * NIN + c] = f2bf(v * row_rs(ss, r)); } };
struct EO { bf16_t* h; __device__ void operator()(int r, int c, float v) const { bf16_t* q = h + (size_t)r * D + c; *q = f2bf(bf2f(*q) + v); } };
__global__ void __launch_bounds__(256) k_rowss(const bf16_t* h, float* ss) {
    const int r = blockIdx.x * 4 + (threadIdx.x >> 6), lane = threadIdx.x & 63; float s = 0.f;
    for (int j = lane; j < D; j += 64) { const float v = bf2f(h[(size_t)r * D + j]); s += v * v; }
    s = wave_sum(s); if (lane == 0) { float* q = ss + (size_t)r * 4; q[0] = s; q[1] = 0.f; q[2] = 0.f; q[3] = 0.f; }
}

__device__ __forceinline__ float conv_qk(const P& p, int l, const bf16_t* z, int r0, int c, int s, int zcol, int cch) {
    float acc = p.conv_b[l * D + cch];
#pragma unroll
    for (int j = 0; j < 4; ++j) { const int pp = c * 64 + s - 3 + j; if (pp >= LEAD) acc += p.conv_w[(l * 4 + j) * D + cch] * bf2f(z[(size_t)(r0 + s - 3 + j) * NIN + zcol]); }
    return silu(acc);
}
__global__ void __launch_bounds__(256) k_mix_local_ref(P p, int l) {
    extern __shared__ float sm[];
    const int tid = threadIdx.x, type = blockIdx.x / NU, u = blockIdx.x % NU, c = u % NCH, hd = (u / NCH) & 3, b = u / (NCH * 4);
    const int r0 = b * TP + c * 64; const bf16_t* z = p.Z();
    if (type == 0) {
        float* ks = sm; float* vs = ks + 64 * 129; float* wv = vs + 64 * 129; float* lfs = wv + 64; float* igs = lfs + 64;
        if (tid < 64) { const int s = tid; const bool valid = (c > 0) || (s >= LEAD); const size_t zr = (size_t)(r0 + s) * NIN;
            lfs[s] = valid ? logsig(bf2f(z[zr + ZO_FG + hd]) + p.gate_b[(l * 2 + 1) * 4 + hd]) : 0.f;
            igs[s] = valid ? bf2f(z[zr + ZO_IG + hd]) + p.gate_b[(l * 2 + 0) * 4 + hd] : -INFINITY; }
        for (int i = tid; i < 64 * 128; i += 256) { const int s = i >> 7, ch = i & 127; const bool valid = (c > 0) || (s >= LEAD);
            ks[s * 129 + ch] = valid ? conv_qk(p, l, z, r0, c, s, ZO_KM + hd * 128 + ch, 512 + hd * 128 + ch) * 0.08838834764831845f : 0.f;
            vs[s * 129 + ch] = valid ? bf2f(z[(size_t)(r0 + s) * NIN + ZO_VM + hd * 128 + ch]) : 0.f; }
        __syncthreads();
        if (tid == 0) { float run = 0.f; for (int s = 0; s < 64; ++s) { run += lfs[s]; lfs[s] = run; }
            const float be = run; float mg = -INFINITY; for (int s = 0; s < 64; ++s) { const float g = be - lfs[s] + igs[s]; igs[s] = g; mg = fmaxf(mg, g); }
            for (int s = 0; s < 64; ++s) wv[s] = __expf(igs[s] - mg);
            float* sc = p.MSC() + (size_t)u * 4; sc[0] = mg; sc[1] = be; }
        __syncthreads();
        bf16_t* Cd = p.MC() + (size_t)u * 16384; const int k = tid & 127;
        for (int i = 0; i < 64; ++i) { const int v = (tid >> 7) + 2 * i; float a = 0.f;
            for (int s = 0; s < 64; ++s) a += wv[s] * vs[s * 129 + v] * ks[s * 129 + k];
            Cd[v * 128 + k] = f2bf(a); }
        if (tid < 128) { float a = 0.f; for (int s = 0; s < 64; ++s) a += wv[s] * ks[s * 129 + tid]; p.MN()[(size_t)u * 128 + tid] = a; }
    } else {
        float* kh = sm; float* vs = kh + 64 * 65; float* bs = vs + 64 * 129; float* cod = bs + 64 * 65;
        for (int i = tid; i < 64 * 16; i += 256) { const int s = i >> 4, q = i & 15; cod[i] = bf2f(z[(size_t)(r0 + s) * NIN + ZO_CODE + q]); }
        __syncthreads();
        for (int i = tid; i < 64 * 64; i += 256) { const int s = i >> 6, j = i & 63; const bool valid = (c > 0) || (s >= LEAD);
            float a = p.a_b[l * 256 + hd * 64 + j];
#pragma unroll
            for (int q = 0; q < 16; ++q) a += cod[s * 16 + q] * p.a_w2[(l * 16 + q) * 256 + hd * 64 + j];
            bs[s * 65 + j] = valid ? logsig(a) * (1.f / 16.f) : 0.f; }
        for (int i = tid; i < 64 * 128; i += 256) { const int s = i >> 7, d = i & 127; const bool valid = (c > 0) || (s >= LEAD);
            vs[s * 129 + d] = valid ? bf2f(z[(size_t)(r0 + s) * NIN + ZO_VG + hd * 128 + d]) : 0.f; }
        __syncthreads();
        if (tid < 64) { float run = 0.f; for (int s = 0; s < 64; ++s) { run += bs[s * 65 + tid]; bs[s * 65 + tid] = run; } p.GB()[(size_t)u * 64 + tid] = run; }
        __syncthreads();
        for (int i = tid; i < 64 * 64; i += 256) { const int s = i >> 6, j = i & 63; const bool valid = (c > 0) || (s >= LEAD);
            kh[s * 65 + j] = valid ? bf2f(z[(size_t)(r0 + s) * NIN + ZO_KG + hd * 64 + j]) * __expf(bs[63 * 65 + j] - bs[s * 65 + j]) : 0.f; }
        __syncthreads();
        bf16_t* Sd = p.GS() + (size_t)u * 8192; const int j = tid & 63;
        for (int i = 0; i < 32; ++i) { const int d = (tid >> 6) + 4 * i; float a = 0.f;
            for (int s = 0; s < 64; ++s) a += vs[s * 129 + d] * kh[s * 65 + j];
            Sd[d * 64 + j] = f2bf(a); }
    }
}
__global__ void __launch_bounds__(256) k_scan_ref(P p) {
    const int nbm = 16 * 65;
    if ((int)blockIdx.x < nbm) {
        const int bh = blockIdx.x / 65, e = (blockIdx.x % 65) * 256 + threadIdx.x; if (e >= 16384 + 128) return;
        float m = 0.f, C = 0.f;
        for (int c = 0; c < NCH; ++c) { const size_t u = (size_t)bh * NCH + c; float* sc = p.MSC() + u * 4; const float mg = sc[0], be = sc[1];
            float dl;
            if (e < 16384) { bf16_t* q = p.MC() + u * 16384 + e; dl = bf2f(*q); *q = f2bf(C); } else { float* q = p.MN() + u * 128 + (e - 16384); dl = *q; *q = C; }
            if (e == 0) sc[2] = m;
            const float mn = fmaxf(be + m, mg), dec = __expf(be + m - mn), wg = __expf(mg - mn);
            C = dec * C + wg * dl; m = mn; }
    } else {
        const int bi = blockIdx.x - nbm, bh = bi / 32, e = (bi % 32) * 256 + threadIdx.x, j = e & 63;
        float S = 0.f;
        for (int c = 0; c < NCH; ++c) { const size_t u = (size_t)bh * NCH + c; bf16_t* q = p.GS() + u * 8192 + e; const float dl = bf2f(*q); *q = f2bf(S);
            S = S * __expf(p.GB()[u * 64 + j]) + dl; }
    }
}
__global__ void __launch_bounds__(256) k_mix_out_ref(P p, int l) {
    extern __shared__ float sm[];
    const int tid = threadIdx.x, type = blockIdx.x / NU, u = blockIdx.x % NU, c = u % NCH, hd = (u / NCH) & 3, b = u / (NCH * 4);
    const int r0 = b * TP + c * 64; bf16_t* z = p.Z();
    if (type == 0) {
        float* qs = sm; float* ks = qs + 64 * 129; float* vs = ks + 64 * 129; float* Ss = vs + 64 * 129; float* bb = Ss + 64 * 65; float* igs = bb + 64; float* mt = igs + 64; float* wi = mt + 64; float* den = wi + 64; float* hn = den + 64;
        if (tid < 64) { const int s = tid; const bool valid = (c > 0) || (s >= LEAD); const size_t zr = (size_t)(r0 + s) * NIN;
            bb[s] = valid ? logsig(bf2f(z[zr + ZO_FG + hd]) + p.gate_b[(l * 2 + 1) * 4 + hd]) : 0.f;
            igs[s] = valid ? bf2f(z[zr + ZO_IG + hd]) + p.gate_b[(l * 2 + 0) * 4 + hd] : -INFINITY; }
        for (int i = tid; i < 64 * 128; i += 256) { const int s = i >> 7, ch = i & 127; const bool valid = (c > 0) || (s >= LEAD);
            qs[s * 129 + ch] = valid ? conv_qk(p, l, z, r0, c, s, ZO_QM + hd * 128 + ch, hd * 128 + ch) : 0.f;
            ks[s * 129 + ch] = valid ? conv_qk(p, l, z, r0, c, s, ZO_KM + hd * 128 + ch, 512 + hd * 128 + ch) * 0.08838834764831845f : 0.f;
            vs[s * 129 + ch] = valid ? bf2f(z[(size_t)(r0 + s) * NIN + ZO_VM + hd * 128 + ch]) : 0.f; }
        __syncthreads();
        if (tid == 0) { float run = 0.f; for (int s = 0; s < 64; ++s) { run += bb[s]; bb[s] = run; } }
        for (int i = tid; i < 4096; i += 256) { const int t = i >> 6, s = i & 63; float a = 0.f;
            for (int d = 0; d < 128; ++d) a += qs[t * 129 + d] * ks[s * 129 + d];
            Ss[t * 65 + s] = a; }
        __syncthreads();
        const float m0 = p.MSC()[(size_t)u * 4 + 2];
        if (tid < 64) { const int t = tid; float dmax = -INFINITY;
            for (int s = 0; s <= t; ++s) dmax = fmaxf(dmax, bb[t] - bb[s] + igs[s]);
            const float mint = bb[t] + m0, m = fmaxf(mint, dmax), w = __expf(mint - m); float dsum = 0.f;
            for (int s = 0; s < 64; ++s) { const float v = (s <= t) ? Ss[t * 65 + s] * __expf(bb[t] - bb[s] + igs[s] - m) : 0.f; Ss[t * 65 + s] = v; dsum += v; }
            float nq = 0.f; const float* nn = p.MN() + (size_t)u * 128;
            for (int k = 0; k < 128; ++k) nq += nn[k] * qs[t * 129 + k];
            mt[t] = m; wi[t] = w; den[t] = dsum + w * nq; }
        __syncthreads();
        { const int v = tid & 127; const bf16_t* Cr = p.MC() + (size_t)u * 16384 + v * 128;
          for (int i = 0; i < 32; ++i) { const int t = (tid >> 7) + 2 * i; float a = 0.f, cq = 0.f;
              for (int s = 0; s < 64; ++s) a += Ss[t * 65 + s] * vs[s * 129 + v];
              for (int k = 0; k < 128; ++k) cq += bf2f(Cr[k]) * qs[t * 129 + k];
              ks[t * 129 + v] = (a + wi[t] * cq) / fmaxf(fabsf(den[t]), __expf(-mt[t])); } }
        __syncthreads();
        if (tid < 64) { float s2 = 0.f; for (int v = 0; v < 128; ++v) { const float x = ks[tid * 129 + v]; s2 += x * x; } hn[tid] = rsqrtf(s2 * (1.f / 128.f) + EPS); }
        __syncthreads();
        for (int i = tid; i < 64 * 128; i += 256) { const int s = i >> 7, v = i & 127; const bool valid = (c > 0) || (s >= LEAD);
            bf16_t* q = z + (size_t)(r0 + s) * NIN + ZO_OM + hd * 128 + v;
            const float y = ks[s * 129 + v] * hn[s] * p.m_norm_g[l * 512 + hd * 128 + v] * sigm(bf2f(*q));
            *q = f2bf(valid ? y : 0.f); }
    } else {
        float* qt = sm; float* kt = qt + 64 * 65; float* vs = kt + 64 * 65; float* As = vs + 64 * 129; float* bs = As + 64 * 65; float* cod = bs + 64 * 65; float* ob = cod + 64 * 16; float* hn = ob + 64 * 129;
        for (int i = tid; i < 64 * 16; i += 256) { const int s = i >> 4, q = i & 15; cod[i] = bf2f(z[(size_t)(r0 + s) * NIN + ZO_CODE + q]); }
        __syncthreads();
        for (int i = tid; i < 64 * 64; i += 256) { const int s = i >> 6, j = i & 63; const bool valid = (c > 0) || (s >= LEAD);
            float a = p.a_b[l * 256 + hd * 64 + j];
#pragma unroll
            for (int q = 0; q < 16; ++q) a += cod[s * 16 + q] * p.a_w2[(l * 16 + q) * 256 + hd * 64 + j];
            bs[s * 65 + j] = valid ? logsig(a) * (1.f / 16.f) : 0.f; }
        for (int i = tid; i < 64 * 128; i += 256) { const int s = i >> 7, d = i & 127; const bool valid = (c > 0) || (s >= LEAD);
            vs[s * 129 + d] = valid ? bf2f(z[(size_t)(r0 + s) * NIN + ZO_VG + hd * 128 + d]) : 0.f; }
        __syncthreads();
        if (tid < 64) { float run = 0.f; for (int s = 0; s < 64; ++s) { run += bs[s * 65 + tid]; bs[s * 65 + tid] = run; } }
        __syncthreads();
        for (int i = tid; i < 64 * 64; i += 256) { const int s = i >> 6, j = i & 63; const bool valid = (c > 0) || (s >= LEAD); const size_t zr = (size_t)(r0 + s) * NIN;
            qt[s * 65 + j] = valid ? bf2f(z[zr + ZO_QG + hd * 64 + j]) * 0.125f * __expf(bs[s * 65 + j]) : 0.f;
            kt[s * 65 + j] = valid ? bf2f(z[zr + ZO_KG + hd * 64 + j]) * __expf(-bs[s * 65 + j]) : 0.f; }
        __syncthreads();
        for (int i = tid; i < 4096; i += 256) { const int t = i >> 6, s = i & 63; float a = 0.f;
            if (s <= t) for (int j = 0; j < 64; ++j) a += qt[t * 65 + j] * kt[s * 65 + j];
            As[t * 65 + s] = a; }
        __syncthreads();
        { const int d = tid & 127; const bf16_t* Sr = p.GS() + (size_t)u * 8192 + d * 64;
          for (int i = 0; i < 32; ++i) { const int t = (tid >> 7) + 2 * i; float a = 0.f;
              for (int s = 0; s < 64; ++s) a += As[t * 65 + s] * vs[s * 129 + d];
              for (int j = 0; j < 64; ++j) a += qt[t * 65 + j] * bf2f(Sr[j]);
              ob[t * 129 + d] = a; } }
        __syncthreads();
        if (tid < 64) { float s2 = 0.f; for (int d = 0; d < 128; ++d) { const float x = ob[tid * 129 + d]; s2 += x * x; } hn[tid] = rsqrtf(s2 * (1.f / 128.f) + EPS); }
        __syncthreads();
        for (int i = tid; i < 64 * 128; i += 256) { const int s = i >> 7, d = i & 127; const bool valid = (c > 0) || (s >= LEAD);
            bf16_t* q = z + (size_t)(r0 + s) * NIN + ZO_GG + hd * 128 + d;
            const float y = ob[s * 129 + d] * hn[s] * p.g_norm_g[l * 512 + hd * 128 + d] * silu(bf2f(*q));
            *q = f2bf(valid ? y : 0.f); }
    }
}
__global__ void __launch_bounds__(256) k_route_ref(P p, int l) {
    __shared__ float lg[4][40];
    const int w = threadIdx.x >> 6, lane = threadIdx.x & 63, r = blockIdx.x * 4 + w;
    int* tokE = p.TokE(); float* tokW = p.TokW();
    if ((r % TP) < LEAD) { if (lane == 0) { tokE[r * 2] = -1; tokE[r * 2 + 1] = -1; tokW[r * 2] = 0.f; tokW[r * 2 + 1] = 0.f; } return; }
    const float rs = row_rs(p.SS2(), r); float xv[16];
#pragma unroll
    for (int i = 0; i < 16; ++i) xv[i] = bf2f(p.H()[(size_t)r * D + lane * 16 + i]) * rs;
    const float* W = p.Wr() + (size_t)l * NR * D;
    for (int o = 0; o < 36; ++o) { float a = 0.f;
#pragma unroll
        for (int i = 0; i < 16; ++i) a += xv[i] * W[o * D + lane * 16 + i];
        a = wave_sum(a); if (lane == 0) lg[w][o] = a + (o < 4 ? p.br_g[l * 4 + o] : p.br_e[l * 32 + o - 4]); }
    if (lane == 0) {
        int g = 0; float gm = lg[w][0];
        for (int i = 1; i < 4; ++i) if (lg[w][i] > gm) { gm = lg[w][i]; g = i; }
        float se = 0.f; for (int i = 0; i < 4; ++i) se += __expf(lg[w][i] - gm);
        const float psel = 1.f / se;
        int i0 = 0; float v0 = lg[w][4 + g * 8];
        for (int i = 1; i < 8; ++i) if (lg[w][4 + g * 8 + i] > v0) { v0 = lg[w][4 + g * 8 + i]; i0 = i; }
        int i1 = -1; float v1 = -INFINITY;
        for (int i = 0; i < 8; ++i) if (i != i0 && lg[w][4 + g * 8 + i] > v1) { v1 = lg[w][4 + g * 8 + i]; i1 = i; }
        const float w0 = 1.f / (1.f + __expf(v1 - v0));
        tokE[r * 2] = g * 8 + i0; tokE[r * 2 + 1] = g * 8 + i1; tokW[r * 2] = w0 * psel; tokW[r * 2 + 1] = (1.f - w0) * psel;
    }
}
__global__ void __launch_bounds__(256) k_moe_ref(P p, int l) {
    __shared__ float xn[1024], pre[512], hid[256], outv[1024], red[4];
    const int r = blockIdx.x, tid = threadIdx.x, w = tid >> 6, lane = tid & 63;
    if ((r % TP) < LEAD) return;
    const float rs = row_rs(p.SS2(), r); bf16_t* hr = p.H() + (size_t)r * D;
    for (int i = tid; i < D; i += 256) { xn[i] = bf2f(hr[i]) * rs; outv[i] = 0.f; }
    __syncthreads();
    for (int rank = 0; rank < 2; ++rank) {
        const int e = p.TokE()[r * 2 + rank]; const float gw = p.TokW()[r * 2 + rank];
        const bf16_t* Wg = p.Wgu() + ((size_t)(l * NE + e) * 512) * D;
        for (int row = w; row < 512; row += 4) { float a = 0.f;
            for (int k = lane; k < D; k += 64) a += bf2f(Wg[(size_t)row * D + k]) * xn[k];
            a = wave_sum(a); if (lane == 0) pre[row] = a; }
        __syncthreads();
        { const int j = tid, gq = j >> 4, i = j & 15; hid[j] = silu(pre[32 * gq + i]) * pre[32 * gq + 16 + i]; }
        __syncthreads();
        const bf16_t* Wd = p.Wd() + ((size_t)(l * NE + e) * D) * DE;
        for (int n = w; n < D; n += 4) { float a = 0.f;
            for (int k = lane; k < DE; k += 64) a += bf2f(Wd[(size_t)n * DE + k]) * hid[k];
            a = wave_sum(a); if (lane == 0) outv[n] += gw * a; }
        __syncthreads();
    }
    float s = 0.f;
    for (int i = tid; i < D; i += 256) { const float v = bf2f(hr[i]) + outv[i]; hr[i] = f2bf(v); s += v * v; }
    s = wave_sum(s); if (lane == 0) red[w] = s;
    __syncthreads();
    if (tid == 0) { float* q = p.SS1() + (size_t)r * 4; q[0] = red[0] + red[1] + red[2] + red[3]; q[1] = 0.f; q[2] = 0.f; q[3] = 0.f; }
}
__global__ void __launch_bounds__(256) k_final_ref(P p) {
    const int t = blockIdx.x * 4 + (threadIdx.x >> 6), lane = threadIdx.x & 63, b = t / SEQ, s = t % SEQ, r = b * TP + 64 + s;
    const float rs = row_rs(p.SS1(), r); const bf16_t* hr = p.H() + (size_t)r * D; float* o = p.out + (size_t)t * D;
#pragma unroll
    for (int j = 0; j < 4; ++j) { const ushort4 hv = ((const ushort4*)hr)[lane + 64 * j]; const f32x4 g = ((const f32x4*)p.final_g)[lane + 64 * j];
        f32x4 v; v.x = bf2f(hv.x) * rs * g.x; v.y = bf2f(hv.y) * rs * g.y; v.z = bf2f(hv.z) * rs * g.z; v.w = bf2f(hv.w) * rs * g.w;
        ((f32x4*)o)[lane + 64 * j] = v; }
}

#define LAS __attribute__((address_space(3)))
constexpr int NWAVES = 8, NTHR = 512;
constexpr int RING_OFF = 0, RING_BYTES = 131072, TAB_OFF = 131072, TAB_BYTES = 24576, MISC_OFF = TAB_OFF + TAB_BYTES, LDS_BYTES = MISC_OFF + 512;
constexpr int RED_OFF = TAB_OFF + 4096;
constexpr int UROW_OFF = TAB_OFF + 8192;
constexpr int CW_BAR = 4096, CW_CNT = 16384;
constexpr int PH_PRO = 0, PH_LAYER0 = 1, PH_PER_LAYER = 9, PH_FINAL = 1 + 9 * DEPTH, PH_COUNT = PH_FINAL + 1;

#define XB_TMO      128
#define XB_XCNT(j)  (256  + 64 * (j))
#define XB_XSUB(j)  (1280 + 64 * (j))
#define XB_XGEN(j)  (2304 + 64 * (j))
#define XB_TOP      3328
#define XB_TOPGEN   3392
#define XCD_BAR_WORDS 3456
#define XB_SPIN_CAP (1u << 18)
__device__ __forceinline__ unsigned xb_ld(unsigned* p)              { return __hip_atomic_load(p, __ATOMIC_RELAXED, __HIP_MEMORY_SCOPE_AGENT); }
__device__ __forceinline__ unsigned xb_add(unsigned* p, unsigned v) { return __hip_atomic_fetch_add(p, v, __ATOMIC_RELAXED, __HIP_MEMORY_SCOPE_AGENT); }
__device__ __forceinline__ unsigned xb_xcc_id() { return (unsigned)__builtin_amdgcn_s_getreg((3 << 11) | 20) & 0xFu; }
#define XB_SPIN(cond, bar) do { unsigned _sp = 0; while (cond) { __builtin_amdgcn_s_sleep(1); \
    if ((++_sp & 255u) == 0u) { if (xb_ld(&(bar)[XB_TMO])) break; if (_sp > XB_SPIN_CAP) { atomicAdd(&(bar)[XB_TMO], 1u); break; } } } } while (0)
struct XcdBarrier { unsigned* bar; unsigned x; volatile LAS unsigned* st; };
__device__ __forceinline__ XcdBarrier xcd_barrier_post(unsigned* bar, volatile LAS unsigned* st) {
    XcdBarrier b; b.bar = bar; b.x = xb_xcc_id(); b.st = st;
    if (threadIdx.x == 0) (void)xb_add(&bar[XB_XCNT(b.x)], 1u);
    return b;
}
__device__ __forceinline__ void xcd_barrier_complete(unsigned* bar, unsigned x, unsigned& nloc, unsigned& nx) {
    const unsigned G = gridDim.x * gridDim.y * gridDim.z;
    unsigned sum, cnt, mine, sp = 0u;
    for (;;) {
        sum = 0u; cnt = 0u; mine = 0u;
#pragma unroll
        for (unsigned j = 0; j < 16; ++j) { const unsigned c = xb_ld(&bar[XB_XCNT(j)]); sum += c; cnt += (c > 0u) ? 1u : 0u; mine = (j == x) ? c : mine; }
        if (sum == G) break;
        __builtin_amdgcn_s_sleep(1);
        if ((++sp & 255u) == 0u) { if (xb_ld(&bar[XB_TMO])) break; if (sp > XB_SPIN_CAP) { atomicAdd(&bar[XB_TMO], 1u); break; } }
    }
    nloc = mine > 0u ? mine : 1u; nx = cnt > 0u ? cnt : 1u;
}
__device__ __forceinline__ void xcd_barrier(const XcdBarrier& b) {
    asm volatile("s_waitcnt vmcnt(0)" ::: "memory");
    __syncthreads();
    if (threadIdx.x == 0) {
        unsigned* bar = b.bar;
        __builtin_amdgcn_s_waitcnt(0);
        unsigned nloc = b.st[0], nx = b.st[1];
        if (nloc == 0u) { xcd_barrier_complete(bar, b.x, nloc, nx); b.st[0] = nloc; b.st[1] = nx; }
        const unsigned old = xb_add(&bar[XB_XSUB(b.x)], 1u);
        const unsigned gen = old / nloc;
        if (old + 1u == (gen + 1u) * nloc) {
            __builtin_amdgcn_fence(__ATOMIC_RELEASE, "agent");
            asm volatile("s_waitcnt vmcnt(0)" ::: "memory");
            const unsigned og = xb_add(&bar[XB_TOP], 1u);
            const unsigned tg = og / nx;
            if (og + 1u == (tg + 1u) * nx) xb_add(&bar[XB_TOPGEN], 1u);
            else XB_SPIN(xb_ld(&bar[XB_TOPGEN]) == tg, bar);
            __builtin_amdgcn_fence(__ATOMIC_ACQUIRE, "agent");
            xb_add(&bar[XB_XGEN(b.x)], 1u);
            asm volatile("s_waitcnt vmcnt(0)" ::: "memory");
        } else {
            XB_SPIN(xb_ld(&bar[XB_XGEN(b.x)]) == gen, bar);
            __builtin_amdgcn_fence(__ATOMIC_ACQUIRE, "agent");
            asm volatile("s_waitcnt vmcnt(0)" ::: "memory");
        }
    }
    __syncthreads();
}

namespace pg8 {
typedef short bf16x8 __attribute__((ext_vector_type(8)));
typedef unsigned u32x4 __attribute__((ext_vector_type(4)));
typedef unsigned u32x2 __attribute__((ext_vector_type(2)));
constexpr int BM = 256, BK = 64, HALF = 128, HTB = HALF * BK * 2, STAGE_BYTES = 8 * HTB, NXCD = 8, WGM = 8;
__host__ __device__ __forceinline__ int lds_byte(int r, int c) { const int st = (r >> 4) * 2 + (c >> 5), rr = r & 15, cc = c & 31, ob = rr * 64 + cc * 2; return st * 1024 + (ob ^ (((ob >> 9) & 1) << 5)); }
__host__ __device__ __forceinline__ void stage_rc(int b, int& R, int& C) { const int st = b / 1024, sb = b % 1024, swz = sb ^ (((sb >> 9) & 1) << 5); R = (st >> 1) * 16 + swz / 64; C = (st & 1) * 32 + (swz % 64) / 2; }
__host__ __device__ __forceinline__ int perm32(int rho) { const int n = rho >> 4, i = rho & 15; return 8 * (i >> 2) + 4 * n + (i & 3); }
__device__ __forceinline__ unsigned cvt_pk_bf16(float lo, float hi) { unsigned r; asm volatile("v_cvt_pk_bf16_f32 %0, %1, %2" : "=v"(r) : "v"(lo), "v"(hi)); return r; }
__device__ __forceinline__ float bflo(unsigned w) { return __uint_as_float(w << 16); }
__device__ __forceinline__ float bfhi(unsigned w) { return __uint_as_float(w & 0xffff0000u); }

struct Unit { int pm, pn; unsigned ao, bo; };

__device__ __forceinline__ int xcd_remap(int L, int nwg) { const int q = nwg / NXCD, r = nwg % NXCD, xcd = L % NXCD, off = L / NXCD; return (xcd < r ? xcd * (q + 1) : r * (q + 1) + (xcd - r) * q) + off; }

template <int LDA, int K> struct DenseOrder {
    static constexpr bool GATHER = false, LIST = false;
    int nM, nN, nwg, G, c;
    __device__ __forceinline__ void init(int M, int N, int G_, int c_) { nM = M / BM; nN = N / BM; nwg = nM * nN; G = G_; c = c_; }
    __device__ __forceinline__ bool next(int i, Unit& u, int, int) const {
        const int L = i * G + c; if (L >= nwg) return false;
        const int wgid = xcd_remap(L, nwg);
        const int nig = WGM * nN, gid = wgid / nig, fm = gid * WGM, gsz = (nM - fm) < WGM ? (nM - fm) : WGM;
        u.pm = fm + ((wgid % nig) % gsz); u.pn = (wgid % nig) / gsz; u.ao = (unsigned)u.pm * (unsigned)(BM * LDA * 2); u.bo = (unsigned)u.pn * (unsigned)(BM * K * 2); return true;
    }
    __device__ __forceinline__ unsigned aoff(int, int rowl, int C) const { return (unsigned)(rowl * LDA + C) * 2u; }
};

template <class Epi, class Sched, bool ALIGN_EPI, int LDA, int K>
__device__ __forceinline__ void gemm_phase(LAS unsigned char* lds, const char* Abase, const char* Bbase, const Sched& S, const Epi& E) {
    int tid_ = threadIdx.x; asm volatile("" : "+v"(tid_));
    const int tid = tid_, wid = __builtin_amdgcn_readfirstlane(tid >> 6), lane = tid & 63, wr = wid >> 2, wc = wid & 3, fr = lane & 15, fq = lane >> 4;
    constexpr int nt = K / BK;
    int Rr[2], Cc[2]; unsigned voffB[2];
#pragma unroll
    for (int i = 0; i < 2; ++i) { stage_rc(tid * 16 + i * 8192, Rr[i], Cc[i]); const int Rb = Epi::PERM ? ((Rr[i] & ~31) + perm32(Rr[i] & 31)) : Rr[i]; voffB[i] = (unsigned)(Rb * K + Cc[i]) * 2u; }
    constexpr unsigned kstep = BK * 2, hstepB = HALF * K * 2;
    const unsigned ldsw = (unsigned)wid * 1024u;
    const int aoff = lds_byte(wr * 64 + fr, fq * 8), boff = lds_byte(wc * 32 + fr, fq * 8);
#define PG8_SA(b, h) (((b) * 2 + (h)) * HTB)
#define PG8_SB(b, h) ((4 + (b) * 2 + (h)) * HTB)
#define PG8_STAGE(bufoff, gbase, uoff, voff) do { _Pragma("unroll") for (int _i = 0; _i < 2; ++_i) \
        __builtin_amdgcn_global_load_lds((const unsigned*)((gbase) + (size_t)(unsigned)((uoff) + (voff)[_i])), (LAS unsigned*)(lds + (bufoff) + ldsw + _i * 8192), 16, 0, 0); } while (0)
#define PG8_LDA(dst, b, h) do { _Pragma("unroll") for (int m = 0; m < 4; ++m) _Pragma("unroll") for (int k = 0; k < 2; ++k) dst[m][k] = *(const LAS bf16x8*)(lds + PG8_SA(b, h) + aoff + m * 2048 + k * 1024); } while (0)
#define PG8_LDB(dst, b, h) do { _Pragma("unroll") for (int n = 0; n < 2; ++n) _Pragma("unroll") for (int k = 0; k < 2; ++k) dst[n][k] = *(const LAS bf16x8*)(lds + PG8_SB(b, h) + boff + n * 2048 + k * 1024); } while (0)
#define PG8_MMA(ai, bj, At, Bt) do { __builtin_amdgcn_s_setprio(1); _Pragma("unroll") for (int m = 0; m < 4; ++m) _Pragma("unroll") for (int n = 0; n < 2; ++n) _Pragma("unroll") for (int k = 0; k < 2; ++k) \
        acc[ai][bj][m][n] = __builtin_amdgcn_mfma_f32_16x16x32_bf16(Bt[n][k], At[m][k], acc[ai][bj][m][n], 0, 0, 0); __builtin_amdgcn_s_setprio(0); } while (0)
#define PG8_WAIT_V(n) asm volatile("s_waitcnt vmcnt(" #n ")" ::: "memory")
#define PG8_WAIT_L(n) asm volatile("s_waitcnt lgkmcnt(" #n ")" ::: "memory")
#define PG8_BAR __builtin_amdgcn_s_barrier()
#define PG8_SCHED __builtin_amdgcn_sched_barrier(0)
    Unit cur, nxt; int ui = 0, ub = 0;
    if (!S.next(0, cur, 0, tid)) return;
    if constexpr (Sched::LIST) { asm volatile("s_waitcnt lgkmcnt(0)" ::: "memory"); __builtin_amdgcn_s_barrier(); asm volatile("" ::: "memory"); }
    unsigned voffA[2][2];
#pragma unroll
    for (int h = 0; h < 2; ++h)
#pragma unroll
        for (int i = 0; i < 2; ++i) voffA[h][i] = S.aoff(0, h * HALF + Rr[i], Cc[i]);
    f32x4 acc[2][2][4][2];
#pragma unroll
    for (int a = 0; a < 2; ++a)
#pragma unroll
        for (int b = 0; b < 2; ++b)
#pragma unroll
            for (int m = 0; m < 4; ++m)
#pragma unroll
                for (int n = 0; n < 2; ++n) acc[a][b][m][n] = (f32x4){0.f, 0.f, 0.f, 0.f};
    bf16x8 At[4][2], B0[2][2], B1[2][2];
    unsigned cA = cur.ao, cB = cur.bo;
    PG8_STAGE(PG8_SB(0, 0), Bbase, cB, voffB); PG8_STAGE(PG8_SB(0, 1), Bbase, cB + hstepB, voffB); PG8_STAGE(PG8_SA(0, 0), Abase, cA, voffA[0]); PG8_STAGE(PG8_SA(0, 1), Abase, cA, voffA[1]);
    if (wr == 1) PG8_BAR;
    PG8_WAIT_V(2); PG8_BAR;
    PG8_STAGE(PG8_SB(1, 0), Bbase, cB + kstep, voffB); PG8_STAGE(PG8_SA(1, 0), Abase, cA + kstep, voffA[0]); PG8_STAGE(PG8_SB(1, 1), Bbase, cB + hstepB + kstep, voffB);
    PG8_WAIT_V(6); PG8_BAR;
    for (;;) {
        const int nub = (ub == 2) ? 0 : ub + 1;
        const bool has_next = S.next(ui + 1, nxt, nub, tid);
        const unsigned nA = has_next ? nxt.ao : cA, nB = has_next ? nxt.bo : cB;
#pragma unroll 1
        for (int t = 0; t < nt; t += 2) {
            const bool last = (t == nt - 2);
            const unsigned a1 = cA + (unsigned)(t + 1) * kstep;
            const unsigned a2 = last ? nA : cA + (unsigned)(t + 2) * kstep, b2 = last ? nB : cB + (unsigned)(t + 2) * kstep;
            const unsigned a3 = a2 + kstep, b3 = b2 + kstep;
            PG8_LDB(B0, 0, 0); PG8_LDB(B1, 0, 1); PG8_SCHED; PG8_LDA(At, 0, 0); PG8_STAGE(PG8_SA(1, 1), Abase, a1, voffA[1]);
            if constexpr (Sched::GATHER) { if (last && has_next) {
#pragma unroll
                for (int h = 0; h < 2; ++h)
#pragma unroll
                    for (int i = 0; i < 2; ++i) voffA[h][i] = S.aoff(nub, h * HALF + Rr[i], Cc[i]); } }
            PG8_WAIT_V(8); PG8_WAIT_L(0); PG8_BAR; PG8_MMA(0, 0, At, B0); PG8_MMA(0, 1, At, B1); PG8_BAR; PG8_SCHED;
            PG8_LDA(At, 0, 1); PG8_STAGE(PG8_SB(0, 0), Bbase, b2, voffB); PG8_STAGE(PG8_SB(0, 1), Bbase, b2 + hstepB, voffB); PG8_STAGE(PG8_SA(0, 0), Abase, a2, voffA[0]);
            PG8_WAIT_V(8); PG8_WAIT_L(0); PG8_BAR; PG8_MMA(1, 0, At, B0); PG8_MMA(1, 1, At, B1); PG8_BAR; PG8_SCHED;
            PG8_LDB(B0, 1, 0); PG8_LDB(B1, 1, 1); PG8_SCHED; PG8_LDA(At, 1, 0); PG8_STAGE(PG8_SA(0, 1), Abase, a2, voffA[1]);
            PG8_WAIT_V(8); PG8_WAIT_L(0); PG8_BAR; PG8_MMA(0, 0, At, B0); PG8_MMA(0, 1, At, B1); PG8_BAR; PG8_SCHED;
            PG8_LDA(At, 1, 1); PG8_STAGE(PG8_SB(1, 0), Bbase, b3, voffB); PG8_STAGE(PG8_SB(1, 1), Bbase, b3 + hstepB, voffB); PG8_STAGE(PG8_SA(1, 0), Abase, a3, voffA[0]);
            PG8_WAIT_V(8); PG8_WAIT_L(0); PG8_BAR; PG8_MMA(1, 0, At, B0); PG8_MMA(1, 1, At, B1); PG8_BAR; PG8_SCHED;
        }
        if constexpr (ALIGN_EPI) { if (wr == 0) PG8_BAR; }
        E(acc, cur, wr, wc, fr, fq, tid, ub);
        if (!has_next) break;
#pragma unroll
        for (int a = 0; a < 2; ++a)
#pragma unroll
            for (int b = 0; b < 2; ++b)
#pragma unroll
                for (int m = 0; m < 4; ++m)
#pragma unroll
                    for (int n = 0; n < 2; ++n) acc[a][b][m][n] = (f32x4){0.f, 0.f, 0.f, 0.f};
        cur = nxt; cA = nA; cB = nB; ++ui; ub = nub;
        if constexpr (ALIGN_EPI) { if (wr == 1) PG8_BAR; }
    }
    PG8_WAIT_V(0);
    if constexpr (!ALIGN_EPI) { if (wr == 0) PG8_BAR; }
    PG8_BAR;
#undef PG8_SA
#undef PG8_SB
#undef PG8_STAGE
#undef PG8_LDA
#undef PG8_LDB
#undef PG8_MMA
#undef PG8_WAIT_V
#undef PG8_WAIT_L
#undef PG8_BAR
#undef PG8_SCHED
}

struct EpiZ {
    static constexpr bool PERM = true;
    unsigned char* ws;
    __device__ __forceinline__ void operator()(const f32x4 (&acc)[2][2][4][2], const Unit& u, int wr, int wc, int fr, int fq, int, int) const {
        const int row0 = u.pm * BM + wr * 64 + fr, col0 = u.pn * BM + wc * 32 + 8 * fq;
        bf16_t* z = (bf16_t*)(ws + WS_Z); const float* ss = (const float*)(ws + WS_SS1);
#pragma unroll
        for (int ai = 0; ai < 2; ++ai)
#pragma unroll
            for (int m = 0; m < 4; ++m) { const int row = row0 + ai * HALF + m * 16; const float rs = row_rs(ss, row); bf16_t* rowp = z + (size_t)row * NIN + col0;
#pragma unroll
                for (int bj = 0; bj < 2; ++bj) if (col0 + bj * HALF < NIN) { const f32x4 v0 = acc[ai][bj][m][0] * rs, v1 = acc[ai][bj][m][1] * rs;
                    u32x4 w; w.x = cvt_pk_bf16(v0[0], v0[1]); w.y = cvt_pk_bf16(v0[2], v0[3]); w.z = cvt_pk_bf16(v1[0], v1[1]); w.w = cvt_pk_bf16(v1[2], v1[3]);
                    *(u32x4*)(rowp + bj * HALF) = w; } }
    }
};
template <bool LIST, bool STATS, size_t SS_OFF> struct EpiRes {
    static constexpr bool PERM = true;
    unsigned char* ws; LAS unsigned char* lds;
    __device__ __forceinline__ void operator()(const f32x4 (&acc)[2][2][4][2], const Unit& u, int wr, int wc, int fr, int fq, int tid, int ub) const {
        const int col0 = u.pn * BM + wc * 32 + 8 * fq;
        bf16_t* h = (bf16_t*)(ws + WS_H); float* ss = (float*)(ws + SS_OFF); LAS float* red = (LAS float*)(lds + RED_OFF); const LAS int* utok = (const LAS int*)(lds + UROW_OFF);
#pragma unroll
        for (int ai = 0; ai < 2; ++ai)
#pragma unroll
            for (int m = 0; m < 4; ++m) { const int rowl = ai * HALF + wr * 64 + m * 16 + fr; int row; bool valid = true;
                if constexpr (LIST) { row = utok[ub * 256 + rowl]; valid = row >= 0; } else row = u.pm * BM + rowl;
                float s = 0.f;
                if (valid) { bf16_t* hp = h + (size_t)row * D + col0;
#pragma unroll
                    for (int bj = 0; bj < 2; ++bj) { const u32x4 o = *(const u32x4*)(hp + bj * HALF); const f32x4 a0 = acc[ai][bj][m][0], a1 = acc[ai][bj][m][1];
                        const float v0 = bflo(o.x) + a0[0], v1 = bfhi(o.x) + a0[1], v2 = bflo(o.y) + a0[2], v3 = bfhi(o.y) + a0[3], v4 = bflo(o.z) + a1[0], v5 = bfhi(o.z) + a1[1], v6 = bflo(o.w) + a1[2], v7 = bfhi(o.w) + a1[3];
                        s += (v0 * v0 + v1 * v1) + (v2 * v2 + v3 * v3) + (v4 * v4 + v5 * v5) + (v6 * v6 + v7 * v7);
                        u32x4 w; w.x = cvt_pk_bf16(v0, v1); w.y = cvt_pk_bf16(v2, v3); w.z = cvt_pk_bf16(v4, v5); w.w = cvt_pk_bf16(v6, v7);
                        *(u32x4*)(hp + bj * HALF) = w; } }
                if constexpr (STATS) { s += __shfl_xor(s, 16); s += __shfl_xor(s, 32); if (fq == 0) red[rowl * 4 + wc] = s; }
                asm volatile("" ::: "memory"); }
        if constexpr (STATS) {
            asm volatile("s_waitcnt lgkmcnt(0)" ::: "memory"); __builtin_amdgcn_s_barrier(); asm volatile("" ::: "memory");
            if (tid < BM) { const f32x4 v = *(const LAS f32x4*)(red + tid * 4); int row; bool valid = true;
                if constexpr (LIST) { row = utok[ub * 256 + tid]; valid = row >= 0; } else row = u.pm * BM + tid;
                if (valid) ss[(size_t)row * 4 + u.pn] = (v.x + v.y) + (v.z + v.w); }
        }
    }
};
struct EpiUp {
    static constexpr bool PERM = false;
    unsigned char* ws; LAS unsigned char* lds;
    __device__ __forceinline__ void operator()(const f32x4 (&acc)[2][2][4][2], const Unit& u, int wr, int wc, int fr, int fq, int, int ub) const {
        const int col0 = u.pn * 128 + wc * 16 + 4 * fq;
        bf16_t* hid = (bf16_t*)(ws + WS_HID); const LAS float* urs = (const LAS float*)(lds + UROW_OFF) + 768;
#pragma unroll
        for (int ai = 0; ai < 2; ++ai)
#pragma unroll
            for (int m = 0; m < 4; ++m) { const int rowl = ai * HALF + wr * 64 + m * 16 + fr;
                const float rs = urs[ub * 256 + rowl], gw = urs[768 + ub * 256 + rowl];
                bf16_t* hp = hid + ((size_t)u.pm * BM + rowl) * DE + col0;
#pragma unroll
                for (int bj = 0; bj < 2; ++bj) { const f32x4 g = acc[ai][bj][m][0] * rs, up = acc[ai][bj][m][1] * rs; float o[4];
#pragma unroll
                    for (int j = 0; j < 4; ++j) o[j] = g[j] / (1.f + __expf(-g[j])) * up[j] * gw;
                    u32x2 w; w.x = cvt_pk_bf16(o[0], o[1]); w.y = cvt_pk_bf16(o[2], o[3]); *(u32x2*)(hp + bj * 64) = w; } }
    }
};
}

struct MoeTab { int cnt[64]; int rb0[65]; int pad[3]; unsigned short li[NBMAX]; unsigned short blk[NBMAX]; };
static_assert(sizeof(MoeTab) <= 4096, "MoeTab fits below RED_OFF");
__device__ __forceinline__ void moe_build_tab(LAS MoeTab* T, unsigned* gcnt) {
    const int tid = threadIdx.x;
    if (tid < 64) T->cnt[tid] = (int)__hip_atomic_load(gcnt + tid * 16, __ATOMIC_RELAXED, __HIP_MEMORY_SCOPE_AGENT);
    __syncthreads();
    if (tid == 0) { int run = 0; for (int i = 0; i < 64; ++i) { T->rb0[i] = run; run += (T->cnt[i] + 255) >> 8; } T->rb0[64] = run; }
    __syncthreads();
    if (tid < 64) { const int b0 = T->rb0[tid], nb = T->rb0[tid + 1] - b0;
#pragma clang loop vectorize(disable) unroll(disable)
        for (int b = 0; b < nb; ++b) { T->li[b0 + b] = (unsigned short)tid; T->blk[b0 + b] = (unsigned short)b; } }
    __syncthreads();
}
template <bool GATHER_, int NN, int LDA, int K, unsigned ESTEP> struct MoeOrder {
    static constexpr bool GATHER = GATHER_, LIST = true;
    LAS unsigned char* lds; unsigned char* ws; int rbLo, nwg, G, c;
    __device__ __forceinline__ bool next(int i, pg8::Unit& u, int ub, int tid) const {
        const int L = i * G + c; if (L >= nwg) return false;
        const LAS MoeTab* T = (const LAS MoeTab*)(lds + TAB_OFF); LAS int* urow = (LAS int*)(lds + UROW_OFF);
        const int wgid = pg8::xcd_remap(L, nwg), rb = rbLo + wgid / NN;
        const int li = T->li[rb], blk = T->blk[rb], cnt = T->cnt[li];
        u.pm = rb; u.pn = wgid % NN; u.ao = GATHER ? 0u : (unsigned)rb * (unsigned)(256 * LDA * 2); u.bo = (unsigned)(li & 31) * ESTEP + (unsigned)u.pn * (unsigned)(256 * K * 2);
        if (tid < 256) { const int slot = blk * 256 + tid; const bool valid = slot < cnt; const size_t idx = (size_t)li * CAPL + slot;
            urow[ub * 256 + tid] = valid ? ((const int*)(ws + WS_LTOK))[idx] : -1;
            if constexpr (GATHER) { ((LAS float*)urow)[768 + ub * 256 + tid] = valid ? ((const float*)(ws + WS_LRS))[idx] : 0.f; ((LAS float*)urow)[1536 + ub * 256 + tid] = valid ? ((const float*)(ws + WS_LW))[idx] : 0.f; } }
        return true;
    }
    __device__ __forceinline__ unsigned aoff(int ub, int rowl, int C) const {
        if constexpr (GATHER) { const int tok = ((const LAS int*)(lds + UROW_OFF))[ub * 256 + rowl]; return (unsigned)((tok < 0 ? 0 : tok) * LDA + C) * 2u; }
        else return (unsigned)(rowl * LDA + C) * 2u;
    }
};

__device__ __forceinline__ void route_phase(const P& p, int l, LAS unsigned char* lds, int G, int bid, unsigned* gcnt) {
    int tid_ = threadIdx.x; asm volatile("" : "+v"(tid_));
    const int tid = tid_, w = tid >> 6, lane = tid & 63;
    const int per = (MP + G - 1) / G, r0 = bid * per, nrows = (r0 + per <= MP) ? per : (MP - r0 > 0 ? MP - r0 : 0);
    LAS float* lg = (LAS float*)lds;
    LAS int* lcnt = (LAS int*)(lds + 2048);
    LAS int* lbase = (LAS int*)(lds + 2048 + 256);
    LAS int* rli = (LAS int*)(lds + 4096);
    LAS int* rpos = rli + 2 * 1056;
    LAS float* rw = (LAS float*)(rpos + 2 * 1056);
    LAS float* rrs = rw + 2 * 1056;
    if (tid < 64) lcnt[tid] = 0;
    __syncthreads();
    const float* W = p.Wr() + (size_t)l * NR * D;
    for (int i = w; i < nrows; i += NWAVES) {
        const int r = r0 + i;
        if ((r % TP) < LEAD) { if (lane == 0) { rli[2 * i] = -1; rli[2 * i + 1] = -1; } continue; }
        const float rs = row_rs(p.SS2(), r); float xv[16];
        { const pg8::u32x4 a = *(const pg8::u32x4*)(p.H() + (size_t)r * D + lane * 16), b = *(const pg8::u32x4*)(p.H() + (size_t)r * D + lane * 16 + 8);
          xv[0] = pg8::bflo(a.x); xv[1] = pg8::bfhi(a.x); xv[2] = pg8::bflo(a.y); xv[3] = pg8::bfhi(a.y); xv[4] = pg8::bflo(a.z); xv[5] = pg8::bfhi(a.z); xv[6] = pg8::bflo(a.w); xv[7] = pg8::bfhi(a.w);
          xv[8] = pg8::bflo(b.x); xv[9] = pg8::bfhi(b.x); xv[10] = pg8::bflo(b.y); xv[11] = pg8::bfhi(b.y); xv[12] = pg8::bflo(b.z); xv[13] = pg8::bfhi(b.z); xv[14] = pg8::bflo(b.w); xv[15] = pg8::bfhi(b.w); }
#pragma unroll
        for (int j = 0; j < 16; ++j) xv[j] *= rs;
        for (int o = 0; o < 36; ++o) { const f32x4* wp = (const f32x4*)(W + o * D + lane * 16); float a = 0.f;
#pragma unroll
            for (int q = 0; q < 4; ++q) { const f32x4 wv = wp[q]; a += xv[4 * q] * wv.x + xv[4 * q + 1] * wv.y + xv[4 * q + 2] * wv.z + xv[4 * q + 3] * wv.w; }
            a = wave_sum(a); if (lane == 0) lg[w * 40 + o] = a + (o < 4 ? p.br_g[l * 4 + o] : p.br_e[l * 32 + o - 4]); }
        if (lane == 0) {
            const LAS float* q = lg + w * 40;
            int g = 0; float gm = q[0];
            for (int j = 1; j < 4; ++j) if (q[j] > gm) { gm = q[j]; g = j; }
            float se = 0.f; for (int j = 0; j < 4; ++j) se += __expf(q[j] - gm);
            const float psel = 1.f / se;
            int i0 = 0; float v0 = q[4 + g * 8];
            for (int j = 1; j < 8; ++j) if (q[4 + g * 8 + j] > v0) { v0 = q[4 + g * 8 + j]; i0 = j; }
            int i1 = -1; float v1 = -INFINITY;
            for (int j = 0; j < 8; ++j) if (j != i0 && q[4 + g * 8 + j] > v1) { v1 = q[4 + g * 8 + j]; i1 = j; }
            const float w0 = 1.f / (1.f + __expf(v1 - v0));
            const int li0 = g * 8 + i0, li1 = 32 + g * 8 + i1;
            rli[2 * i] = li0; rli[2 * i + 1] = li1; rw[2 * i] = w0 * psel; rw[2 * i + 1] = (1.f - w0) * psel; rrs[i] = rs;
            rpos[2 * i] = __hip_atomic_fetch_add(&lcnt[li0], 1, __ATOMIC_RELAXED, __HIP_MEMORY_SCOPE_WORKGROUP); rpos[2 * i + 1] = __hip_atomic_fetch_add(&lcnt[li1], 1, __ATOMIC_RELAXED, __HIP_MEMORY_SCOPE_WORKGROUP);
        }
    }
    __syncthreads();
    if (tid < 64) { const int n = lcnt[tid]; lbase[tid] = n ? (int)__hip_atomic_fetch_add(gcnt + tid * 16, (unsigned)n, __ATOMIC_RELAXED, __HIP_MEMORY_SCOPE_AGENT) : 0; }
    __syncthreads();
    int* ltok = (int*)(p.ws + WS_LTOK); float* lrs = (float*)(p.ws + WS_LRS); float* lw = (float*)(p.ws + WS_LW);
    for (int i = tid; i < 2 * nrows; i += NTHR) { const int li = rli[i]; if (li >= 0) { const size_t idx = (size_t)li * CAPL + lbase[li] + rpos[i]; ltok[idx] = r0 + (i >> 1); lrs[idx] = rrs[i >> 1]; lw[idx] = rw[i]; } }
    __syncthreads();
}

namespace mx {
using pg8::bf16x8; using pg8::u32x4; using pg8::u32x2; using pg8::cvt_pk_bf16; using pg8::bflo; using pg8::bfhi;
__device__ __forceinline__ f32x4 mfma16(bf16x8 a, bf16x8 b, f32x4 c) { return __builtin_amdgcn_mfma_f32_16x16x32_bf16(a, b, c, 0, 0, 0); }
__device__ __forceinline__ float wscan_add(float v, int lane) {
#pragma unroll
    for (int o = 1; o < 64; o <<= 1) { const float t = __shfl_up(v, o); if (lane >= o) v += t; }
    return v; }
__device__ __forceinline__ float wscan_max(float v, int lane) {
#pragma unroll
    for (int o = 1; o < 64; o <<= 1) { const float t = __shfl_up(v, o); if (lane >= o) v = fmaxf(v, t); }
    return v; }
__device__ __forceinline__ float wave_max(float v) {
#pragma unroll
    for (int o = 1; o < 64; o <<= 1) v = fmaxf(v, __shfl_xor(v, o));
    return v; }
__device__ __forceinline__ void unpack8(const u32x4 a, float (&x)[8]) { x[0] = bflo(a.x); x[1] = bfhi(a.x); x[2] = bflo(a.y); x[3] = bfhi(a.y); x[4] = bflo(a.z); x[5] = bfhi(a.z); x[6] = bflo(a.w); x[7] = bfhi(a.w); }
__device__ __forceinline__ u32x4 pack8(const float (&x)[8]) { u32x4 w; w.x = cvt_pk_bf16(x[0], x[1]); w.y = cvt_pk_bf16(x[2], x[3]); w.z = cvt_pk_bf16(x[4], x[5]); w.w = cvt_pk_bf16(x[6], x[7]); return w; }
__device__ __forceinline__ bf16x8 ldfrag(const LAS unsigned char* p) { return *(const LAS bf16x8*)p; }
constexpr int SQ = 272, ST = 144;

template <int NS> __device__ __forceinline__ void conv8(const P& p, int l, const bf16_t* z, int r0, int c, int s0, int zcol, int cch, float scale, float (&o)[NS][8]) {
    float x[NS + 3][8];
#pragma unroll
    for (int i = 0; i < NS + 3; ++i) { const int s = s0 - 3 + i, pp = c * 64 + s;
        if (pp >= LEAD) unpack8(*(const u32x4*)(z + (size_t)(r0 + s) * NIN + zcol), x[i]);
        else {
#pragma unroll
            for (int q = 0; q < 8; ++q) x[i][q] = 0.f; } }
    float bias[8];
    { const f32x4 b0 = *(const f32x4*)(p.conv_b + l * D + cch), b1 = *(const f32x4*)(p.conv_b + l * D + cch + 4); bias[0] = b0.x; bias[1] = b0.y; bias[2] = b0.z; bias[3] = b0.w; bias[4] = b1.x; bias[5] = b1.y; bias[6] = b1.z; bias[7] = b1.w; }
#pragma unroll
    for (int i = 0; i < NS; ++i)
#pragma unroll
        for (int q = 0; q < 8; ++q) o[i][q] = bias[q];
#pragma unroll
    for (int j = 0; j < 4; ++j) { float w[8];
        { const f32x4 w0 = *(const f32x4*)(p.conv_w + (l * 4 + j) * D + cch), w1 = *(const f32x4*)(p.conv_w + (l * 4 + j) * D + cch + 4); w[0] = w0.x; w[1] = w0.y; w[2] = w0.z; w[3] = w0.w; w[4] = w1.x; w[5] = w1.y; w[6] = w1.z; w[7] = w1.w; }
#pragma unroll
        for (int i = 0; i < NS; ++i)
#pragma unroll
            for (int q = 0; q < 8; ++q) o[i][q] += w[q] * x[i + j][q]; }
#pragma unroll
    for (int i = 0; i < NS; ++i) { const bool valid = (c > 0) || (s0 + i >= LEAD);
#pragma unroll
        for (int q = 0; q < 8; ++q) o[i][q] = valid ? silu(o[i][q]) * scale : 0.f; }
}

__device__ __forceinline__ void mlstm_local(const P& p, int l, int u, LAS unsigned char* lds, int tid) {
    asm volatile("" : "+v"(tid));
    const int lane = tid & 63, w = __builtin_amdgcn_readfirstlane(tid >> 6), c = u % NCH, hd = (u / NCH) & 3, b = u / (NCH * 4), r0 = b * TP + c * 64;
    const bf16_t* z = p.Z();
    LAS unsigned char* KT = lds; LAS unsigned char* VT = lds + 18432; LAS float* wS = (LAS float*)(lds + 39168);
    if (w == 0) { const int s = lane; const bool valid = (c > 0) || (s >= LEAD); const size_t zr = (size_t)(r0 + s) * NIN;
        const float lf = valid ? logsig(bf2f(z[zr + ZO_FG + hd]) + p.gate_b[(l * 2 + 1) * 4 + hd]) : 0.f;
        const float ig = valid ? bf2f(z[zr + ZO_IG + hd]) + p.gate_b[(l * 2 + 0) * 4 + hd] : -INFINITY;
        const float bb = wscan_add(lf, lane), be = __shfl(bb, 63), g = be - bb + ig, mg = wave_max(g);
        wS[s] = __expf(g - mg);
        if (lane == 0) { float* sc = p.MSC() + (size_t)u * 4; sc[0] = mg; sc[1] = be; } }
    {
        const int ch8 = tid & 15, s0 = (tid >> 4) * 2; float o[2][8];
        conv8<2>(p, l, z, r0, c, s0, ZO_KM + hd * 128 + ch8 * 8, 512 + hd * 128 + ch8 * 8, 0.08838834764831845f, o);
#pragma unroll
        for (int i = 0; i < 2; ++i)
#pragma unroll
            for (int q = 0; q < 8; ++q) *(LAS bf16_t*)(KT + (ch8 * 8 + q) * ST + (s0 + i) * 2) = f2bf(o[i][q]); }
    __syncthreads();
    {
#pragma unroll
        for (int it = 0; it < 2; ++it) { const int item = tid + it * NTHR, s = item >> 4, v8 = item & 15; const bool valid = (c > 0) || (s >= LEAD); float x[8];
            unpack8(*(const u32x4*)(z + (size_t)(r0 + s) * NIN + ZO_VM + hd * 128 + v8 * 8), x); const float ws = wS[s];
#pragma unroll
            for (int q = 0; q < 8; ++q) *(LAS bf16_t*)(VT + (v8 * 8 + q) * ST + s * 2) = f2bf(valid ? x[q] * ws : 0.f); }
        for (int i = tid; i < 16 * 64; i += NTHR) { const int row = 128 + (i >> 6), s = i & 63; *(LAS bf16_t*)(VT + row * ST + s * 2) = (row == 128) ? f2bf(wS[s]) : (bf16_t)0; } }
    __syncthreads();
    {
        const int r = lane & 15, q = lane >> 4; bf16x8 bfr[2];
#pragma unroll
        for (int ks = 0; ks < 2; ++ks) bfr[ks] = ldfrag(KT + (w * 16 + r) * ST + (ks * 32 + q * 8) * 2);
        bf16_t* Cd = p.MC() + (size_t)u * 16384;
#pragma unroll
        for (int rt = 0; rt < 9; ++rt) { f32x4 acc = {0.f, 0.f, 0.f, 0.f};
#pragma unroll
            for (int ks = 0; ks < 2; ++ks) acc = mfma16(ldfrag(VT + (rt * 16 + r) * ST + (ks * 32 + q * 8) * 2), bfr[ks], acc);
            if (rt < 8) {
#pragma unroll
                for (int j = 0; j < 4; ++j) Cd[(rt * 16 + q * 4 + j) * 128 + w * 16 + r] = f2bf(acc[j]); }
            else if (q == 0) p.MN()[(size_t)u * 128 + w * 16 + r] = acc[0]; } }
    __syncthreads();
}

__device__ __forceinline__ void gla_cumdecay(const P& p, int l, int hd, int c, int r0, const bf16_t* z, LAS float* LA, LAS float* segtot, LAS float* cod, LAS float* aw, LAS float* ab, int tid) {
    for (int i = tid; i < 64 * 16; i += NTHR) { const int s = i >> 4, q = i & 15; cod[i] = bf2f(z[(size_t)(r0 + s) * NIN + ZO_CODE + q]); }
    for (int i = tid; i < 16 * 64; i += NTHR) { const int q = i >> 6, j = i & 63; aw[i] = p.a_w2[(l * 16 + q) * 256 + hd * 64 + j]; }
    if (tid < 64) ab[tid] = p.a_b[l * 256 + hd * 64 + tid];
    __syncthreads();
    const int j = tid & 63, seg = tid >> 6; float run = 0.f, v[8];
#pragma unroll
    for (int i = 0; i < 8; ++i) { const int s = seg * 8 + i; const bool valid = (c > 0) || (s >= LEAD); float a = ab[j];
#pragma unroll
        for (int q = 0; q < 16; ++q) a += cod[s * 16 + q] * aw[q * 64 + j];
        run += valid ? logsig(a) * (1.f / 16.f) : 0.f; v[i] = run; }
    segtot[seg * 64 + j] = run;
    __syncthreads();
    float pre = 0.f;
#pragma unroll
    for (int g = 0; g < 8; ++g) pre += (g < seg) ? segtot[g * 64 + j] : 0.f;
#pragma unroll
    for (int i = 0; i < 8; ++i) LA[(seg * 8 + i) * 65 + j] = v[i] + pre;
    __syncthreads();
}
__device__ __forceinline__ void gla_local(const P& p, int l, int u, LAS unsigned char* lds, int tid) {
    asm volatile("" : "+v"(tid));
    const int lane = tid & 63, w = __builtin_amdgcn_readfirstlane(tid >> 6), c = u % NCH, hd = (u / NCH) & 3, b = u / (NCH * 4), r0 = b * TP + c * 64;
    const bf16_t* z = p.Z();
    LAS float* LA = (LAS float*)lds; LAS float* segtot = (LAS float*)(lds + 16640); LAS unsigned char* KHT = lds + 18688; LAS unsigned char* VT = lds + 27904;
    LAS float* cod = (LAS float*)(lds + 46336); LAS float* aw = (LAS float*)(lds + 50432); LAS float* ab = (LAS float*)(lds + 54528);
    gla_cumdecay(p, l, hd, c, r0, z, LA, segtot, cod, aw, ab, tid);
    if (tid < 64) p.GB()[(size_t)u * 64 + tid] = LA[63 * 65 + tid];
    { const int s = tid >> 3, j8 = tid & 7; const bool valid = (c > 0) || (s >= LEAD); float x[8];
        unpack8(*(const u32x4*)(z + (size_t)(r0 + s) * NIN + ZO_KG + hd * 64 + j8 * 8), x);
#pragma unroll
        for (int q = 0; q < 8; ++q) { const int j = j8 * 8 + q; *(LAS bf16_t*)(KHT + j * ST + s * 2) = f2bf(valid ? x[q] * __expf(LA[63 * 65 + j] - LA[s * 65 + j]) : 0.f); } }
#pragma unroll
    for (int it = 0; it < 2; ++it) { const int item = tid + it * NTHR, s = item >> 4, v8 = item & 15; const bool valid = (c > 0) || (s >= LEAD); float x[8];
        unpack8(*(const u32x4*)(z + (size_t)(r0 + s) * NIN + ZO_VG + hd * 128 + v8 * 8), x);
#pragma unroll
        for (int q = 0; q < 8; ++q) *(LAS bf16_t*)(VT + (v8 * 8 + q) * ST + s * 2) = f2bf(valid ? x[q] : 0.f); }
    __syncthreads();
    { const int r = lane & 15, q = lane >> 4; bf16x8 afr[2];
#pragma unroll
        for (int ks = 0; ks < 2; ++ks) afr[ks] = ldfrag(VT + (w * 16 + r) * ST + (ks * 32 + q * 8) * 2);
        bf16_t* Sd = p.GS() + (size_t)u * 8192;
#pragma unroll
        for (int ct = 0; ct < 4; ++ct) { f32x4 acc = {0.f, 0.f, 0.f, 0.f};
#pragma unroll
            for (int ks = 0; ks < 2; ++ks) acc = mfma16(afr[ks], ldfrag(KHT + (ct * 16 + r) * ST + (ks * 32 + q * 8) * 2), acc);
#pragma unroll
            for (int j = 0; j < 4; ++j) Sd[(w * 16 + q * 4 + j) * 64 + ct * 16 + r] = f2bf(acc[j]); } }
    __syncthreads();
}

__device__ __forceinline__ void scan_phase(const P& p, LAS unsigned char* lds, int G, int bid, int tid) {
    asm volatile("" : "+v"(tid));
    LAS float* dec = (LAS float*)lds; LAS float* wgt = dec + 132;
    for (int item = bid; item < 16 * 49; item += G) { const int bh = item / 49, sl = item % 49;
        __syncthreads();
        if (sl < 33) {
            if (tid < NCH) { const float* sc = p.MSC() + ((size_t)bh * NCH + tid) * 4; dec[tid] = sc[1]; wgt[tid] = sc[0]; }
            __syncthreads();
            if (tid == 0) { float m = 0.f; for (int c = 0; c < NCH; ++c) { const float mg = wgt[c], be = dec[c];
                    if (sl == 0) p.MSC()[((size_t)bh * NCH + c) * 4 + 2] = m; const float mn = fmaxf(be + m, mg); dec[c] = __expf(be + m - mn); wgt[c] = __expf(mg - mn); m = mn; } } }
        __syncthreads();
        if (sl < 32) { const int e = sl * 512 + tid; float C = 0.f; bf16_t* q = p.MC() + (size_t)bh * NCH * 16384 + e;
#pragma unroll 8
            for (int c = 0; c < NCH; ++c) { const float dl = bf2f(q[(size_t)c * 16384]); q[(size_t)c * 16384] = f2bf(C); C = dec[c] * C + wgt[c] * dl; } }
        else if (sl == 32) { if (tid < 128) { float C = 0.f; float* q = p.MN() + (size_t)bh * NCH * 128 + tid;
#pragma unroll 4
            for (int c = 0; c < NCH; ++c) { const float dl = q[(size_t)c * 128]; q[(size_t)c * 128] = C; C = dec[c] * C + wgt[c] * dl; } } }
        else { const int e = (sl - 33) * 512 + tid, j = e & 63; float S = 0.f; bf16_t* q = p.GS() + (size_t)bh * NCH * 8192 + e; const float* gb = p.GB() + (size_t)bh * NCH * 64 + j;
#pragma unroll 8
            for (int c = 0; c < NCH; ++c) { const float dl = bf2f(q[(size_t)c * 8192]); q[(size_t)c * 8192] = f2bf(S); S = S * __expf(gb[(size_t)c * 64]) + dl; } }
    }
    __syncthreads();
}

__device__ __forceinline__ void mlstm_out(const P& p, int l, int u, LAS unsigned char* lds, int tid) {
    asm volatile("" : "+v"(tid));
    const int lane = tid & 63, w = __builtin_amdgcn_readfirstlane(tid >> 6), c = u % NCH, hd = (u / NCH) & 3, b = u / (NCH * 4), r0 = b * TP + c * 64;
    bf16_t* z = p.Z();
    LAS unsigned char* QS = lds; LAS unsigned char* KS = lds + 17408; LAS unsigned char* VT = lds + 34816; LAS unsigned char* SS = lds + 55552;
    LAS float* aS = (LAS float*)(lds + 64768); LAS float* MS = aS + 64; LAS float* wiS = MS + 64; LAS float* emtS = wiS + 64; LAS float* denS = emtS + 64; LAS float* part = denS + 64;
    if (w == 0) { const int s = lane; const bool valid = (c > 0) || (s >= LEAD); const size_t zr = (size_t)(r0 + s) * NIN;
        const float lf = valid ? logsig(bf2f(z[zr + ZO_FG + hd]) + p.gate_b[(l * 2 + 1) * 4 + hd]) : 0.f;
        const float ig = valid ? bf2f(z[zr + ZO_IG + hd]) + p.gate_b[(l * 2 + 0) * 4 + hd] : -INFINITY;
        const float bb = wscan_add(lf, lane), a = ig - bb, pm = wscan_max(a, lane), m0 = p.MSC()[(size_t)u * 4 + 2], M = fmaxf(m0, pm);
        aS[s] = a; MS[s] = M; wiS[s] = __expf(m0 - M); emtS[s] = __expf(-(bb + M)); }
    { const int which = tid >> 8, ch8 = tid & 15, s0 = ((tid >> 4) & 15) * 4; float o[4][8];
        conv8<4>(p, l, z, r0, c, s0, (which ? ZO_KM : ZO_QM) + hd * 128 + ch8 * 8, which * 512 + hd * 128 + ch8 * 8, which ? 0.08838834764831845f : 1.f, o);
        LAS unsigned char* dst = which ? KS : QS;
#pragma unroll
        for (int i = 0; i < 4; ++i) *(LAS u32x4*)(dst + (s0 + i) * SQ + ch8 * 16) = pack8(o[i]); }
#pragma unroll
    for (int it = 0; it < 2; ++it) { const int item = tid + it * NTHR, s = item >> 4, v8 = item & 15; const bool valid = (c > 0) || (s >= LEAD); float x[8];
        unpack8(*(const u32x4*)(z + (size_t)(r0 + s) * NIN + ZO_VM + hd * 128 + v8 * 8), x);
#pragma unroll
        for (int q = 0; q < 8; ++q) *(LAS bf16_t*)(VT + (v8 * 8 + q) * ST + s * 2) = f2bf(valid ? x[q] : 0.f); }
    for (int i = tid; i < 16 * 64; i += NTHR) { const int row = 128 + (i >> 6), s = i & 63; *(LAS bf16_t*)(VT + row * ST + s * 2) = (row == 128) ? (bf16_t)0x3f80 : (bf16_t)0; }
    __syncthreads();
    const int r = lane & 15, q = lane >> 4, rt = w >> 1;
    {
#pragma unroll
        for (int cc = 0; cc < 2; ++cc) { const int ct = (w & 1) * 2 + cc; f32x4 acc = {0.f, 0.f, 0.f, 0.f};
            if (ct <= rt) {
#pragma unroll
                for (int ks = 0; ks < 4; ++ks) acc = mfma16(ldfrag(QS + (rt * 16 + r) * SQ + (ks * 32 + q * 8) * 2), ldfrag(KS + (ct * 16 + r) * SQ + (ks * 32 + q * 8) * 2), acc); }
            const int s = ct * 16 + r; const float as = aS[s];
#pragma unroll
            for (int j = 0; j < 4; ++j) { const int t = rt * 16 + q * 4 + j; const float v = (s <= t) ? acc[j] * __expf(as - MS[t]) : 0.f; *(LAS bf16_t*)(SS + t * ST + s * 2) = f2bf(v); } } }
    __syncthreads();
    const int nct = (w & 1) ? 4 : 5; f32x4 hv[5];
    { bf16x8 sa[2], qa[4];
#pragma unroll
        for (int ks = 0; ks < 2; ++ks) sa[ks] = ldfrag(SS + (rt * 16 + r) * ST + (ks * 32 + q * 8) * 2);
#pragma unroll
        for (int ks = 0; ks < 4; ++ks) qa[ks] = ldfrag(QS + (rt * 16 + r) * SQ + (ks * 32 + q * 8) * 2);
        const bf16_t* Cg = p.MC() + (size_t)u * 16384; const float* ng = p.MN() + (size_t)u * 128;
#pragma unroll
        for (int i = 0; i < 5; ++i) { if (i < nct) { const int ct = (i < 4) ? (w & 1) * 4 + i : 8; f32x4 a1 = {0.f, 0.f, 0.f, 0.f}, a2 = {0.f, 0.f, 0.f, 0.f};
#pragma unroll
            for (int ks = 0; ks < 2; ++ks) a1 = mfma16(sa[ks], ldfrag(VT + (ct * 16 + r) * ST + (ks * 32 + q * 8) * 2), a1);
#pragma unroll
            for (int ks = 0; ks < 4; ++ks) { bf16x8 bfr;
                if (i < 4) bfr = *(const bf16x8*)(Cg + (ct * 16 + r) * 128 + ks * 32 + q * 8);
                else { float nn[8];
#pragma unroll
                    for (int e = 0; e < 8; ++e) nn[e] = (r == 0) ? ng[ks * 32 + q * 8 + e] : 0.f;
                    bfr = __builtin_bit_cast(bf16x8, pack8(nn)); }
                a2 = mfma16(qa[ks], bfr, a2); }
#pragma unroll
            for (int j = 0; j < 4; ++j) hv[i][j] = a1[j] + wiS[rt * 16 + q * 4 + j] * a2[j]; } }
        if (!(w & 1) && r == 0) {
#pragma unroll
            for (int j = 0; j < 4; ++j) denS[rt * 16 + q * 4 + j] = hv[4][j]; } }
    __syncthreads();
    { float ssq[4] = {0.f, 0.f, 0.f, 0.f};
#pragma unroll
        for (int j = 0; j < 4; ++j) { const int t = rt * 16 + q * 4 + j; const float dn = 1.f / fmaxf(fabsf(denS[t]), emtS[t]);
#pragma unroll
            for (int i = 0; i < 4; ++i) { hv[i][j] *= dn; ssq[j] += hv[i][j] * hv[i][j]; } }
#pragma unroll
        for (int j = 0; j < 4; ++j) { float s = ssq[j]; s += __shfl_xor(s, 1); s += __shfl_xor(s, 2); s += __shfl_xor(s, 4); s += __shfl_xor(s, 8); if (r == 0) part[(rt * 16 + q * 4 + j) * 2 + (w & 1)] = s; } }
    __syncthreads();
#pragma unroll
    for (int j = 0; j < 4; ++j) { const int t = rt * 16 + q * 4 + j; const bool valid = (c > 0) || (t >= LEAD); const float sc = rsqrtf((part[t * 2] + part[t * 2 + 1]) * (1.f / 128.f) + EPS);
#pragma unroll
        for (int i = 0; i < 4; ++i) { const int v = ((w & 1) * 4 + i) * 16 + r; bf16_t* zp = z + (size_t)(r0 + t) * NIN + ZO_OM + hd * 128 + v;
            const float y = hv[i][j] * sc * p.m_norm_g[l * 512 + hd * 128 + v] * sigm(bf2f(*zp)); *zp = f2bf(valid ? y : 0.f); } }
    __syncthreads();
}

__device__ __forceinline__ void gla_out(const P& p, int l, int u, LAS unsigned char* lds, int tid) {
    asm volatile("" : "+v"(tid));
    const int lane = tid & 63, w = __builtin_amdgcn_readfirstlane(tid >> 6), c = u % NCH, hd = (u / NCH) & 3, b = u / (NCH * 4), r0 = b * TP + c * 64;
    bf16_t* z = p.Z();
    LAS float* LA = (LAS float*)lds; LAS float* segtot = (LAS float*)(lds + 16640); LAS unsigned char* QT = lds + 18688; LAS unsigned char* KT2 = lds + 27904; LAS unsigned char* VT = lds + 37120; LAS unsigned char* AS = lds + 55552;
    LAS float* cod = (LAS float*)(lds + 64768); LAS float* aw = (LAS float*)(lds + 68864); LAS float* ab = (LAS float*)(lds + 72960); LAS float* part = (LAS float*)(lds + 73216);
    gla_cumdecay(p, l, hd, c, r0, z, LA, segtot, cod, aw, ab, tid);
    { const int s = tid >> 3, j8 = tid & 7; const bool valid = (c > 0) || (s >= LEAD); float xq[8], xk[8]; const size_t zr = (size_t)(r0 + s) * NIN;
        unpack8(*(const u32x4*)(z + zr + ZO_QG + hd * 64 + j8 * 8), xq); unpack8(*(const u32x4*)(z + zr + ZO_KG + hd * 64 + j8 * 8), xk);
#pragma unroll
        for (int q = 0; q < 8; ++q) { const float bb = LA[s * 65 + j8 * 8 + q]; xq[q] = valid ? xq[q] * 0.125f * __expf(bb) : 0.f; xk[q] = valid ? xk[q] * __expf(-bb) : 0.f; }
        *(LAS u32x4*)(QT + s * ST + j8 * 16) = pack8(xq); *(LAS u32x4*)(KT2 + s * ST + j8 * 16) = pack8(xk); }
#pragma unroll
    for (int it = 0; it < 2; ++it) { const int item = tid + it * NTHR, s = item >> 4, v8 = item & 15; const bool valid = (c > 0) || (s >= LEAD); float x[8];
        unpack8(*(const u32x4*)(z + (size_t)(r0 + s) * NIN + ZO_VG + hd * 128 + v8 * 8), x);
#pragma unroll
        for (int q = 0; q < 8; ++q) *(LAS bf16_t*)(VT + (v8 * 8 + q) * ST + s * 2) = f2bf(valid ? x[q] : 0.f); }
    __syncthreads();
    const int r = lane & 15, q = lane >> 4, rt = w >> 1;
#pragma unroll
    for (int cc = 0; cc < 2; ++cc) { const int ct = (w & 1) * 2 + cc; f32x4 acc = {0.f, 0.f, 0.f, 0.f};
        if (ct <= rt) {
#pragma unroll
            for (int ks = 0; ks < 2; ++ks) acc = mfma16(ldfrag(QT + (rt * 16 + r) * ST + (ks * 32 + q * 8) * 2), ldfrag(KT2 + (ct * 16 + r) * ST + (ks * 32 + q * 8) * 2), acc); }
        const int s = ct * 16 + r;
#pragma unroll
        for (int j = 0; j < 4; ++j) { const int t = rt * 16 + q * 4 + j; *(LAS bf16_t*)(AS + t * ST + s * 2) = f2bf((s <= t) ? acc[j] : 0.f); } }
    __syncthreads();
    f32x4 hv[4];
    { bf16x8 aa[2], qa[2];
#pragma unroll
        for (int ks = 0; ks < 2; ++ks) { aa[ks] = ldfrag(AS + (rt * 16 + r) * ST + (ks * 32 + q * 8) * 2); qa[ks] = ldfrag(QT + (rt * 16 + r) * ST + (ks * 32 + q * 8) * 2); }
        const bf16_t* Sg = p.GS() + (size_t)u * 8192;
#pragma unroll
        for (int i = 0; i < 4; ++i) { const int ct = (w & 1) * 4 + i; f32x4 acc = {0.f, 0.f, 0.f, 0.f};
#pragma unroll
            for (int ks = 0; ks < 2; ++ks) { acc = mfma16(aa[ks], ldfrag(VT + (ct * 16 + r) * ST + (ks * 32 + q * 8) * 2), acc);
                acc = mfma16(qa[ks], *(const bf16x8*)(Sg + (ct * 16 + r) * 64 + ks * 32 + q * 8), acc); }
            hv[i] = acc; } }
    { float ssq[4] = {0.f, 0.f, 0.f, 0.f};
#pragma unroll
        for (int j = 0; j < 4; ++j)
#pragma unroll
            for (int i = 0; i < 4; ++i) ssq[j] += hv[i][j] * hv[i][j];
#pragma unroll
        for (int j = 0; j < 4; ++j) { float s = ssq[j]; s += __shfl_xor(s, 1); s += __shfl_xor(s, 2); s += __shfl_xor(s, 4); s += __shfl_xor(s, 8); if (r == 0) part[(rt * 16 + q * 4 + j) * 2 + (w & 1)] = s; } }
    __syncthreads();
#pragma unroll
    for (int j = 0; j < 4; ++j) { const int t = rt * 16 + q * 4 + j; const bool valid = (c > 0) || (t >= LEAD); const float sc = rsqrtf((part[t * 2] + part[t * 2 + 1]) * (1.f / 128.f) + EPS);
#pragma unroll
        for (int i = 0; i < 4; ++i) { const int d = ((w & 1) * 4 + i) * 16 + r; bf16_t* zp = z + (size_t)(r0 + t) * NIN + ZO_GG + hd * 128 + d;
            const float y = hv[i][j] * sc * p.g_norm_g[l * 512 + hd * 128 + d] * silu(bf2f(*zp)); *zp = f2bf(valid ? y : 0.f); } }
    __syncthreads();
}
}

namespace pro {
#define PRO_TILE(LDEXPR, OUTROW) do { \
        _Pragma("unroll 8") for (int i = 0; i < 32; ++i) { const int kk = 2 * i + (lane >> 5), nn = lane & 31; scr[kk * 33 + nn] = (LDEXPR); } \
        asm volatile("s_waitcnt lgkmcnt(0)" ::: "memory"); \
        { const int c8 = lane & 7; _Pragma("unroll") for (int j = 0; j < 4; ++j) { const int nn = (lane >> 3) + 8 * j; const LAS float* s_ = scr + (8 * c8) * 33 + nn; \
            pg8::u32x4 o_; o_.x = pg8::cvt_pk_bf16(s_[0], s_[33]); o_.y = pg8::cvt_pk_bf16(s_[66], s_[99]); o_.z = pg8::cvt_pk_bf16(s_[132], s_[165]); o_.w = pg8::cvt_pk_bf16(s_[198], s_[231]); \
            *(pg8::u32x4*)((OUTROW) + 8 * c8) = o_; } } \
        asm volatile("s_waitcnt lgkmcnt(0)" ::: "memory"); } while (0)
__device__ __forceinline__ void prologue_phase(const P& p, LAS unsigned char* lds, int G, int bid, int tid) {
    asm volatile("" : "+v"(tid));
    const int lane = tid & 63, w = __builtin_amdgcn_readfirstlane(tid >> 6), gw = bid * NWAVES + w, NGW = G * NWAVES;
    LAS float* scr = (LAS float*)(lds + w * 8448);
    constexpr int I_IN = DEPTH * 16 * (NZP / 32), I_OUT = DEPTH * 16 * (D / 32), I_GU = DEPTH * NE * 16 * (512 / 32), I_D = DEPTH * NE * (DE / 64) * (D / 32);
    for (int it = gw; it < I_IN + I_OUT + I_GU + I_D; it += NGW) {
        int r = it;
        if (r < I_IN) { const int nb = r % (NZP / 32), kb = (r / (NZP / 32)) % 16, l = r / (16 * (NZP / 32)), k0 = kb * 64, n0 = nb * 32;
            const int n = n0 + (lane & 31); const int sc = zsrc(n); const float* src = p.w_in + ((size_t)l * D + k0) * NIN + sc; const float* g = p.norm1_g + l * D + k0;
            bf16_t* ob = (bf16_t*)(p.ws + WS_WIN) + ((size_t)l * NZP + n0) * D + k0;
            PRO_TILE((n < NIN) ? src[(size_t)kk * NIN] * g[kk] : 0.f, ob + (size_t)nn * D);
            continue; }
        r -= I_IN;
        if (r < I_OUT) { const int nb = r % 32, kb = (r / 32) % 16, l = r / 512, k0 = kb * 64, n0 = nb * 32;
            const float* src = p.w_out + ((size_t)l * D + k0) * D + n0 + (lane & 31); bf16_t* ob = (bf16_t*)(p.ws + WS_WOUT) + ((size_t)l * D + n0) * D + k0;
            PRO_TILE(src[(size_t)kk * D], ob + (size_t)nn * D);
            continue; }
        r -= I_OUT;
        if (r < I_GU) { const int nb = r % 16, kb = (r / 16) % 16, bz = r / 256, k0 = kb * 64, n0 = nb * 32;
            const int i = lane & 31; const float* src = ((i < 16) ? p.w_gate : p.w_up) + ((size_t)bz * D + k0) * DE + 16 * nb + (i & 15); const float* g = p.norm2_g + (bz >> 5) * D + k0;
            bf16_t* ob = (bf16_t*)(p.ws + WS_WGU) + ((size_t)bz * 512 + n0) * D + k0;
            PRO_TILE(src[(size_t)kk * DE] * g[kk], ob + (size_t)nn * D);
            continue; }
        r -= I_GU;
        { const int nb = r % 32, kb = (r / 32) % 4, bz = r / 128, k0 = kb * 64, n0 = nb * 32;
            const float* src = p.w_down + ((size_t)bz * DE + k0) * D + n0 + (lane & 31); bf16_t* ob = (bf16_t*)(p.ws + WS_WD) + ((size_t)bz * D + n0) * DE + k0;
            PRO_TILE(src[(size_t)kk * D], ob + (size_t)nn * DE); }
    }
    for (int idx = bid * NTHR + tid; idx < DEPTH * NR * D; idx += G * NTHR) { const int k = idx % D, o = (idx / D) % NR, l = idx / (D * NR); float v = 0.f;
        if (o < 4) v = p.wr_g[((size_t)l * D + k) * 4 + o]; else if (o < 36) v = p.wr_e[((size_t)l * D + k) * 32 + (o - 4)];
        p.Wr()[idx] = v * p.norm2_g[l * D + k]; }
    for (int r = gw; r < MP; r += NGW) { const int b = r / TP, pp = r % TP; const float* src = nullptr;
        if (pp >= 64) src = p.x + ((size_t)b * SEQ + (pp - 64)) * D; else if (pp >= LEAD) src = p.meta + (size_t)(pp - LEAD) * D;
        float s = 0.f; bf16_t* hr = p.H() + (size_t)r * D;
#pragma unroll
        for (int j = 0; j < 4; ++j) { f32x4 v = {0.f, 0.f, 0.f, 0.f}; if (src) v = ((const f32x4*)src)[lane + 64 * j];
            s += v.x * v.x + v.y * v.y + v.z * v.z + v.w * v.w;
            pg8::u32x2 o; o.x = pg8::cvt_pk_bf16(v.x, v.y); o.y = pg8::cvt_pk_bf16(v.z, v.w); ((pg8::u32x2*)hr)[lane + 64 * j] = o; }
        s = wave_sum(s);
        if (lane == 0) { f32x4 q = {s, 0.f, 0.f, 0.f}; *(f32x4*)(p.SS1() + (size_t)r * 4) = q; } }
}
#undef PRO_TILE
__device__ __forceinline__ void final_phase(const P& p, int G, int bid, int tid) {
    asm volatile("" : "+v"(tid));
    const int lane = tid & 63, w = tid >> 6;
    for (int t = bid * NWAVES + w; t < B * SEQ; t += G * NWAVES) { const int b = t / SEQ, s = t % SEQ, r = b * TP + 64 + s;
        const float rs = row_rs(p.SS1(), r); const bf16_t* hr = p.H() + (size_t)r * D; float* o = p.out + (size_t)t * D;
#pragma unroll
        for (int j = 0; j < 4; ++j) { const pg8::u32x2 hv = ((const pg8::u32x2*)hr)[lane + 64 * j]; const f32x4 g = ((const f32x4*)p.final_g)[lane + 64 * j];
            f32x4 v; v.x = pg8::bflo(hv.x) * rs * g.x; v.y = pg8::bfhi(hv.x) * rs * g.y; v.z = pg8::bflo(hv.y) * rs * g.z; v.w = pg8::bfhi(hv.y) * rs * g.w;
            ((f32x4*)o)[lane + 64 * j] = v; } }
}
}

struct Args { P p; int ph_lo, ph_hi; };
__global__ void __launch_bounds__(NTHR, 2) fwd(Args a) {
    extern __shared__ __attribute__((aligned(16))) unsigned char lds_raw[];
    LAS unsigned char* lds = (LAS unsigned char*)lds_raw;
    const P& p = a.p;
    const int tid = threadIdx.x, G = gridDim.x, bid = blockIdx.x;
    unsigned* ctl = (unsigned*)(p.ws + WS_CTL);
    volatile LAS unsigned* MISC = (volatile LAS unsigned*)(lds + MISC_OFF);
    if (tid < 128) MISC[tid] = 0u;
    __syncthreads();
    const bool multi = (a.ph_hi - a.ph_lo) > 1;
    XcdBarrier bar; bar.bar = ctl + CW_BAR; bar.x = 0; bar.st = nullptr;
    if (multi) bar = xcd_barrier_post(ctl + CW_BAR, MISC + 8);
#define IN(k) (a.ph_lo <= (k) && (k) < a.ph_hi)
#define SEAM(k) do { if (IN(k) && IN((k) + 1)) xcd_barrier(bar); } while (0)
#if !defined(ONLY) || ONLY==100
    if (IN(PH_PRO)) pro::prologue_phase(p, lds, G, bid, tid);
#endif
    SEAM(PH_PRO);
    for (int l = 0; l < DEPTH; ++l) {
        const int pb = PH_LAYER0 + l * PH_PER_LAYER;
        unsigned* gcnt = ctl + CW_CNT + l * 64 * 16;
#if !defined(ONLY) || ONLY==0
        if (IN(pb + 0)) {
            pg8::DenseOrder<D, D> S; S.init(MP, NZP, G, bid);
            pg8::EpiZ E{p.ws};
            pg8::gemm_phase<pg8::EpiZ, pg8::DenseOrder<D, D>, true, D, D>(lds + RING_OFF, (const char*)(p.ws + WS_H), (const char*)(p.ws + WS_WIN) + (size_t)l * NZP * D * 2, S, E);
        }
#endif
        SEAM(pb + 0);
#if !defined(ONLY) || ONLY==1
        if (IN(pb + 1)) { for (int u = bid; u < 2 * NU; u += G) { if (u < NU) mx::mlstm_local(p, l, u, lds, tid); else mx::gla_local(p, l, u - NU, lds, tid); } }
#endif
        SEAM(pb + 1);
#if !defined(ONLY) || ONLY==2
        if (IN(pb + 2)) mx::scan_phase(p, lds, G, bid, tid);
#endif
        SEAM(pb + 2);
#if !defined(ONLY) || ONLY==3
        if (IN(pb + 3)) { for (int u = bid; u < 2 * NU; u += G) { if (u < NU) mx::mlstm_out(p, l, u, lds, tid); else mx::gla_out(p, l, u - NU, lds, tid); } }
#endif
        SEAM(pb + 3);
#if !defined(ONLY) || ONLY==4
        if (IN(pb + 4)) {
            pg8::DenseOrder<NIN, D> S; S.init(MP, D, G, bid);
            pg8::EpiRes<false, true, WS_SS2> E{p.ws, lds};
            pg8::gemm_phase<pg8::EpiRes<false, true, WS_SS2>, pg8::DenseOrder<NIN, D>, true, NIN, D>(lds + RING_OFF, (const char*)(p.ws + WS_Z), (const char*)(p.ws + WS_WOUT) + (size_t)l * D * D * 2, S, E);
        }
#endif
        SEAM(pb + 4);
#if !defined(ONLY) || ONLY==5
        if (IN(pb + 5)) route_phase(p, l, lds, G, bid, gcnt);
#endif
        SEAM(pb + 5);
#if !defined(ONLY) || ONLY==6
        if (IN(pb + 6)) {
            moe_build_tab((LAS MoeTab*)(lds + TAB_OFF), gcnt);
            typedef MoeOrder<true, 2, D, D, 512u * D * 2u> Ord;
            Ord S; S.lds = lds; S.ws = p.ws; S.rbLo = 0; S.nwg = ((const LAS MoeTab*)(lds + TAB_OFF))->rb0[64] * 2; S.G = G; S.c = bid;
            pg8::EpiUp E{p.ws, lds};
            pg8::gemm_phase<pg8::EpiUp, Ord, true, D, D>(lds + RING_OFF, (const char*)(p.ws + WS_H), (const char*)(p.ws + WS_WGU) + (size_t)l * NE * 512 * D * 2, S, E);
        }
#endif
        SEAM(pb + 6);
#if !defined(ONLY) || ONLY==7
#pragma unroll
        for (int rank = 0; rank < 2; ++rank) {
            if (IN(pb + 7 + rank)) {
                moe_build_tab((LAS MoeTab*)(lds + TAB_OFF), gcnt);
                const LAS MoeTab* T = (const LAS MoeTab*)(lds + TAB_OFF);
                typedef MoeOrder<false, 4, DE, DE, (unsigned)D * DE * 2u> Ord;
                Ord S; S.lds = lds; S.ws = p.ws; S.rbLo = T->rb0[32 * rank]; S.nwg = (T->rb0[32 * rank + 32] - T->rb0[32 * rank]) * 4; S.G = G; S.c = bid;
                const char* Ab = (const char*)(p.ws + WS_HID); const char* Bb = (const char*)(p.ws + WS_WD) + (size_t)l * NE * D * DE * 2;
                if (rank == 0) { pg8::EpiRes<true, false, WS_SS1> E{p.ws, lds}; pg8::gemm_phase<pg8::EpiRes<true, false, WS_SS1>, Ord, true, DE, DE>(lds + RING_OFF, Ab, Bb, S, E); }
                else { pg8::EpiRes<true, true, WS_SS1> E{p.ws, lds}; pg8::gemm_phase<pg8::EpiRes<true, true, WS_SS1>, Ord, true, DE, DE>(lds + RING_OFF, Ab, Bb, S, E); }
            }
            SEAM(pb + 7 + rank);
        }
#endif
    }
#if !defined(ONLY) || ONLY==101
    if (IN(PH_FINAL)) pro::final_phase(p, G, bid, tid);
#endif
#undef IN
#undef SEAM
}

#ifndef FAST_GEMM
#define FAST_GEMM 1
#endif
#ifndef FAST_MIX
#define FAST_MIX 1
#endif
#ifndef FAST_PRO
#define FAST_PRO 1
#endif
#ifndef ONE_LAUNCH
#define ONE_LAUNCH 1
#endif
#ifndef FAST_MOE
#define FAST_MOE 1
#endif
extern "C" void kernel_launch(void* const* d_in, const int* in_sizes, int n_in, void* d_out, int out_size, void* d_ws, size_t ws_size, hipStream_t stream) {
    if (n_in != 21 || ws_size < WS_END || out_size != B * SEQ * D) { fprintf(stderr, "kernel_launch: unexpected sizes n_in %d ws %zu (need %zu) out %d\n", n_in, ws_size, (size_t)WS_END, out_size); return; }
    P p{};
    const float** f = (const float**)&p.x;
    for (int i = 0; i < 21; ++i) f[i] = (const float*)d_in[i];
    p.out = (float*)d_out; p.ws = (unsigned char*)d_ws;
    static int grid = 0;
    constexpr int LDS_LOCAL = 18000 * 4, LDS_OUT = 35000 * 4;
    if (!grid) {
        (void)hipFuncSetAttribute((const void*)k_mix_local_ref, hipFuncAttributeMaxDynamicSharedMemorySize, LDS_LOCAL);
        (void)hipFuncSetAttribute((const void*)k_mix_out_ref, hipFuncAttributeMaxDynamicSharedMemorySize, LDS_OUT);
        (void)hipFuncSetAttribute((const void*)fwd, hipFuncAttributeMaxDynamicSharedMemorySize, LDS_BYTES);
        int dev = 0, cus = 0, per_cu = 0;
        (void)hipGetDevice(&dev); (void)hipDeviceGetAttribute(&cus, hipDeviceAttributeMultiprocessorCount, dev);
        (void)hipOccupancyMaxActiveBlocksPerMultiprocessor(&per_cu, (const void*)fwd, NTHR, LDS_BYTES);
        (void)hipGetLastError();
        grid = cus > 0 ? cus : 256;
        if (per_cu < 1) fprintf(stderr, "kernel_launch: occupancy query reports %d blocks/CU for fwd\n", per_cu);
    }
    (void)hipMemsetAsync(d_ws, 0, CTL_BYTES, stream);
    Args a{}; a.p = p;
    auto run_phase = [&](int ph) { a.ph_lo = ph; a.ph_hi = ph + 1; hipLaunchKernelGGL(fwd, dim3(grid), dim3(NTHR), LDS_BYTES, stream, a); };
    if (ONE_LAUNCH) { a.ph_lo = 0; a.ph_hi = PH_COUNT; hipLaunchKernelGGL(fwd, dim3(grid), dim3(NTHR), LDS_BYTES, stream, a); return; }
    if (FAST_PRO) run_phase(PH_PRO);
    else {
    hipLaunchKernelGGL(k_transpose<TWin>, dim3(NZP / 32, D / 32, DEPTH), dim3(256), 0, stream, TWin{p.w_in, p.norm1_g, (bf16_t*)(p.ws + WS_WIN)});
    hipLaunchKernelGGL(k_transpose<TWout>, dim3(D / 32, D / 32, DEPTH), dim3(256), 0, stream, TWout{p.w_out, (bf16_t*)(p.ws + WS_WOUT)});
    hipLaunchKernelGGL(k_transpose<TWgu>, dim3(512 / 32, D / 32, DEPTH * NE), dim3(256), 0, stream, TWgu{p.w_gate, p.w_up, p.norm2_g, (bf16_t*)(p.ws + WS_WGU)});
    hipLaunchKernelGGL(k_transpose<TWd>, dim3(D / 32, DE / 32, DEPTH * NE), dim3(256), 0, stream, TWd{p.w_down, (bf16_t*)(p.ws + WS_WD)});
    hipLaunchKernelGGL(k_prep_wr, dim3((DEPTH * NR * D + 255) / 256), dim3(256), 0, stream, p);
    hipLaunchKernelGGL(k_prep_h, dim3(MP / 4), dim3(256), 0, stream, p);
    }
    bf16_t* H = (bf16_t*)(p.ws + WS_H); bf16_t* Z = (bf16_t*)(p.ws + WS_Z);
    for (int l = 0; l < DEPTH; ++l) {
        const int pb = PH_LAYER0 + l * PH_PER_LAYER;
        if (FAST_GEMM) run_phase(pb + 0);
        else hipLaunchKernelGGL(k_gemm_ref<EZ>, dim3((NIN + 63) / 64, MP / 64), dim3(256), 0, stream, H, D, (const bf16_t*)(p.ws + WS_WIN) + (size_t)l * NZP * D, D, NIN, EZ{Z, (const float*)(p.ws + WS_SS1)});
        if (FAST_MIX) { run_phase(pb + 1); run_phase(pb + 2); run_phase(pb + 3); }
        else { hipLaunchKernelGGL(k_mix_local_ref, dim3(2 * NU), dim3(256), LDS_LOCAL, stream, p, l);
               hipLaunchKernelGGL(k_scan_ref, dim3(16 * 65 + 16 * 32), dim3(256), 0, stream, p);
               hipLaunchKernelGGL(k_mix_out_ref, dim3(2 * NU), dim3(256), LDS_OUT, stream, p, l); }
        if (FAST_GEMM) run_phase(pb + 4);
        else { hipLaunchKernelGGL(k_gemm_ref<EO>, dim3(D / 64, MP / 64), dim3(256), 0, stream, Z, NIN, (const bf16_t*)(p.ws + WS_WOUT) + (size_t)l * D * D, D, D, EO{H});
               hipLaunchKernelGGL(k_rowss, dim3(MP / 4), dim3(256), 0, stream, H, (float*)(p.ws + WS_SS2)); }
        if (FAST_MOE) { run_phase(pb + 5); run_phase(pb + 6); run_phase(pb + 7); run_phase(pb + 8); }
        else { hipLaunchKernelGGL(k_route_ref, dim3(MP / 4), dim3(256), 0, stream, p, l);
               hipLaunchKernelGGL(k_moe_ref, dim3(MP), dim3(256), 0, stream, p, l); }
    }
    if (FAST_PRO) run_phase(PH_FINAL); else hipLaunchKernelGGL(k_final_ref, dim3(B * SEQ / 4), dim3(256), 0, stream, p);
}
```

```cpp
#include <hip/hip_runtime.h>
#include <cstdio>
#include <cstdint>

typedef unsigned short bf16_t;
typedef float f32x4 __attribute__((ext_vector_type(4)));

namespace cfg {
constexpr int B = 4, SEQ = 8192, D = 1024, DEPTH = 2;
constexpr int CH = 64, NMETA = 16, LEAD = 48;
constexpr int TP = LEAD + NMETA + SEQ;
constexpr int NCH = TP / CH;
constexpr int MP = B * TP;
constexpr int NIN = 3608, NZP = 3840;
constexpr int ZO_OM = 0, ZO_GG = 512, ZO_QM = 1024, ZO_KM = 1536, ZO_VM = 2048, ZO_QG = 2560, ZO_KG = 2816, ZO_VG = 3072, ZO_IG = 3584, ZO_FG = 3588, ZO_CODE = 3592;
constexpr int NE = 32, DE = 256, NR = 40;
constexpr float EPS = 1e-6f;
constexpr int NU = B * 4 * NCH;

constexpr size_t al(size_t x) { return (x + 255) & ~(size_t)255; }
constexpr size_t WS_CTL = 0, CTL_BYTES = 4u << 20;
constexpr size_t WS_WIN = WS_CTL + CTL_BYTES;
constexpr size_t WS_WOUT = WS_WIN + al((size_t)DEPTH * NZP * D * 2);
constexpr size_t WS_WGU = WS_WOUT + al((size_t)DEPTH * D * D * 2);
constexpr size_t WS_WD = WS_WGU + al((size_t)DEPTH * NE * 512 * D * 2);
constexpr size_t WS_WR = WS_WD + al((size_t)DEPTH * NE * D * DE * 2);
constexpr size_t WS_H = WS_WR + al((size_t)DEPTH * NR * D * 4);
constexpr size_t WS_Z = WS_H + al((size_t)MP * D * 2);
constexpr size_t WS_SS1 = WS_Z + al((size_t)MP * NIN * 2);
constexpr size_t WS_SS2 = WS_SS1 + al((size_t)MP * 16);
constexpr size_t WS_TOKE = WS_SS2 + al((size_t)MP * 16);
constexpr size_t WS_TOKW = WS_TOKE + al((size_t)MP * 8);
constexpr int CAPL = MP, NBMAX = 352;
constexpr size_t WS_LTOK = WS_TOKW + al((size_t)MP * 8);
constexpr size_t WS_LRS = WS_LTOK + al((size_t)64 * CAPL * 4);
constexpr size_t WS_LW = WS_LRS + al((size_t)64 * CAPL * 4);
constexpr size_t WS_WRS = WS_LW + al((size_t)64 * CAPL * 4);
constexpr size_t WS_END = WS_WRS + al((size_t)2 * DEPTH * 48 * D * 2);
constexpr size_t WS_HID = WS_Z;
static_assert((size_t)NBMAX * 256 * 256 * 2 <= (size_t)MP * NIN * 2, "hid fits in z");
constexpr size_t ST_MC = 0;
constexpr size_t ST_GS = ST_MC + al((size_t)NU * 16384 * 2);
constexpr size_t ST_MN = ST_GS + al((size_t)NU * 8192 * 2);
constexpr size_t ST_MSC = ST_MN + al((size_t)NU * 128 * 4);
constexpr size_t ST_GB = ST_MSC + al((size_t)NU * 16);
constexpr size_t ST_END = ST_GB + al((size_t)NU * 64 * 4);
static_assert(ST_END <= (size_t)B * SEQ * D * 4, "state scratch fits d_out");
}
using namespace cfg;

__device__ __forceinline__ float bf2f(bf16_t v) { return __uint_as_float(((unsigned)v) << 16); }
__device__ __forceinline__ bf16_t f2bf(float f) { unsigned u = __float_as_uint(f); u += 0x7fffu + ((u >> 16) & 1u); return (bf16_t)(u >> 16); }
__device__ __forceinline__ float wave_sum(float v) {
#pragma unroll
    for (int o = 1; o < 64; o <<= 1) v += __shfl_xor(v, o);
    return v;
}
__device__ __forceinline__ float logsig(float x) { return fminf(x, 0.f) - log1pf(__expf(-fabsf(x))); }
__device__ __forceinline__ float sigm(float x) { return 1.f / (1.f + __expf(-x)); }
__device__ __forceinline__ float silu(float x) { return x * sigm(x); }

__host__ __device__ __forceinline__ int zsrc(int n) {
    if (n < 512) return 1536 + n;
    if (n < 1024) return 3080 + (n - 512);
    if (n < 2048) return n - 1024;
    if (n < 2560) return 1024 + (n - 2048);
    if (n < 2816) return 2056 + (n - 2560);
    if (n < 3072) return 2312 + (n - 2816);
    if (n < 3584) return 2568 + (n - 3072);
    if (n < 3588) return 2048 + (n - 3584);
    if (n < 3592) return 2052 + (n - 3588);
    return n;
}

struct P {
    const float *x, *meta, *norm1_g, *w_in, *conv_w, *conv_b, *gate_b, *m_norm_g, *a_w2, *a_b, *g_norm_g, *w_out, *norm2_g, *wr_g, *br_g, *wr_e, *br_e, *w_gate, *w_up, *w_down, *final_g;
    float* out; unsigned char* ws;
    __device__ __forceinline__ bf16_t* Win() const { return (bf16_t*)(ws + WS_WIN); }
    __device__ __forceinline__ bf16_t* Wout() const { return (bf16_t*)(ws + WS_WOUT); }
    __device__ __forceinline__ bf16_t* Wgu() const { return (bf16_t*)(ws + WS_WGU); }
    __device__ __forceinline__ bf16_t* Wd() const { return (bf16_t*)(ws + WS_WD); }
    __device__ __forceinline__ float* Wr() const { return (float*)(ws + WS_WR); }
    __device__ __forceinline__ bf16_t* H() const { return (bf16_t*)(ws + WS_H); }
    __device__ __forceinline__ bf16_t* Z() const { return (bf16_t*)(ws + WS_Z); }
    __device__ __forceinline__ float* SS1() const { return (float*)(ws + WS_SS1); }
    __device__ __forceinline__ float* SS2() const { return (float*)(ws + WS_SS2); }
    __device__ __forceinline__ int* TokE() const { return (int*)(ws + WS_TOKE); }
    __device__ __forceinline__ float* TokW() const { return (float*)(ws + WS_TOKW); }
    __device__ __forceinline__ bf16_t* MC() const { return (bf16_t*)((unsigned char*)out + ST_MC); }
    __device__ __forceinline__ bf16_t* GS() const { return (bf16_t*)((unsigned char*)out + ST_GS); }
    __device__ __forceinline__ float* MN() const { return (float*)((unsigned char*)out + ST_MN); }
    __device__ __forceinline__ float* MSC() const { return (float*)((unsigned char*)out + ST_MSC); }
    __device__ __forceinline__ float* GB() const { return (float*)((unsigned char*)out + ST_GB); }
};

template <class F> __global__ void __launch_bounds__(256) k_transpose(F f) {
    __shared__ float t[32][33];
    const int n0 = blockIdx.x * 32, k0 = blockIdx.y * 32, bz = blockIdx.z, tx = threadIdx.x & 31, ty = threadIdx.x >> 5;
    for (int i = ty; i < 32; i += 8) t[i][tx] = f.load(bz, k0 + i, n0 + tx);
    __syncthreads();
    for (int i = ty; i < 32; i += 8) f.store(bz, n0 + i, k0 + tx, t[tx][i]);
}
struct TWin { const float* w; const float* g; bf16_t* o;
    __device__ float load(int l, int k, int n) const { return n < NIN ? w[((size_t)l * D + k) * NIN + zsrc(n)] * g[l * D + k] : 0.f; }
    __device__ void store(int l, int n, int k, float v) const { o[((size_t)l * NZP + n) * D + k] = f2bf(v); } };
struct TWout { const float* w; bf16_t* o;
    __device__ float load(int l, int k, int n) const { return w[((size_t)l * D + k) * D + n]; }
    __device__ void store(int l, int n, int k, float v) const { o[((size_t)l * D + n) * D + k] = f2bf(v); } };
struct TWgu { const float* wg; const float* wu; const float* g; bf16_t* o;
    __device__ float load(int bz, int k, int n) const { const int gq = n >> 5, i = n & 31, col = 16 * gq + (i & 15); const float* s = (i < 16) ? wg : wu;
        return s[((size_t)bz * D + k) * DE + col] * g[(bz >> 5) * D + k]; }
    __device__ void store(int bz, int n, int k, float v) const { o[((size_t)bz * 512 + n) * D + k] = f2bf(v); } };
struct TWd { const float* w; bf16_t* o;
    __device__ float load(int bz, int k, int n) const { return w[((size_t)bz * DE + k) * D + n]; }
    __device__ void store(int bz, int n, int k, float v) const { o[((size_t)bz * D + n) * DE + k] = f2bf(v); } };
__global__ void k_prep_wr(P p) {
    const int idx = blockIdx.x * 256 + threadIdx.x; if (idx >= DEPTH * NR * D) return;
    const int k = idx % D, o = (idx / D) % NR, l = idx / (D * NR);
    float v = 0.f;
    if (o < 4) v = p.wr_g[((size_t)l * D + k) * 4 + o]; else if (o < 36) v = p.wr_e[((size_t)l * D + k) * 32 + (o - 4)];
    p.Wr()[idx] = v * p.norm2_g[l * D + k];
}
__global__ void __launch_bounds__(256) k_prep_h(P p) {
    const int r = blockIdx.x * 4 + (threadIdx.x >> 6), lane = threadIdx.x & 63;
    const int b = r / TP, pp = r % TP;
    const float* src = nullptr;
    if (pp >= 64) src = p.x + ((size_t)b * SEQ + (pp - 64)) * D; else if (pp >= LEAD) src = p.meta + (size_t)(pp - LEAD) * D;
    float s = 0.f; bf16_t* hr = p.H() + (size_t)r * D;
#pragma unroll
    for (int j = 0; j < 4; ++j) { f32x4 v = {0.f, 0.f, 0.f, 0.f}; if (src) v = ((const f32x4*)src)[lane + 64 * j];
        s += v.x * v.x + v.y * v.y + v.z * v.z + v.w * v.w;
        ushort4 o; o.x = f2bf(v.x); o.y = f2bf(v.y); o.z = f2bf(v.z); o.w = f2bf(v.w); ((ushort4*)hr)[lane + 64 * j] = o; }
    s = wave_sum(s);
    if (lane == 0) { float* q = p.SS1() + (size_t)r * 4; q[0] = s; q[1] = 0.f; q[2] = 0.f; q[3] = 0.f; }
}
__device__ __forceinline__ float row_rs(const float* ss, int r) {
    if ((r % TP) < LEAD) return 0.f;
    const f32x4 v = *(const f32x4*)(ss + (size_t)r * 4);
    return rsqrtf((v.x + v.y + v.z + v.w) * (1.f / D) + EPS);
}
template <class Epi> __global__ void __launch_bounds__(256) k_gemm_ref(const bf16_t* A, int lda, const bf16_t* Bt, int K, int N, Epi E) {
    __shared__ __attribute__((aligned(16))) float As[32][68]; __shared__ __attribute__((aligned(16))) float Bs[32][68];
    const int tx = threadIdx.x & 15, ty = threadIdx.x >> 4, m0 = blockIdx.y * 64, n0 = blockIdx.x * 64;
    float acc[4][4];
#pragma unroll
    for (int i = 0; i < 4; ++i)
#pragma unroll
        for (int j = 0; j < 4; ++j) acc[i][j] = 0.f;
    for (int k0 = 0; k0 < K; k0 += 32) {
        for (int i = threadIdx.x; i < 2048; i += 256) { const int r = i >> 5, c = i & 31;
            As[c][r] = bf2f(A[(size_t)(m0 + r) * lda + k0 + c]);
            Bs[c][r] = (n0 + r < N) ? bf2f(Bt[(size_t)(n0 + r) * K + k0 + c]) : 0.f; }
        __syncthreads();
#pragma unroll 8
        for (int kk = 0; kk < 32; ++kk) { const f32x4 a = *(const f32x4*)&As[kk][ty * 4], b = *(const f32x4*)&Bs[kk][tx * 4];
            const float av[4] = {a.x, a.y, a.z, a.w}, bv[4] = {b.x, b.y, b.z, b.w};
#pragma unroll
            for (int i = 0; i < 4; ++i)
#pragma unroll
                for (int j = 0; j < 4; ++j) acc[i][j] += av[i] * bv[j]; }
        __syncthreads();
    }
#pragma unroll
    for (int i = 0; i < 4; ++i)
#pragma unroll
        for (int j = 0; j < 4; ++j) { const int r = m0 + ty * 4 + i, c = n0 + tx * 4 + j; if (c < N) E(r, c, acc[i][j]); }
}
struct EZ { bf16_t* z; const float* ss; __device__ void operator()(int r, int c, float v) const { z[(size_t)r * NIN + c] = f2bf(v * row_rs(ss, r)); } };
struct EO { bf16_t* h; __device__ void operator()(int r, int c, float v) const { bf16_t* q = h + (size_t)r * D + c; *q = f2bf(bf2f(*q) + v); } };
__global__ void __launch_bounds__(256) k_rowss(const bf16_t* h, float* ss) {
    const int r = blockIdx.x * 4 + (threadIdx.x >> 6), lane = threadIdx.x & 63; float s = 0.f;
    for (int j = lane; j < D; j += 64) { const float v = bf2f(h[(size_t)r * D + j]); s += v * v; }
    s = wave_sum(s); if (lane == 0) { float* q = ss + (size_t)r * 4; q[0] = s; q[1] = 0.f; q[2] = 0.f; q[3] = 0.f; }
}

__device__ __forceinline__ float conv_qk(const P& p, int l, const bf16_t* z, int r0, int c, int s, int zcol, int cch) {
    float acc = p.conv_b[l * D + cch];
#pragma unroll
    for (int j = 0; j < 4; ++j) { const int pp = c * 64 + s - 3 + j; if (pp >= LEAD) acc += p.conv_w[(l * 4 + j) * D + cch] * bf2f(z[(size_t)(r0 + s - 3 + j) * NIN + zcol]); }
    return silu(acc);
}
__global__ void __launch_bounds__(256) k_mix_local_ref(P p, int l) {
    extern __shared__ float sm[];
    const int tid = threadIdx.x, type = blockIdx.x / NU, u = blockIdx.x % NU, c = u % NCH, hd = (u / NCH) & 3, b = u / (NCH * 4);
    const int r0 = b * TP + c * 64; const bf16_t* z = p.Z();
    if (type == 0) {
        float* ks = sm; float* vs = ks + 64 * 129; float* wv = vs + 64 * 129; float* lfs = wv + 64; float* igs = lfs + 64;
        if (tid < 64) { const int s = tid; const bool valid = (c > 0) || (s >= LEAD); const size_t zr = (size_t)(r0 + s) * NIN;
            lfs[s] = valid ? logsig(bf2f(z[zr + ZO_FG + hd]) + p.gate_b[(l * 2 + 1) * 4 + hd]) : 0.f;
            igs[s] = valid ? bf2f(z[zr + ZO_IG + hd]) + p.gate_b[(l * 2 + 0) * 4 + hd] : -INFINITY; }
        for (int i = tid; i < 64 * 128; i += 256) { const int s = i >> 7, ch = i & 127; const bool valid = (c > 0) || (s >= LEAD);
            ks[s * 129 + ch] = valid ? conv_qk(p, l, z, r0, c, s, ZO_KM + hd * 128 + ch, 512 + hd * 128 + ch) * 0.08838834764831845f : 0.f;
            vs[s * 129 + ch] = valid ? bf2f(z[(size_t)(r0 + s) * NIN + ZO_VM + hd * 128 + ch]) : 0.f; }
        __syncthreads();
        if (tid == 0) { float run = 0.f; for (int s = 0; s < 64; ++s) { run += lfs[s]; lfs[s] = run; }
            const float be = run; float mg = -INFINITY; for (int s = 0; s < 64; ++s) { const float g = be - lfs[s] + igs[s]; igs[s] = g; mg = fmaxf(mg, g); }
            for (int s = 0; s < 64; ++s) wv[s] = __expf(igs[s] - mg);
            float* sc = p.MSC() + (size_t)u * 4; sc[0] = mg; sc[1] = be; }
        __syncthreads();
        bf16_t* Cd = p.MC() + (size_t)u * 16384; const int k = tid & 127;
        for (int i = 0; i < 64; ++i) { const int v = (tid >> 7) + 2 * i; float a = 0.f;
            for (int s = 0; s < 64; ++s) a += wv[s] * vs[s * 129 + v] * ks[s * 129 + k];
            Cd[v * 128 + k] = f2bf(a); }
        if (tid < 128) { float a = 0.f; for (int s = 0; s < 64; ++s) a += wv[s] * ks[s * 129 + tid]; p.MN()[(size_t)u * 128 + tid] = a; }
    } else {
        float* kh = sm; float* vs = kh + 64 * 65; float* bs = vs + 64 * 129; float* cod = bs + 64 * 65;
        for (int i = tid; i < 64 * 16; i += 256) { const int s = i >> 4, q = i & 15; cod[i] = bf2f(z[(size_t)(r0 + s) * NIN + ZO_CODE + q]); }
        __syncthreads();
        for (int i = tid; i < 64 * 64; i += 256) { const int s = i >> 6, j = i & 63; const bool valid = (c > 0) || (s >= LEAD);
            float a = p.a_b[l * 256 + hd * 64 + j];
#pragma unroll
            for (int q = 0; q < 16; ++q) a += cod[s * 16 + q] * p.a_w2[(l * 16 + q) * 256 + hd * 64 + j];
            bs[s * 65 + j] = valid ? logsig(a) * (1.f / 16.f) : 0.f; }
        for (int i = tid; i < 64 * 128; i += 256) { const int s = i >> 7, d = i & 127; const bool valid = (c > 0) || (s >= LEAD);
            vs[s * 129 + d] = valid ? bf2f(z[(size_t)(r0 + s) * NIN + ZO_VG + hd * 128 + d]) : 0.f; }
        __syncthreads();
        if (tid < 64) { float run = 0.f; for (int s = 0; s < 64; ++s) { run += bs[s * 65 + tid]; bs[s * 65 + tid] = run; } p.GB()[(size_t)u * 64 + tid] = run; }
        __syncthreads();
        for (int i = tid; i < 64 * 64; i += 256) { const int s = i >> 6, j = i & 63; const bool valid = (c > 0) || (s >= LEAD);
            kh[s * 65 + j] = valid ? bf2f(z[(size_t)(r0 + s) * NIN + ZO_KG + hd * 64 + j]) * __expf(bs[63 * 65 + j] - bs[s * 65 + j]) : 0.f; }
        __syncthreads();
        bf16_t* Sd = p.GS() + (size_t)u * 8192; const int j = tid & 63;
        for (int i = 0; i < 32; ++i) { const int d = (tid >> 6) + 4 * i; float a = 0.f;
            for (int s = 0; s < 64; ++s) a += vs[s * 129 + d] * kh[s * 65 + j];
            Sd[d * 64 + j] = f2bf(a); }
    }
}
__global__ void __launch_bounds__(256) k_scan_ref(P p) {
    const int nbm = 16 * 65;
    if ((int)blockIdx.x < nbm) {
        const int bh = blockIdx.x / 65, e = (blockIdx.x % 65) * 256 + threadIdx.x; if (e >= 16384 + 128) return;
        float m = 0.f, C = 0.f;
        for (int c = 0; c < NCH; ++c) { const size_t u = (size_t)bh * NCH + c; float* sc = p.MSC() + u * 4; const float mg = sc[0], be = sc[1];
            float dl;
            if (e < 16384) { bf16_t* q = p.MC() + u * 16384 + e; dl = bf2f(*q); *q = f2bf(C); } else { float* q = p.MN() + u * 128 + (e - 16384); dl = *q; *q = C; }
            if (e == 0) sc[2] = m;
            const float mn = fmaxf(be + m, mg), dec = __expf(be + m - mn), wg = __expf(mg - mn);
            C = dec * C + wg * dl; m = mn; }
    } else {
        const int bi = blockIdx.x - nbm, bh = bi / 32, e = (bi % 32) * 256 + threadIdx.x, j = e & 63;
        float S = 0.f;
        for (int c = 0; c < NCH; ++c) { const size_t u = (size_t)bh * NCH + c; bf16_t* q = p.GS() + u * 8192 + e; const float dl = bf2f(*q); *q = f2bf(S);
            S = S * __expf(p.GB()[u * 64 + j]) + dl; }
    }
}
__global__ void __launch_bounds__(256) k_mix_out_ref(P p, int l) {
    extern __shared__ float sm[];
    const int tid = threadIdx.x, type = blockIdx.x / NU, u = blockIdx.x % NU, c = u % NCH, hd = (u / NCH) & 3, b = u / (NCH * 4);
    const int r0 = b * TP + c * 64; bf16_t* z = p.Z();
    if (type == 0) {
        float* qs = sm; float* ks = qs + 64 * 129; float* vs = ks + 64 * 129; float* Ss = vs + 64 * 129; float* bb = Ss + 64 * 65; float* igs = bb + 64; float* mt = igs + 64; float* wi = mt + 64; float* den = wi + 64; float* hn = den + 64;
        if (tid < 64) { const int s = tid; const bool valid = (c > 0) || (s >= LEAD); const size_t zr = (size_t)(r0 + s) * NIN;
            bb[s] = valid ? logsig(bf2f(z[zr + ZO_FG + hd]) + p.gate_b[(l * 2 + 1) * 4 + hd]) : 0.f;
            igs[s] = valid ? bf2f(z[zr + ZO_IG + hd]) + p.gate_b[(l * 2 + 0) * 4 + hd] : -INFINITY; }
        for (int i = tid; i < 64 * 128; i += 256) { const int s = i >> 7, ch = i & 127; const bool valid = (c > 0) || (s >= LEAD);
            qs[s * 129 + ch] = valid ? conv_qk(p, l, z, r0, c, s, ZO_QM + hd * 128 + ch, hd * 128 + ch) : 0.f;
            ks[s * 129 + ch] = valid ? conv_qk(p, l, z, r0, c, s, ZO_KM + hd * 128 + ch, 512 + hd * 128 + ch) * 0.08838834764831845f : 0.f;
            vs[s * 129 + ch] = valid ? bf2f(z[(size_t)(r0 + s) * NIN + ZO_VM + hd * 128 + ch]) : 0.f; }
        __syncthreads();
        if (tid == 0) { float run = 0.f; for (int s = 0; s < 64; ++s) { run += bb[s]; bb[s] = run; } }
        for (int i = tid; i < 4096; i += 256) { const int t = i >> 6, s = i & 63; float a = 0.f;
            for (int d = 0; d < 128; ++d) a += qs[t * 129 + d] * ks[s * 129 + d];
            Ss[t * 65 + s] = a; }
        __syncthreads();
        const float m0 = p.MSC()[(size_t)u * 4 + 2];
        if (tid < 64) { const int t = tid; float dmax = -INFINITY;
            for (int s = 0; s <= t; ++s) dmax = fmaxf(dmax, bb[t] - bb[s] + igs[s]);
            const float mint = bb[t] + m0, m = fmaxf(mint, dmax), w = __expf(mint - m); float dsum = 0.f;
            for (int s = 0; s < 64; ++s) { const float v = (s <= t) ? Ss[t * 65 + s] * __expf(bb[t] - bb[s] + igs[s] - m) : 0.f; Ss[t * 65 + s] = v; dsum += v; }
            float nq = 0.f; const float* nn = p.MN() + (size_t)u * 128;
            for (int k = 0; k < 128; ++k) nq += nn[k] * qs[t * 129 + k];
            mt[t] = m; wi[t] = w; den[t] = dsum + w * nq; }
        __syncthreads();
        { const int v = tid & 127; const bf16_t* Cr = p.MC() + (size_t)u * 16384 + v * 128;
          for (int i = 0; i < 32; ++i) { const int t = (tid >> 7) + 2 * i; float a = 0.f, cq = 0.f;
              for (int s = 0; s < 64; ++s) a += Ss[t * 65 + s] * vs[s * 129 + v];
              for (int k = 0; k < 128; ++k) cq += bf2f(Cr[k]) * qs[t * 129 + k];
              ks[t * 129 + v] = (a + wi[t] * cq) / fmaxf(fabsf(den[t]), __expf(-mt[t])); } }
        __syncthreads();
        if (tid < 64) { float s2 = 0.f; for (int v = 0; v < 128; ++v) { const float x = ks[tid * 129 + v]; s2 += x * x; } hn[tid] = rsqrtf(s2 * (1.f / 128.f) + EPS); }
        __syncthreads();
        for (int i = tid; i < 64 * 128; i += 256) { const int s = i >> 7, v = i & 127; const bool valid = (c > 0) || (s >= LEAD);
            const bf16_t* q = z + (size_t)(r0 + s) * NIN + ZO_OM + hd * 128 + v;
            const float y = ks[s * 129 + v] * hn[s] * p.m_norm_g[l * 512 + hd * 128 + v] * sigm(bf2f(*q));
            p.Z()[(size_t)(r0 + s) * NIN + ZO_OM + hd * 128 + v] = f2bf(valid ? y : 0.f); }
    } else {
        float* qt = sm; float* kt = qt + 64 * 65; float* vs = kt + 64 * 65; float* As = vs + 64 * 129; float* bs = As + 64 * 65; float* cod = bs + 64 * 65; float* ob = cod + 64 * 16; float* hn = ob + 64 * 129;
        for (int i = tid; i < 64 * 16; i += 256) { const int s = i >> 4, q = i & 15; cod[i] = bf2f(z[(size_t)(r0 + s) * NIN + ZO_CODE + q]); }
        __syncthreads();
        for (int i = tid; i < 64 * 64; i += 256) { const int s = i >> 6, j = i & 63; const bool valid = (c > 0) || (s >= LEAD);
            float a = p.a_b[l * 256 + hd * 64 + j];
#pragma unroll
            for (int q = 0; q < 16; ++q) a += cod[s * 16 + q] * p.a_w2[(l * 16 + q) * 256 + hd * 64 + j];
            bs[s * 65 + j] = valid ? logsig(a) * (1.f / 16.f) : 0.f; }
        for (int i = tid; i < 64 * 128; i += 256) { const int s = i >> 7, d = i & 127; const bool valid = (c > 0) || (s >= LEAD);
            vs[s * 129 + d] = valid ? bf2f(z[(size_t)(r0 + s) * NIN + ZO_VG + hd * 128 + d]) : 0.f; }
        __syncthreads();
        if (tid < 64) { float run = 0.f; for (int s = 0; s < 64; ++s) { run += bs[s * 65 + tid]; bs[s * 65 + tid] = run; } }
        __syncthreads();
        for (int i = tid; i < 64 * 64; i += 256) { const int s = i >> 6, j = i & 63; const bool valid = (c > 0) || (s >= LEAD); const size_t zr = (size_t)(r0 + s) * NIN;
            qt[s * 65 + j] = valid ? bf2f(z[zr + ZO_QG + hd * 64 + j]) * 0.125f * __expf(bs[s * 65 + j]) : 0.f;
            kt[s * 65 + j] = valid ? bf2f(z[zr + ZO_KG + hd * 64 + j]) * __expf(-bs[s * 65 + j]) : 0.f; }
        __syncthreads();
        for (int i = tid; i < 4096; i += 256) { const int t = i >> 6, s = i & 63; float a = 0.f;
            if (s <= t) for (int j = 0; j < 64; ++j) a += qt[t * 65 + j] * kt[s * 65 + j];
            As[t * 65 + s] = a; }
        __syncthreads();
        { const int d = tid & 127; const bf16_t* Sr = p.GS() + (size_t)u * 8192 + d * 64;
          for (int i = 0; i < 32; ++i) { const int t = (tid >> 7) + 2 * i; float a = 0.f;
              for (int s = 0; s < 64; ++s) a += As[t * 65 + s] * vs[s * 129 + d];
              for (int j = 0; j < 64; ++j) a += qt[t * 65 + j] * bf2f(Sr[j]);
              ob[t * 129 + d] = a; } }
        __syncthreads();
        if (tid < 64) { float s2 = 0.f; for (int d = 0; d < 128; ++d) { const float x = ob[tid * 129 + d]; s2 += x * x; } hn[tid] = rsqrtf(s2 * (1.f / 128.f) + EPS); }
        __syncthreads();
        for (int i = tid; i < 64 * 128; i += 256) { const int s = i >> 7, d = i & 127; const bool valid = (c > 0) || (s >= LEAD);
            const bf16_t* q = z + (size_t)(r0 + s) * NIN + ZO_GG + hd * 128 + d;
            const float y = ob[s * 129 + d] * hn[s] * p.g_norm_g[l * 512 + hd * 128 + d] * silu(bf2f(*q));
            p.Z()[(size_t)(r0 + s) * NIN + ZO_GG + hd * 128 + d] = f2bf(valid ? y : 0.f); }
    }
}
__global__ void __launch_bounds__(256) k_route_ref(P p, int l) {
    __shared__ float lg[4][40];
    const int w = threadIdx.x >> 6, lane = threadIdx.x & 63, r = blockIdx.x * 4 + w;
    int* tokE = p.TokE(); float* tokW = p.TokW();
    if ((r % TP) < LEAD) { if (lane == 0) { tokE[r * 2] = -1; tokE[r * 2 + 1] = -1; tokW[r * 2] = 0.f; tokW[r * 2 + 1] = 0.f; } return; }
    const float rs = row_rs(p.SS2(), r); float xv[16];
#pragma unroll
    for (int i = 0; i < 16; ++i) xv[i] = bf2f(p.H()[(size_t)r * D + lane * 16 + i]) * rs;
    const float* W = p.Wr() + (size_t)l * NR * D;
    for (int o = 0; o < 36; ++o) { float a = 0.f;
#pragma unroll
        for (int i = 0; i < 16; ++i) a += xv[i] * W[o * D + lane * 16 + i];
        a = wave_sum(a); if (lane == 0) lg[w][o] = a + (o < 4 ? p.br_g[l * 4 + o] : p.br_e[l * 32 + o - 4]); }
    if (lane == 0) {
        int g = 0; float gm = lg[w][0];
        for (int i = 1; i < 4; ++i) if (lg[w][i] > gm) { gm = lg[w][i]; g = i; }
        float se = 0.f; for (int i = 0; i < 4; ++i) se += __expf(lg[w][i] - gm);
        const float psel = 1.f / se;
        int i0 = 0; float v0 = lg[w][4 + g * 8];
        for (int i = 1; i < 8; ++i) if (lg[w][4 + g * 8 + i] > v0) { v0 = lg[w][4 + g * 8 + i]; i0 = i; }
        int i1 = -1; float v1 = -INFINITY;
        for (int i = 0; i < 8; ++i) if (i != i0 && lg[w][4 + g * 8 + i] > v1) { v1 = lg[w][4 + g * 8 + i]; i1 = i; }
        const float w0 = 1.f / (1.f + __expf(v1 - v0));
        tokE[r * 2] = g * 8 + i0; tokE[r * 2 + 1] = g * 8 + i1; tokW[r * 2] = w0 * psel; tokW[r * 2 + 1] = (1.f - w0) * psel;
    }
}
__global__ void __launch_bounds__(256) k_moe_ref(P p, int l) {
    __shared__ float xn[1024], pre[512], hid[256], outv[1024], red[4];
    const int r = blockIdx.x, tid = threadIdx.x, w = tid >> 6, lane = tid & 63;
    if ((r % TP) < LEAD) return;
    const float rs = row_rs(p.SS2(), r); bf16_t* hr = p.H() + (size_t)r * D;
    for (int i = tid; i < D; i += 256) { xn[i] = bf2f(hr[i]) * rs; outv[i] = 0.f; }
    __syncthreads();
    for (int rank = 0; rank < 2; ++rank) {
        const int e = p.TokE()[r * 2 + rank]; const float gw = p.TokW()[r * 2 + rank];
        const bf16_t* Wg = p.Wgu() + ((size_t)(l * NE + e) * 512) * D;
        for (int row = w; row < 512; row += 4) { float a = 0.f;
            for (int k = lane; k < D; k += 64) a += bf2f(Wg[(size_t)row * D + k]) * xn[k];
            a = wave_sum(a); if (lane == 0) pre[row] = a; }
        __syncthreads();
        { const int j = tid, gq = j >> 4, i = j & 15; hid[j] = silu(pre[32 * gq + i]) * pre[32 * gq + 16 + i]; }
        __syncthreads();
        const bf16_t* Wd = p.Wd() + ((size_t)(l * NE + e) * D) * DE;
        for (int n = w; n < D; n += 4) { float a = 0.f;
            for (int k = lane; k < DE; k += 64) a += bf2f(Wd[(size_t)n * DE + k]) * hid[k];
            a = wave_sum(a); if (lane == 0) outv[n] += gw * a; }
        __syncthreads();
    }
    float s = 0.f;
    for (int i = tid; i < D; i += 256) { const float v = bf2f(hr[i]) + outv[i]; hr[i] = f2bf(v); s += v * v; }
    s = wave_sum(s); if (lane == 0) red[w] = s;
    __syncthreads();
    if (tid == 0) { float* q = p.SS1() + (size_t)r * 4; q[0] = red[0] + red[1] + red[2] + red[3]; q[1] = 0.f; q[2] = 0.f; q[3] = 0.f; }
}
__global__ void __launch_bounds__(256) k_final_ref(P p) {
    const int t = blockIdx.x * 4 + (threadIdx.x >> 6), lane = threadIdx.x & 63, b = t / SEQ, s = t % SEQ, r = b * TP + 64 + s;
    const float rs = row_rs(p.SS1(), r); const bf16_t* hr = p.H() + (size_t)r * D; float* o = p.out + (size_t)t * D;
#pragma unroll
    for (int j = 0; j < 4; ++j) { const ushort4 hv = ((const ushort4*)hr)[lane + 64 * j]; const f32x4 g = ((const f32x4*)p.final_g)[lane + 64 * j];
        f32x4 v; v.x = bf2f(hv.x) * rs * g.x; v.y = bf2f(hv.y) * rs * g.y; v.z = bf2f(hv.z) * rs * g.z; v.w = bf2f(hv.w) * rs * g.w;
        ((f32x4*)o)[lane + 64 * j] = v; }
}

#define LAS __attribute__((address_space(3)))
constexpr int NWAVES = 8, NTHR = 512;
constexpr int RING_OFF = 0, RING_BYTES = 131072, TAB_OFF = 131072, TAB_BYTES = 24576, MISC_OFF = TAB_OFF + TAB_BYTES, LDS_BYTES = MISC_OFF + 512;
constexpr int RED_OFF = TAB_OFF + 4096;
constexpr int UROW_OFF = TAB_OFF + 8192;
constexpr int CW_BAR = 4096, CW_CNT = 16384;
constexpr int PH_PRO = 0, PH_LAYER0 = 1, PH_PER_LAYER = 9, PH_FINAL = 1 + 9 * DEPTH, PH_COUNT = PH_FINAL + 1;

#define XB_TMO      128
#define XB_XCNT(j)  (256  + 64 * (j))
#define XB_XSUB(j)  (1280 + 64 * (j))
#define XB_XGEN(j)  (2304 + 64 * (j))
#define XB_TOP      3328
#define XB_TOPGEN   3392
#define XCD_BAR_WORDS 3456
#define XB_SPIN_CAP (1u << 18)
__device__ __forceinline__ unsigned xb_ld(unsigned* p)              { return __hip_atomic_load(p, __ATOMIC_RELAXED, __HIP_MEMORY_SCOPE_AGENT); }
__device__ __forceinline__ unsigned xb_add(unsigned* p, unsigned v) { return __hip_atomic_fetch_add(p, v, __ATOMIC_RELAXED, __HIP_MEMORY_SCOPE_AGENT); }
__device__ __forceinline__ unsigned xb_xcc_id() { return (unsigned)__builtin_amdgcn_s_getreg((3 << 11) | 20) & 0xFu; }
#define XB_SPIN(cond, bar) do { unsigned _sp = 0; while (cond) { __builtin_amdgcn_s_sleep(1); \
    if ((++_sp & 255u) == 0u) { if (xb_ld(&(bar)[XB_TMO])) break; if (_sp > XB_SPIN_CAP) { atomicAdd(&(bar)[XB_TMO], 1u); break; } } } } while (0)
struct XcdBarrier { unsigned* bar; unsigned x; volatile LAS unsigned* st; };
__device__ __forceinline__ XcdBarrier xcd_barrier_post(unsigned* bar, volatile LAS unsigned* st) {
    XcdBarrier b; b.bar = bar; b.x = xb_xcc_id(); b.st = st;
    if (threadIdx.x == 0) (void)xb_add(&bar[XB_XCNT(b.x)], 1u);
    return b;
}
__device__ __forceinline__ void xcd_barrier_complete(unsigned* bar, unsigned x, unsigned& nloc, unsigned& nx) {
    const unsigned G = gridDim.x * gridDim.y * gridDim.z;
    unsigned sum, cnt, mine, sp = 0u;
    for (;;) {
        sum = 0u; cnt = 0u; mine = 0u;
#pragma unroll
        for (unsigned j = 0; j < 16; ++j) { const unsigned c = xb_ld(&bar[XB_XCNT(j)]); sum += c; cnt += (c > 0u) ? 1u : 0u; mine = (j == x) ? c : mine; }
        if (sum == G) break;
        __builtin_amdgcn_s_sleep(1);
        if ((++sp & 255u) == 0u) { if (xb_ld(&bar[XB_TMO])) break; if (sp > XB_SPIN_CAP) { atomicAdd(&bar[XB_TMO], 1u); break; } }
    }
    nloc = mine > 0u ? mine : 1u; nx = cnt > 0u ? cnt : 1u;
}
__device__ __forceinline__ void xcd_barrier(const XcdBarrier& b) {
    asm volatile("s_waitcnt vmcnt(0)" ::: "memory");
    __syncthreads();
    if (threadIdx.x == 0) {
        unsigned* bar = b.bar;
        __builtin_amdgcn_s_waitcnt(0);
        unsigned nloc = b.st[0], nx = b.st[1];
        if (nloc == 0u) { xcd_barrier_complete(bar, b.x, nloc, nx); b.st[0] = nloc; b.st[1] = nx; }
        const unsigned old = xb_add(&bar[XB_XSUB(b.x)], 1u);
        const unsigned gen = old / nloc;
        if (old + 1u == (gen + 1u) * nloc) {
            __builtin_amdgcn_fence(__ATOMIC_RELEASE, "agent");
            asm volatile("s_waitcnt vmcnt(0)" ::: "memory");
            const unsigned og = xb_add(&bar[XB_TOP], 1u);
            const unsigned tg = og / nx;
            if (og + 1u == (tg + 1u) * nx) xb_add(&bar[XB_TOPGEN], 1u);
            else XB_SPIN(xb_ld(&bar[XB_TOPGEN]) == tg, bar);
            __builtin_amdgcn_fence(__ATOMIC_ACQUIRE, "agent");
            xb_add(&bar[XB_XGEN(b.x)], 1u);
            asm volatile("s_waitcnt vmcnt(0)" ::: "memory");
        } else {
            XB_SPIN(xb_ld(&bar[XB_XGEN(b.x)]) == gen, bar);
            __builtin_amdgcn_fence(__ATOMIC_ACQUIRE, "agent");
            asm volatile("s_waitcnt vmcnt(0)" ::: "memory");
        }
    }
    __syncthreads();
}

namespace pg8 {
typedef short bf16x8 __attribute__((ext_vector_type(8)));
typedef unsigned u32x4 __attribute__((ext_vector_type(4)));
typedef unsigned u32x2 __attribute__((ext_vector_type(2)));
constexpr int BM = 256, BK = 64, HALF = 128, HTB = HALF * BK * 2, STAGE_BYTES = 8 * HTB, NXCD = 8, WGM = 8;
__host__ __device__ __forceinline__ int lds_byte(int r, int c) { const int st = (r >> 4) * 2 + (c >> 5), rr = r & 15, cc = c & 31, ob = rr * 64 + cc * 2; return st * 1024 + (ob ^ (((ob >> 9) & 1) << 5)); }
__host__ __device__ __forceinline__ void stage_rc(int b, int& R, int& C) { const int st = b / 1024, sb = b % 1024, swz = sb ^ (((sb >> 9) & 1) << 5); R = (st >> 1) * 16 + swz / 64; C = (st & 1) * 32 + (swz % 64) / 2; }
__host__ __device__ __forceinline__ int perm32(int rho) { const int n = rho >> 4, i = rho & 15; return 8 * (i >> 2) + 4 * n + (i & 3); }
typedef float f32x2_ __attribute__((ext_vector_type(2))); typedef __bf16 bf16x2_ __attribute__((ext_vector_type(2)));
__device__ __forceinline__ unsigned cvt_pk_bf16(float lo, float hi) { const f32x2_ v = {lo, hi}; return __builtin_bit_cast(unsigned, __builtin_convertvector(v, bf16x2_)); }
__device__ __forceinline__ float bflo(unsigned w) { return __uint_as_float(w << 16); }
__device__ __forceinline__ float bfhi(unsigned w) { return __uint_as_float(w & 0xffff0000u); }

struct Unit { int pm, pn; unsigned ao, bo; };

__device__ __forceinline__ int xcd_remap(int L, int nwg) { const int q = nwg / NXCD, r = nwg % NXCD, xcd = L % NXCD, off = L / NXCD; return (xcd < r ? xcd * (q + 1) : r * (q + 1) + (xcd - r) * q) + off; }

template <int LDA, int K> struct DenseOrder {
    static constexpr bool GATHER = false, LIST = false;
    int nM, nN, nwg, G, c;
    __device__ __forceinline__ void init(int M, int N, int G_, int c_) { nM = M / BM; nN = N / BM; nwg = nM * nN; G = G_; c = c_; }
    __device__ __forceinline__ bool next(int i, Unit& u, int, int) const {
        const int L = i * G + c; if (L >= nwg) return false;
        const int wgid = xcd_remap(L, nwg);
        const int nig = WGM * nN, gid = wgid / nig, fm = gid * WGM, gsz = (nM - fm) < WGM ? (nM - fm) : WGM;
        u.pm = fm + ((wgid % nig) % gsz); u.pn = (wgid % nig) / gsz; u.ao = (unsigned)u.pm * (unsigned)(BM * LDA * 2); u.bo = (unsigned)u.pn * (unsigned)(BM * K * 2); return true;
    }
    __device__ __forceinline__ unsigned aoff(int, int rowl, int C) const { return (unsigned)(rowl * LDA + C) * 2u; }
};

template <class Epi, class Sched, bool ALIGN_EPI, int LDA, int K>
__device__ __forceinline__ void gemm_phase(LAS unsigned char* lds, const char* Abase, const char* Bbase, const Sched& S, const Epi& E) {
    int tid_ = threadIdx.x; asm volatile("" : "+v"(tid_));
    const int tid = tid_, wid = __builtin_amdgcn_readfirstlane(tid >> 6), lane = tid & 63, wr = wid >> 2, wc = wid & 3, fr = lane & 15, fq = lane >> 4;
    constexpr int nt = K / BK;
    int Rr[2], Cc[2]; unsigned voffB[2];
#pragma unroll
    for (int i = 0; i < 2; ++i) { stage_rc(tid * 16 + i * 8192, Rr[i], Cc[i]); const int Rb = Epi::PERM ? ((Rr[i] & ~31) + perm32(Rr[i] & 31)) : Rr[i]; voffB[i] = (unsigned)(Rb * K + Cc[i]) * 2u; }
    constexpr unsigned kstep = BK * 2, hstepB = HALF * K * 2;
    const unsigned ldsw = (unsigned)wid * 1024u;
    const int aoff = lds_byte(wr * 64 + fr, fq * 8), boff = lds_byte(wc * 32 + fr, fq * 8);
#define PG8_SA(b, h) (((b) * 2 + (h)) * HTB)
#define PG8_SB(b, h) ((4 + (b) * 2 + (h)) * HTB)
#define PG8_STAGE(bufoff, gbase, uoff, voff) do { _Pragma("unroll") for (int _i = 0; _i < 2; ++_i) \
        __builtin_amdgcn_global_load_lds((const unsigned*)((gbase) + (size_t)(unsigned)((uoff) + (voff)[_i])), (LAS unsigned*)(lds + (bufoff) + ldsw + _i * 8192), 16, 0, 0); } while (0)
#define PG8_LDA(dst, b, h) do { _Pragma("unroll") for (int m = 0; m < 4; ++m) _Pragma("unroll") for (int k = 0; k < 2; ++k) dst[m][k] = *(const LAS bf16x8*)(lds + PG8_SA(b, h) + aoff + m * 2048 + k * 1024); } while (0)
#define PG8_LDB(dst, b, h) do { _Pragma("unroll") for (int n = 0; n < 2; ++n) _Pragma("unroll") for (int k = 0; k < 2; ++k) dst[n][k] = *(const LAS bf16x8*)(lds + PG8_SB(b, h) + boff + n * 2048 + k * 1024); } while (0)
#define PG8_MMA(ai, bj, At, Bt) do { __builtin_amdgcn_s_setprio(1); _Pragma("unroll") for (int m = 0; m < 4; ++m) _Pragma("unroll") for (int n = 0; n < 2; ++n) _Pragma("unroll") for (int k = 0; k < 2; ++k) \
        acc[ai][bj][m][n] = __builtin_amdgcn_mfma_f32_16x16x32_bf16(Bt[n][k], At[m][k], acc[ai][bj][m][n], 0, 0, 0); __builtin_amdgcn_s_setprio(0); } while (0)
#define PG8_WAIT_V(n) asm volatile("s_waitcnt vmcnt(" #n ")" ::: "memory")
#define PG8_WAIT_L(n) asm volatile("s_waitcnt lgkmcnt(" #n ")" ::: "memory")
#define PG8_BAR __builtin_amdgcn_s_barrier()
#define PG8_SCHED __builtin_amdgcn_sched_barrier(0)
    Unit cur, nxt; int ui = 0, ub = 0;
    if (!S.next(0, cur, 0, tid)) return;
    if constexpr (Sched::LIST) { asm volatile("s_waitcnt lgkmcnt(0)" ::: "memory"); __builtin_amdgcn_s_barrier(); asm volatile("" ::: "memory"); }
    unsigned voffA[2][2];
#pragma unroll
    for (int h = 0; h < 2; ++h)
#pragma unroll
        for (int i = 0; i < 2; ++i) voffA[h][i] = S.aoff(0, h * HALF + Rr[i], Cc[i]);
    f32x4 acc[2][2][4][2];
#pragma unroll
    for (int a = 0; a < 2; ++a)
#pragma unroll
        for (int b = 0; b < 2; ++b)
#pragma unroll
            for (int m = 0; m < 4; ++m)
#pragma unroll
                for (int n = 0; n < 2; ++n) acc[a][b][m][n] = (f32x4){0.f, 0.f, 0.f, 0.f};
    bf16x8 At[4][2], B0[2][2], B1[2][2];
    unsigned cA = cur.ao, cB = cur.bo;
    PG8_STAGE(PG8_SB(0, 0), Bbase, cB, voffB); PG8_STAGE(PG8_SB(0, 1), Bbase, cB + hstepB, voffB); PG8_STAGE(PG8_SA(0, 0), Abase, cA, voffA[0]); PG8_STAGE(PG8_SA(0, 1), Abase, cA, voffA[1]);
    if (wr == 1) PG8_BAR;
    PG8_WAIT_V(2); PG8_BAR;
    PG8_STAGE(PG8_SB(1, 0), Bbase, cB + kstep, voffB); PG8_STAGE(PG8_SA(1, 0), Abase, cA + kstep, voffA[0]); PG8_STAGE(PG8_SB(1, 1), Bbase, cB + hstepB + kstep, voffB);
    PG8_WAIT_V(6); PG8_BAR;
    for (;;) {
        const int nub = (ub == 2) ? 0 : ub + 1;
        const bool has_next = S.next(ui + 1, nxt, nub, tid);
        const unsigned nA = has_next ? nxt.ao : cA, nB = has_next ? nxt.bo : cB;
#pragma unroll 1
        for (int t = 0; t < nt; t += 2) {
            const bool last = (t == nt - 2);
            const unsigned a1 = cA + (unsigned)(t + 1) * kstep;
            const unsigned a2 = last ? nA : cA + (unsigned)(t + 2) * kstep, b2 = last ? nB : cB + (unsigned)(t + 2) * kstep;
            const unsigned a3 = a2 + kstep, b3 = b2 + kstep;
            PG8_LDB(B0, 0, 0); PG8_LDB(B1, 0, 1); PG8_SCHED; PG8_LDA(At, 0, 0); PG8_STAGE(PG8_SA(1, 1), Abase, a1, voffA[1]);
            if constexpr (Sched::GATHER) { if (last && has_next) {
#pragma unroll
                for (int h = 0; h < 2; ++h)
#pragma unroll
                    for (int i = 0; i < 2; ++i) voffA[h][i] = S.aoff(nub, h * HALF + Rr[i], Cc[i]); } }
            PG8_WAIT_V(8); PG8_WAIT_L(0); PG8_BAR; PG8_MMA(0, 0, At, B0); PG8_MMA(0, 1, At, B1); PG8_BAR; PG8_SCHED;
            PG8_LDA(At, 0, 1); PG8_STAGE(PG8_SB(0, 0), Bbase, b2, voffB); PG8_STAGE(PG8_SB(0, 1), Bbase, b2 + hstepB, voffB); PG8_STAGE(PG8_SA(0, 0), Abase, a2, voffA[0]);
            PG8_WAIT_V(8); PG8_WAIT_L(0); PG8_BAR; PG8_MMA(1, 0, At, B0); PG8_MMA(1, 1, At, B1); PG8_BAR; PG8_SCHED;
            PG8_LDB(B0, 1, 0); PG8_LDB(B1, 1, 1); PG8_SCHED; PG8_LDA(At, 1, 0); PG8_STAGE(PG8_SA(0, 1), Abase, a2, voffA[1]);
            PG8_WAIT_V(8); PG8_WAIT_L(0); PG8_BAR; PG8_MMA(0, 0, At, B0); PG8_MMA(0, 1, At, B1); PG8_BAR; PG8_SCHED;
            PG8_LDA(At, 1, 1); PG8_STAGE(PG8_SB(1, 0), Bbase, b3, voffB); PG8_STAGE(PG8_SB(1, 1), Bbase, b3 + hstepB, voffB); PG8_STAGE(PG8_SA(1, 0), Abase, a3, voffA[0]);
            PG8_WAIT_V(8); PG8_WAIT_L(0); PG8_BAR; PG8_MMA(1, 0, At, B0); PG8_MMA(1, 1, At, B1); PG8_BAR; PG8_SCHED;
        }
        if constexpr (ALIGN_EPI) { if (wr == 0) PG8_BAR; }
        E(acc, cur, wr, wc, fr, fq, tid, ub);
        if (!has_next) break;
#pragma unroll
        for (int a = 0; a < 2; ++a)
#pragma unroll
            for (int b = 0; b < 2; ++b)
#pragma unroll
                for (int m = 0; m < 4; ++m)
#pragma unroll
                    for (int n = 0; n < 2; ++n) acc[a][b][m][n] = (f32x4){0.f, 0.f, 0.f, 0.f};
        cur = nxt; cA = nA; cB = nB; ++ui; ub = nub;
        if constexpr (ALIGN_EPI) { if (wr == 1) PG8_BAR; }
    }
    PG8_WAIT_V(0);
    if constexpr (!ALIGN_EPI) { if (wr == 0) PG8_BAR; }
    PG8_BAR;
#undef PG8_SA
#undef PG8_SB
#undef PG8_STAGE
#undef PG8_LDA
#undef PG8_LDB
#undef PG8_MMA
#undef PG8_WAIT_V
#undef PG8_WAIT_L
#undef PG8_BAR
#undef PG8_SCHED
}

struct EpiZ {
    static constexpr bool PERM = true;
    unsigned char* ws;
    __device__ __forceinline__ void operator()(const f32x4 (&acc)[2][2][4][2], const Unit& u, int wr, int wc, int fr, int fq, int, int) const {
        const int row0 = u.pm * BM + wr * 64 + fr, col0 = u.pn * BM + wc * 32 + 8 * fq;
        bf16_t* z = (bf16_t*)(ws + WS_Z); const float* ss = (const float*)(ws + WS_SS1);
#pragma unroll
        for (int ai = 0; ai < 2; ++ai)
#pragma unroll
            for (int m = 0; m < 4; ++m) { const int row = row0 + ai * HALF + m * 16; const float rs = row_rs(ss, row); bf16_t* rowp = z + (size_t)row * NIN + col0;
#pragma unroll
                for (int bj = 0; bj < 2; ++bj) if (col0 + bj * HALF < NIN) { const f32x4 v0 = acc[ai][bj][m][0] * rs, v1 = acc[ai][bj][m][1] * rs;
                    u32x4 w; w.x = cvt_pk_bf16(v0[0], v0[1]); w.y = cvt_pk_bf16(v0[2], v0[3]); w.z = cvt_pk_bf16(v1[0], v1[1]); w.w = cvt_pk_bf16(v1[2], v1[3]);
                    *(u32x4*)(rowp + bj * HALF) = w; } }
    }
};
template <bool LIST, bool STATS, size_t SS_OFF> struct EpiRes {
    static constexpr bool PERM = true;
    unsigned char* ws; LAS unsigned char* lds;
    __device__ __forceinline__ void operator()(const f32x4 (&acc)[2][2][4][2], const Unit& u, int wr, int wc, int fr, int fq, int tid, int ub) const {
        const int col0 = u.pn * BM + wc * 32 + 8 * fq;
        bf16_t* h = (bf16_t*)(ws + WS_H); float* ss = (float*)(ws + SS_OFF); LAS float* red = (LAS float*)(lds + RED_OFF); const LAS int* utok = (const LAS int*)(lds + UROW_OFF);
#pragma unroll
        for (int ai = 0; ai < 2; ++ai)
#pragma unroll
            for (int m = 0; m < 4; ++m) { const int rowl = ai * HALF + wr * 64 + m * 16 + fr; int row; bool valid = true;
                if constexpr (LIST) { row = utok[ub * 256 + rowl]; valid = row >= 0; } else row = u.pm * BM + rowl;
                float s = 0.f;
                if (valid) { bf16_t* hp = h + (size_t)row * D + col0;
#pragma unroll
                    for (int bj = 0; bj < 2; ++bj) { const u32x4 o = *(const u32x4*)(hp + bj * HALF); const f32x4 a0 = acc[ai][bj][m][0], a1 = acc[ai][bj][m][1];
                        const float v0 = bflo(o.x) + a0[0], v1 = bfhi(o.x) + a0[1], v2 = bflo(o.y) + a0[2], v3 = bfhi(o.y) + a0[3], v4 = bflo(o.z) + a1[0], v5 = bfhi(o.z) + a1[1], v6 = bflo(o.w) + a1[2], v7 = bfhi(o.w) + a1[3];
                        s += (v0 * v0 + v1 * v1) + (v2 * v2 + v3 * v3) + (v4 * v4 + v5 * v5) + (v6 * v6 + v7 * v7);
                        u32x4 w; w.x = cvt_pk_bf16(v0, v1); w.y = cvt_pk_bf16(v2, v3); w.z = cvt_pk_bf16(v4, v5); w.w = cvt_pk_bf16(v6, v7);
                        *(u32x4*)(hp + bj * HALF) = w; } }
                if constexpr (STATS) { s += __shfl_xor(s, 16); s += __shfl_xor(s, 32); if (fq == 0) red[rowl * 4 + wc] = s; }
                asm volatile("" ::: "memory"); }
        if constexpr (STATS) {
            asm volatile("s_waitcnt lgkmcnt(0)" ::: "memory"); __builtin_amdgcn_s_barrier(); asm volatile("" ::: "memory");
            if (tid < BM) { const f32x4 v = *(const LAS f32x4*)(red + tid * 4); int row; bool valid = true;
                if constexpr (LIST) { row = utok[ub * 256 + tid]; valid = row >= 0; } else row = u.pm * BM + tid;
                if (valid) ss[(size_t)row * 4 + u.pn] = (v.x + v.y) + (v.z + v.w); }
        }
    }
};
struct EpiUp {
    static constexpr bool PERM = false;
    unsigned char* ws; LAS unsigned char* lds;
    __device__ __forceinline__ void operator()(const f32x4 (&acc)[2][2][4][2], const Unit& u, int wr, int wc, int fr, int fq, int, int ub) const {
        const int col0 = u.pn * 128 + wc * 16 + 4 * fq;
        bf16_t* hid = (bf16_t*)(ws + WS_HID); const LAS float* urs = (const LAS float*)(lds + UROW_OFF) + 768;
#pragma unroll
        for (int ai = 0; ai < 2; ++ai)
#pragma unroll
            for (int m = 0; m < 4; ++m) { const int rowl = ai * HALF + wr * 64 + m * 16 + fr;
                const float rs = urs[ub * 256 + rowl], gw = urs[768 + ub * 256 + rowl];
                bf16_t* hp = hid + ((size_t)u.pm * BM + rowl) * DE + col0;
#pragma unroll
                for (int bj = 0; bj < 2; ++bj) { const f32x4 g = acc[ai][bj][m][0] * rs, up = acc[ai][bj][m][1] * rs; float o[4];
#pragma unroll
                    for (int j = 0; j < 4; ++j) o[j] = g[j] / (1.f + __expf(-g[j])) * up[j] * gw;
                    u32x2 w; w.x = cvt_pk_bf16(o[0], o[1]); w.y = cvt_pk_bf16(o[2], o[3]); *(u32x2*)(hp + bj * 64) = w; } }
    }
};
}

struct MoeTab { int cnt[64]; int rb0[65]; int pad[3]; unsigned short li[NBMAX]; unsigned short blk[NBMAX]; };
static_assert(sizeof(MoeTab) <= 4096, "MoeTab fits below RED_OFF");
__device__ __forceinline__ void moe_build_tab(LAS MoeTab* T, unsigned* gcnt) {
    const int tid = threadIdx.x;
    if (tid < 64) T->cnt[tid] = (int)__hip_atomic_load(gcnt + tid * 16, __ATOMIC_RELAXED, __HIP_MEMORY_SCOPE_AGENT);
    __syncthreads();
    if (tid == 0) { int run = 0; for (int i = 0; i < 64; ++i) { T->rb0[i] = run; run += (T->cnt[i] + 255) >> 8; } T->rb0[64] = run; }
    __syncthreads();
    if (tid < 64) { const int b0 = T->rb0[tid], nb = T->rb0[tid + 1] - b0;
#pragma clang loop vectorize(disable) unroll(disable)
        for (int b = 0; b < nb; ++b) { T->li[b0 + b] = (unsigned short)tid; T->blk[b0 + b] = (unsigned short)b; } }
    __syncthreads();
}
template <bool GATHER_, int NN, int LDA, int K, unsigned ESTEP> struct MoeOrder {
    static constexpr bool GATHER = GATHER_, LIST = true;
    LAS unsigned char* lds; unsigned char* ws; int rbLo, nwg, G, c;
    __device__ __forceinline__ bool next(int i, pg8::Unit& u, int ub, int tid) const {
        const int L = i * G + c; if (L >= nwg) return false;
        const LAS MoeTab* T = (const LAS MoeTab*)(lds + TAB_OFF); LAS int* urow = (LAS int*)(lds + UROW_OFF);
        const int wgid = pg8::xcd_remap(L, nwg), rb = rbLo + wgid / NN;
        const int li = T->li[rb], blk = T->blk[rb], cnt = T->cnt[li];
        u.pm = rb; u.pn = wgid % NN; u.ao = GATHER ? 0u : (unsigned)rb * (unsigned)(256 * LDA * 2); u.bo = (unsigned)(li & 31) * ESTEP + (unsigned)u.pn * (unsigned)(256 * K * 2);
        if (tid < 256) { const int slot = blk * 256 + tid; const bool valid = slot < cnt; const size_t idx = (size_t)li * CAPL + slot;
            urow[ub * 256 + tid] = valid ? ((const int*)(ws + WS_LTOK))[idx] : -1;
            if constexpr (GATHER) { ((LAS float*)urow)[768 + ub * 256 + tid] = valid ? ((const float*)(ws + WS_LRS))[idx] : 0.f; ((LAS float*)urow)[1536 + ub * 256 + tid] = valid ? ((const float*)(ws + WS_LW))[idx] : 0.f; } }
        return true;
    }
    __device__ __forceinline__ unsigned aoff(int ub, int rowl, int C) const {
        if constexpr (GATHER) { const int tok = ((const LAS int*)(lds + UROW_OFF))[ub * 256 + rowl]; return (unsigned)((tok < 0 ? 0 : tok) * LDA + C) * 2u; }
        else return (unsigned)(rowl * LDA + C) * 2u;
    }
};

__device__ __forceinline__ void route_phase(const P& p, int l, LAS unsigned char* lds, int G, int bid, unsigned* gcnt) {
    int tid_ = threadIdx.x; asm volatile("" : "+v"(tid_));
    const int tid = tid_, w = __builtin_amdgcn_readfirstlane(tid >> 6), lane = tid & 63, r = lane & 15, q = lane >> 4;
    const int per = (MP + G - 1) / G, r0 = bid * per, nrows = (r0 + per <= MP) ? per : (MP - r0 > 0 ? MP - r0 : 0);
    constexpr int WROW = 1040;
    LAS unsigned char* WHs = lds; LAS unsigned char* WLs = lds + 48 * WROW;
    LAS float* lg = (LAS float*)(lds + 2 * 48 * WROW);
    LAS int* lcnt = (LAS int*)(lds + TAB_OFF);
    LAS int* lbase = lcnt + 64;
    LAS int* rli = lbase + 64;
    LAS int* rpos = rli + 528;
    LAS float* rw = (LAS float*)(rpos + 528);
    LAS float* rrs = rw + 528;
    if (tid < 64) lcnt[tid] = 0;
    const bf16_t* WH = (const bf16_t*)(p.ws + WS_WRS) + (size_t)l * 48 * D; const bf16_t* WL = WH + (size_t)DEPTH * 48 * D;
    f32x4 acc[2][3];
#pragma unroll
    for (int gi = 0; gi < 2; ++gi)
#pragma unroll
        for (int tl = 0; tl < 3; ++tl) acc[gi][tl] = (f32x4){0.f, 0.f, 0.f, 0.f};
#pragma unroll 1
    for (int half = 0; half < 2; ++half) {
        __syncthreads();
        for (int idx = tid; idx < 48 * 64; idx += NTHR) { const int row = idx >> 6, pc = idx & 63;
            *(LAS pg8::u32x4*)(WHs + row * WROW + pc * 16) = *(const pg8::u32x4*)(WH + (size_t)row * D + half * 512 + pc * 8);
            *(LAS pg8::u32x4*)(WLs + row * WROW + pc * 16) = *(const pg8::u32x4*)(WL + (size_t)row * D + half * 512 + pc * 8); }
        __syncthreads();
#pragma unroll
        for (int gi = 0; gi < 2; ++gi) { const int g = w + gi * NWAVES;
            if (g * 16 < nrows) { const bool ina = (g * 16 + r) < nrows; const bf16_t* ap = p.H() + (size_t)(ina ? r0 + g * 16 + r : 0) * D + half * 512 + q * 8;
                pg8::bf16x8 a[16];
#pragma unroll
                for (int ks = 0; ks < 16; ++ks) a[ks] = *(const pg8::bf16x8*)(ap + ks * 32);
#pragma unroll
                for (int ks = 0; ks < 16; ++ks)
#pragma unroll
                    for (int tl = 0; tl < 3; ++tl) { const int wo = (tl * 16 + r) * WROW + (ks * 32 + q * 8) * 2;
                        acc[gi][tl] = __builtin_amdgcn_mfma_f32_16x16x32_bf16(a[ks], *(const LAS pg8::bf16x8*)(WHs + wo), acc[gi][tl], 0, 0, 0);
                        acc[gi][tl] = __builtin_amdgcn_mfma_f32_16x16x32_bf16(a[ks], *(const LAS pg8::bf16x8*)(WLs + wo), acc[gi][tl], 0, 0, 0); } } }
    }
#pragma unroll
    for (int gi = 0; gi < 2; ++gi) { const int g = w + gi * NWAVES;
        if (g * 16 < nrows) {
            LAS float* lgw = lg + w * 16 * 48;
#pragma unroll
            for (int tl = 0; tl < 3; ++tl)
#pragma unroll
                for (int j = 0; j < 4; ++j) lgw[(q * 4 + j) * 48 + tl * 16 + r] = acc[gi][tl][j];
            asm volatile("s_waitcnt lgkmcnt(0)" ::: "memory");
            if (lane < 16) { const int i = g * 16 + lane, rr = r0 + i;
                if (i < nrows) {
                    if ((rr % TP) < LEAD) { int neg = -1; asm volatile("" : "+v"(neg)); rli[2 * i] = neg; rli[2 * i + 1] = neg; }
                    else { const float rs = row_rs(p.SS2(), rr); const LAS float* x = lgw + lane * 48; float gl[4];
#pragma unroll
                        for (int j = 0; j < 4; ++j) gl[j] = x[j] * rs + p.br_g[l * 4 + j];
                        int gsel = 0; float gm = gl[0];
#pragma unroll
                        for (int j = 1; j < 4; ++j) if (gl[j] > gm) { gm = gl[j]; gsel = j; }
                        float se = 0.f;
#pragma unroll
                        for (int j = 0; j < 4; ++j) se += __expf(gl[j] - gm);
                        const float psel = 1.f / se;
                        int i0 = 0, i1 = -1; float v0 = -INFINITY, v1 = -INFINITY;
                        for (int j = 0; j < 8; ++j) { const float v = x[4 + gsel * 8 + j] * rs + p.br_e[l * 32 + gsel * 8 + j];
                            if (v > v0) { v1 = v0; i1 = i0; v0 = v; i0 = j; } else if (v > v1) { v1 = v; i1 = j; } }
                        const float w0 = 1.f / (1.f + __expf(v1 - v0));
                        const int li0 = gsel * 8 + i0, li1 = 32 + gsel * 8 + i1;
                        rli[2 * i] = li0; rli[2 * i + 1] = li1; rw[2 * i] = w0 * psel; rw[2 * i + 1] = (1.f - w0) * psel; rrs[i] = rs;
                        rpos[2 * i] = __hip_atomic_fetch_add(&lcnt[li0], 1, __ATOMIC_RELAXED, __HIP_MEMORY_SCOPE_WORKGROUP); rpos[2 * i + 1] = __hip_atomic_fetch_add(&lcnt[li1], 1, __ATOMIC_RELAXED, __HIP_MEMORY_SCOPE_WORKGROUP); } } }
            asm volatile("s_waitcnt lgkmcnt(0)" ::: "memory"); } }
    __syncthreads();
    if (tid < 64) { const int n = lcnt[tid]; lbase[tid] = n ? (int)__hip_atomic_fetch_add(gcnt + tid * 16, (unsigned)n, __ATOMIC_RELAXED, __HIP_MEMORY_SCOPE_AGENT) : 0; }
    __syncthreads();
    int* ltok = (int*)(p.ws + WS_LTOK); float* lrs = (float*)(p.ws + WS_LRS); float* lw = (float*)(p.ws + WS_LW);
    for (int i = tid; i < 2 * nrows; i += NTHR) { const int li = rli[i]; if (li >= 0) { const size_t idx = (size_t)li * CAPL + lbase[li] + rpos[i]; ltok[idx] = r0 + (i >> 1); lrs[idx] = rrs[i >> 1]; lw[idx] = rw[i]; } }
    __syncthreads();
}

namespace mx {
using pg8::bf16x8; using pg8::u32x4; using pg8::u32x2; using pg8::cvt_pk_bf16; using pg8::bflo; using pg8::bfhi;
__device__ __forceinline__ f32x4 mfma16(bf16x8 a, bf16x8 b, f32x4 c) { return __builtin_amdgcn_mfma_f32_16x16x32_bf16(a, b, c, 0, 0, 0); }
__device__ __forceinline__ float wscan_add(float v, int lane) {
#pragma unroll
    for (int o = 1; o < 64; o <<= 1) { const float t = __shfl_up(v, o); if (lane >= o) v += t; }
    return v; }
__device__ __forceinline__ float wscan_max(float v, int lane) {
#pragma unroll
    for (int o = 1; o < 64; o <<= 1) { const float t = __shfl_up(v, o); if (lane >= o) v = fmaxf(v, t); }
    return v; }
__device__ __forceinline__ float wave_max(float v) {
#pragma unroll
    for (int o = 1; o < 64; o <<= 1) v = fmaxf(v, __shfl_xor(v, o));
    return v; }
__device__ __forceinline__ void unpack8(const u32x4 a, float (&x)[8]) { x[0] = bflo(a.x); x[1] = bfhi(a.x); x[2] = bflo(a.y); x[3] = bfhi(a.y); x[4] = bflo(a.z); x[5] = bfhi(a.z); x[6] = bflo(a.w); x[7] = bfhi(a.w); }
__device__ __forceinline__ u32x4 pack8(const float (&x)[8]) { u32x4 w; w.x = cvt_pk_bf16(x[0], x[1]); w.y = cvt_pk_bf16(x[2], x[3]); w.z = cvt_pk_bf16(x[4], x[5]); w.w = cvt_pk_bf16(x[6], x[7]); return w; }
__device__ __forceinline__ bf16x8 ldfrag(const LAS unsigned char* p) { return *(const LAS bf16x8*)p; }
constexpr int SQ = 272, ST = 144;

struct UC { int c, hd, b, r0; };
__device__ __forceinline__ UC ucoord(int u) { UC k; k.c = u % NCH; k.hd = (u / NCH) & 3; k.b = u / (NCH * 4); k.r0 = k.b * TP + k.c * 64; return k; }
template <int NS> struct PreM { u32x4 x[NS + 3]; u32x4 v[2]; pg8::f32x2_ g; };
struct PreG { u32x4 v[2]; u32x4 q, k; f32x4 ca; };
template <int NS> __device__ __forceinline__ void load_m(const P& p, int u, PreM<NS>& R, int tid, int zvcol) {
    asm volatile("" : "+v"(tid));
    const UC k = ucoord(u); const bf16_t* z = p.Z(); const int lane = tid & 63, w = tid >> 6;
    { const size_t zr = (size_t)(k.r0 + lane) * NIN; pg8::f32x2_ g = {0.f, 0.f}; if (w == 0) { g.x = bf2f(z[zr + ZO_FG + k.hd]); g.y = bf2f(z[zr + ZO_IG + k.hd]); } R.g = g; }
    int zcol, s0;
    if (NS == 4) { const int which = tid >> 8; zcol = (which ? ZO_KM : ZO_QM) + k.hd * 128 + (tid & 15) * 8; s0 = ((tid >> 4) & 15) * 4; }
    else { zcol = ZO_KM + k.hd * 128 + (tid & 15) * 8; s0 = (tid >> 4) * 2; }
#pragma unroll
    for (int i = 0; i < NS + 3; ++i) { const int s = s0 - 3 + i, pp = k.c * 64 + s; R.x[i] = (u32x4){0u, 0u, 0u, 0u}; if (pp >= LEAD) R.x[i] = *(const u32x4*)(z + (size_t)(k.r0 + s) * NIN + zcol); }
#pragma unroll
    for (int it = 0; it < 2; ++it) { const int item = tid + it * NTHR, s = item >> 4, v8 = item & 15; R.v[it] = *(const u32x4*)(z + (size_t)(k.r0 + s) * NIN + zvcol + k.hd * 128 + v8 * 8); }
}
__device__ __forceinline__ void load_g(const P& p, int l, int u, PreG& R, int tid, bool needq) {
    asm volatile("" : "+v"(tid));
    const UC k = ucoord(u); const bf16_t* z = p.Z();
#pragma unroll
    for (int it = 0; it < 2; ++it) { const int item = tid + it * NTHR, s = item >> 4, v8 = item & 15; R.v[it] = *(const u32x4*)(z + (size_t)(k.r0 + s) * NIN + ZO_VG + k.hd * 128 + v8 * 8); }
    const size_t zr = (size_t)(k.r0 + (tid >> 3)) * NIN; R.k = *(const u32x4*)(z + zr + ZO_KG + k.hd * 64 + (tid & 7) * 8); R.q = R.k;
    if (needq) R.q = *(const u32x4*)(z + zr + ZO_QG + k.hd * 64 + (tid & 7) * 8);
    { const int i0 = tid, i1 = tid + NTHR; f32x4 ca;
        ca.x = bf2f(z[(size_t)(k.r0 + (i0 >> 4)) * NIN + ZO_CODE + (i0 & 15)]); ca.y = bf2f(z[(size_t)(k.r0 + (i1 >> 4)) * NIN + ZO_CODE + (i1 & 15)]);
        ca.z = p.a_w2[(l * 16 + (i0 >> 6)) * 256 + k.hd * 64 + (i0 & 63)]; ca.w = p.a_w2[(l * 16 + (i1 >> 6)) * 256 + k.hd * 64 + (i1 & 63)]; R.ca = ca; }
}
template <int NS> __device__ __forceinline__ void conv8(const P& p, int l, const u32x4 (&xr)[NS + 3], int c, int s0, int cch, float scale, float (&o)[NS][8]) {
    float x[NS + 3][8];
#pragma unroll
    for (int i = 0; i < NS + 3; ++i) unpack8(xr[i], x[i]);
    float bias[8];
    { const f32x4 b0 = *(const f32x4*)(p.conv_b + l * D + cch), b1 = *(const f32x4*)(p.conv_b + l * D + cch + 4); bias[0] = b0.x; bias[1] = b0.y; bias[2] = b0.z; bias[3] = b0.w; bias[4] = b1.x; bias[5] = b1.y; bias[6] = b1.z; bias[7] = b1.w; }
#pragma unroll
    for (int i = 0; i < NS; ++i)
#pragma unroll
        for (int q = 0; q < 8; ++q) o[i][q] = bias[q];
#pragma unroll
    for (int j = 0; j < 4; ++j) { float w[8];
        { const f32x4 w0 = *(const f32x4*)(p.conv_w + (l * 4 + j) * D + cch), w1 = *(const f32x4*)(p.conv_w + (l * 4 + j) * D + cch + 4); w[0] = w0.x; w[1] = w0.y; w[2] = w0.z; w[3] = w0.w; w[4] = w1.x; w[5] = w1.y; w[6] = w1.z; w[7] = w1.w; }
#pragma unroll
        for (int i = 0; i < NS; ++i)
#pragma unroll
            for (int q = 0; q < 8; ++q) o[i][q] += w[q] * x[i + j][q]; }
#pragma unroll
    for (int i = 0; i < NS; ++i) { const bool valid = (c > 0) || (s0 + i >= LEAD);
#pragma unroll
        for (int q = 0; q < 8; ++q) o[i][q] = valid ? silu(o[i][q]) * scale : 0.f; }
}

__device__ __forceinline__ void gla_cumdecay(const P& p, int l, int hd, const PreG& R, int c, LAS float* LA, LAS float* segtot, LAS float* cod, LAS float* aw, LAS float* ab, int tid) {
    cod[tid] = R.ca.x; cod[tid + NTHR] = R.ca.y; aw[tid] = R.ca.z; aw[tid + NTHR] = R.ca.w;
    if (tid < 64) ab[tid] = p.a_b[l * 256 + hd * 64 + tid];
    __syncthreads();
    const int j = tid & 63, seg = tid >> 6; float run = 0.f, v[8];
#pragma unroll
    for (int i = 0; i < 8; ++i) { const int s = seg * 8 + i; const bool valid = (c > 0) || (s >= LEAD); float a = ab[j];
#pragma unroll
        for (int q = 0; q < 16; ++q) a += cod[s * 16 + q] * aw[q * 64 + j];
        run += valid ? logsig(a) * (1.f / 16.f) : 0.f; v[i] = run; }
    segtot[seg * 64 + j] = run;
    __syncthreads();
    float pre = 0.f;
#pragma unroll
    for (int g = 0; g < 8; ++g) pre += (g < seg) ? segtot[g * 64 + j] : 0.f;
#pragma unroll
    for (int i = 0; i < 8; ++i) LA[(seg * 8 + i) * 65 + j] = v[i] + pre;
    __syncthreads();
}
__device__ __forceinline__ void mlstm_local(const P& p, int l, int u, LAS unsigned char* lds, int tid, const PreM<2>& R) {
    asm volatile("" : "+v"(tid));
    const int lane = tid & 63, w = __builtin_amdgcn_readfirstlane(tid >> 6), c = u % NCH, hd = (u / NCH) & 3, b = u / (NCH * 4), r0 = b * TP + c * 64;
    const bf16_t* z = p.Z();
    LAS unsigned char* KT = lds; LAS unsigned char* VT = lds + 18432; LAS float* wS = (LAS float*)(lds + 39168);
    if (w == 0) { const int s = lane; const bool valid = (c > 0) || (s >= LEAD);
        const float lf = valid ? logsig(R.g.x + p.gate_b[(l * 2 + 1) * 4 + hd]) : 0.f;
        const float ig = valid ? R.g.y + p.gate_b[(l * 2 + 0) * 4 + hd] : -INFINITY;
        const float bb = wscan_add(lf, lane), be = __shfl(bb, 63), g = be - bb + ig, mg = wave_max(g);
        wS[s] = __expf(g - mg);
        if (lane == 0) { float* sc = p.MSC() + (size_t)u * 4; sc[0] = mg; sc[1] = be; } }
    { const int ch8 = tid & 15, s0 = (tid >> 4) * 2; float o[2][8];
        conv8<2>(p, l, R.x, c, s0, 512 + hd * 128 + ch8 * 8, 0.08838834764831845f, o);
#pragma unroll
        for (int q = 0; q < 8; ++q) *(LAS unsigned*)(KT + (ch8 * 8 + q) * ST + s0 * 2) = cvt_pk_bf16(o[0][q], o[1][q]); }
    __syncthreads();
#pragma unroll
    for (int it = 0; it < 2; ++it) { const int item = tid + it * NTHR, s = item >> 4, v8 = item & 15; const bool valid = (c > 0) || (s >= LEAD); float x[8];
        unpack8(R.v[it], x); const float ws = wS[s];
#pragma unroll
        for (int q = 0; q < 8; ++q) *(LAS bf16_t*)(VT + (v8 * 8 + q) * ST + s * 2) = f2bf(valid ? x[q] * ws : 0.f); }
    for (int i = tid; i < 16 * 64; i += NTHR) { const int row = 128 + (i >> 6), s = i & 63; *(LAS bf16_t*)(VT + row * ST + s * 2) = (row == 128) ? f2bf(wS[s]) : (bf16_t)0; }
    __syncthreads();
    { const int r = lane & 15, q = lane >> 4; bf16x8 afr[2];
#pragma unroll
        for (int ks = 0; ks < 2; ++ks) afr[ks] = ldfrag(KT + (w * 16 + r) * ST + (ks * 32 + q * 8) * 2);
        bf16_t* Cd = p.MC() + (size_t)u * 16384;
#pragma unroll
        for (int vt = 0; vt < 9; ++vt) { f32x4 acc = {0.f, 0.f, 0.f, 0.f};
#pragma unroll
            for (int ks = 0; ks < 2; ++ks) acc = mfma16(afr[ks], ldfrag(VT + (vt * 16 + r) * ST + (ks * 32 + q * 8) * 2), acc);
            if (vt < 8) { u32x2 o; o.x = cvt_pk_bf16(acc[0], acc[1]); o.y = cvt_pk_bf16(acc[2], acc[3]); *(u32x2*)(Cd + (vt * 16 + r) * 128 + w * 16 + q * 4) = o; }
            else if (r == 0) *(f32x4*)(p.MN() + (size_t)u * 128 + w * 16 + q * 4) = acc; } }
    __syncthreads();
}

__device__ __forceinline__ void gla_local(const P& p, int l, int u, LAS unsigned char* lds, int tid, const PreG& R) {
    asm volatile("" : "+v"(tid));
    const int lane = tid & 63, w = __builtin_amdgcn_readfirstlane(tid >> 6), c = u % NCH, hd = (u / NCH) & 3, b = u / (NCH * 4), r0 = b * TP + c * 64;
    const bf16_t* z = p.Z();
    LAS float* LA = (LAS float*)lds; LAS float* segtot = (LAS float*)(lds + 16640); LAS unsigned char* KHT = lds + 18688; LAS unsigned char* VT = lds + 27904;
    LAS float* cod = (LAS float*)(lds + 46336); LAS float* aw = (LAS float*)(lds + 50432); LAS float* ab = (LAS float*)(lds + 54528);
    gla_cumdecay(p, l, hd, R, c, LA, segtot, cod, aw, ab, tid);
    if (tid < 64) p.GB()[(size_t)u * 64 + tid] = LA[63 * 65 + tid];
    { const int s = tid >> 3, j8 = tid & 7; const bool valid = (c > 0) || (s >= LEAD); float x[8];
        unpack8(R.k, x);
#pragma unroll
        for (int q = 0; q < 8; ++q) { const int j = j8 * 8 + q; *(LAS bf16_t*)(KHT + j * ST + s * 2) = f2bf(valid ? x[q] * __expf(LA[63 * 65 + j] - LA[s * 65 + j]) : 0.f); } }
#pragma unroll
    for (int it = 0; it < 2; ++it) { const int item = tid + it * NTHR, s = item >> 4, v8 = item & 15; const bool valid = (c > 0) || (s >= LEAD); float x[8];
        unpack8(R.v[it], x);
#pragma unroll
        for (int q = 0; q < 8; ++q) *(LAS bf16_t*)(VT + (v8 * 8 + q) * ST + s * 2) = f2bf(valid ? x[q] : 0.f); }
    __syncthreads();
    { const int r = lane & 15, q = lane >> 4; bf16x8 bfr[2];
#pragma unroll
        for (int ks = 0; ks < 2; ++ks) bfr[ks] = ldfrag(VT + (w * 16 + r) * ST + (ks * 32 + q * 8) * 2);
        bf16_t* Sd = p.GS() + (size_t)u * 8192;
#pragma unroll
        for (int jt = 0; jt < 4; ++jt) { f32x4 acc = {0.f, 0.f, 0.f, 0.f};
#pragma unroll
            for (int ks = 0; ks < 2; ++ks) acc = mfma16(ldfrag(KHT + (jt * 16 + r) * ST + (ks * 32 + q * 8) * 2), bfr[ks], acc);
            u32x2 o; o.x = cvt_pk_bf16(acc[0], acc[1]); o.y = cvt_pk_bf16(acc[2], acc[3]); *(u32x2*)(Sd + (w * 16 + r) * 64 + jt * 16 + q * 4) = o; } }
    __syncthreads();
}

__device__ __forceinline__ void scan_phase(const P& p, LAS unsigned char* lds, int G, int bid, int tid) {
    asm volatile("" : "+v"(tid));
    LAS float* dec = (LAS float*)lds; LAS float* wgt = dec + 132;
    for (int item = bid; item < 16 * 13; item += G) { const int bh = item / 13, sl = item % 13;
        __syncthreads();
        if (sl < 9) {
            if (tid < NCH) { const float* sc = p.MSC() + ((size_t)bh * NCH + tid) * 4; dec[tid] = sc[1]; wgt[tid] = sc[0]; }
            __syncthreads();
            if (tid == 0) { float m = 0.f; for (int c = 0; c < NCH; ++c) { const float mg = wgt[c], be = dec[c];
                    if (sl == 0) p.MSC()[((size_t)bh * NCH + c) * 4 + 2] = m; const float mn = fmaxf(be + m, mg); dec[c] = __expf(be + m - mn); wgt[c] = __expf(mg - mn); m = mn; } } }
        __syncthreads();
        if (sl < 8) { float C0 = 0.f, C1 = 0.f, C2 = 0.f, C3 = 0.f; u32x2* q = (u32x2*)(p.MC() + (size_t)bh * NCH * 16384 + sl * 2048 + tid * 4);
#pragma unroll 16
            for (int c = 0; c < NCH; ++c) { const u32x2 dl = q[(size_t)c * 4096]; u32x2 o; o.x = cvt_pk_bf16(C0, C1); o.y = cvt_pk_bf16(C2, C3); q[(size_t)c * 4096] = o; const float d = dec[c], g = wgt[c];
                C0 = d * C0 + g * bflo(dl.x); C1 = d * C1 + g * bfhi(dl.x); C2 = d * C2 + g * bflo(dl.y); C3 = d * C3 + g * bfhi(dl.y); } }
        else if (sl == 8) { if (tid < 128) { float C = 0.f; float* q = p.MN() + (size_t)bh * NCH * 128 + tid;
#pragma unroll 8
            for (int c = 0; c < NCH; ++c) { const float dl = q[(size_t)c * 128]; q[(size_t)c * 128] = C; C = dec[c] * C + wgt[c] * dl; } } }
        else { const int e = (sl - 9) * 2048 + tid * 4, j = e & 63; float S0 = 0.f, S1 = 0.f, S2 = 0.f, S3 = 0.f; u32x2* q = (u32x2*)(p.GS() + (size_t)bh * NCH * 8192 + e); const f32x4* gb = (const f32x4*)(p.GB() + (size_t)bh * NCH * 64 + j);
#pragma unroll 16
            for (int c = 0; c < NCH; ++c) { const u32x2 dl = q[(size_t)c * 2048]; const f32x4 bv = gb[(size_t)c * 16]; u32x2 o; o.x = cvt_pk_bf16(S0, S1); o.y = cvt_pk_bf16(S2, S3); q[(size_t)c * 2048] = o;
                S0 = S0 * __expf(bv.x) + bflo(dl.x); S1 = S1 * __expf(bv.y) + bfhi(dl.x); S2 = S2 * __expf(bv.z) + bflo(dl.y); S3 = S3 * __expf(bv.w) + bfhi(dl.y); } }
    }
    __syncthreads();
}

__device__ __forceinline__ void mlstm_out(const P& p, int l, int u, LAS unsigned char* lds, int tid, const PreM<4>& R) {
    asm volatile("" : "+v"(tid));
    const int lane = tid & 63, w = __builtin_amdgcn_readfirstlane(tid >> 6), c = u % NCH, hd = (u / NCH) & 3, b = u / (NCH * 4), r0 = b * TP + c * 64;
    const bf16_t* z = p.Z();
    LAS unsigned char* QS = lds; LAS unsigned char* KS = lds + 17408; LAS unsigned char* VT = lds + 34816; LAS unsigned char* SS = lds + 55552;
    LAS float* aS = (LAS float*)(lds + 64768); LAS float* MS = aS + 64; LAS float* wiS = MS + 64; LAS float* emtS = wiS + 64; LAS float* denS = emtS + 64; LAS float* part = denS + 64; LAS float* nS = part + 128;
    if (tid < 128) nS[tid] = p.MN()[(size_t)u * 128 + tid];
    if (w == 0) { const int s = lane; const bool valid = (c > 0) || (s >= LEAD);
        const float lf = valid ? logsig(R.g.x + p.gate_b[(l * 2 + 1) * 4 + hd]) : 0.f;
        const float ig = valid ? R.g.y + p.gate_b[(l * 2 + 0) * 4 + hd] : -INFINITY;
        const float bb = wscan_add(lf, lane), a = ig - bb, pm = wscan_max(a, lane), m0 = p.MSC()[(size_t)u * 4 + 2], M = fmaxf(m0, pm);
        aS[s] = a; MS[s] = M; wiS[s] = __expf(m0 - M); emtS[s] = __expf(-(bb + M)); }
    { const int which = tid >> 8, ch8 = tid & 15, s0 = ((tid >> 4) & 15) * 4; float o[4][8];
        conv8<4>(p, l, R.x, c, s0, which * 512 + hd * 128 + ch8 * 8, which ? 0.08838834764831845f : 1.f, o);
        LAS unsigned char* dst = which ? KS : QS;
#pragma unroll
        for (int i = 0; i < 4; ++i) *(LAS u32x4*)(dst + (s0 + i) * SQ + ch8 * 16) = pack8(o[i]); }
#pragma unroll
    for (int it = 0; it < 2; ++it) { const int item = tid + it * NTHR, s = item >> 4, v8 = item & 15; const bool valid = (c > 0) || (s >= LEAD); float x[8];
        unpack8(R.v[it], x);
#pragma unroll
        for (int q = 0; q < 8; ++q) *(LAS bf16_t*)(VT + (v8 * 8 + q) * ST + s * 2) = f2bf(valid ? x[q] : 0.f); }
    for (int i = tid; i < 16 * 64; i += NTHR) { const int row = 128 + (i >> 6), s = i & 63; *(LAS bf16_t*)(VT + row * ST + s * 2) = (row == 128) ? (bf16_t)0x3f80 : (bf16_t)0; }
    const int r = lane & 15, q = lane >> 4, tt = w & 3, vh = w >> 2, t = tt * 16 + r;
    const int nvt = vh ? 4 : 5;
    bf16x8 cfr[4][4];
    { const bf16_t* Cg = p.MC() + (size_t)u * 16384;
#pragma unroll
        for (int i = 0; i < 4; ++i)
#pragma unroll
            for (int ks = 0; ks < 4; ++ks) cfr[i][ks] = *(const bf16x8*)(Cg + ((vh * 4 + i) * 16 + r) * 128 + ks * 32 + q * 8); }
    __syncthreads();
    f32x4 acc2[5];
    { bf16x8 qb[4];
#pragma unroll
        for (int ks = 0; ks < 4; ++ks) qb[ks] = ldfrag(QS + (tt * 16 + r) * SQ + (ks * 32 + q * 8) * 2);
#pragma unroll
        for (int i = 0; i < 5; ++i) { acc2[i] = (f32x4){0.f, 0.f, 0.f, 0.f}; if (i < nvt) {
#pragma unroll
            for (int ks = 0; ks < 4; ++ks) { bf16x8 afr;
                if (i < 4) afr = cfr[i][ks];
                else { float nn[8];
#pragma unroll
                    for (int e = 0; e < 8; ++e) nn[e] = (r == 0) ? nS[ks * 32 + q * 8 + e] : 0.f;
                    afr = __builtin_bit_cast(bf16x8, pack8(nn)); }
                acc2[i] = mfma16(afr, qb[ks], acc2[i]); } } }
        const float Mt = MS[t];
#pragma unroll
        for (int cc = 0; cc < 2; ++cc) { const int st = vh * 2 + cc; f32x4 acc = {0.f, 0.f, 0.f, 0.f};
            if (st <= tt) {
#pragma unroll
                for (int ks = 0; ks < 4; ++ks) acc = mfma16(ldfrag(KS + (st * 16 + r) * SQ + (ks * 32 + q * 8) * 2), qb[ks], acc); }
            float sv[4];
#pragma unroll
            for (int j = 0; j < 4; ++j) { const int s = st * 16 + q * 4 + j; sv[j] = (s <= t) ? acc[j] * __expf(aS[s] - Mt) : 0.f; }
            u32x2 o; o.x = cvt_pk_bf16(sv[0], sv[1]); o.y = cvt_pk_bf16(sv[2], sv[3]); *(LAS u32x2*)(SS + t * ST + (st * 16 + q * 4) * 2) = o; } }
    __syncthreads();
    f32x4 hv[5];
    { bf16x8 sb[2];
#pragma unroll
        for (int ks = 0; ks < 2; ++ks) sb[ks] = ldfrag(SS + (tt * 16 + r) * ST + (ks * 32 + q * 8) * 2);
        const float wi = wiS[t];
#pragma unroll
        for (int i = 0; i < 5; ++i) { if (i < nvt) { const int vt = (i < 4) ? vh * 4 + i : 8; f32x4 a1 = {0.f, 0.f, 0.f, 0.f};
#pragma unroll
            for (int ks = 0; ks < 2; ++ks) a1 = mfma16(ldfrag(VT + (vt * 16 + r) * ST + (ks * 32 + q * 8) * 2), sb[ks], a1);
            hv[i] = a1 + acc2[i] * wi; } }
        if (vh == 0 && q == 0) denS[t] = hv[4][0]; }
    u32x2 og[4]; f32x4 gn[4];
#pragma unroll
    for (int i = 0; i < 4; ++i) { const int v0 = (vh * 4 + i) * 16 + q * 4; og[i] = *(const u32x2*)(z + (size_t)(r0 + t) * NIN + ZO_OM + hd * 128 + v0); gn[i] = *(const f32x4*)(p.m_norm_g + l * 512 + hd * 128 + v0); }
    __syncthreads();
    { const float dn = 1.f / fmaxf(fabsf(denS[t]), emtS[t]); float ssq = 0.f;
#pragma unroll
        for (int i = 0; i < 4; ++i) { hv[i] = hv[i] * dn; ssq += hv[i][0] * hv[i][0] + hv[i][1] * hv[i][1] + hv[i][2] * hv[i][2] + hv[i][3] * hv[i][3]; }
        ssq += __shfl_xor(ssq, 16); ssq += __shfl_xor(ssq, 32); if (q == 0) part[t * 2 + vh] = ssq; }
    __syncthreads();
    { const bool valid = (c > 0) || (t >= LEAD); const float sc = rsqrtf((part[t * 2] + part[t * 2 + 1]) * (1.f / 128.f) + EPS); bf16_t* yp = p.Z() + (size_t)(r0 + t) * NIN + ZO_OM + hd * 128;
#pragma unroll
        for (int i = 0; i < 4; ++i) { const int v0 = (vh * 4 + i) * 16 + q * 4; float y[4];
            y[0] = hv[i][0] * sc * gn[i][0] * sigm(bflo(og[i].x)); y[1] = hv[i][1] * sc * gn[i][1] * sigm(bfhi(og[i].x)); y[2] = hv[i][2] * sc * gn[i][2] * sigm(bflo(og[i].y)); y[3] = hv[i][3] * sc * gn[i][3] * sigm(bfhi(og[i].y));
            u32x2 o; o.x = valid ? cvt_pk_bf16(y[0], y[1]) : 0u; o.y = valid ? cvt_pk_bf16(y[2], y[3]) : 0u; *(u32x2*)(yp + v0) = o; } }
    __syncthreads();
}

__device__ __forceinline__ void gla_out(const P& p, int l, int u, LAS unsigned char* lds, int tid, const PreG& R) {
    asm volatile("" : "+v"(tid));
    const int lane = tid & 63, w = __builtin_amdgcn_readfirstlane(tid >> 6), c = u % NCH, hd = (u / NCH) & 3, b = u / (NCH * 4), r0 = b * TP + c * 64;
    const bf16_t* z = p.Z();
    LAS float* LA = (LAS float*)lds; LAS float* segtot = (LAS float*)(lds + 16640); LAS unsigned char* QT = lds + 18688; LAS unsigned char* KT2 = lds + 27904; LAS unsigned char* VT = lds + 37120; LAS unsigned char* AS = lds + 55552;
    LAS float* cod = (LAS float*)(lds + 64768); LAS float* aw = (LAS float*)(lds + 68864); LAS float* ab = (LAS float*)(lds + 72960); LAS float* part = (LAS float*)(lds + 73216);
    gla_cumdecay(p, l, hd, R, c, LA, segtot, cod, aw, ab, tid);
    { const int s = tid >> 3, j8 = tid & 7; const bool valid = (c > 0) || (s >= LEAD); float xq[8], xk[8];
        unpack8(R.q, xq); unpack8(R.k, xk);
#pragma unroll
        for (int q = 0; q < 8; ++q) { const float bb = LA[s * 65 + j8 * 8 + q]; xq[q] = valid ? xq[q] * 0.125f * __expf(bb) : 0.f; xk[q] = valid ? xk[q] * __expf(-bb) : 0.f; }
        *(LAS u32x4*)(QT + s * ST + j8 * 16) = pack8(xq); *(LAS u32x4*)(KT2 + s * ST + j8 * 16) = pack8(xk); }
#pragma unroll
    for (int it = 0; it < 2; ++it) { const int item = tid + it * NTHR, s = item >> 4, v8 = item & 15; const bool valid = (c > 0) || (s >= LEAD); float x[8];
        unpack8(R.v[it], x);
#pragma unroll
        for (int q = 0; q < 8; ++q) *(LAS bf16_t*)(VT + (v8 * 8 + q) * ST + s * 2) = f2bf(valid ? x[q] : 0.f); }
    const int r = lane & 15, q = lane >> 4, tt = w & 3, dh = w >> 2, t = tt * 16 + r;
    bf16x8 sfr[4][2];
    { const bf16_t* Sg = p.GS() + (size_t)u * 8192;
#pragma unroll
        for (int i = 0; i < 4; ++i)
#pragma unroll
            for (int ks = 0; ks < 2; ++ks) sfr[i][ks] = *(const bf16x8*)(Sg + ((dh * 4 + i) * 16 + r) * 64 + ks * 32 + q * 8); }
    __syncthreads();
    f32x4 hv[4];
    { bf16x8 qb[2];
#pragma unroll
        for (int ks = 0; ks < 2; ++ks) qb[ks] = ldfrag(QT + (tt * 16 + r) * ST + (ks * 32 + q * 8) * 2);
#pragma unroll
        for (int i = 0; i < 4; ++i) { hv[i] = (f32x4){0.f, 0.f, 0.f, 0.f};
#pragma unroll
            for (int ks = 0; ks < 2; ++ks) hv[i] = mfma16(sfr[i][ks], qb[ks], hv[i]); }
#pragma unroll
        for (int cc = 0; cc < 2; ++cc) { const int st = dh * 2 + cc; f32x4 acc = {0.f, 0.f, 0.f, 0.f};
            if (st <= tt) {
#pragma unroll
                for (int ks = 0; ks < 2; ++ks) acc = mfma16(ldfrag(KT2 + (st * 16 + r) * ST + (ks * 32 + q * 8) * 2), qb[ks], acc); }
            float sv[4];
#pragma unroll
            for (int j = 0; j < 4; ++j) { const int s = st * 16 + q * 4 + j; sv[j] = (s <= t) ? acc[j] : 0.f; }
            u32x2 o; o.x = cvt_pk_bf16(sv[0], sv[1]); o.y = cvt_pk_bf16(sv[2], sv[3]); *(LAS u32x2*)(AS + t * ST + (st * 16 + q * 4) * 2) = o; } }
    u32x2 og[4]; f32x4 gn[4];
#pragma unroll
    for (int i = 0; i < 4; ++i) { const int d0 = (dh * 4 + i) * 16 + q * 4; og[i] = *(const u32x2*)(z + (size_t)(r0 + t) * NIN + ZO_GG + hd * 128 + d0); gn[i] = *(const f32x4*)(p.g_norm_g + l * 512 + hd * 128 + d0); }
    __syncthreads();
    { bf16x8 ab2[2];
#pragma unroll
        for (int ks = 0; ks < 2; ++ks) ab2[ks] = ldfrag(AS + (tt * 16 + r) * ST + (ks * 32 + q * 8) * 2);
        float ssq = 0.f;
#pragma unroll
        for (int i = 0; i < 4; ++i) { const int dt = dh * 4 + i;
#pragma unroll
            for (int ks = 0; ks < 2; ++ks) hv[i] = mfma16(ldfrag(VT + (dt * 16 + r) * ST + (ks * 32 + q * 8) * 2), ab2[ks], hv[i]);
            ssq += hv[i][0] * hv[i][0] + hv[i][1] * hv[i][1] + hv[i][2] * hv[i][2] + hv[i][3] * hv[i][3]; }
        ssq += __shfl_xor(ssq, 16); ssq += __shfl_xor(ssq, 32); if (q == 0) part[t * 2 + dh] = ssq; }
    __syncthreads();
    { const bool valid = (c > 0) || (t >= LEAD); const float sc = rsqrtf((part[t * 2] + part[t * 2 + 1]) * (1.f / 128.f) + EPS); bf16_t* yp = p.Z() + (size_t)(r0 + t) * NIN + ZO_GG + hd * 128;
#pragma unroll
        for (int i = 0; i < 4; ++i) { const int d0 = (dh * 4 + i) * 16 + q * 4; float y[4];
            y[0] = hv[i][0] * sc * gn[i][0] * silu(bflo(og[i].x)); y[1] = hv[i][1] * sc * gn[i][1] * silu(bfhi(og[i].x)); y[2] = hv[i][2] * sc * gn[i][2] * silu(bflo(og[i].y)); y[3] = hv[i][3] * sc * gn[i][3] * silu(bfhi(og[i].y));
            u32x2 o; o.x = valid ? cvt_pk_bf16(y[0], y[1]) : 0u; o.y = valid ? cvt_pk_bf16(y[2], y[3]) : 0u; *(u32x2*)(yp + d0) = o; } }
    __syncthreads();
}
}

namespace pro {
#define PRO_TILE(LDEXPR, OUTROW) do { \
        _Pragma("unroll 8") for (int i = 0; i < 32; ++i) { const int kk = 2 * i + (lane >> 5), nn = lane & 31; scr[kk * 33 + nn] = (LDEXPR); } \
        asm volatile("s_waitcnt lgkmcnt(0)" ::: "memory"); \
        { const int c8 = lane & 7; _Pragma("unroll") for (int j = 0; j < 4; ++j) { const int nn = (lane >> 3) + 8 * j; const LAS float* s_ = scr + (8 * c8) * 33 + nn; \
            pg8::u32x4 o_; o_.x = pg8::cvt_pk_bf16(s_[0], s_[33]); o_.y = pg8::cvt_pk_bf16(s_[66], s_[99]); o_.z = pg8::cvt_pk_bf16(s_[132], s_[165]); o_.w = pg8::cvt_pk_bf16(s_[198], s_[231]); \
            *(pg8::u32x4*)((OUTROW) + 8 * c8) = o_; } } \
        asm volatile("s_waitcnt lgkmcnt(0)" ::: "memory"); } while (0)
__device__ __forceinline__ void prologue_phase(const P& p, LAS unsigned char* lds, int G, int bid, int tid) {
    asm volatile("" : "+v"(tid));
    const int lane = tid & 63, w = __builtin_amdgcn_readfirstlane(tid >> 6), gw = bid * NWAVES + w, NGW = G * NWAVES;
    LAS float* scr = (LAS float*)(lds + w * 8448);
    constexpr int I_IN = DEPTH * 16 * (NZP / 32), I_OUT = DEPTH * 16 * (D / 32), I_GU = DEPTH * NE * 16 * (512 / 32), I_D = DEPTH * NE * (DE / 64) * (D / 32);
    for (int it = gw; it < I_IN + I_OUT + I_GU + I_D; it += NGW) {
        int r = it;
        if (r < I_IN) { const int nb = r % (NZP / 32), kb = (r / (NZP / 32)) % 16, l = r / (16 * (NZP / 32)), k0 = kb * 64, n0 = nb * 32;
            const int n = n0 + (lane & 31); const int sc = zsrc(n); const float* src = p.w_in + ((size_t)l * D + k0) * NIN + sc; const float* g = p.norm1_g + l * D + k0;
            bf16_t* ob = (bf16_t*)(p.ws + WS_WIN) + ((size_t)l * NZP + n0) * D + k0;
            PRO_TILE((n < NIN) ? src[(size_t)kk * NIN] * g[kk] : 0.f, ob + (size_t)nn * D);
            continue; }
        r -= I_IN;
        if (r < I_OUT) { const int nb = r % 32, kb = (r / 32) % 16, l = r / 512, k0 = kb * 64, n0 = nb * 32;
            const float* src = p.w_out + ((size_t)l * D + k0) * D + n0 + (lane & 31); bf16_t* ob = (bf16_t*)(p.ws + WS_WOUT) + ((size_t)l * D + n0) * D + k0;
            PRO_TILE(src[(size_t)kk * D], ob + (size_t)nn * D);
            continue; }
        r -= I_OUT;
        if (r < I_GU) { const int nb = r % 16, kb = (r / 16) % 16, bz = r / 256, k0 = kb * 64, n0 = nb * 32;
            const int i = lane & 31; const float* src = ((i < 16) ? p.w_gate : p.w_up) + ((size_t)bz * D + k0) * DE + 16 * nb + (i & 15); const float* g = p.norm2_g + (bz >> 5) * D + k0;
            bf16_t* ob = (bf16_t*)(p.ws + WS_WGU) + ((size_t)bz * 512 + n0) * D + k0;
            PRO_TILE(src[(size_t)kk * DE] * g[kk], ob + (size_t)nn * D);
            continue; }
        r -= I_GU;
        { const int nb = r % 32, kb = (r / 32) % 4, bz = r / 128, k0 = kb * 64, n0 = nb * 32;
            const float* src = p.w_down + ((size_t)bz * DE + k0) * D + n0 + (lane & 31); bf16_t* ob = (bf16_t*)(p.ws + WS_WD) + ((size_t)bz * D + n0) * DE + k0;
            PRO_TILE(src[(size_t)kk * D], ob + (size_t)nn * DE); }
    }
    for (int idx = bid * NTHR + tid; idx < DEPTH * NR * D; idx += G * NTHR) { const int k = idx % D, o = (idx / D) % NR, l = idx / (D * NR); float v = 0.f;
        if (o < 4) v = p.wr_g[((size_t)l * D + k) * 4 + o]; else if (o < 36) v = p.wr_e[((size_t)l * D + k) * 32 + (o - 4)];
        p.Wr()[idx] = v * p.norm2_g[l * D + k]; }
    for (int idx = bid * NTHR + tid; idx < DEPTH * 48 * D; idx += G * NTHR) { const int k = idx % D, o = (idx / D) % 48, l = idx / (D * 48); float v = 0.f;
        if (o < 4) v = p.wr_g[((size_t)l * D + k) * 4 + o]; else if (o < 36) v = p.wr_e[((size_t)l * D + k) * 32 + (o - 4)];
        v *= p.norm2_g[l * D + k]; const bf16_t hi = f2bf(v), lo = f2bf(v - bf2f(hi));
        bf16_t* wh = (bf16_t*)(p.ws + WS_WRS); wh[idx] = hi; wh[(size_t)DEPTH * 48 * D + idx] = lo; }
    for (int r = gw; r < MP; r += NGW) { const int b = r / TP, pp = r % TP; const float* src = nullptr;
        if (pp >= 64) src = p.x + ((size_t)b * SEQ + (pp - 64)) * D; else if (pp >= LEAD) src = p.meta + (size_t)(pp - LEAD) * D;
        float s = 0.f; bf16_t* hr = p.H() + (size_t)r * D;
#pragma unroll
        for (int j = 0; j < 4; ++j) { f32x4 v = {0.f, 0.f, 0.f, 0.f}; if (src) v = ((const f32x4*)src)[lane + 64 * j];
            s += v.x * v.x + v.y * v.y + v.z * v.z + v.w * v.w;
            pg8::u32x2 o; o.x = pg8::cvt_pk_bf16(v.x, v.y); o.y = pg8::cvt_pk_bf16(v.z, v.w); ((pg8::u32x2*)hr)[lane + 64 * j] = o; }
        s = wave_sum(s);
        if (lane == 0) { f32x4 q = {s, 0.f, 0.f, 0.f}; *(f32x4*)(p.SS1() + (size_t)r * 4) = q; } }
}
#undef PRO_TILE
__device__ __forceinline__ void final_phase(const P& p, int G, int bid, int tid) {
    asm volatile("" : "+v"(tid));
    const int lane = tid & 63, w = tid >> 6;
    for (int t = bid * NWAVES + w; t < B * SEQ; t += G * NWAVES) { const int b = t / SEQ, s = t % SEQ, r = b * TP + 64 + s;
        const float rs = row_rs(p.SS1(), r); const bf16_t* hr = p.H() + (size_t)r * D; float* o = p.out + (size_t)t * D;
#pragma unroll
        for (int j = 0; j < 4; ++j) { const pg8::u32x2 hv = ((const pg8::u32x2*)hr)[lane + 64 * j]; const f32x4 g = ((const f32x4*)p.final_g)[lane + 64 * j];
            f32x4 v; v.x = pg8::bflo(hv.x) * rs * g.x; v.y = pg8::bfhi(hv.x) * rs * g.y; v.z = pg8::bflo(hv.y) * rs * g.z; v.w = pg8::bfhi(hv.y) * rs * g.w;
            ((f32x4*)o)[lane + 64 * j] = v; } }
}
}

#ifndef REP_PRO
#define REP_PRO 1
#endif
#ifndef REP_IN
#define REP_IN 1
#endif
#ifndef REP_LOC
#define REP_LOC 1
#endif
#ifndef REP_UP
#define REP_UP 1
#endif
#ifndef REP_FIN
#define REP_FIN 1
#endif
struct Args { P p; int ph_lo, ph_hi; };
__global__ void __launch_bounds__(NTHR, 2) fwd(Args a) {
    extern __shared__ __attribute__((aligned(16))) unsigned char lds_raw[];
    LAS unsigned char* lds = (LAS unsigned char*)lds_raw;
    const P& p = a.p;
    const int tid = threadIdx.x, G = gridDim.x, bid = blockIdx.x;
    unsigned* ctl = (unsigned*)(p.ws + WS_CTL);
    volatile LAS unsigned* MISC = (volatile LAS unsigned*)(lds + MISC_OFF);
    if (tid < 128) MISC[tid] = 0u;
    __syncthreads();
    const bool multi = (a.ph_hi - a.ph_lo) > 1;
    XcdBarrier bar; bar.bar = ctl + CW_BAR; bar.x = 0; bar.st = nullptr;
    if (multi) bar = xcd_barrier_post(ctl + CW_BAR, MISC + 8);
#define IN(k) (a.ph_lo <= (k) && (k) < a.ph_hi)
#ifndef PROBE_MASK
#define PROBE_MASK 0
#endif
#ifndef PROBE_K
#define PROBE_K 10
#endif
    unsigned long long tacc_ = 0, tprev_ = PROBE_MASK ? __builtin_amdgcn_s_memrealtime() : 0ull;
#define SEAM(k) do { if (IN(k) && IN((k) + 1)) xcd_barrier(bar); \
        if (PROBE_MASK) { const unsigned long long tn_ = __builtin_amdgcn_s_memrealtime(); const int kk_ = (k); const int bit_ = (kk_ == PH_PRO) ? 9 : (kk_ >= PH_FINAL ? 10 : (kk_ - PH_LAYER0) % PH_PER_LAYER); \
            if ((PROBE_MASK >> bit_) & 1) tacc_ += tn_ - tprev_; tprev_ = tn_; } } while (0)
#if !defined(ONLY) || ONLY==100
    if (IN(PH_PRO)) {
_Pragma("unroll 1") for (int rep_ = 0; rep_ < REP_PRO; ++rep_) { pro::prologue_phase(p, lds, G, bid, tid); if (rep_ + 1 < REP_PRO) xcd_barrier(bar); } }
#endif
    SEAM(PH_PRO);
    for (int l = 0; l < DEPTH; ++l) {
        const int pb = PH_LAYER0 + l * PH_PER_LAYER;
        unsigned* gcnt = ctl + CW_CNT + l * 64 * 16;
#if !defined(ONLY) || ONLY==0
        if (IN(pb + 0)) {
_Pragma("unroll 1") for (int rep_ = 0; rep_ < REP_IN; ++rep_) {
            pg8::DenseOrder<D, D> S; S.init(MP, NZP, G, bid);
            pg8::EpiZ E{p.ws};
            pg8::gemm_phase<pg8::EpiZ, pg8::DenseOrder<D, D>, true, D, D>(lds + RING_OFF, (const char*)(p.ws + WS_H), (const char*)(p.ws + WS_WIN) + (size_t)l * NZP * D * 2, S, E);
            if (rep_ + 1 < REP_IN) xcd_barrier(bar); }
        }
#endif
        SEAM(pb + 0);
#if !defined(ONLY) || ONLY==1
        if (IN(pb + 1)) {
_Pragma("unroll 1") for (int rep_ = 0; rep_ < REP_LOC; ++rep_) { { const int ulo = (int)((long)bid * NU / G), uhi = (int)((long)(bid + 1) * NU / G);
                if (ulo < uhi) { mx::PreM<2> pre; mx::load_m<2>(p, ulo, pre, tid, ZO_VM);
                    for (int u = ulo; u < uhi; ++u) { mx::PreM<2> nxt = pre; if (u + 1 < uhi) mx::load_m<2>(p, u + 1, nxt, tid, ZO_VM); mx::mlstm_local(p, l, u, lds, tid, pre); pre = nxt; } }
                if (ulo < uhi) { mx::PreG pre; mx::load_g(p, l, ulo, pre, tid, false);
                    for (int u = ulo; u < uhi; ++u) { mx::PreG nxt = pre; if (u + 1 < uhi) mx::load_g(p, l, u + 1, nxt, tid, false); mx::gla_local(p, l, u, lds, tid, pre); pre = nxt; } } } if (rep_ + 1 < REP_LOC) xcd_barrier(bar); } }
#endif
        SEAM(pb + 1);
#if !defined(ONLY) || ONLY==2
        if (IN(pb + 2)) mx::scan_phase(p, lds, G, bid, tid);
#endif
        SEAM(pb + 2);
#if !defined(ONLY) || ONLY==3
        if (IN(pb + 3)) { { const int ulo = (int)((long)bid * NU / G), uhi = (int)((long)(bid + 1) * NU / G);
                if (ulo < uhi) { mx::PreM<4> pre; mx::load_m<4>(p, ulo, pre, tid, ZO_VM);
                    for (int u = ulo; u < uhi; ++u) { mx::PreM<4> nxt = pre; if (u + 1 < uhi) mx::load_m<4>(p, u + 1, nxt, tid, ZO_VM); mx::mlstm_out(p, l, u, lds, tid, pre); pre = nxt; } }
                if (ulo < uhi) { mx::PreG pre; mx::load_g(p, l, ulo, pre, tid, true);
                    for (int u = ulo; u < uhi; ++u) { mx::PreG nxt = pre; if (u + 1 < uhi) mx::load_g(p, l, u + 1, nxt, tid, true); mx::gla_out(p, l, u, lds, tid, pre); pre = nxt; } } } }
#endif
        SEAM(pb + 3);
#if !defined(ONLY) || ONLY==4
        if (IN(pb + 4)) {
            pg8::DenseOrder<NIN, D> S; S.init(MP, D, G, bid);
            pg8::EpiRes<false, true, WS_SS2> E{p.ws, lds};
            pg8::gemm_phase<pg8::EpiRes<false, true, WS_SS2>, pg8::DenseOrder<NIN, D>, true, NIN, D>(lds + RING_OFF, (const char*)(p.ws + WS_Z), (const char*)(p.ws + WS_WOUT) + (size_t)l * D * D * 2, S, E);
        }
#endif
        SEAM(pb + 4);
#if !defined(ONLY) || ONLY==5
        if (IN(pb + 5)) route_phase(p, l, lds, G, bid, gcnt);
#endif
        SEAM(pb + 5);
#if !defined(ONLY) || ONLY==6
        if (IN(pb + 6)) {
_Pragma("unroll 1") for (int rep_ = 0; rep_ < REP_UP; ++rep_) {
            moe_build_tab((LAS MoeTab*)(lds + TAB_OFF), gcnt);
            typedef MoeOrder<true, 2, D, D, 512u * D * 2u> Ord;
            Ord S; S.lds = lds; S.ws = p.ws; S.rbLo = 0; S.nwg = ((const LAS MoeTab*)(lds + TAB_OFF))->rb0[64] * 2; S.G = G; S.c = bid;
            pg8::EpiUp E{p.ws, lds};
            pg8::gemm_phase<pg8::EpiUp, Ord, true, D, D>(lds + RING_OFF, (const char*)(p.ws + WS_H), (const char*)(p.ws + WS_WGU) + (size_t)l * NE * 512 * D * 2, S, E);
            if (rep_ + 1 < REP_UP) xcd_barrier(bar); }
        }
#endif
        SEAM(pb + 6);
#if !defined(ONLY) || ONLY==7
#pragma unroll
        for (int rank = 0; rank < 2; ++rank) {
            if (IN(pb + 7 + rank)) {
                moe_build_tab((LAS MoeTab*)(lds + TAB_OFF), gcnt);
                const LAS MoeTab* T = (const LAS MoeTab*)(lds + TAB_OFF);
                typedef MoeOrder<false, 4, DE, DE, (unsigned)D * DE * 2u> Ord;
                Ord S; S.lds = lds; S.ws = p.ws; S.rbLo = T->rb0[32 * rank]; S.nwg = (T->rb0[32 * rank + 32] - T->rb0[32 * rank]) * 4; S.G = G; S.c = bid;
                const char* Ab = (const char*)(p.ws + WS_HID); const char* Bb = (const char*)(p.ws + WS_WD) + (size_t)l * NE * D * DE * 2;
                if (rank == 0) { pg8::EpiRes<true, false, WS_SS1> E{p.ws, lds}; pg8::gemm_phase<pg8::EpiRes<true, false, WS_SS1>, Ord, true, DE, DE>(lds + RING_OFF, Ab, Bb, S, E); }
                else { pg8::EpiRes<true, true, WS_SS1> E{p.ws, lds}; pg8::gemm_phase<pg8::EpiRes<true, true, WS_SS1>, Ord, true, DE, DE>(lds + RING_OFF, Ab, Bb, S, E); }
            }
            SEAM(pb + 7 + rank);
        }
#endif
    }
#if !defined(ONLY) || ONLY==101
    if (IN(PH_FINAL)) {
_Pragma("unroll 1") for (int rep_ = 0; rep_ < REP_FIN; ++rep_) { pro::final_phase(p, G, bid, tid); if (rep_ + 1 < REP_FIN) xcd_barrier(bar); } }
#endif
    if (PROBE_MASK) { const unsigned long long tn_ = __builtin_amdgcn_s_memrealtime(); if ((PROBE_MASK >> 10) & 1) tacc_ += tn_ - tprev_;
        if (bid == 0 && tid == 0) { const unsigned long long tgt_ = tn_ + (unsigned long long)PROBE_K * tacc_; while (__builtin_amdgcn_s_memrealtime() < tgt_) __builtin_amdgcn_s_sleep(8); } }
#undef IN
#undef SEAM
}

#ifndef FAST_GEMM
#define FAST_GEMM 1
#endif
#ifndef FAST_MIX
#define FAST_MIX 1
#endif
#ifndef FAST_PRO
#define FAST_PRO 1
#endif
#ifndef ONE_LAUNCH
#define ONE_LAUNCH 1
#endif
#ifndef FAST_MOE
#define FAST_MOE 1
#endif
extern "C" void kernel_launch(void* const* d_in, const int* in_sizes, int n_in, void* d_out, int out_size, void* d_ws, size_t ws_size, hipStream_t stream) {
    if (n_in != 21 || ws_size < WS_END || out_size != B * SEQ * D) { fprintf(stderr, "kernel_launch: unexpected sizes n_in %d ws %zu (need %zu) out %d\n", n_in, ws_size, (size_t)WS_END, out_size); return; }
    P p{};
    const float** f = (const float**)&p.x;
    for (int i = 0; i < 21; ++i) f[i] = (const float*)d_in[i];
    p.out = (float*)d_out; p.ws = (unsigned char*)d_ws;
    static int grid = 0;
    constexpr int LDS_LOCAL = 18000 * 4, LDS_OUT = 35000 * 4;
    if (!grid) {
        (void)hipFuncSetAttribute((const void*)k_mix_local_ref, hipFuncAttributeMaxDynamicSharedMemorySize, LDS_LOCAL);
        (void)hipFuncSetAttribute((const void*)k_mix_out_ref, hipFuncAttributeMaxDynamicSharedMemorySize, LDS_OUT);
        (void)hipFuncSetAttribute((const void*)fwd, hipFuncAttributeMaxDynamicSharedMemorySize, LDS_BYTES);
        int dev = 0, cus = 0, per_cu = 0;
        (void)hipGetDevice(&dev); (void)hipDeviceGetAttribute(&cus, hipDeviceAttributeMultiprocessorCount, dev);
        (void)hipOccupancyMaxActiveBlocksPerMultiprocessor(&per_cu, (const void*)fwd, NTHR, LDS_BYTES);
        (void)hipGetLastError();
        grid = cus > 0 ? cus : 256;
        if (per_cu < 1) fprintf(stderr, "kernel_launch: occupancy query reports %d blocks/CU for fwd\n", per_cu);
    }
    (void)hipMemsetAsync(d_ws, 0, CTL_BYTES, stream);
    Args a{}; a.p = p;
    auto run_phase = [&](int ph) { a.ph_lo = ph; a.ph_hi = ph + 1; hipLaunchKernelGGL(fwd, dim3(grid), dim3(NTHR), LDS_BYTES, stream, a); };
    if (ONE_LAUNCH) { a.ph_lo = 0; a.ph_hi = PH_COUNT; hipLaunchKernelGGL(fwd, dim3(grid), dim3(NTHR), LDS_BYTES, stream, a); return; }
    if (FAST_PRO) run_phase(PH_PRO);
    else {
    hipLaunchKernelGGL(k_transpose<TWin>, dim3(NZP / 32, D / 32, DEPTH), dim3(256), 0, stream, TWin{p.w_in, p.norm1_g, (bf16_t*)(p.ws + WS_WIN)});
    hipLaunchKernelGGL(k_transpose<TWout>, dim3(D / 32, D / 32, DEPTH), dim3(256), 0, stream, TWout{p.w_out, (bf16_t*)(p.ws + WS_WOUT)});
    hipLaunchKernelGGL(k_transpose<TWgu>, dim3(512 / 32, D / 32, DEPTH * NE), dim3(256), 0, stream, TWgu{p.w_gate, p.w_up, p.norm2_g, (bf16_t*)(p.ws + WS_WGU)});
    hipLaunchKernelGGL(k_transpose<TWd>, dim3(D / 32, DE / 32, DEPTH * NE), dim3(256), 0, stream, TWd{p.w_down, (bf16_t*)(p.ws + WS_WD)});
    hipLaunchKernelGGL(k_prep_wr, dim3((DEPTH * NR * D + 255) / 256), dim3(256), 0, stream, p);
    hipLaunchKernelGGL(k_prep_h, dim3(MP / 4), dim3(256), 0, stream, p);
    }
    bf16_t* H = (bf16_t*)(p.ws + WS_H); bf16_t* Z = (bf16_t*)(p.ws + WS_Z);
    for (int l = 0; l < DEPTH; ++l) {
        const int pb = PH_LAYER0 + l * PH_PER_LAYER;
        if (FAST_GEMM) run_phase(pb + 0);
        else hipLaunchKernelGGL(k_gemm_ref<EZ>, dim3((NIN + 63) / 64, MP / 64), dim3(256), 0, stream, H, D, (const bf16_t*)(p.ws + WS_WIN) + (size_t)l * NZP * D, D, NIN, EZ{Z, (const float*)(p.ws + WS_SS1)});
        if (FAST_MIX) { run_phase(pb + 1); run_phase(pb + 2); run_phase(pb + 3); }
        else { hipLaunchKernelGGL(k_mix_local_ref, dim3(2 * NU), dim3(256), LDS_LOCAL, stream, p, l);
               hipLaunchKernelGGL(k_scan_ref, dim3(16 * 65 + 16 * 32), dim3(256), 0, stream, p);
               hipLaunchKernelGGL(k_mix_out_ref, dim3(2 * NU), dim3(256), LDS_OUT, stream, p, l); }
        if (FAST_GEMM) run_phase(pb + 4);
        else { hipLaunchKernelGGL(k_gemm_ref<EO>, dim3(D / 64, MP / 64), dim3(256), 0, stream, Z, NIN, (const bf16_t*)(p.ws + WS_WOUT) + (size_t)l * D * D, D, D, EO{H});
               hipLaunchKernelGGL(k_rowss, dim3(MP / 4), dim3(256), 0, stream, H, (float*)(p.ws + WS_SS2)); }
        if (FAST_MOE) { run_phase(pb + 5); run_phase(pb + 6); run_phase(pb + 7); run_phase(pb + 8); }
        else { hipLaunchKernelGGL(k_route_ref, dim3(MP / 4), dim3(256), 0, stream, p, l);
               hipLaunchKernelGGL(k_moe_ref, dim3(MP), dim3(256), 0, stream, p, l); }
    }
    if (FAST_PRO) run_phase(PH_FINAL); else hipLaunchKernelGGL(k_final_ref, dim3(B * SEQ / 4), dim3(256), 0, stream, p);
}
```

```cpp
#include <hip/hip_runtime.h>
#include <cstdio>
#include <cstdint>

typedef unsigned short bf16_t;
typedef float f32x4 __attribute__((ext_vector_type(4)));

namespace cfg {
constexpr int B = 4, SEQ = 8192, D = 1024, DEPTH = 2;
constexpr int CH = 64, NMETA = 16, LEAD = 48;
constexpr int TP = LEAD + NMETA + SEQ;
constexpr int NCH = TP / CH;
constexpr int MP = B * TP;
constexpr int NIN = 3608, NZP = 3840;
constexpr int ZO_OM = 0, ZO_GG = 512, ZO_QM = 1024, ZO_KM = 1536, ZO_VM = 2048, ZO_QG = 2560, ZO_KG = 2816, ZO_VG = 3072, ZO_IG = 3584, ZO_FG = 3588, ZO_CODE = 3592;
constexpr int NE = 32, DE = 256, NR = 40;
constexpr float EPS = 1e-6f;
constexpr int NU = B * 4 * NCH;

constexpr size_t al(size_t x) { return (x + 255) & ~(size_t)255; }
constexpr size_t WS_CTL = 0, CTL_BYTES = 4u << 20;
constexpr size_t WS_WIN = WS_CTL + CTL_BYTES;
constexpr size_t WS_WOUT = WS_WIN + al((size_t)DEPTH * NZP * D * 2);
constexpr size_t WS_WGU = WS_WOUT + al((size_t)DEPTH * D * D * 2);
constexpr size_t WS_WD = WS_WGU + al((size_t)DEPTH * NE * 512 * D * 2);
constexpr size_t WS_WR = WS_WD + al((size_t)DEPTH * NE * D * DE * 2);
constexpr size_t WS_H = WS_WR + al((size_t)DEPTH * NR * D * 4);
constexpr size_t WS_Z = WS_H + al((size_t)MP * D * 2);
constexpr size_t WS_SS1 = WS_Z + al((size_t)MP * NIN * 2);
constexpr size_t WS_SS2 = WS_SS1 + al((size_t)MP * 16);
constexpr size_t WS_TOKE = WS_SS2 + al((size_t)MP * 16);
constexpr size_t WS_TOKW = WS_TOKE + al((size_t)MP * 8);
constexpr int CAPL = MP, NBMAX = 352;
constexpr size_t WS_LTOK = WS_TOKW + al((size_t)MP * 8);
constexpr size_t WS_LRS = WS_LTOK + al((size_t)64 * CAPL * 4);
constexpr size_t WS_LW = WS_LRS + al((size_t)64 * CAPL * 4);
constexpr size_t WS_WRS = WS_LW + al((size_t)64 * CAPL * 4);
constexpr size_t WS_QKC = WS_WRS + al((size_t)2 * DEPTH * 48 * D * 2);
constexpr size_t WS_END = WS_QKC + al((size_t)MP * 1024 * 2);
constexpr size_t WS_HID = WS_Z;
static_assert((size_t)NBMAX * 256 * 256 * 2 <= (size_t)MP * NIN * 2, "hid fits in z");
constexpr size_t ST_MC = 0;
constexpr size_t ST_GS = ST_MC + al((size_t)NU * 16384 * 2);
constexpr size_t ST_MN = ST_GS + al((size_t)NU * 8192 * 2);
constexpr size_t ST_MSC = ST_MN + al((size_t)NU * 128 * 4);
constexpr size_t ST_GB = ST_MSC + al((size_t)NU * 16);
constexpr size_t ST_GA = ST_GB + al((size_t)NU * 64 * 4);
constexpr size_t ST_END = ST_GA + al((size_t)NU * 192 * 4);
static_assert(ST_END <= (size_t)B * SEQ * D * 4, "state scratch fits d_out");
}
using namespace cfg;

__device__ __forceinline__ float bf2f(bf16_t v) { return __uint_as_float(((unsigned)v) << 16); }
__device__ __forceinline__ bf16_t f2bf(float f) { unsigned u = __float_as_uint(f); u += 0x7fffu + ((u >> 16) & 1u); return (bf16_t)(u >> 16); }
__device__ __forceinline__ float wave_sum(float v) {
#pragma unroll
    for (int o = 1; o < 64; o <<= 1) v += __shfl_xor(v, o);
    return v;
}
__device__ __forceinline__ float logsig(float x) { return fminf(x, 0.f) - log1pf(__expf(-fabsf(x))); }
__device__ __forceinline__ float sigm(float x) { return 1.f / (1.f + __expf(-x)); }
__device__ __forceinline__ float silu(float x) { return x * sigm(x); }

__host__ __device__ __forceinline__ int zsrc(int n) {
    if (n < 512) return 1536 + n;
    if (n < 1024) return 3080 + (n - 512);
    if (n < 2048) return n - 1024;
    if (n < 2560) return 1024 + (n - 2048);
    if (n < 2816) return 2056 + (n - 2560);
    if (n < 3072) return 2312 + (n - 2816);
    if (n < 3584) return 2568 + (n - 3072);
    if (n < 3588) return 2048 + (n - 3584);
    if (n < 3592) return 2052 + (n - 3588);
    return n;
}

struct P {
    const float *x, *meta, *norm1_g, *w_in, *conv_w, *conv_b, *gate_b, *m_norm_g, *a_w2, *a_b, *g_norm_g, *w_out, *norm2_g, *wr_g, *br_g, *wr_e, *br_e, *w_gate, *w_up, *w_down, *final_g;
    float* out; unsigned char* ws;
    __device__ __forceinline__ bf16_t* Win() const { return (bf16_t*)(ws + WS_WIN); }
    __device__ __forceinline__ bf16_t* Wout() const { return (bf16_t*)(ws + WS_WOUT); }
    __device__ __forceinline__ bf16_t* Wgu() const { return (bf16_t*)(ws + WS_WGU); }
    __device__ __forceinline__ bf16_t* Wd() const { return (bf16_t*)(ws + WS_WD); }
    __device__ __forceinline__ float* Wr() const { return (float*)(ws + WS_WR); }
    __device__ __forceinline__ bf16_t* H() const { return (bf16_t*)(ws + WS_H); }
    __device__ __forceinline__ bf16_t* Z() const { return (bf16_t*)(ws + WS_Z); }
    __device__ __forceinline__ float* SS1() const { return (float*)(ws + WS_SS1); }
    __device__ __forceinline__ float* SS2() const { return (float*)(ws + WS_SS2); }
    __device__ __forceinline__ int* TokE() const { return (int*)(ws + WS_TOKE); }
    __device__ __forceinline__ float* TokW() const { return (float*)(ws + WS_TOKW); }
    __device__ __forceinline__ bf16_t* MC() const { return (bf16_t*)((unsigned char*)out + ST_MC); }
    __device__ __forceinline__ bf16_t* GS() const { return (bf16_t*)((unsigned char*)out + ST_GS); }
    __device__ __forceinline__ float* MN() const { return (float*)((unsigned char*)out + ST_MN); }
    __device__ __forceinline__ float* MSC() const { return (float*)((unsigned char*)out + ST_MSC); }
    __device__ __forceinline__ float* GB() const { return (float*)((unsigned char*)out + ST_GB); }
};

__device__ __forceinline__ float row_rs(const float* ss, int r) {
    if ((r % TP) < LEAD) return 0.f;
    const f32x4 v = *(const f32x4*)(ss + (size_t)r * 4);
    return rsqrtf((v.x + v.y + v.z + v.w) * (1.f / D) + EPS);
}

#define LAS __attribute__((address_space(3)))
constexpr int NWAVES = 8, NTHR = 512;
constexpr int RING_OFF = 0, RING_BYTES = 131072, TAB_OFF = 131072, TAB_BYTES = 24576, MISC_OFF = TAB_OFF + TAB_BYTES, LDS_BYTES = MISC_OFF + 512;
constexpr int RED_OFF = TAB_OFF + 4096;
constexpr int UROW_OFF = TAB_OFF + 8192;
constexpr int CW_BAR = 4096, CW_CNT = 16384;
constexpr int PH_PRO = 0, PH_LAYER0 = 1, PH_PER_LAYER = 9, PH_FINAL = 1 + 9 * DEPTH, PH_COUNT = PH_FINAL + 1;

#define XB_TMO      128
#define XB_XCNT(j)  (256  + 64 * (j))
#define XB_XSUB(j)  (1280 + 64 * (j))
#define XB_XGEN(j)  (2304 + 64 * (j))
#define XB_TOP      3328
#define XB_TOPGEN   3392
#define XCD_BAR_WORDS 3456
#define XB_SPIN_CAP (1u << 18)
__device__ __forceinline__ unsigned xb_ld(unsigned* p)              { return __hip_atomic_load(p, __ATOMIC_RELAXED, __HIP_MEMORY_SCOPE_AGENT); }
__device__ __forceinline__ unsigned xb_add(unsigned* p, unsigned v) { return __hip_atomic_fetch_add(p, v, __ATOMIC_RELAXED, __HIP_MEMORY_SCOPE_AGENT); }
__device__ __forceinline__ unsigned xb_xcc_id() { return (unsigned)__builtin_amdgcn_s_getreg((3 << 11) | 20) & 0xFu; }
#define XB_SPIN(cond, bar) do { unsigned _sp = 0; while (cond) { __builtin_amdgcn_s_sleep(1); \
    if ((++_sp & 255u) == 0u) { if (xb_ld(&(bar)[XB_TMO])) break; if (_sp > XB_SPIN_CAP) { atomicAdd(&(bar)[XB_TMO], 1u); break; } } } } while (0)
struct XcdBarrier { unsigned* bar; unsigned x; volatile LAS unsigned* st; };
__device__ __forceinline__ XcdBarrier xcd_barrier_post(unsigned* bar, volatile LAS unsigned* st) {
    XcdBarrier b; b.bar = bar; b.x = xb_xcc_id(); b.st = st;
    if (threadIdx.x == 0) (void)xb_add(&bar[XB_XCNT(b.x)], 1u);
    return b;
}
__device__ __forceinline__ void xcd_barrier_complete(unsigned* bar, unsigned x, unsigned& nloc, unsigned& nx) {
    const unsigned G = gridDim.x * gridDim.y * gridDim.z;
    unsigned sum, cnt, mine, sp = 0u;
    for (;;) {
        sum = 0u; cnt = 0u; mine = 0u;
#pragma unroll
        for (unsigned j = 0; j < 16; ++j) { const unsigned c = xb_ld(&bar[XB_XCNT(j)]); sum += c; cnt += (c > 0u) ? 1u : 0u; mine = (j == x) ? c : mine; }
        if (sum == G) break;
        __builtin_amdgcn_s_sleep(1);
        if ((++sp & 255u) == 0u) { if (xb_ld(&bar[XB_TMO])) break; if (sp > XB_SPIN_CAP) { atomicAdd(&bar[XB_TMO], 1u); break; } }
    }
    nloc = mine > 0u ? mine : 1u; nx = cnt > 0u ? cnt : 1u;
}
__device__ __forceinline__ void xcd_barrier(const XcdBarrier& b) {
    asm volatile("s_waitcnt vmcnt(0)" ::: "memory");
    __syncthreads();
    if (threadIdx.x == 0) {
        unsigned* bar = b.bar;
        __builtin_amdgcn_s_waitcnt(0);
        unsigned nloc = b.st[0], nx = b.st[1];
        if (nloc == 0u) { xcd_barrier_complete(bar, b.x, nloc, nx); b.st[0] = nloc; b.st[1] = nx; }
        const unsigned old = xb_add(&bar[XB_XSUB(b.x)], 1u);
        const unsigned gen = old / nloc;
        if (old + 1u == (gen + 1u) * nloc) {
            __builtin_amdgcn_fence(__ATOMIC_RELEASE, "agent");
            asm volatile("s_waitcnt vmcnt(0)" ::: "memory");
            const unsigned og = xb_add(&bar[XB_TOP], 1u);
            const unsigned tg = og / nx;
            if (og + 1u == (tg + 1u) * nx) xb_add(&bar[XB_TOPGEN], 1u);
            else XB_SPIN(xb_ld(&bar[XB_TOPGEN]) == tg, bar);
            __builtin_amdgcn_fence(__ATOMIC_ACQUIRE, "agent");
            xb_add(&bar[XB_XGEN(b.x)], 1u);
            asm volatile("s_waitcnt vmcnt(0)" ::: "memory");
        } else {
            XB_SPIN(xb_ld(&bar[XB_XGEN(b.x)]) == gen, bar);
            __builtin_amdgcn_fence(__ATOMIC_ACQUIRE, "agent");
            asm volatile("s_waitcnt vmcnt(0)" ::: "memory");
        }
    }
    __syncthreads();
}

namespace pg8 {
typedef short bf16x8 __attribute__((ext_vector_type(8)));
typedef unsigned u32x4 __attribute__((ext_vector_type(4)));
typedef unsigned u32x2 __attribute__((ext_vector_type(2)));
constexpr int BM = 256, BK = 64, HALF = 128, HTB = HALF * BK * 2, STAGE_BYTES = 8 * HTB, NXCD = 8, WGM = 8;
__host__ __device__ __forceinline__ int lds_byte(int r, int c) { const int st = (r >> 4) * 2 + (c >> 5), rr = r & 15, cc = c & 31, ob = rr * 64 + cc * 2; return st * 1024 + (ob ^ (((ob >> 9) & 1) << 5)); }
__host__ __device__ __forceinline__ void stage_rc(int b, int& R, int& C) { const int st = b / 1024, sb = b % 1024, swz = sb ^ (((sb >> 9) & 1) << 5); R = (st >> 1) * 16 + swz / 64; C = (st & 1) * 32 + (swz % 64) / 2; }
__host__ __device__ __forceinline__ int perm32(int rho) { const int n = rho >> 4, i = rho & 15; return 8 * (i >> 2) + 4 * n + (i & 3); }
typedef float f32x2_ __attribute__((ext_vector_type(2))); typedef __bf16 bf16x2_ __attribute__((ext_vector_type(2)));
__device__ __forceinline__ unsigned cvt_pk_bf16(float lo, float hi) { const f32x2_ v = {lo, hi}; return __builtin_bit_cast(unsigned, __builtin_convertvector(v, bf16x2_)); }
__device__ __forceinline__ float bflo(unsigned w) { return __uint_as_float(w << 16); }
__device__ __forceinline__ float bfhi(unsigned w) { return __uint_as_float(w & 0xffff0000u); }

struct Unit { int pm, pn; unsigned ao, bo; };

__device__ __forceinline__ int xcd_remap(int L, int nwg) { const int q = nwg / NXCD, r = nwg % NXCD, xcd = L % NXCD, off = L / NXCD; return (xcd < r ? xcd * (q + 1) : r * (q + 1) + (xcd - r) * q) + off; }

template <int LDA, int K> struct DenseOrder {
    static constexpr bool GATHER = false, LIST = false;
    int nM, nN, nwg, G, c;
    __device__ __forceinline__ void init(int M, int N, int G_, int c_) { nM = M / BM; nN = N / BM; nwg = nM * nN; G = G_; c = c_; }
    __device__ __forceinline__ bool next(int i, Unit& u, int, int) const {
        const int L = i * G + c; if (L >= nwg) return false;
        const int wgid = xcd_remap(L, nwg);
        const int nig = WGM * nN, gid = wgid / nig, fm = gid * WGM, gsz = (nM - fm) < WGM ? (nM - fm) : WGM;
        u.pm = fm + ((wgid % nig) % gsz); u.pn = (wgid % nig) / gsz; u.ao = (unsigned)u.pm * (unsigned)(BM * LDA * 2); u.bo = (unsigned)u.pn * (unsigned)(BM * K * 2); return true;
    }
    __device__ __forceinline__ unsigned aoff(int, int rowl, int C) const { return (unsigned)(rowl * LDA + C) * 2u; }
};
template <int LDA, int K> struct DenseOrderRS : DenseOrder<LDA, K> {
    static constexpr bool GATHER = false, LIST = true;
    LAS unsigned char* lds; unsigned char* ws;
    __device__ __forceinline__ bool next(int i, Unit& u, int ub, int tid) const {
        if (!DenseOrder<LDA, K>::next(i, u, 0, 0)) return false;
        if (tid < 256) ((LAS float*)(lds + UROW_OFF))[ub * 256 + tid] = row_rs((const float*)(ws + WS_SS1), u.pm * BM + tid);
        return true;
    }
};

template <class Epi, class Sched, bool ALIGN_EPI, int LDA, int K>
__device__ __forceinline__ void gemm_phase(LAS unsigned char* lds, const char* Abase, const char* Bbase, const Sched& S, const Epi& E) {
    int tid_ = threadIdx.x; asm volatile("" : "+v"(tid_));
    const int tid = tid_, wid = __builtin_amdgcn_readfirstlane(tid >> 6), lane = tid & 63, wr = wid >> 2, wc = wid & 3, fr = lane & 15, fq = lane >> 4;
    constexpr int nt = K / BK;
    int Rr[2], Cc[2]; unsigned voffB[2];
#pragma unroll
    for (int i = 0; i < 2; ++i) { stage_rc(tid * 16 + i * 8192, Rr[i], Cc[i]); const int Rb = Epi::PERM ? ((Rr[i] & ~31) + perm32(Rr[i] & 31)) : Rr[i]; voffB[i] = (unsigned)(Rb * K + Cc[i]) * 2u; }
    constexpr unsigned kstep = BK * 2, hstepB = HALF * K * 2;
    const unsigned ldsw = (unsigned)wid * 1024u;
    const int aoff = lds_byte(wr * 64 + fr, fq * 8), boff = lds_byte(wc * 32 + fr, fq * 8);
#define PG8_SA(b, h) (((b) * 2 + (h)) * HTB)
#define PG8_SB(b, h) ((4 + (b) * 2 + (h)) * HTB)
#define PG8_STAGE(bufoff, gbase, uoff, voff) do { _Pragma("unroll") for (int _i = 0; _i < 2; ++_i) \
        __builtin_amdgcn_global_load_lds((const unsigned*)((gbase) + (size_t)(unsigned)((uoff) + (voff)[_i])), (LAS unsigned*)(lds + (bufoff) + ldsw + _i * 8192), 16, 0, 0); } while (0)
#define PG8_LDA(dst, b, h) do { _Pragma("unroll") for (int m = 0; m < 4; ++m) _Pragma("unroll") for (int k = 0; k < 2; ++k) dst[m][k] = *(const LAS bf16x8*)(lds + PG8_SA(b, h) + aoff + m * 2048 + k * 1024); } while (0)
#define PG8_LDB(dst, b, h) do { _Pragma("unroll") for (int n = 0; n < 2; ++n) _Pragma("unroll") for (int k = 0; k < 2; ++k) dst[n][k] = *(const LAS bf16x8*)(lds + PG8_SB(b, h) + boff + n * 2048 + k * 1024); } while (0)
#define PG8_MMA(ai, bj, At, Bt) do { __builtin_amdgcn_s_setprio(1); _Pragma("unroll") for (int m = 0; m < 4; ++m) _Pragma("unroll") for (int n = 0; n < 2; ++n) _Pragma("unroll") for (int k = 0; k < 2; ++k) \
        acc[ai][bj][m][n] = __builtin_amdgcn_mfma_f32_16x16x32_bf16(Bt[n][k], At[m][k], acc[ai][bj][m][n], 0, 0, 0); __builtin_amdgcn_s_setprio(0); } while (0)
#define PG8_WAIT_V(n) asm volatile("s_waitcnt vmcnt(" #n ")" ::: "memory")
#define PG8_WAIT_L(n) asm volatile("s_waitcnt lgkmcnt(" #n ")" ::: "memory")
#define PG8_BAR __builtin_amdgcn_s_barrier()
#define PG8_SCHED __builtin_amdgcn_sched_barrier(0)
    Unit cur, nxt; int ui = 0, ub = 0;
    if (!S.next(0, cur, 0, tid)) return;
    if constexpr (Sched::LIST) { asm volatile("s_waitcnt lgkmcnt(0)" ::: "memory"); __builtin_amdgcn_s_barrier(); asm volatile("" ::: "memory"); }
    unsigned voffA[2][2];
#pragma unroll
    for (int h = 0; h < 2; ++h)
#pragma unroll
        for (int i = 0; i < 2; ++i) voffA[h][i] = S.aoff(0, h * HALF + Rr[i], Cc[i]);
    f32x4 acc[2][2][4][2];
#pragma unroll
    for (int a = 0; a < 2; ++a)
#pragma unroll
        for (int b = 0; b < 2; ++b)
#pragma unroll
            for (int m = 0; m < 4; ++m)
#pragma unroll
                for (int n = 0; n < 2; ++n) acc[a][b][m][n] = (f32x4){0.f, 0.f, 0.f, 0.f};
    bf16x8 At[4][2], B0[2][2], B1[2][2];
    unsigned cA = cur.ao, cB = cur.bo;
    PG8_STAGE(PG8_SB(0, 0), Bbase, cB, voffB); PG8_STAGE(PG8_SB(0, 1), Bbase, cB + hstepB, voffB); PG8_STAGE(PG8_SA(0, 0), Abase, cA, voffA[0]); PG8_STAGE(PG8_SA(0, 1), Abase, cA, voffA[1]);
    if (wr == 1) PG8_BAR;
    PG8_WAIT_V(2); PG8_BAR;
    PG8_STAGE(PG8_SB(1, 0), Bbase, cB + kstep, voffB); PG8_STAGE(PG8_SA(1, 0), Abase, cA + kstep, voffA[0]); PG8_STAGE(PG8_SB(1, 1), Bbase, cB + hstepB + kstep, voffB);
    PG8_WAIT_V(6); PG8_BAR;
    for (;;) {
        const int nub = (ub == 2) ? 0 : ub + 1;
        const bool has_next = S.next(ui + 1, nxt, nub, tid);
        const unsigned nA = has_next ? nxt.ao : cA, nB = has_next ? nxt.bo : cB;
#pragma unroll 1
        for (int t = 0; t < nt; t += 2) {
            const bool last = (t == nt - 2);
            const unsigned a1 = cA + (unsigned)(t + 1) * kstep;
            const unsigned a2 = last ? nA : cA + (unsigned)(t + 2) * kstep, b2 = last ? nB : cB + (unsigned)(t + 2) * kstep;
            const unsigned a3 = a2 + kstep, b3 = b2 + kstep;
            PG8_LDB(B0, 0, 0); PG8_LDB(B1, 0, 1); PG8_SCHED; PG8_LDA(At, 0, 0); PG8_STAGE(PG8_SA(1, 1), Abase, a1, voffA[1]);
            if constexpr (Sched::GATHER) { if (last && has_next) {
#pragma unroll
                for (int h = 0; h < 2; ++h)
#pragma unroll
                    for (int i = 0; i < 2; ++i) voffA[h][i] = S.aoff(nub, h * HALF + Rr[i], Cc[i]); } }
            PG8_WAIT_V(8); PG8_WAIT_L(0); PG8_BAR; PG8_MMA(0, 0, At, B0); PG8_MMA(0, 1, At, B1); PG8_BAR; PG8_SCHED;
            PG8_LDA(At, 0, 1); PG8_STAGE(PG8_SB(0, 0), Bbase, b2, voffB); PG8_STAGE(PG8_SB(0, 1), Bbase, b2 + hstepB, voffB); PG8_STAGE(PG8_SA(0, 0), Abase, a2, voffA[0]);
            PG8_WAIT_V(8); PG8_WAIT_L(0); PG8_BAR; PG8_MMA(1, 0, At, B0); PG8_MMA(1, 1, At, B1); PG8_BAR; PG8_SCHED;
            PG8_LDB(B0, 1, 0); PG8_LDB(B1, 1, 1); PG8_SCHED; PG8_LDA(At, 1, 0); PG8_STAGE(PG8_SA(0, 1), Abase, a2, voffA[1]);
            PG8_WAIT_V(8); PG8_WAIT_L(0); PG8_BAR; PG8_MMA(0, 0, At, B0); PG8_MMA(0, 1, At, B1); PG8_BAR; PG8_SCHED;
            PG8_LDA(At, 1, 1); PG8_STAGE(PG8_SB(1, 0), Bbase, b3, voffB); PG8_STAGE(PG8_SB(1, 1), Bbase, b3 + hstepB, voffB); PG8_STAGE(PG8_SA(1, 0), Abase, a3, voffA[0]);
            PG8_WAIT_V(8); PG8_WAIT_L(0); PG8_BAR; PG8_MMA(1, 0, At, B0); PG8_MMA(1, 1, At, B1); PG8_BAR; PG8_SCHED;
        }
        if constexpr (ALIGN_EPI) { if (wr == 0) PG8_BAR; }
        E(acc, cur, wr, wc, fr, fq, tid, ub);
        if (!has_next) break;
#pragma unroll
        for (int a = 0; a < 2; ++a)
#pragma unroll
            for (int b = 0; b < 2; ++b)
#pragma unroll
                for (int m = 0; m < 4; ++m)
#pragma unroll
                    for (int n = 0; n < 2; ++n) acc[a][b][m][n] = (f32x4){0.f, 0.f, 0.f, 0.f};
        cur = nxt; cA = nA; cB = nB; ++ui; ub = nub;
        if constexpr (ALIGN_EPI) { if (wr == 1) PG8_BAR; }
    }
    PG8_WAIT_V(0);
    if constexpr (!ALIGN_EPI) { if (wr == 0) PG8_BAR; }
    PG8_BAR;
#undef PG8_SA
#undef PG8_SB
#undef PG8_STAGE
#undef PG8_LDA
#undef PG8_LDB
#undef PG8_MMA
#undef PG8_WAIT_V
#undef PG8_WAIT_L
#undef PG8_BAR
#undef PG8_SCHED
}

struct EpiZ {
    static constexpr bool PERM = true;
    unsigned char* ws; LAS unsigned char* lds;
    __device__ __forceinline__ void operator()(const f32x4 (&acc)[2][2][4][2], const Unit& u, int wr, int wc, int fr, int fq, int, int ub) const {
        const int row0 = u.pm * BM + wr * 64 + fr, col0 = u.pn * BM + wc * 32 + 8 * fq;
        bf16_t* z = (bf16_t*)(ws + WS_Z); const LAS float* rsb = (const LAS float*)(lds + UROW_OFF) + ub * 256 + wr * 64 + fr;
#pragma unroll
        for (int ai = 0; ai < 2; ++ai)
#pragma unroll
            for (int m = 0; m < 4; ++m) { const int row = row0 + ai * HALF + m * 16; const float rs = rsb[ai * HALF + m * 16]; bf16_t* rowp = z + (size_t)row * NIN + col0;
#pragma unroll
                for (int bj = 0; bj < 2; ++bj) if (col0 + bj * HALF < NIN) { const f32x4 v0 = acc[ai][bj][m][0] * rs, v1 = acc[ai][bj][m][1] * rs;
                    u32x4 w; w.x = cvt_pk_bf16(v0[0], v0[1]); w.y = cvt_pk_bf16(v0[2], v0[3]); w.z = cvt_pk_bf16(v1[0], v1[1]); w.w = cvt_pk_bf16(v1[2], v1[3]);
                    *(u32x4*)(rowp + bj * HALF) = w; } }
    }
};
template <bool LIST, bool STATS, size_t SS_OFF> struct EpiRes {
    static constexpr bool PERM = true;
    unsigned char* ws; LAS unsigned char* lds;
    __device__ __forceinline__ void operator()(const f32x4 (&acc)[2][2][4][2], const Unit& u, int wr, int wc, int fr, int fq, int tid, int ub) const {
        const int col0 = u.pn * BM + wc * 32 + 8 * fq;
        bf16_t* h = (bf16_t*)(ws + WS_H); float* ss = (float*)(ws + SS_OFF); LAS float* red = (LAS float*)(lds + RED_OFF); const LAS int* utok = (const LAS int*)(lds + UROW_OFF);
#pragma unroll
        for (int ai = 0; ai < 2; ++ai)
#pragma unroll
            for (int m = 0; m < 4; ++m) { const int rowl = ai * HALF + wr * 64 + m * 16 + fr; int row; bool valid = true;
                if constexpr (LIST) { row = utok[ub * 256 + rowl]; valid = row >= 0; } else row = u.pm * BM + rowl;
                float s = 0.f;
                if (valid) { bf16_t* hp = h + (size_t)row * D + col0;
#pragma unroll
                    for (int bj = 0; bj < 2; ++bj) { const u32x4 o = *(const u32x4*)(hp + bj * HALF); const f32x4 a0 = acc[ai][bj][m][0], a1 = acc[ai][bj][m][1];
                        const float v0 = bflo(o.x) + a0[0], v1 = bfhi(o.x) + a0[1], v2 = bflo(o.y) + a0[2], v3 = bfhi(o.y) + a0[3], v4 = bflo(o.z) + a1[0], v5 = bfhi(o.z) + a1[1], v6 = bflo(o.w) + a1[2], v7 = bfhi(o.w) + a1[3];
                        s += (v0 * v0 + v1 * v1) + (v2 * v2 + v3 * v3) + (v4 * v4 + v5 * v5) + (v6 * v6 + v7 * v7);
                        u32x4 w; w.x = cvt_pk_bf16(v0, v1); w.y = cvt_pk_bf16(v2, v3); w.z = cvt_pk_bf16(v4, v5); w.w = cvt_pk_bf16(v6, v7);
                        *(u32x4*)(hp + bj * HALF) = w; } }
                if constexpr (STATS) { s += __shfl_xor(s, 16); s += __shfl_xor(s, 32); if (fq == 0) red[rowl * 4 + wc] = s; }
                asm volatile("" ::: "memory"); }
        if constexpr (STATS) {
            asm volatile("s_waitcnt lgkmcnt(0)" ::: "memory"); __builtin_amdgcn_s_barrier(); asm volatile("" ::: "memory");
            if (tid < BM) { const f32x4 v = *(const LAS f32x4*)(red + tid * 4); int row; bool valid = true;
                if constexpr (LIST) { row = utok[ub * 256 + tid]; valid = row >= 0; } else row = u.pm * BM + tid;
                if (valid) ss[(size_t)row * 4 + u.pn] = (v.x + v.y) + (v.z + v.w); }
        }
    }
};
struct EpiUp {
    static constexpr bool PERM = false;
    unsigned char* ws; LAS unsigned char* lds;
    __device__ __forceinline__ void operator()(const f32x4 (&acc)[2][2][4][2], const Unit& u, int wr, int wc, int fr, int fq, int, int ub) const {
        const int col0 = u.pn * 128 + wc * 16 + 4 * fq;
        bf16_t* hid = (bf16_t*)(ws + WS_HID); const LAS float* urs = (const LAS float*)(lds + UROW_OFF) + 768;
#pragma unroll
        for (int ai = 0; ai < 2; ++ai)
#pragma unroll
            for (int m = 0; m < 4; ++m) { const int rowl = ai * HALF + wr * 64 + m * 16 + fr;
                const float rs = urs[ub * 256 + rowl], gw = urs[768 + ub * 256 + rowl];
                bf16_t* hp = hid + ((size_t)u.pm * BM + rowl) * DE + col0;
#pragma unroll
                for (int bj = 0; bj < 2; ++bj) { const f32x4 g = acc[ai][bj][m][0] * rs, up = acc[ai][bj][m][1] * rs; float o[4];
#pragma unroll
                    for (int j = 0; j < 4; ++j) o[j] = g[j] * __builtin_amdgcn_rcpf(1.f + __builtin_amdgcn_exp2f(g[j] * -1.4426950408889634f)) * up[j] * gw;
                    u32x2 w; w.x = cvt_pk_bf16(o[0], o[1]); w.y = cvt_pk_bf16(o[2], o[3]); *(u32x2*)(hp + bj * 64) = w; } }
    }
};
}

struct MoeTab { int cnt[64]; int rb0[65]; int pad[3]; unsigned short li[NBMAX]; unsigned short blk[NBMAX]; };
static_assert(sizeof(MoeTab) <= 4096, "MoeTab fits below RED_OFF");
__device__ __forceinline__ void moe_build_tab(LAS MoeTab* T, unsigned* gcnt) {
    const int tid = threadIdx.x;
    if (tid < 64) T->cnt[tid] = (int)__hip_atomic_load(gcnt + tid * 16, __ATOMIC_RELAXED, __HIP_MEMORY_SCOPE_AGENT);
    __syncthreads();
    if (tid == 0) { int run = 0; for (int i = 0; i < 64; ++i) { T->rb0[i] = run; run += (T->cnt[i] + 255) >> 8; } T->rb0[64] = run; }
    __syncthreads();
    if (tid < 64) { const int b0 = T->rb0[tid], nb = T->rb0[tid + 1] - b0;
#pragma clang loop vectorize(disable) unroll(disable)
        for (int b = 0; b < nb; ++b) { T->li[b0 + b] = (unsigned short)tid; T->blk[b0 + b] = (unsigned short)b; } }
    __syncthreads();
}
template <bool GATHER_, int NN, int LDA, int K, unsigned ESTEP> struct MoeOrder {
    static constexpr bool GATHER = GATHER_, LIST = true;
    LAS unsigned char* lds; unsigned char* ws; int rbLo, nwg, G, c;
    __device__ __forceinline__ bool next(int i, pg8::Unit& u, int ub, int tid) const {
        const int L = i * G + c; if (L >= nwg) return false;
        const LAS MoeTab* T = (const LAS MoeTab*)(lds + TAB_OFF); LAS int* urow = (LAS int*)(lds + UROW_OFF);
        const int wgid = pg8::xcd_remap(L, nwg), rb = rbLo + wgid / NN;
        const int li = T->li[rb], blk = T->blk[rb], cnt = T->cnt[li];
        u.pm = rb; u.pn = wgid % NN; u.ao = GATHER ? 0u : (unsigned)rb * (unsigned)(256 * LDA * 2); u.bo = (unsigned)(li & 31) * ESTEP + (unsigned)u.pn * (unsigned)(256 * K * 2);
        if (tid < 256) { const int slot = blk * 256 + tid; const bool valid = slot < cnt; const size_t idx = (size_t)li * CAPL + slot;
            urow[ub * 256 + tid] = valid ? ((const int*)(ws + WS_LTOK))[idx] : -1;
            if constexpr (GATHER) { ((LAS float*)urow)[768 + ub * 256 + tid] = valid ? ((const float*)(ws + WS_LRS))[idx] : 0.f; ((LAS float*)urow)[1536 + ub * 256 + tid] = valid ? ((const float*)(ws + WS_LW))[idx] : 0.f; } }
        return true;
    }
    __device__ __forceinline__ unsigned aoff(int ub, int rowl, int C) const {
        if constexpr (GATHER) { const int tok = ((const LAS int*)(lds + UROW_OFF))[ub * 256 + rowl]; return (unsigned)((tok < 0 ? 0 : tok) * LDA + C) * 2u; }
        else return (unsigned)(rowl * LDA + C) * 2u;
    }
};

__device__ __forceinline__ void route_phase(const P& p, int l, LAS unsigned char* lds, int G, int bid, unsigned* gcnt) {
    int tid_ = threadIdx.x; asm volatile("" : "+v"(tid_));
    const int tid = tid_, w = __builtin_amdgcn_readfirstlane(tid >> 6), lane = tid & 63, r = lane & 15, q = lane >> 4;
    const int per = (MP + G - 1) / G, r0 = bid * per, nrows = (r0 + per <= MP) ? per : (MP - r0 > 0 ? MP - r0 : 0);
    constexpr int WROW = 1040;
    LAS unsigned char* WHs = lds; LAS unsigned char* WLs = lds + 48 * WROW;
    LAS float* lg = (LAS float*)(lds + 2 * 48 * WROW);
    LAS int* lcnt = (LAS int*)(lds + TAB_OFF);
    LAS int* lbase = lcnt + 64;
    LAS int* rli = lbase + 64;
    LAS int* rpos = rli + 528;
    LAS float* rw = (LAS float*)(rpos + 528);
    LAS float* rrs = rw + 528;
    if (tid < 64) lcnt[tid] = 0;
    const bf16_t* WH = (const bf16_t*)(p.ws + WS_WRS) + (size_t)l * 48 * D; const bf16_t* WL = WH + (size_t)DEPTH * 48 * D;
    f32x4 acc[2][3];
#pragma unroll
    for (int gi = 0; gi < 2; ++gi)
#pragma unroll
        for (int tl = 0; tl < 3; ++tl) acc[gi][tl] = (f32x4){0.f, 0.f, 0.f, 0.f};
#pragma unroll 1
    for (int half = 0; half < 2; ++half) {
        __syncthreads();
        for (int idx = tid; idx < 48 * 64; idx += NTHR) { const int row = idx >> 6, pc = idx & 63;
            *(LAS pg8::u32x4*)(WHs + row * WROW + pc * 16) = *(const pg8::u32x4*)(WH + (size_t)row * D + half * 512 + pc * 8);
            *(LAS pg8::u32x4*)(WLs + row * WROW + pc * 16) = *(const pg8::u32x4*)(WL + (size_t)row * D + half * 512 + pc * 8); }
        __syncthreads();
#pragma unroll
        for (int gi = 0; gi < 2; ++gi) { const int g = w + gi * NWAVES;
            if (g * 16 < nrows) { const bool ina = (g * 16 + r) < nrows; const bf16_t* ap = p.H() + (size_t)(ina ? r0 + g * 16 + r : 0) * D + half * 512 + q * 8;
                pg8::bf16x8 a[16];
#pragma unroll
                for (int ks = 0; ks < 16; ++ks) a[ks] = *(const pg8::bf16x8*)(ap + ks * 32);
#pragma unroll
                for (int ks = 0; ks < 16; ++ks)
#pragma unroll
                    for (int tl = 0; tl < 3; ++tl) { const int wo = (tl * 16 + r) * WROW + (ks * 32 + q * 8) * 2;
                        acc[gi][tl] = __builtin_amdgcn_mfma_f32_16x16x32_bf16(a[ks], *(const LAS pg8::bf16x8*)(WHs + wo), acc[gi][tl], 0, 0, 0);
                        acc[gi][tl] = __builtin_amdgcn_mfma_f32_16x16x32_bf16(a[ks], *(const LAS pg8::bf16x8*)(WLs + wo), acc[gi][tl], 0, 0, 0); } } }
    }
#pragma unroll
    for (int gi = 0; gi < 2; ++gi) { const int g = w + gi * NWAVES;
        if (g * 16 < nrows) {
            LAS float* lgw = lg + w * 16 * 48;
#pragma unroll
            for (int tl = 0; tl < 3; ++tl)
#pragma unroll
                for (int j = 0; j < 4; ++j) lgw[(q * 4 + j) * 48 + tl * 16 + r] = acc[gi][tl][j];
            asm volatile("s_waitcnt lgkmcnt(0)" ::: "memory");
            if (lane < 16) { const int i = g * 16 + lane, rr = r0 + i;
                if (i < nrows) {
                    if ((rr % TP) < LEAD) { int neg = -1; asm volatile("" : "+v"(neg)); rli[2 * i] = neg; rli[2 * i + 1] = neg; }
                    else { const float rs = row_rs(p.SS2(), rr); const LAS float* x = lgw + lane * 48; float gl[4];
#pragma unroll
                        for (int j = 0; j < 4; ++j) gl[j] = x[j] * rs + p.br_g[l * 4 + j];
                        int gsel = 0; float gm = gl[0];
#pragma unroll
                        for (int j = 1; j < 4; ++j) if (gl[j] > gm) { gm = gl[j]; gsel = j; }
                        float se = 0.f;
#pragma unroll
                        for (int j = 0; j < 4; ++j) se += __expf(gl[j] - gm);
                        const float psel = 1.f / se;
                        int i0 = 0, i1 = -1; float v0 = -INFINITY, v1 = -INFINITY;
                        for (int j = 0; j < 8; ++j) { const float v = x[4 + gsel * 8 + j] * rs + p.br_e[l * 32 + gsel * 8 + j];
                            if (v > v0) { v1 = v0; i1 = i0; v0 = v; i0 = j; } else if (v > v1) { v1 = v; i1 = j; } }
                        const float w0 = 1.f / (1.f + __expf(v1 - v0));
                        const int li0 = gsel * 8 + i0, li1 = 32 + gsel * 8 + i1;
                        rli[2 * i] = li0; rli[2 * i + 1] = li1; rw[2 * i] = w0 * psel; rw[2 * i + 1] = (1.f - w0) * psel; rrs[i] = rs;
                        rpos[2 * i] = __hip_atomic_fetch_add(&lcnt[li0], 1, __ATOMIC_RELAXED, __HIP_MEMORY_SCOPE_WORKGROUP); rpos[2 * i + 1] = __hip_atomic_fetch_add(&lcnt[li1], 1, __ATOMIC_RELAXED, __HIP_MEMORY_SCOPE_WORKGROUP); } } }
            asm volatile("s_waitcnt lgkmcnt(0)" ::: "memory"); } }
    __syncthreads();
    if (tid < 64) { const int n = lcnt[tid]; lbase[tid] = n ? (int)__hip_atomic_fetch_add(gcnt + tid * 16, (unsigned)n, __ATOMIC_RELAXED, __HIP_MEMORY_SCOPE_AGENT) : 0; }
    __syncthreads();
    int* ltok = (int*)(p.ws + WS_LTOK); float* lrs = (float*)(p.ws + WS_LRS); float* lw = (float*)(p.ws + WS_LW);
    for (int i = tid; i < 2 * nrows; i += NTHR) { const int li = rli[i]; if (li >= 0) { const size_t idx = (size_t)li * CAPL + lbase[li] + rpos[i]; ltok[idx] = r0 + (i >> 1); lrs[idx] = rrs[i >> 1]; lw[idx] = rw[i]; } }
    __syncthreads();
}

namespace mx {
#define LDS_BARRIER() do { asm volatile("s_waitcnt lgkmcnt(0)" ::: "memory"); __builtin_amdgcn_s_barrier(); asm volatile("" ::: "memory"); } while (0)
using pg8::bf16x8; using pg8::u32x4; using pg8::u32x2; using pg8::cvt_pk_bf16; using pg8::bflo; using pg8::bfhi;
__device__ __forceinline__ f32x4 mfma16(bf16x8 a, bf16x8 b, f32x4 c) { return __builtin_amdgcn_mfma_f32_16x16x32_bf16(a, b, c, 0, 0, 0); }
__device__ __forceinline__ float wscan_add(float v, int lane) {
#pragma unroll
    for (int o = 1; o < 64; o <<= 1) { const float t = __shfl_up(v, o); if (lane >= o) v += t; }
    return v; }
__device__ __forceinline__ float wscan_max(float v, int lane) {
#pragma unroll
    for (int o = 1; o < 64; o <<= 1) { const float t = __shfl_up(v, o); if (lane >= o) v = fmaxf(v, t); }
    return v; }
__device__ __forceinline__ float wave_max(float v) {
#pragma unroll
    for (int o = 1; o < 64; o <<= 1) v = fmaxf(v, __shfl_xor(v, o));
    return v; }
__device__ __forceinline__ void unpack8(const u32x4 a, float (&x)[8]) { x[0] = bflo(a.x); x[1] = bfhi(a.x); x[2] = bflo(a.y); x[3] = bfhi(a.y); x[4] = bflo(a.z); x[5] = bfhi(a.z); x[6] = bflo(a.w); x[7] = bfhi(a.w); }
__device__ __forceinline__ u32x4 pack8(const float (&x)[8]) { u32x4 w; w.x = cvt_pk_bf16(x[0], x[1]); w.y = cvt_pk_bf16(x[2], x[3]); w.z = cvt_pk_bf16(x[4], x[5]); w.w = cvt_pk_bf16(x[6], x[7]); return w; }
__device__ __forceinline__ bf16x8 ldfrag(const LAS unsigned char* p) { return *(const LAS bf16x8*)p; }
__device__ __forceinline__ float fexp(float x) { return __builtin_amdgcn_exp2f(x * 1.4426950408889634f); }
__device__ __forceinline__ float frcp(float x) { return __builtin_amdgcn_rcpf(x); }
__device__ __forceinline__ float fsigm(float x) { return frcp(1.f + fexp(-x)); }
__device__ __forceinline__ float fsilu(float x) { return x * fsigm(x); }
__device__ __forceinline__ float flogsig(float x) { return fminf(x, 0.f) - __builtin_amdgcn_logf(1.f + fexp(-fabsf(x))) * 0.6931471805599453f; }
__device__ __forceinline__ float frsq(float x) { return __builtin_amdgcn_rsqf(x); }
constexpr int SQ = 272, ST = 144;
__device__ __forceinline__ int tsw(int row, int s) { return row * ST + ((((s >> 3) ^ (row >> 3)) & 7) << 4) + ((s & 7) << 1); }
__device__ __forceinline__ int tfr(int row, int chunk) { return row * ST + (((chunk ^ (row >> 3)) & 7) << 4); }

struct UC { int c, hd, b, r0; };
__device__ __forceinline__ UC ucoord(int u) { UC k; k.c = u % NCH; k.hd = (u / NCH) & 3; k.b = u / (NCH * 4); k.r0 = k.b * TP + k.c * 64; return k; }
template <int NS> struct PreM { u32x4 x[NS + 3]; u32x4 v[2]; pg8::f32x2_ g; };
struct PreO { u32x4 qk[4]; u32x4 v[2]; f32x4 g; pg8::f32x2_ n; };
struct PreG { u32x4 v[2]; u32x4 q, k; f32x4 ca; pg8::f32x2_ ab; };
template <int NS> __device__ __forceinline__ void load_m(const P& p, int u, PreM<NS>& R, int tid, int zvcol) {
    asm volatile("" : "+v"(tid));
    const UC k = ucoord(u); const bf16_t* z = p.Z(); const int lane = tid & 63, w = tid >> 6;
    { const size_t zr = (size_t)(k.r0 + lane) * NIN; pg8::f32x2_ g = {0.f, 0.f}; if (w == 0) { g.x = bf2f(z[zr + ZO_FG + k.hd]); g.y = bf2f(z[zr + ZO_IG + k.hd]); } R.g = g; }
    int zcol, s0;
    if (NS == 4) { const int which = tid >> 8; zcol = (which ? ZO_KM : ZO_QM) + k.hd * 128 + (tid & 15) * 8; s0 = ((tid >> 4) & 15) * 4; }
    else { zcol = ZO_KM + k.hd * 128 + (tid & 15) * 8; s0 = (tid >> 4) * 2; }
#pragma unroll
    for (int i = 0; i < NS + 3; ++i) { const int s = s0 - 3 + i, pp = k.c * 64 + s, row = k.r0 + (pp >= 0 ? s : 0);
        const u32x4 v = *(const u32x4*)(z + (size_t)row * NIN + zcol); const unsigned m = pp >= 0 ? 0xffffffffu : 0u; R.x[i] = (u32x4){v.x & m, v.y & m, v.z & m, v.w & m}; }
#pragma unroll
    for (int it = 0; it < 2; ++it) { const int s = 2 * (tid >> 4) + it, v8 = tid & 15; R.v[it] = *(const u32x4*)(z + (size_t)(k.r0 + s) * NIN + zvcol + k.hd * 128 + v8 * 8); }
}
__device__ __forceinline__ void load_o(const P& p, int u, PreO& R, int tid) {
    asm volatile("" : "+v"(tid));
    const UC k = ucoord(u); const bf16_t* z = p.Z(); const bf16_t* qkc = (const bf16_t*)(p.ws + WS_QKC);
#pragma unroll
    for (int it = 0; it < 4; ++it) { const int item = tid + it * NTHR, which = item >> 10, s = (item >> 4) & 63, ch8 = item & 15; R.qk[it] = *(const u32x4*)(qkc + (size_t)(k.r0 + s) * 1024 + which * 512 + k.hd * 128 + ch8 * 8); }
#pragma unroll
    for (int it = 0; it < 2; ++it) { const int s = 2 * (tid >> 4) + it, v8 = tid & 15; R.v[it] = *(const u32x4*)(z + (size_t)(k.r0 + s) * NIN + ZO_VM + k.hd * 128 + v8 * 8); }
    { f32x4 g = {0.f, 0.f, 0.f, 0.f}; if (tid < 64) { const float* ga = (const float*)((const unsigned char*)p.out + ST_GA) + (size_t)u * 192; g.x = ga[tid]; g.y = ga[64 + tid]; g.z = ga[128 + tid]; g.w = p.MSC()[(size_t)u * 4 + 2]; } R.g = g;
      pg8::f32x2_ n = {0.f, 0.f}; if (tid < 128) n.x = p.MN()[(size_t)u * 128 + tid]; R.n = n; }
}
__device__ __forceinline__ void load_g(const P& p, int l, int u, PreG& R, int tid, bool needq) {
    asm volatile("" : "+v"(tid));
    const UC k = ucoord(u); const bf16_t* z = p.Z();
#pragma unroll
    for (int it = 0; it < 2; ++it) { const int s = 2 * (tid >> 4) + it, v8 = tid & 15; R.v[it] = *(const u32x4*)(z + (size_t)(k.r0 + s) * NIN + ZO_VG + k.hd * 128 + v8 * 8); }
    const size_t zr = (size_t)(k.r0 + (tid >> 3)) * NIN; R.k = *(const u32x4*)(z + zr + ZO_KG + k.hd * 64 + (tid & 7) * 8); R.q = R.k;
    if (needq) R.q = *(const u32x4*)(z + zr + ZO_QG + k.hd * 64 + (tid & 7) * 8);
    { const int i0 = tid, i1 = tid + NTHR; f32x4 ca;
        ca.x = bf2f(z[(size_t)(k.r0 + (i0 >> 4)) * NIN + ZO_CODE + (i0 & 15)]); ca.y = bf2f(z[(size_t)(k.r0 + (i1 >> 4)) * NIN + ZO_CODE + (i1 & 15)]);
        ca.z = p.a_w2[(l * 16 + (i0 >> 6)) * 256 + k.hd * 64 + (i0 & 63)]; ca.w = p.a_w2[(l * 16 + (i1 >> 6)) * 256 + k.hd * 64 + (i1 & 63)]; R.ca = ca;
      pg8::f32x2_ ab = {0.f, 0.f}; if (tid < 64) ab.x = p.a_b[l * 256 + k.hd * 64 + tid]; R.ab = ab; }
}
template <int NS> __device__ __forceinline__ void conv8(const P& p, int l, const u32x4 (&xr)[NS + 3], int c, int s0, int cch, float scale, float (&o)[NS][8]) {
    float x[NS + 3][8];
#pragma unroll
    for (int i = 0; i < NS + 3; ++i) unpack8(xr[i], x[i]);
    float bias[8];
    { const f32x4 b0 = *(const f32x4*)(p.conv_b + l * D + cch), b1 = *(const f32x4*)(p.conv_b + l * D + cch + 4); bias[0] = b0.x; bias[1] = b0.y; bias[2] = b0.z; bias[3] = b0.w; bias[4] = b1.x; bias[5] = b1.y; bias[6] = b1.z; bias[7] = b1.w; }
#pragma unroll
    for (int i = 0; i < NS; ++i)
#pragma unroll
        for (int q = 0; q < 8; ++q) o[i][q] = bias[q];
#pragma unroll
    for (int j = 0; j < 4; ++j) { float w[8];
        { const f32x4 w0 = *(const f32x4*)(p.conv_w + (l * 4 + j) * D + cch), w1 = *(const f32x4*)(p.conv_w + (l * 4 + j) * D + cch + 4); w[0] = w0.x; w[1] = w0.y; w[2] = w0.z; w[3] = w0.w; w[4] = w1.x; w[5] = w1.y; w[6] = w1.z; w[7] = w1.w; }
#pragma unroll
        for (int i = 0; i < NS; ++i)
#pragma unroll
            for (int q = 0; q < 8; ++q) o[i][q] += w[q] * x[i + j][q]; }
#pragma unroll
    for (int i = 0; i < NS; ++i) { const bool valid = (c > 0) || (s0 + i >= LEAD);
#pragma unroll
        for (int q = 0; q < 8; ++q) o[i][q] = valid ? fsilu(o[i][q]) * scale : 0.f; }
}

__device__ __forceinline__ void gla_cumdecay(const P& p, int l, int hd, const PreG& R, int c, LAS float* LA, LAS float* segtot, LAS float* cod, LAS float* aw, LAS float* ab, int tid) {
    cod[tid] = R.ca.x; cod[tid + NTHR] = R.ca.y; aw[tid] = R.ca.z; aw[tid + NTHR] = R.ca.w;
    if (tid < 64) ab[tid] = p.a_b[l * 256 + hd * 64 + tid];
    LDS_BARRIER();
    const int j = tid & 63, seg = tid >> 6; float run = 0.f, v[8];
#pragma unroll
    for (int i = 0; i < 8; ++i) { const int s = seg * 8 + i; const bool valid = (c > 0) || (s >= LEAD); float a = ab[j];
#pragma unroll
        for (int q = 0; q < 16; ++q) a += cod[s * 16 + q] * aw[q * 64 + j];
        run += valid ? flogsig(a) * (1.f / 16.f) : 0.f; v[i] = run; }
    segtot[seg * 64 + j] = run;
    LDS_BARRIER();
    float pre = 0.f;
#pragma unroll
    for (int g = 0; g < 8; ++g) pre += (g < seg) ? segtot[g * 64 + j] : 0.f;
#pragma unroll
    for (int i = 0; i < 8; ++i) LA[(seg * 8 + i) * 65 + j] = v[i] + pre;
    LDS_BARRIER();
}
__device__ __forceinline__ void mlstm_local(const P& p, int l, int u, LAS unsigned char* lds, int tid, PreM<4>& R, int unext) {
    asm volatile("" : "+v"(tid));
    const int lane = tid & 63, w = __builtin_amdgcn_readfirstlane(tid >> 6), c = u % NCH, hd = (u / NCH) & 3, b = u / (NCH * 4), r0 = b * TP + c * 64;
    LAS unsigned char* KT = lds; LAS unsigned char* VT = lds + 18432; LAS float* wS = (LAS float*)(lds + 39168);
    if (w == 0) { const int s = lane; const bool valid = (c > 0) || (s >= LEAD);
        const float lf = valid ? flogsig(R.g.x + p.gate_b[(l * 2 + 1) * 4 + hd]) : 0.f;
        const float ig = valid ? R.g.y + p.gate_b[(l * 2 + 0) * 4 + hd] : -INFINITY;
        const float bb = wscan_add(lf, lane), be = __shfl(bb, 63), g = be - bb + ig, mg = wave_max(g), a = ig - bb, pm = wscan_max(a, lane);
        wS[s] = fexp(g - mg);
        float* ga = (float*)((unsigned char*)p.out + ST_GA) + (size_t)u * 192; ga[s] = bb; ga[64 + s] = a; ga[128 + s] = pm;
        if (lane == 0) { float* sc = p.MSC() + (size_t)u * 4; sc[0] = mg; sc[1] = be; } }
    { const int which = tid >> 8, ch8 = tid & 15, s0 = ((tid >> 4) & 15) * 4; float o[4][8];
        conv8<4>(p, l, R.x, c, s0, which * 512 + hd * 128 + ch8 * 8, which ? 0.08838834764831845f : 1.f, o);
        bf16_t* qkc = (bf16_t*)(p.ws + WS_QKC) + (size_t)(r0 + s0) * 1024 + which * 512 + hd * 128 + ch8 * 8;
#pragma unroll
        for (int i = 0; i < 4; ++i) *(u32x4*)(qkc + (size_t)i * 1024) = pack8(o[i]);
        if (which) {
#pragma unroll
            for (int q = 0; q < 8; ++q) { *(LAS unsigned*)(KT + tsw(ch8 * 8 + q, s0)) = cvt_pk_bf16(o[0][q], o[1][q]); *(LAS unsigned*)(KT + tsw(ch8 * 8 + q, s0 + 2)) = cvt_pk_bf16(o[2][q], o[3][q]); } } }
    LDS_BARRIER();
    { const int s0 = 2 * (tid >> 4), v8 = tid & 15; float x0[8], x1[8]; unpack8(R.v[0], x0); unpack8(R.v[1], x1);
        const float w0 = ((c > 0) || (s0 >= LEAD)) ? wS[s0] : 0.f, w1 = ((c > 0) || (s0 + 1 >= LEAD)) ? wS[s0 + 1] : 0.f;
#pragma unroll
        for (int q = 0; q < 8; ++q) *(LAS unsigned*)(VT + tsw(v8 * 8 + q, s0)) = cvt_pk_bf16(x0[q] * w0, x1[q] * w1); }
    for (int i = tid; i < 16 * 64; i += NTHR) { const int row = 128 + (i >> 6), s = i & 63; *(LAS bf16_t*)(VT + tsw(row, s)) = (row == 128) ? (bf16_t)(cvt_pk_bf16(wS[s], 0.f) & 0xffffu) : (bf16_t)0; }
    if (unext >= 0) load_m<4>(p, unext, R, tid, ZO_VM);
    LDS_BARRIER();
    { const int r = lane & 15, q = lane >> 4; bf16x8 afr[2];
#pragma unroll
        for (int ks = 0; ks < 2; ++ks) afr[ks] = ldfrag(KT + tfr(w * 16 + r, ks * 4 + q));
        bf16_t* Cd = p.MC() + (size_t)u * 16384;
#pragma unroll
        for (int vt = 0; vt < 9; ++vt) { f32x4 acc = {0.f, 0.f, 0.f, 0.f};
#pragma unroll
            for (int ks = 0; ks < 2; ++ks) acc = mfma16(afr[ks], ldfrag(VT + tfr(vt * 16 + r, ks * 4 + q)), acc);
            if (vt < 8) { u32x2 o; o.x = cvt_pk_bf16(acc[0], acc[1]); o.y = cvt_pk_bf16(acc[2], acc[3]); *(u32x2*)(Cd + (vt * 16 + r) * 128 + w * 16 + q * 4) = o; }
            else if (r == 0) *(f32x4*)(p.MN() + (size_t)u * 128 + w * 16 + q * 4) = acc; } }
    LDS_BARRIER();
}

__device__ __forceinline__ void gla_local(const P& p, int l, int u, LAS unsigned char* lds, int tid, PreG& R, int unext) {
    asm volatile("" : "+v"(tid));
    const int lane = tid & 63, w = __builtin_amdgcn_readfirstlane(tid >> 6), c = u % NCH, hd = (u / NCH) & 3, b = u / (NCH * 4), r0 = b * TP + c * 64;
    const bf16_t* z = p.Z();
    LAS float* LA = (LAS float*)lds; LAS float* segtot = (LAS float*)(lds + 16640); LAS unsigned char* KHT = lds + 18688; LAS unsigned char* VT = lds + 27904;
    LAS float* cod = (LAS float*)(lds + 46336); LAS float* aw = (LAS float*)(lds + 50432); LAS float* ab = (LAS float*)(lds + 54528);
    gla_cumdecay(p, l, hd, R, c, LA, segtot, cod, aw, ab, tid);
    if (tid < 64) p.GB()[(size_t)u * 64 + tid] = LA[63 * 65 + tid];
    { const int s = tid >> 3, j8 = tid & 7; const bool valid = (c > 0) || (s >= LEAD); float x[8];
        unpack8(R.k, x);
#pragma unroll
        for (int q = 0; q < 8; ++q) { const int j = j8 * 8 + q; *(LAS bf16_t*)(KHT + tsw(j, s)) = (bf16_t)(cvt_pk_bf16(valid ? x[q] * fexp(LA[63 * 65 + j] - LA[s * 65 + j]) : 0.f, 0.f) & 0xffffu); } }
    { const int s0 = 2 * (tid >> 4), v8 = tid & 15; float x0[8], x1[8]; unpack8(R.v[0], x0); unpack8(R.v[1], x1);
        const float w0 = ((c > 0) || (s0 >= LEAD)) ? 1.f : 0.f, w1 = ((c > 0) || (s0 + 1 >= LEAD)) ? 1.f : 0.f;
#pragma unroll
        for (int q = 0; q < 8; ++q) *(LAS unsigned*)(VT + tsw(v8 * 8 + q, s0)) = cvt_pk_bf16(x0[q] * w0, x1[q] * w1); }
    if (unext >= 0) load_g(p, l, unext, R, tid, false);
    LDS_BARRIER();
    { const int r = lane & 15, q = lane >> 4; bf16x8 bfr[2];
#pragma unroll
        for (int ks = 0; ks < 2; ++ks) bfr[ks] = ldfrag(VT + tfr(w * 16 + r, ks * 4 + q));
        bf16_t* Sd = p.GS() + (size_t)u * 8192;
#pragma unroll
        for (int jt = 0; jt < 4; ++jt) { f32x4 acc = {0.f, 0.f, 0.f, 0.f};
#pragma unroll
            for (int ks = 0; ks < 2; ++ks) acc = mfma16(ldfrag(KHT + tfr(jt * 16 + r, ks * 4 + q)), bfr[ks], acc);
            u32x2 o; o.x = cvt_pk_bf16(acc[0], acc[1]); o.y = cvt_pk_bf16(acc[2], acc[3]); *(u32x2*)(Sd + (w * 16 + r) * 64 + jt * 16 + q * 4) = o; } }
    LDS_BARRIER();
}

template <class LD, class FOLD> __device__ __forceinline__ void scan_stream(LD ld, FOLD fold) {
    u32x2 cur[16], nxt[16];
#pragma unroll
    for (int i = 0; i < 16; ++i) cur[i] = ld(i);
#pragma unroll 1
    for (int c0 = 0; c0 < 128; c0 += 16) {
#pragma unroll
        for (int i = 0; i < 16; ++i) nxt[i] = ld(c0 + 16 + i < NCH ? c0 + 16 + i : NCH - 1);
#pragma unroll
        for (int i = 0; i < 16; ++i) fold(c0 + i, cur[i]);
#pragma unroll
        for (int i = 0; i < 16; ++i) cur[i] = nxt[i];
    }
    fold(128, cur[0]);
}
__device__ __forceinline__ void scan_phase(const P& p, LAS unsigned char* lds, int G, int bid, int tid) {
    asm volatile("" : "+v"(tid));
    LAS float* dec = (LAS float*)lds; LAS float* wgt = dec + 132;
    for (int item = bid; item < 16 * 13; item += G) { const int bh = item / 13, sl = item % 13;
        __syncthreads();
        if (sl < 9 && tid < 64) {
            const int lane = tid; float* sc = p.MSC() + (size_t)bh * NCH * 4; const int c0 = 2 * lane, c1 = c0 + 1;
            const float a0 = sc[c0 * 4 + 1], b0 = sc[c0 * 4], a1 = sc[c1 * 4 + 1], b1 = sc[c1 * 4];
            float A = a0 + a1, Bv = fmaxf(b0 + a1, b1);
#pragma unroll
            for (int o = 1; o < 64; o <<= 1) { const float At = __shfl_up(A, o), Bt = __shfl_up(Bv, o); if (lane >= o) { Bv = fmaxf(Bt + A, Bv); A = At + A; } }
            float EA = __shfl_up(A, 1), EB = __shfl_up(Bv, 1); if (lane == 0) { EA = 0.f; EB = -INFINITY; }
            const float mp = fmaxf(EA, EB), m0 = fmaxf(mp + a0, b0), m1 = fmaxf(m0 + a1, b1);
            dec[c0] = fexp(a0 + mp - m0); wgt[c0] = fexp(b0 - m0); dec[c1] = fexp(a1 + m0 - m1); wgt[c1] = fexp(b1 - m1);
            if (sl == 0) { sc[c0 * 4 + 2] = mp; sc[c1 * 4 + 2] = m0; }
            if (lane == 63) { const float a2 = sc[128 * 4 + 1], b2 = sc[128 * 4], m2 = fmaxf(m1 + a2, b2); dec[128] = fexp(a2 + m1 - m2); wgt[128] = fexp(b2 - m2); if (sl == 0) sc[128 * 4 + 2] = m1; } }
        __syncthreads();
        if (sl < 8) { float C0 = 0.f, C1 = 0.f, C2 = 0.f, C3 = 0.f; u32x2* q = (u32x2*)(p.MC() + (size_t)bh * NCH * 16384 + sl * 2048 + tid * 4);
            scan_stream([&](int c) { return q[(size_t)c * 4096]; },
                        [&](int c, u32x2 dl) { u32x2 o; o.x = cvt_pk_bf16(C0, C1); o.y = cvt_pk_bf16(C2, C3); q[(size_t)c * 4096] = o; const float d = dec[c], g = wgt[c];
                            C0 = d * C0 + g * bflo(dl.x); C1 = d * C1 + g * bfhi(dl.x); C2 = d * C2 + g * bflo(dl.y); C3 = d * C3 + g * bfhi(dl.y); }); }
        else if (sl == 8) { if (tid < 128) { float C = 0.f; float* q = p.MN() + (size_t)bh * NCH * 128 + tid;
#pragma unroll 16
            for (int c = 0; c < NCH; ++c) { const float dl = q[(size_t)c * 128]; q[(size_t)c * 128] = C; C = dec[c] * C + wgt[c] * dl; } } }
        else { const int e = (sl - 9) * 2048 + tid * 4, j = e & 63; float S0 = 0.f, S1 = 0.f, S2 = 0.f, S3 = 0.f; u32x2* q = (u32x2*)(p.GS() + (size_t)bh * NCH * 8192 + e); const f32x4* gb = (const f32x4*)(p.GB() + (size_t)bh * NCH * 64 + j);
            scan_stream([&](int c) { return q[(size_t)c * 2048]; },
                        [&](int c, u32x2 dl) { const f32x4 bv = gb[(size_t)c * 16]; u32x2 o; o.x = cvt_pk_bf16(S0, S1); o.y = cvt_pk_bf16(S2, S3); q[(size_t)c * 2048] = o;
                            S0 = S0 * fexp(bv.x) + bflo(dl.x); S1 = S1 * fexp(bv.y) + bfhi(dl.x); S2 = S2 * fexp(bv.z) + bflo(dl.y); S3 = S3 * fexp(bv.w) + bfhi(dl.y); }); }
    }
    __syncthreads();
}

__device__ __forceinline__ void mlstm_out(const P& p, int l, int u, LAS unsigned char* lds, int tid, PreO& R, int unext) {
    asm volatile("" : "+v"(tid));
    const int lane = tid & 63, w = __builtin_amdgcn_readfirstlane(tid >> 6), c = u % NCH, hd = (u / NCH) & 3, b = u / (NCH * 4), r0 = b * TP + c * 64;
    const bf16_t* z = p.Z();
    LAS unsigned char* QS = lds; LAS unsigned char* KS = lds + 17408; LAS unsigned char* VT = lds + 34816; LAS unsigned char* SS = lds + 55552;
    LAS float* aS = (LAS float*)(lds + 64768); LAS float* MS = aS + 64; LAS float* wiS = MS + 64; LAS float* emtS = wiS + 64; LAS float* denS = emtS + 64; LAS float* part = denS + 64; LAS float* nS = part + 128;
    const int r = lane & 15, q = lane >> 4, tt = w & 3, vh = w >> 2, t = tt * 16 + r;
    const int nvt = vh ? 4 : 5;
    bf16x8 cfr[4][4];
    { const bf16_t* Cg = p.MC() + (size_t)u * 16384;
#pragma unroll
        for (int i = 0; i < 4; ++i)
#pragma unroll
            for (int ks = 0; ks < 4; ++ks) cfr[i][ks] = *(const bf16x8*)(Cg + ((vh * 4 + i) * 16 + r) * 128 + ks * 32 + q * 8); }
    if (tid < 128) nS[tid] = R.n.x;
    if (w == 0) { const int s = lane; const float bb = R.g.x, aa = R.g.y, pm = R.g.z, m0 = R.g.w, M = fmaxf(m0, pm);
        aS[s] = aa; MS[s] = M; wiS[s] = fexp(m0 - M); emtS[s] = fexp(-(bb + M)); }
#pragma unroll
    for (int it = 0; it < 4; ++it) { const int item = tid + it * NTHR, which = item >> 10, s = (item >> 4) & 63, ch8 = item & 15; *(LAS u32x4*)((which ? KS : QS) + s * SQ + ch8 * 16) = R.qk[it]; }
    { const int s0 = 2 * (tid >> 4), v8 = tid & 15; float x0[8], x1[8]; unpack8(R.v[0], x0); unpack8(R.v[1], x1);
        const float w0 = ((c > 0) || (s0 >= LEAD)) ? 1.f : 0.f, w1 = ((c > 0) || (s0 + 1 >= LEAD)) ? 1.f : 0.f;
#pragma unroll
        for (int q = 0; q < 8; ++q) *(LAS unsigned*)(VT + tsw(v8 * 8 + q, s0)) = cvt_pk_bf16(x0[q] * w0, x1[q] * w1); }
    for (int i = tid; i < 16 * 64; i += NTHR) { const int row = 128 + (i >> 6), s = i & 63; *(LAS bf16_t*)(VT + tsw(row, s)) = (row == 128) ? (bf16_t)0x3f80 : (bf16_t)0; }
    if (unext >= 0) load_o(p, unext, R, tid);
    LDS_BARRIER();
    f32x4 acc2[5];
    { bf16x8 qb[4];
#pragma unroll
        for (int ks = 0; ks < 4; ++ks) qb[ks] = ldfrag(QS + (tt * 16 + r) * SQ + (ks * 32 + q * 8) * 2);
#pragma unroll
        for (int i = 0; i < 5; ++i) { acc2[i] = (f32x4){0.f, 0.f, 0.f, 0.f}; if (i < nvt) {
#pragma unroll
            for (int ks = 0; ks < 4; ++ks) { bf16x8 afr;
                if (i < 4) afr = cfr[i][ks];
                else { const f32x4 n0 = *(const LAS f32x4*)(nS + ks * 32 + q * 8), n1 = *(const LAS f32x4*)(nS + ks * 32 + q * 8 + 4); const float mk = (r == 0) ? 1.f : 0.f;
                    const float nn[8] = {n0.x * mk, n0.y * mk, n0.z * mk, n0.w * mk, n1.x * mk, n1.y * mk, n1.z * mk, n1.w * mk};
                    afr = __builtin_bit_cast(bf16x8, pack8(nn)); }
                acc2[i] = mfma16(afr, qb[ks], acc2[i]); } } }
        const float Mt = MS[t];
#pragma unroll
        for (int cc = 0; cc < 2; ++cc) { const int st = vh * 2 + cc; f32x4 acc = {0.f, 0.f, 0.f, 0.f};
            if (st <= tt) {
#pragma unroll
                for (int ks = 0; ks < 4; ++ks) acc = mfma16(ldfrag(KS + (st * 16 + r) * SQ + (ks * 32 + q * 8) * 2), qb[ks], acc); }
            float sv[4];
#pragma unroll
            for (int j = 0; j < 4; ++j) { const int s = st * 16 + q * 4 + j; sv[j] = (s <= t) ? acc[j] * fexp(aS[s] - Mt) : 0.f; }
            u32x2 o; o.x = cvt_pk_bf16(sv[0], sv[1]); o.y = cvt_pk_bf16(sv[2], sv[3]); *(LAS u32x2*)(SS + t * ST + (st * 16 + q * 4) * 2) = o; } }
    LDS_BARRIER();
    f32x4 hv[5];
    { bf16x8 sb[2];
#pragma unroll
        for (int ks = 0; ks < 2; ++ks) sb[ks] = ldfrag(SS + (tt * 16 + r) * ST + (ks * 32 + q * 8) * 2);
        const float wi = wiS[t];
#pragma unroll
        for (int i = 0; i < 5; ++i) { if (i < nvt) { const int vt = (i < 4) ? vh * 4 + i : 8; f32x4 a1 = {0.f, 0.f, 0.f, 0.f};
#pragma unroll
            for (int ks = 0; ks < 2; ++ks) a1 = mfma16(ldfrag(VT + tfr(vt * 16 + r, ks * 4 + q)), sb[ks], a1);
            hv[i] = a1 + acc2[i] * wi; } }
        if (vh == 0 && q == 0) denS[t] = hv[4][0]; }
    u32x2 og[4]; f32x4 gn[4];
#pragma unroll
    for (int i = 0; i < 4; ++i) { const int v0 = (vh * 4 + i) * 16 + q * 4; og[i] = *(const u32x2*)(z + (size_t)(r0 + t) * NIN + ZO_OM + hd * 128 + v0); gn[i] = *(const f32x4*)(p.m_norm_g + l * 512 + hd * 128 + v0); }
    LDS_BARRIER();
    { const float dn = frcp(fmaxf(fabsf(denS[t]), emtS[t])); float ssq = 0.f;
#pragma unroll
        for (int i = 0; i < 4; ++i) { hv[i] = hv[i] * dn; ssq += hv[i][0] * hv[i][0] + hv[i][1] * hv[i][1] + hv[i][2] * hv[i][2] + hv[i][3] * hv[i][3]; }
        ssq += __shfl_xor(ssq, 16); ssq += __shfl_xor(ssq, 32); if (q == 0) part[t * 2 + vh] = ssq; }
    LDS_BARRIER();
    { const bool valid = (c > 0) || (t >= LEAD); const float sc = frsq((part[t * 2] + part[t * 2 + 1]) * (1.f / 128.f) + EPS); bf16_t* yp = p.Z() + (size_t)(r0 + t) * NIN + ZO_OM + hd * 128;
#pragma unroll
        for (int i = 0; i < 4; ++i) { const int v0 = (vh * 4 + i) * 16 + q * 4; float y[4];
            y[0] = hv[i][0] * sc * gn[i][0] * fsigm(bflo(og[i].x)); y[1] = hv[i][1] * sc * gn[i][1] * fsigm(bfhi(og[i].x)); y[2] = hv[i][2] * sc * gn[i][2] * fsigm(bflo(og[i].y)); y[3] = hv[i][3] * sc * gn[i][3] * fsigm(bfhi(og[i].y));
            u32x2 o; o.x = valid ? cvt_pk_bf16(y[0], y[1]) : 0u; o.y = valid ? cvt_pk_bf16(y[2], y[3]) : 0u; *(u32x2*)(yp + v0) = o; } }
    LDS_BARRIER();
}

__device__ __forceinline__ void gla_out(const P& p, int l, int u, LAS unsigned char* lds, int tid, PreG& R, int unext) {
    asm volatile("" : "+v"(tid));
    const int lane = tid & 63, w = __builtin_amdgcn_readfirstlane(tid >> 6), c = u % NCH, hd = (u / NCH) & 3, b = u / (NCH * 4), r0 = b * TP + c * 64;
    const bf16_t* z = p.Z();
    LAS float* LA = (LAS float*)lds; LAS float* segtot = (LAS float*)(lds + 16640); LAS unsigned char* QT = lds + 18688; LAS unsigned char* KT2 = lds + 27904; LAS unsigned char* VT = lds + 37120; LAS unsigned char* AS = lds + 55552;
    LAS float* cod = (LAS float*)(lds + 64768); LAS float* aw = (LAS float*)(lds + 68864); LAS float* ab = (LAS float*)(lds + 72960); LAS float* part = (LAS float*)(lds + 73216);
    const int r = lane & 15, q = lane >> 4, tt = w & 3, dh = w >> 2, t = tt * 16 + r;
    bf16x8 sfr[4][2];
    { const bf16_t* Sg = p.GS() + (size_t)u * 8192;
#pragma unroll
        for (int i = 0; i < 4; ++i)
#pragma unroll
            for (int ks = 0; ks < 2; ++ks) sfr[i][ks] = *(const bf16x8*)(Sg + ((dh * 4 + i) * 16 + r) * 64 + ks * 32 + q * 8); }
    gla_cumdecay(p, l, hd, R, c, LA, segtot, cod, aw, ab, tid);
    { const int s = tid >> 3, j8 = tid & 7; const bool valid = (c > 0) || (s >= LEAD); float xq[8], xk[8];
        unpack8(R.q, xq); unpack8(R.k, xk);
#pragma unroll
        for (int q = 0; q < 8; ++q) { const float bb = LA[s * 65 + j8 * 8 + q]; xq[q] = valid ? xq[q] * 0.125f * fexp(bb) : 0.f; xk[q] = valid ? xk[q] * fexp(-bb) : 0.f; }
        *(LAS u32x4*)(QT + s * ST + j8 * 16) = pack8(xq); *(LAS u32x4*)(KT2 + s * ST + j8 * 16) = pack8(xk); }
    { const int s0 = 2 * (tid >> 4), v8 = tid & 15; float x0[8], x1[8]; unpack8(R.v[0], x0); unpack8(R.v[1], x1);
        const float w0 = ((c > 0) || (s0 >= LEAD)) ? 1.f : 0.f, w1 = ((c > 0) || (s0 + 1 >= LEAD)) ? 1.f : 0.f;
#pragma unroll
        for (int q = 0; q < 8; ++q) *(LAS unsigned*)(VT + tsw(v8 * 8 + q, s0)) = cvt_pk_bf16(x0[q] * w0, x1[q] * w1); }
    if (unext >= 0) load_g(p, l, unext, R, tid, true);
    LDS_BARRIER();
    f32x4 hv[4];
    { bf16x8 qb[2];
#pragma unroll
        for (int ks = 0; ks < 2; ++ks) qb[ks] = ldfrag(QT + (tt * 16 + r) * ST + (ks * 32 + q * 8) * 2);
#pragma unroll
        for (int i = 0; i < 4; ++i) { hv[i] = (f32x4){0.f, 0.f, 0.f, 0.f};
#pragma unroll
            for (int ks = 0; ks < 2; ++ks) hv[i] = mfma16(sfr[i][ks], qb[ks], hv[i]); }
#pragma unroll
        for (int cc = 0; cc < 2; ++cc) { const int st = dh * 2 + cc; f32x4 acc = {0.f, 0.f, 0.f, 0.f};
            if (st <= tt) {
#pragma unroll
                for (int ks = 0; ks < 2; ++ks) acc = mfma16(ldfrag(KT2 + (st * 16 + r) * ST + (ks * 32 + q * 8) * 2), qb[ks], acc); }
            float sv[4];
#pragma unroll
            for (int j = 0; j < 4; ++j) { const int s = st * 16 + q * 4 + j; sv[j] = (s <= t) ? acc[j] : 0.f; }
            u32x2 o; o.x = cvt_pk_bf16(sv[0], sv[1]); o.y = cvt_pk_bf16(sv[2], sv[3]); *(LAS u32x2*)(AS + t * ST + (st * 16 + q * 4) * 2) = o; } }
    u32x2 og[4]; f32x4 gn[4];
#pragma unroll
    for (int i = 0; i < 4; ++i) { const int d0 = (dh * 4 + i) * 16 + q * 4; og[i] = *(const u32x2*)(z + (size_t)(r0 + t) * NIN + ZO_GG + hd * 128 + d0); gn[i] = *(const f32x4*)(p.g_norm_g + l * 512 + hd * 128 + d0); }
    LDS_BARRIER();
    { bf16x8 ab2[2];
#pragma unroll
        for (int ks = 0; ks < 2; ++ks) ab2[ks] = ldfrag(AS + (tt * 16 + r) * ST + (ks * 32 + q * 8) * 2);
        float ssq = 0.f;
#pragma unroll
        for (int i = 0; i < 4; ++i) { const int dt = dh * 4 + i;
#pragma unroll
            for (int ks = 0; ks < 2; ++ks) hv[i] = mfma16(ldfrag(VT + tfr(dt * 16 + r, ks * 4 + q)), ab2[ks], hv[i]);
            ssq += hv[i][0] * hv[i][0] + hv[i][1] * hv[i][1] + hv[i][2] * hv[i][2] + hv[i][3] * hv[i][3]; }
        ssq += __shfl_xor(ssq, 16); ssq += __shfl_xor(ssq, 32); if (q == 0) part[t * 2 + dh] = ssq; }
    LDS_BARRIER();
    { const bool valid = (c > 0) || (t >= LEAD); const float sc = frsq((part[t * 2] + part[t * 2 + 1]) * (1.f / 128.f) + EPS); bf16_t* yp = p.Z() + (size_t)(r0 + t) * NIN + ZO_GG + hd * 128;
#pragma unroll
        for (int i = 0; i < 4; ++i) { const int d0 = (dh * 4 + i) * 16 + q * 4; float y[4];
            y[0] = hv[i][0] * sc * gn[i][0] * fsilu(bflo(og[i].x)); y[1] = hv[i][1] * sc * gn[i][1] * fsilu(bfhi(og[i].x)); y[2] = hv[i][2] * sc * gn[i][2] * fsilu(bflo(og[i].y)); y[3] = hv[i][3] * sc * gn[i][3] * fsilu(bfhi(og[i].y));
            u32x2 o; o.x = valid ? cvt_pk_bf16(y[0], y[1]) : 0u; o.y = valid ? cvt_pk_bf16(y[2], y[3]) : 0u; *(u32x2*)(yp + d0) = o; } }
    LDS_BARRIER();
}
}

namespace pro {
#define PRO_TILE(LDEXPR, OUTROW) do { \
        _Pragma("unroll 8") for (int i = 0; i < 32; ++i) { const int kk = 2 * i + (lane >> 5), nn = lane & 31; scr[kk * 33 + nn] = (LDEXPR); } \
        asm volatile("s_waitcnt lgkmcnt(0)" ::: "memory"); \
        { const int c8 = lane & 7; _Pragma("unroll") for (int j = 0; j < 4; ++j) { const int nn = (lane >> 3) + 8 * j; const LAS float* s_ = scr + (8 * c8) * 33 + nn; \
            pg8::u32x4 o_; o_.x = pg8::cvt_pk_bf16(s_[0], s_[33]); o_.y = pg8::cvt_pk_bf16(s_[66], s_[99]); o_.z = pg8::cvt_pk_bf16(s_[132], s_[165]); o_.w = pg8::cvt_pk_bf16(s_[198], s_[231]); \
            *(pg8::u32x4*)((OUTROW) + 8 * c8) = o_; } } \
        asm volatile("s_waitcnt lgkmcnt(0)" ::: "memory"); } while (0)
__device__ __forceinline__ void prologue_phase(const P& p, LAS unsigned char* lds, int G, int bid, int tid) {
    asm volatile("" : "+v"(tid));
    const int lane = tid & 63, w = __builtin_amdgcn_readfirstlane(tid >> 6), gw = bid * NWAVES + w, NGW = G * NWAVES;
    LAS float* scr = (LAS float*)(lds + w * 8448);
    constexpr int I_IN = DEPTH * 16 * (NZP / 32), I_OUT = DEPTH * 16 * (D / 32), I_GU = DEPTH * NE * 16 * (512 / 32), I_D = DEPTH * NE * (DE / 64) * (D / 32);
    for (int it = gw; it < I_IN + I_OUT + I_GU + I_D; it += NGW) {
        int r = it;
        if (r < I_IN) { const int nb = r % (NZP / 32), kb = (r / (NZP / 32)) % 16, l = r / (16 * (NZP / 32)), k0 = kb * 64, n0 = nb * 32;
            const int n = n0 + (lane & 31); const int sc = zsrc(n); const float* src = p.w_in + ((size_t)l * D + k0) * NIN + sc; const float* g = p.norm1_g + l * D + k0;
            bf16_t* ob = (bf16_t*)(p.ws + WS_WIN) + ((size_t)l * NZP + n0) * D + k0;
            PRO_TILE((n < NIN) ? src[(size_t)kk * NIN] * g[kk] : 0.f, ob + (size_t)nn * D);
            continue; }
        r -= I_IN;
        if (r < I_OUT) { const int nb = r % 32, kb = (r / 32) % 16, l = r / 512, k0 = kb * 64, n0 = nb * 32;
            const float* src = p.w_out + ((size_t)l * D + k0) * D + n0 + (lane & 31); bf16_t* ob = (bf16_t*)(p.ws + WS_WOUT) + ((size_t)l * D + n0) * D + k0;
            PRO_TILE(src[(size_t)kk * D], ob + (size_t)nn * D);
            continue; }
        r -= I_OUT;
        if (r < I_GU) { const int nb = r % 16, kb = (r / 16) % 16, bz = r / 256, k0 = kb * 64, n0 = nb * 32;
            const int i = lane & 31; const float* src = ((i < 16) ? p.w_gate : p.w_up) + ((size_t)bz * D + k0) * DE + 16 * nb + (i & 15); const float* g = p.norm2_g + (bz >> 5) * D + k0;
            bf16_t* ob = (bf16_t*)(p.ws + WS_WGU) + ((size_t)bz * 512 + n0) * D + k0;
            PRO_TILE(src[(size_t)kk * DE] * g[kk], ob + (size_t)nn * D);
            continue; }
        r -= I_GU;
        { const int nb = r % 32, kb = (r / 32) % 4, bz = r / 128, k0 = kb * 64, n0 = nb * 32;
            const float* src = p.w_down + ((size_t)bz * DE + k0) * D + n0 + (lane & 31); bf16_t* ob = (bf16_t*)(p.ws + WS_WD) + ((size_t)bz * D + n0) * DE + k0;
            PRO_TILE(src[(size_t)kk * D], ob + (size_t)nn * DE); }
    }
    for (int idx = bid * NTHR + tid; idx < DEPTH * 48 * D; idx += G * NTHR) { const int k = idx % D, o = (idx / D) % 48, l = idx / (D * 48); float v = 0.f;
        if (o < 4) v = p.wr_g[((size_t)l * D + k) * 4 + o]; else if (o < 36) v = p.wr_e[((size_t)l * D + k) * 32 + (o - 4)];
        v *= p.norm2_g[l * D + k]; const bf16_t hi = f2bf(v), lo = f2bf(v - bf2f(hi));
        bf16_t* wh = (bf16_t*)(p.ws + WS_WRS); wh[idx] = hi; wh[(size_t)DEPTH * 48 * D + idx] = lo; }
    for (int r = gw; r < MP; r += NGW) { const int b = r / TP, pp = r % TP; const float* src = nullptr;
        if (pp >= 64) src = p.x + ((size_t)b * SEQ + (pp - 64)) * D; else if (pp >= LEAD) src = p.meta + (size_t)(pp - LEAD) * D;
        float s = 0.f; bf16_t* hr = p.H() + (size_t)r * D;
#pragma unroll
        for (int j = 0; j < 4; ++j) { f32x4 v = {0.f, 0.f, 0.f, 0.f}; if (src) v = ((const f32x4*)src)[lane + 64 * j];
            s += v.x * v.x + v.y * v.y + v.z * v.z + v.w * v.w;
            pg8::u32x2 o; o.x = pg8::cvt_pk_bf16(v.x, v.y); o.y = pg8::cvt_pk_bf16(v.z, v.w); ((pg8::u32x2*)hr)[lane + 64 * j] = o; }
        s = wave_sum(s);
        if (lane == 0) { f32x4 q = {s, 0.f, 0.f, 0.f}; *(f32x4*)(p.SS1() + (size_t)r * 4) = q; } }
}
#undef PRO_TILE
__device__ __forceinline__ void final_phase(const P& p, int G, int bid, int tid) {
    asm volatile("" : "+v"(tid));
    const int lane = tid & 63, w = tid >> 6;
    for (int t = bid * NWAVES + w; t < B * SEQ; t += G * NWAVES) { const int b = t / SEQ, s = t % SEQ, r = b * TP + 64 + s;
        const float rs = row_rs(p.SS1(), r); const bf16_t* hr = p.H() + (size_t)r * D; float* o = p.out + (size_t)t * D;
#pragma unroll
        for (int j = 0; j < 4; ++j) { const pg8::u32x2 hv = ((const pg8::u32x2*)hr)[lane + 64 * j]; const f32x4 g = ((const f32x4*)p.final_g)[lane + 64 * j];
            f32x4 v; v.x = pg8::bflo(hv.x) * rs * g.x; v.y = pg8::bfhi(hv.x) * rs * g.y; v.z = pg8::bflo(hv.y) * rs * g.z; v.w = pg8::bfhi(hv.y) * rs * g.w;
            ((f32x4*)o)[lane + 64 * j] = v; } }
}
}

struct Args { P p; int ph_lo, ph_hi; };
__global__ void __launch_bounds__(NTHR, 2) fwd(Args a) {
    extern __shared__ __attribute__((aligned(16))) unsigned char lds_raw[];
    LAS unsigned char* lds = (LAS unsigned char*)lds_raw;
    const P& p = a.p;
    const int tid = threadIdx.x, G = gridDim.x, bid = blockIdx.x;
    unsigned* ctl = (unsigned*)(p.ws + WS_CTL);
    volatile LAS unsigned* MISC = (volatile LAS unsigned*)(lds + MISC_OFF);
    if (tid < 128) MISC[tid] = 0u;
    __syncthreads();
    const bool multi = (a.ph_hi - a.ph_lo) > 1;
    XcdBarrier bar; bar.bar = ctl + CW_BAR; bar.x = 0; bar.st = nullptr;
    if (multi) bar = xcd_barrier_post(ctl + CW_BAR, MISC + 8);
#define IN(k) (a.ph_lo <= (k) && (k) < a.ph_hi)
#define SEAM(k) do { if (IN(k) && IN((k) + 1)) xcd_barrier(bar); } while (0)
    if (IN(PH_PRO)) {
pro::prologue_phase(p, lds, G, bid, tid); }
    SEAM(PH_PRO);
    for (int l = 0; l < DEPTH; ++l) {
        const int pb = PH_LAYER0 + l * PH_PER_LAYER;
        unsigned* gcnt = ctl + CW_CNT + l * 64 * 16;
        if (IN(pb + 0)) {
{
            pg8::DenseOrderRS<D, D> S; S.init(MP, NZP, G, bid); S.lds = lds; S.ws = p.ws;
            pg8::EpiZ E{p.ws, lds};
            pg8::gemm_phase<pg8::EpiZ, pg8::DenseOrderRS<D, D>, true, D, D>(lds + RING_OFF, (const char*)(p.ws + WS_H), (const char*)(p.ws + WS_WIN) + (size_t)l * NZP * D * 2, S, E);
            }
        }
        SEAM(pb + 0);
        if (IN(pb + 1)) {
{ { const int ulo = (int)((long)bid * NU / G), uhi = (int)((long)(bid + 1) * NU / G);
                if (ulo < uhi) { mx::PreM<4> pre; mx::load_m<4>(p, ulo, pre, tid, ZO_VM); for (int u = ulo; u < uhi; ++u) mx::mlstm_local(p, l, u, lds, tid, pre, u + 1 < uhi ? u + 1 : -1); }
                { const int glo = (int)((long)(G - 1 - bid) * NU / G), ghi = (int)((long)(G - bid) * NU / G);
                if (glo < ghi) { mx::PreG pre; mx::load_g(p, l, glo, pre, tid, false); for (int u = glo; u < ghi; ++u) mx::gla_local(p, l, u, lds, tid, pre, u + 1 < ghi ? u + 1 : -1); } } } } }
        SEAM(pb + 1);
        if (IN(pb + 2)) mx::scan_phase(p, lds, G, bid, tid);
        SEAM(pb + 2);
        if (IN(pb + 3)) { { const int ulo = (int)((long)bid * NU / G), uhi = (int)((long)(bid + 1) * NU / G);
                if (ulo < uhi) { mx::PreO pre; mx::load_o(p, ulo, pre, tid); for (int u = ulo; u < uhi; ++u) mx::mlstm_out(p, l, u, lds, tid, pre, u + 1 < uhi ? u + 1 : -1); }
                { const int glo = (int)((long)(G - 1 - bid) * NU / G), ghi = (int)((long)(G - bid) * NU / G);
                if (glo < ghi) { mx::PreG pre; mx::load_g(p, l, glo, pre, tid, true); for (int u = glo; u < ghi; ++u) mx::gla_out(p, l, u, lds, tid, pre, u + 1 < ghi ? u + 1 : -1); } } } }
        SEAM(pb + 3);
        if (IN(pb + 4)) {
            pg8::DenseOrder<NIN, D> S; S.init(MP, D, G, bid);
            pg8::EpiRes<false, true, WS_SS2> E{p.ws, lds};
            pg8::gemm_phase<pg8::EpiRes<false, true, WS_SS2>, pg8::DenseOrder<NIN, D>, true, NIN, D>(lds + RING_OFF, (const char*)(p.ws + WS_Z), (const char*)(p.ws + WS_WOUT) + (size_t)l * D * D * 2, S, E);
        }
        SEAM(pb + 4);
        if (IN(pb + 5)) route_phase(p, l, lds, G, bid, gcnt);
        SEAM(pb + 5);
        if (IN(pb + 6)) {
{
            moe_build_tab((LAS MoeTab*)(lds + TAB_OFF), gcnt);
            typedef MoeOrder<true, 2, D, D, 512u * D * 2u> Ord;
            Ord S; S.lds = lds; S.ws = p.ws; S.rbLo = 0; S.nwg = ((const LAS MoeTab*)(lds + TAB_OFF))->rb0[64] * 2; S.G = G; S.c = bid;
            pg8::EpiUp E{p.ws, lds};
            pg8::gemm_phase<pg8::EpiUp, Ord, true, D, D>(lds + RING_OFF, (const char*)(p.ws + WS_H), (const char*)(p.ws + WS_WGU) + (size_t)l * NE * 512 * D * 2, S, E);
            }
        }
        SEAM(pb + 6);
#pragma unroll
        for (int rank = 0; rank < 2; ++rank) {
            if (IN(pb + 7 + rank)) {
                moe_build_tab((LAS MoeTab*)(lds + TAB_OFF), gcnt);
                const LAS MoeTab* T = (const LAS MoeTab*)(lds + TAB_OFF);
                typedef MoeOrder<false, 4, DE, DE, (unsigned)D * DE * 2u> Ord;
                Ord S; S.lds = lds; S.ws = p.ws; S.rbLo = T->rb0[32 * rank]; S.nwg = (T->rb0[32 * rank + 32] - T->rb0[32 * rank]) * 4; S.G = G; S.c = bid;
                const char* Ab = (const char*)(p.ws + WS_HID); const char* Bb = (const char*)(p.ws + WS_WD) + (size_t)l * NE * D * DE * 2;
                if (rank == 0) { pg8::EpiRes<true, false, WS_SS1> E{p.ws, lds}; pg8::gemm_phase<pg8::EpiRes<true, false, WS_SS1>, Ord, true, DE, DE>(lds + RING_OFF, Ab, Bb, S, E); }
                else { pg8::EpiRes<true, true, WS_SS1> E{p.ws, lds}; pg8::gemm_phase<pg8::EpiRes<true, true, WS_SS1>, Ord, true, DE, DE>(lds + RING_OFF, Ab, Bb, S, E); }
            }
            SEAM(pb + 7 + rank);
        }
    }
    if (IN(PH_FINAL)) pro::final_phase(p, G, bid, tid);
#undef IN
#undef SEAM
}

extern "C" void kernel_launch(void* const* d_in, const int* in_sizes, int n_in, void* d_out, int out_size, void* d_ws, size_t ws_size, hipStream_t stream) {
    if (n_in != 21 || ws_size < WS_END || out_size != B * SEQ * D) { fprintf(stderr, "kernel_launch: unexpected sizes n_in %d ws %zu (need %zu) out %d\n", n_in, ws_size, (size_t)WS_END, out_size); return; }
    P p{};
    const float** f = (const float**)&p.x;
    for (int i = 0; i < 21; ++i) f[i] = (const float*)d_in[i];
    p.out = (float*)d_out; p.ws = (unsigned char*)d_ws;
    static int grid = 0;
    if (!grid) {
        (void)hipFuncSetAttribute((const void*)fwd, hipFuncAttributeMaxDynamicSharedMemorySize, LDS_BYTES);
        int dev = 0, cus = 0, per_cu = 0;
        (void)hipGetDevice(&dev); (void)hipDeviceGetAttribute(&cus, hipDeviceAttributeMultiprocessorCount, dev);
        (void)hipOccupancyMaxActiveBlocksPerMultiprocessor(&per_cu, (const void*)fwd, NTHR, LDS_BYTES);
        (void)hipGetLastError();
        grid = cus > 0 ? cus : 256;
        if (per_cu < 1) fprintf(stderr, "kernel_launch: occupancy query reports %d blocks/CU for fwd\n", per_cu);
    }
    (void)hipMemsetAsync(d_ws, 0, CTL_BYTES, stream);
    Args a{}; a.p = p; a.ph_lo = 0; a.ph_hi = PH_COUNT;
    hipLaunchKernelGGL(fwd, dim3(grid), dim3(NTHR), LDS_BYTES, stream, a);
}
```

```cpp
#include <hip/hip_runtime.h>
#include <cstdio>
#include <cstdint>

typedef unsigned short bf16_t;
typedef float f32x4 __attribute__((ext_vector_type(4)));

namespace cfg {
constexpr int B = 4, SEQ = 8192, D = 1024, DEPTH = 2;
constexpr int CH = 64, NMETA = 16, LEAD = 48;
constexpr int TP = LEAD + NMETA + SEQ;
constexpr int NCH = TP / CH;
constexpr int MP = B * TP;
constexpr int NIN = 3608, NZP = 3840;
constexpr int ZO_OM = 0, ZO_GG = 512, ZO_QM = 1024, ZO_KM = 1536, ZO_VM = 2048, ZO_QG = 2560, ZO_KG = 2816, ZO_VG = 3072, ZO_IG = 3584, ZO_FG = 3588, ZO_CODE = 3592;
constexpr int NE = 32, DE = 256, NR = 40;
constexpr float EPS = 1e-6f;
constexpr int NU = B * 4 * NCH;

constexpr size_t al(size_t x) { return (x + 255) & ~(size_t)255; }
constexpr size_t WS_CTL = 0, CTL_BYTES = 4u << 20;
constexpr size_t WS_WIN = WS_CTL + CTL_BYTES;
constexpr size_t WS_WOUT = WS_WIN + al((size_t)DEPTH * NZP * D * 2);
constexpr size_t WS_WGU = WS_WOUT + al((size_t)DEPTH * D * D * 2);
constexpr size_t WS_H8 = WS_WGU + al((size_t)DEPTH * NE * 512 * D);
constexpr size_t WS_WD = WS_H8 + al((size_t)MP * D);
constexpr size_t WS_WR = WS_WD + al((size_t)DEPTH * NE * D * DE * 2);
constexpr size_t WS_H = WS_WR + al((size_t)DEPTH * NR * D * 4);
constexpr size_t WS_Z = WS_H + al((size_t)MP * D * 2);
constexpr size_t WS_SS1 = WS_Z + al((size_t)MP * NIN * 2);
constexpr size_t WS_SS2 = WS_SS1 + al((size_t)MP * 16);
constexpr size_t WS_TOKE = WS_SS2 + al((size_t)MP * 16);
constexpr size_t WS_TOKW = WS_TOKE + al((size_t)MP * 8);
constexpr int CAPL = MP, NBMAX = 352;
constexpr size_t WS_LTOK = WS_TOKW + al((size_t)MP * 8);
constexpr size_t WS_LRS = WS_LTOK + al((size_t)64 * CAPL * 4);
constexpr size_t WS_LW = WS_LRS + al((size_t)64 * CAPL * 4);
constexpr size_t WS_WRS = WS_LW + al((size_t)64 * CAPL * 4);
constexpr size_t WS_QKC = WS_WRS + al((size_t)2 * DEPTH * 48 * D * 2);
constexpr size_t WS_END = WS_QKC + al((size_t)MP * 1024 * 2);
constexpr size_t WS_HID = WS_QKC;
static_assert((size_t)NBMAX * 256 * 256 * 2 <= (size_t)MP * 1024 * 2, "hid fits in the q|k buffer");
constexpr size_t ST_MC = 0;
constexpr size_t ST_GS = ST_MC + al((size_t)NU * 16384 * 2);
constexpr size_t ST_MN = ST_GS + al((size_t)NU * 8192 * 2);
constexpr size_t ST_MSC = ST_MN + al((size_t)NU * 128 * 4);
constexpr size_t ST_GB = ST_MSC + al((size_t)NU * 16);
constexpr size_t ST_GA = ST_GB + al((size_t)NU * 64 * 4);
constexpr size_t ST_END = ST_GA + al((size_t)NU * 192 * 4);
static_assert(ST_END <= (size_t)B * SEQ * D * 4, "state scratch fits d_out");
}
using namespace cfg;

__device__ __forceinline__ float bf2f(bf16_t v) { return __uint_as_float(((unsigned)v) << 16); }
__device__ __forceinline__ bf16_t f2bf(float f) { unsigned u = __float_as_uint(f); u += 0x7fffu + ((u >> 16) & 1u); return (bf16_t)(u >> 16); }
__device__ __forceinline__ float wave_sum(float v) {
#pragma unroll
    for (int o = 1; o < 64; o <<= 1) v += __shfl_xor(v, o);
    return v;
}
__device__ __forceinline__ float logsig(float x) { return fminf(x, 0.f) - log1pf(__expf(-fabsf(x))); }
__device__ __forceinline__ float sigm(float x) { return 1.f / (1.f + __expf(-x)); }
__device__ __forceinline__ float silu(float x) { return x * sigm(x); }

__host__ __device__ __forceinline__ int zsrc(int n) {
    if (n < 512) return 1536 + n;
    if (n < 1024) return 3080 + (n - 512);
    if (n < 2048) return n - 1024;
    if (n < 2560) return 1024 + (n - 2048);
    if (n < 2816) return 2056 + (n - 2560);
    if (n < 3072) return 2312 + (n - 2816);
    if (n < 3584) return 2568 + (n - 3072);
    if (n < 3588) return 2048 + (n - 3584);
    if (n < 3592) return 2052 + (n - 3588);
    return n;
}

struct P {
    const float *x, *meta, *norm1_g, *w_in, *conv_w, *conv_b, *gate_b, *m_norm_g, *a_w2, *a_b, *g_norm_g, *w_out, *norm2_g, *wr_g, *br_g, *wr_e, *br_e, *w_gate, *w_up, *w_down, *final_g;
    float* out; unsigned char* ws;
    __device__ __forceinline__ bf16_t* Win() const { return (bf16_t*)(ws + WS_WIN); }
    __device__ __forceinline__ bf16_t* Wout() const { return (bf16_t*)(ws + WS_WOUT); }
    __device__ __forceinline__ bf16_t* Wgu() const { return (bf16_t*)(ws + WS_WGU); }
    __device__ __forceinline__ bf16_t* Wd() const { return (bf16_t*)(ws + WS_WD); }
    __device__ __forceinline__ float* Wr() const { return (float*)(ws + WS_WR); }
    __device__ __forceinline__ bf16_t* H() const { return (bf16_t*)(ws + WS_H); }
    __device__ __forceinline__ bf16_t* Z() const { return (bf16_t*)(ws + WS_Z); }
    __device__ __forceinline__ float* SS1() const { return (float*)(ws + WS_SS1); }
    __device__ __forceinline__ float* SS2() const { return (float*)(ws + WS_SS2); }
    __device__ __forceinline__ int* TokE() const { return (int*)(ws + WS_TOKE); }
    __device__ __forceinline__ float* TokW() const { return (float*)(ws + WS_TOKW); }
    __device__ __forceinline__ bf16_t* MC() const { return (bf16_t*)((unsigned char*)out + ST_MC); }
    __device__ __forceinline__ bf16_t* GS() const { return (bf16_t*)((unsigned char*)out + ST_GS); }
    __device__ __forceinline__ float* MN() const { return (float*)((unsigned char*)out + ST_MN); }
    __device__ __forceinline__ float* MSC() const { return (float*)((unsigned char*)out + ST_MSC); }
    __device__ __forceinline__ float* GB() const { return (float*)((unsigned char*)out + ST_GB); }
};

__device__ __forceinline__ float row_rs(const float* ss, int r) {
    if ((r % TP) < LEAD) return 0.f;
    const f32x4 v = *(const f32x4*)(ss + (size_t)r * 4);
    return rsqrtf((v.x + v.y + v.z + v.w) * (1.f / D) + EPS);
}

#define LAS __attribute__((address_space(3)))
constexpr int NWAVES = 8, NTHR = 512;
constexpr int RING_OFF = 0, RING_BYTES = 131072, TAB_OFF = 131072, TAB_BYTES = 24576, MISC_OFF = TAB_OFF + TAB_BYTES, LDS_BYTES = MISC_OFF + 512;
constexpr int RED_OFF = TAB_OFF + 4096;
constexpr int UROW_OFF = TAB_OFF + 8192;
constexpr int CW_BAR = 4096, CW_CNT = 16384;
constexpr int PH_PRO = 0, PH_LAYER0 = 1, PH_PER_LAYER = 9, PH_FINAL = 1 + 9 * DEPTH, PH_COUNT = PH_FINAL + 1;

#define XB_TMO      128
#define XB_XCNT(j)  (256  + 64 * (j))
#define XB_XSUB(j)  (1280 + 64 * (j))
#define XB_XGEN(j)  (2304 + 64 * (j))
#define XB_TOP      3328
#define XB_TOPGEN   3392
#define XCD_BAR_WORDS 3456
#define XB_SPIN_CAP (1u << 18)
__device__ __forceinline__ unsigned xb_ld(unsigned* p)              { return __hip_atomic_load(p, __ATOMIC_RELAXED, __HIP_MEMORY_SCOPE_AGENT); }
__device__ __forceinline__ unsigned xb_add(unsigned* p, unsigned v) { return __hip_atomic_fetch_add(p, v, __ATOMIC_RELAXED, __HIP_MEMORY_SCOPE_AGENT); }
__device__ __forceinline__ unsigned xb_xcc_id() { return (unsigned)__builtin_amdgcn_s_getreg((3 << 11) | 20) & 0xFu; }
#define XB_SPIN(cond, bar) do { unsigned _sp = 0; while (cond) { __builtin_amdgcn_s_sleep(1); \
    if ((++_sp & 255u) == 0u) { if (xb_ld(&(bar)[XB_TMO])) break; if (_sp > XB_SPIN_CAP) { atomicAdd(&(bar)[XB_TMO], 1u); break; } } } } while (0)
struct XcdBarrier { unsigned* bar; unsigned x; volatile LAS unsigned* st; };
__device__ __forceinline__ XcdBarrier xcd_barrier_post(unsigned* bar, volatile LAS unsigned* st) {
    XcdBarrier b; b.bar = bar; b.x = xb_xcc_id(); b.st = st;
    if (threadIdx.x == 0) (void)xb_add(&bar[XB_XCNT(b.x)], 1u);
    return b;
}
__device__ __forceinline__ void xcd_barrier_complete(unsigned* bar, unsigned x, unsigned& nloc, unsigned& nx) {
    const unsigned G = gridDim.x * gridDim.y * gridDim.z;
    unsigned sum, cnt, mine, sp = 0u;
    for (;;) {
        sum = 0u; cnt = 0u; mine = 0u;
#pragma unroll
        for (unsigned j = 0; j < 16; ++j) { const unsigned c = xb_ld(&bar[XB_XCNT(j)]); sum += c; cnt += (c > 0u) ? 1u : 0u; mine = (j == x) ? c : mine; }
        if (sum == G) break;
        __builtin_amdgcn_s_sleep(1);
        if ((++sp & 255u) == 0u) { if (xb_ld(&bar[XB_TMO])) break; if (sp > XB_SPIN_CAP) { atomicAdd(&bar[XB_TMO], 1u); break; } }
    }
    nloc = mine > 0u ? mine : 1u; nx = cnt > 0u ? cnt : 1u;
}
__device__ __forceinline__ void xcd_barrier(const XcdBarrier& b) {
    asm volatile("s_waitcnt vmcnt(0)" ::: "memory");
    __syncthreads();
    if (threadIdx.x == 0) {
        unsigned* bar = b.bar;
        __builtin_amdgcn_s_waitcnt(0);
        unsigned nloc = b.st[0], nx = b.st[1];
        if (nloc == 0u) { xcd_barrier_complete(bar, b.x, nloc, nx); b.st[0] = nloc; b.st[1] = nx; }
        const unsigned old = xb_add(&bar[XB_XSUB(b.x)], 1u);
        const unsigned gen = old / nloc;
        if (old + 1u == (gen + 1u) * nloc) {
            __builtin_amdgcn_fence(__ATOMIC_RELEASE, "agent");
            asm volatile("s_waitcnt vmcnt(0)" ::: "memory");
            const unsigned og = xb_add(&bar[XB_TOP], 1u);
            const unsigned tg = og / nx;
            if (og + 1u == (tg + 1u) * nx) xb_add(&bar[XB_TOPGEN], 1u);
            else XB_SPIN(xb_ld(&bar[XB_TOPGEN]) == tg, bar);
            __builtin_amdgcn_fence(__ATOMIC_ACQUIRE, "agent");
            xb_add(&bar[XB_XGEN(b.x)], 1u);
            asm volatile("s_waitcnt vmcnt(0)" ::: "memory");
        } else {
            XB_SPIN(xb_ld(&bar[XB_XGEN(b.x)]) == gen, bar);
            __builtin_amdgcn_fence(__ATOMIC_ACQUIRE, "agent");
            asm volatile("s_waitcnt vmcnt(0)" ::: "memory");
        }
    }
    __syncthreads();
}

namespace pg8 {
typedef short bf16x8 __attribute__((ext_vector_type(8)));
typedef unsigned u32x4 __attribute__((ext_vector_type(4)));
typedef unsigned u32x2 __attribute__((ext_vector_type(2)));
constexpr int BM = 256, BK = 64, HALF = 128, HTB = HALF * BK * 2, STAGE_BYTES = 8 * HTB, NXCD = 8, WGM = 8;
__host__ __device__ __forceinline__ int lds_byte(int r, int c) { const int st = (r >> 4) * 2 + (c >> 5), rr = r & 15, cc = c & 31, ob = rr * 64 + cc * 2; return st * 1024 + (ob ^ (((ob >> 9) & 1) << 5)); }
__host__ __device__ __forceinline__ void stage_rc(int b, int& R, int& C) { const int st = b / 1024, sb = b % 1024, swz = sb ^ (((sb >> 9) & 1) << 5); R = (st >> 1) * 16 + swz / 64; C = (st & 1) * 32 + (swz % 64) / 2; }
__host__ __device__ __forceinline__ int perm32(int rho) { const int n = rho >> 4, i = rho & 15; return 8 * (i >> 2) + 4 * n + (i & 3); }
typedef float f32x2_ __attribute__((ext_vector_type(2))); typedef __bf16 bf16x2_ __attribute__((ext_vector_type(2)));
__device__ __forceinline__ unsigned cvt_pk_bf16(float lo, float hi) { const f32x2_ v = {lo, hi}; return __builtin_bit_cast(unsigned, __builtin_convertvector(v, bf16x2_)); }
__device__ __forceinline__ float bflo(unsigned w) { return __uint_as_float(w << 16); }
__device__ __forceinline__ float bfhi(unsigned w) { return __uint_as_float(w & 0xffff0000u); }

struct Unit { int pm, pn; unsigned ao, bo; };

__device__ __forceinline__ int xcd_remap(int L, int nwg) { const int q = nwg / NXCD, r = nwg % NXCD, xcd = L % NXCD, off = L / NXCD; return (xcd < r ? xcd * (q + 1) : r * (q + 1) + (xcd - r) * q) + off; }

template <int LDA, int K> struct DenseOrder {
    static constexpr bool GATHER = false, LIST = false;
    int nM, nN, nwg, G, c;
    __device__ __forceinline__ void init(int M, int N, int G_, int c_) { nM = M / BM; nN = N / BM; nwg = nM * nN; G = G_; c = c_; }
    __device__ __forceinline__ bool next(int i, Unit& u, int, int) const {
        const int L = i * G + c; if (L >= nwg) return false;
        const int wgid = xcd_remap(L, nwg);
        const int nig = WGM * nN, gid = wgid / nig, fm = gid * WGM, gsz = (nM - fm) < WGM ? (nM - fm) : WGM;
        u.pm = fm + ((wgid % nig) % gsz); u.pn = (wgid % nig) / gsz; u.ao = (unsigned)u.pm * (unsigned)(BM * LDA * 2); u.bo = (unsigned)u.pn * (unsigned)(BM * K * 2); return true;
    }
    __device__ __forceinline__ unsigned aoff(int, int rowl, int C) const { return (unsigned)(rowl * LDA + C) * 2u; }
};
template <int LDA, int K> struct DenseOrderRS : DenseOrder<LDA, K> {
    static constexpr bool GATHER = false, LIST = true;
    LAS unsigned char* lds; unsigned char* ws;
    __device__ __forceinline__ bool next(int i, Unit& u, int ub, int tid) const {
        if (!DenseOrder<LDA, K>::next(i, u, 0, 0)) return false;
        if (tid < 256) ((LAS float*)(lds + UROW_OFF))[ub * 256 + tid] = row_rs((const float*)(ws + WS_SS1), u.pm * BM + tid);
        return true;
    }
};

template <class Epi, class Sched, bool ALIGN_EPI, int LDA, int K, bool FP8 = false>
__device__ __forceinline__ void gemm_phase(LAS unsigned char* lds, const char* Abase, const char* Bbase, const Sched& S, const Epi& E) {
    int tid_ = threadIdx.x; asm volatile("" : "+v"(tid_));
    const int tid = tid_, wid = __builtin_amdgcn_readfirstlane(tid >> 6), lane = tid & 63, wr = wid >> 2, wc = wid & 3, fr = lane & 15, fq = lane >> 4;
    constexpr int nt = K / BK;
    int Rr[2], Cc[2]; unsigned voffB[2];
#pragma unroll
    for (int i = 0; i < 2; ++i) { stage_rc(tid * 16 + i * 8192, Rr[i], Cc[i]); const int Rb = Epi::PERM ? ((Rr[i] & ~31) + perm32(Rr[i] & 31)) : Rr[i]; voffB[i] = (unsigned)(Rb * K + Cc[i]) * 2u; }
    constexpr unsigned kstep = BK * 2, hstepB = HALF * K * 2;
    const unsigned ldsw = (unsigned)wid * 1024u;
    int aofs[2], bofs[2];
#pragma unroll
    for (int e = 0; e < 2; ++e) { aofs[e] = FP8 ? lds_byte(wr * 64 + fr, (2 * fq + e) * 8) : lds_byte(wr * 64 + fr, fq * 8) + e * 1024; bofs[e] = FP8 ? lds_byte(wc * 32 + fr, (2 * fq + e) * 8) : lds_byte(wc * 32 + fr, fq * 8) + e * 1024; }
#define PG8_SA(b, h) (((b) * 2 + (h)) * HTB)
#define PG8_SB(b, h) ((4 + (b) * 2 + (h)) * HTB)
#define PG8_STAGE(bufoff, gbase, uoff, voff) do { _Pragma("unroll") for (int _i = 0; _i < 2; ++_i) \
        __builtin_amdgcn_global_load_lds((const unsigned*)((gbase) + (size_t)(unsigned)((uoff) + (voff)[_i])), (LAS unsigned*)(lds + (bufoff) + ldsw + _i * 8192), 16, 0, 0); } while (0)
#define PG8_LDA(dst, b, h) do { _Pragma("unroll") for (int m = 0; m < 4; ++m) _Pragma("unroll") for (int k = 0; k < 2; ++k) dst[m][k] = *(const LAS bf16x8*)(lds + PG8_SA(b, h) + aofs[k] + m * 2048); } while (0)
#define PG8_LDB(dst, b, h) do { _Pragma("unroll") for (int n = 0; n < 2; ++n) _Pragma("unroll") for (int k = 0; k < 2; ++k) dst[n][k] = *(const LAS bf16x8*)(lds + PG8_SB(b, h) + bofs[k] + n * 2048); } while (0)
#define PG8_MMA(ai, bj, At, Bt) do { __builtin_amdgcn_s_setprio(1); _Pragma("unroll") for (int m = 0; m < 4; ++m) _Pragma("unroll") for (int n = 0; n < 2; ++n) { \
        if constexpr (FP8) { typedef int i32x4_ __attribute__((ext_vector_type(4))); typedef int i32x8_ __attribute__((ext_vector_type(8))); \
            const i32x8_ b8_ = __builtin_shufflevector(__builtin_bit_cast(i32x4_, Bt[n][0]), __builtin_bit_cast(i32x4_, Bt[n][1]), 0, 1, 2, 3, 4, 5, 6, 7), a8_ = __builtin_shufflevector(__builtin_bit_cast(i32x4_, At[m][0]), __builtin_bit_cast(i32x4_, At[m][1]), 0, 1, 2, 3, 4, 5, 6, 7); \
            acc[ai][bj][m][n] = __builtin_amdgcn_mfma_scale_f32_16x16x128_f8f6f4(b8_, a8_, acc[ai][bj][m][n], 0, 0, 0, 0x7F7F7F7F, 0, 0x7F7F7F7F); } \
        else { _Pragma("unroll") for (int k = 0; k < 2; ++k) acc[ai][bj][m][n] = __builtin_amdgcn_mfma_f32_16x16x32_bf16(Bt[n][k], At[m][k], acc[ai][bj][m][n], 0, 0, 0); } } __builtin_amdgcn_s_setprio(0); } while (0)
#define PG8_WAIT_V(n) asm volatile("s_waitcnt vmcnt(" #n ")" ::: "memory")
#define PG8_WAIT_L(n) asm volatile("s_waitcnt lgkmcnt(" #n ")" ::: "memory")
#define PG8_BAR __builtin_amdgcn_s_barrier()
#define PG8_SCHED __builtin_amdgcn_sched_barrier(0)
    Unit cur, nxt; int ui = 0, ub = 0;
    if (!S.next(0, cur, 0, tid)) return;
    if constexpr (Sched::LIST) { asm volatile("s_waitcnt lgkmcnt(0)" ::: "memory"); __builtin_amdgcn_s_barrier(); asm volatile("" ::: "memory"); }
    unsigned voffA[2][2];
#pragma unroll
    for (int h = 0; h < 2; ++h)
#pragma unroll
        for (int i = 0; i < 2; ++i) voffA[h][i] = S.aoff(0, h * HALF + Rr[i], Cc[i]);
    f32x4 acc[2][2][4][2];
#pragma unroll
    for (int a = 0; a < 2; ++a)
#pragma unroll
        for (int b = 0; b < 2; ++b)
#pragma unroll
            for (int m = 0; m < 4; ++m)
#pragma unroll
                for (int n = 0; n < 2; ++n) acc[a][b][m][n] = (f32x4){0.f, 0.f, 0.f, 0.f};
    bf16x8 At[4][2], B0[2][2], B1[2][2];
    unsigned cA = cur.ao, cB = cur.bo;
    PG8_STAGE(PG8_SB(0, 0), Bbase, cB, voffB); PG8_STAGE(PG8_SB(0, 1), Bbase, cB + hstepB, voffB); PG8_STAGE(PG8_SA(0, 0), Abase, cA, voffA[0]); PG8_STAGE(PG8_SA(0, 1), Abase, cA, voffA[1]);
    if (wr == 1) PG8_BAR;
    PG8_WAIT_V(2); PG8_BAR;
    PG8_STAGE(PG8_SB(1, 0), Bbase, cB + kstep, voffB); PG8_STAGE(PG8_SA(1, 0), Abase, cA + kstep, voffA[0]); PG8_STAGE(PG8_SB(1, 1), Bbase, cB + hstepB + kstep, voffB);
    PG8_WAIT_V(6); PG8_BAR;
    for (;;) {
        const int nub = (ub == 2) ? 0 : ub + 1;
        const bool has_next = S.next(ui + 1, nxt, nub, tid);
        const unsigned nA = has_next ? nxt.ao : cA, nB = has_next ? nxt.bo : cB;
#pragma unroll 1
        for (int t = 0; t < nt; t += 2) {
            const bool last = (t == nt - 2);
            const unsigned a1 = cA + (unsigned)(t + 1) * kstep;
            const unsigned a2 = last ? nA : cA + (unsigned)(t + 2) * kstep, b2 = last ? nB : cB + (unsigned)(t + 2) * kstep;
            const unsigned a3 = a2 + kstep, b3 = b2 + kstep;
            PG8_LDB(B0, 0, 0); PG8_LDB(B1, 0, 1); PG8_SCHED; PG8_LDA(At, 0, 0); PG8_STAGE(PG8_SA(1, 1), Abase, a1, voffA[1]);
            if constexpr (Sched::GATHER) { if (last && has_next) {
#pragma unroll
                for (int h = 0; h < 2; ++h)
#pragma unroll
                    for (int i = 0; i < 2; ++i) voffA[h][i] = S.aoff(nub, h * HALF + Rr[i], Cc[i]); } }
            PG8_WAIT_V(8); PG8_WAIT_L(0); PG8_BAR; PG8_MMA(0, 0, At, B0); PG8_MMA(0, 1, At, B1); PG8_BAR; PG8_SCHED;
            PG8_LDA(At, 0, 1); PG8_STAGE(PG8_SB(0, 0), Bbase, b2, voffB); PG8_STAGE(PG8_SB(0, 1), Bbase, b2 + hstepB, voffB); PG8_STAGE(PG8_SA(0, 0), Abase, a2, voffA[0]);
            PG8_WAIT_V(8); PG8_WAIT_L(0); PG8_BAR; PG8_MMA(1, 0, At, B0); PG8_MMA(1, 1, At, B1); PG8_BAR; PG8_SCHED;
            PG8_LDB(B0, 1, 0); PG8_LDB(B1, 1, 1); PG8_SCHED; PG8_LDA(At, 1, 0); PG8_STAGE(PG8_SA(0, 1), Abase, a2, voffA[1]);
            PG8_WAIT_V(8); PG8_WAIT_L(0); PG8_BAR; PG8_MMA(0, 0, At, B0); PG8_MMA(0, 1, At, B1); PG8_BAR; PG8_SCHED;
            PG8_LDA(At, 1, 1); PG8_STAGE(PG8_SB(1, 0), Bbase, b3, voffB); PG8_STAGE(PG8_SB(1, 1), Bbase, b3 + hstepB, voffB); PG8_STAGE(PG8_SA(1, 0), Abase, a3, voffA[0]);
            PG8_WAIT_V(8); PG8_WAIT_L(0); PG8_BAR; PG8_MMA(1, 0, At, B0); PG8_MMA(1, 1, At, B1); PG8_BAR; PG8_SCHED;
        }
        if constexpr (ALIGN_EPI) { if (wr == 0) PG8_BAR; }
        E(acc, cur, wr, wc, fr, fq, tid, ub);
        if (!has_next) break;
#pragma unroll
        for (int a = 0; a < 2; ++a)
#pragma unroll
            for (int b = 0; b < 2; ++b)
#pragma unroll
                for (int m = 0; m < 4; ++m)
#pragma unroll
                    for (int n = 0; n < 2; ++n) acc[a][b][m][n] = (f32x4){0.f, 0.f, 0.f, 0.f};
        cur = nxt; cA = nA; cB = nB; ++ui; ub = nub;
        if constexpr (ALIGN_EPI) { if (wr == 1) PG8_BAR; }
    }
    PG8_WAIT_V(0);
    if constexpr (!ALIGN_EPI) { if (wr == 0) PG8_BAR; }
    PG8_BAR;
#undef PG8_SA
#undef PG8_SB
#undef PG8_STAGE
#undef PG8_LDA
#undef PG8_LDB
#undef PG8_MMA
#undef PG8_WAIT_V
#undef PG8_WAIT_L
#undef PG8_BAR
#undef PG8_SCHED
}

struct EpiZ {
    static constexpr bool PERM = true;
    unsigned char* ws; LAS unsigned char* lds;
    __device__ __forceinline__ void operator()(const f32x4 (&acc)[2][2][4][2], const Unit& u, int wr, int wc, int fr, int fq, int, int ub) const {
        const int row0 = u.pm * BM + wr * 64 + fr, col0 = u.pn * BM + wc * 32 + 8 * fq;
        bf16_t* z = (bf16_t*)(ws + WS_Z); const LAS float* rsb = (const LAS float*)(lds + UROW_OFF) + ub * 256 + wr * 64 + fr;
#pragma unroll
        for (int ai = 0; ai < 2; ++ai)
#pragma unroll
            for (int m = 0; m < 4; ++m) { const int row = row0 + ai * HALF + m * 16; const float rs = rsb[ai * HALF + m * 16]; bf16_t* rowp = z + (size_t)row * NIN + col0;
#pragma unroll
                for (int bj = 0; bj < 2; ++bj) if (col0 + bj * HALF < NIN) { const f32x4 v0 = acc[ai][bj][m][0] * rs, v1 = acc[ai][bj][m][1] * rs;
                    u32x4 w; w.x = cvt_pk_bf16(v0[0], v0[1]); w.y = cvt_pk_bf16(v0[2], v0[3]); w.z = cvt_pk_bf16(v1[0], v1[1]); w.w = cvt_pk_bf16(v1[2], v1[3]);
                    *(u32x4*)(rowp + bj * HALF) = w; } }
    }
};
__device__ __forceinline__ unsigned pk_fp8x4(float a, float b, float c, float d) { int r = __builtin_amdgcn_cvt_pk_fp8_f32(a, b, 0, false); r = __builtin_amdgcn_cvt_pk_fp8_f32(c, d, r, true); return (unsigned)r; }
template <bool LIST, bool STATS, size_t SS_OFF, bool H8OUT = false> struct EpiRes {
    static constexpr bool PERM = true;
    unsigned char* ws; LAS unsigned char* lds;
    __device__ __forceinline__ void operator()(const f32x4 (&acc)[2][2][4][2], const Unit& u, int wr, int wc, int fr, int fq, int tid, int ub) const {
        const int col0 = u.pn * BM + wc * 32 + 8 * fq;
        bf16_t* h = (bf16_t*)(ws + WS_H); float* ss = (float*)(ws + SS_OFF); LAS float* red = (LAS float*)(lds + RED_OFF); const LAS int* utok = (const LAS int*)(lds + UROW_OFF);
#pragma unroll
        for (int ai = 0; ai < 2; ++ai)
#pragma unroll
            for (int m = 0; m < 4; ++m) { const int rowl = ai * HALF + wr * 64 + m * 16 + fr; int row; bool valid = true;
                if constexpr (LIST) { row = utok[ub * 256 + rowl]; valid = row >= 0; } else row = u.pm * BM + rowl;
                float s = 0.f;
                if (valid) { bf16_t* hp = h + (size_t)row * D + col0;
#pragma unroll
                    for (int bj = 0; bj < 2; ++bj) { const u32x4 o = *(const u32x4*)(hp + bj * HALF); const f32x4 a0 = acc[ai][bj][m][0], a1 = acc[ai][bj][m][1];
                        const float v0 = bflo(o.x) + a0[0], v1 = bfhi(o.x) + a0[1], v2 = bflo(o.y) + a0[2], v3 = bfhi(o.y) + a0[3], v4 = bflo(o.z) + a1[0], v5 = bfhi(o.z) + a1[1], v6 = bflo(o.w) + a1[2], v7 = bfhi(o.w) + a1[3];
                        s += (v0 * v0 + v1 * v1) + (v2 * v2 + v3 * v3) + (v4 * v4 + v5 * v5) + (v6 * v6 + v7 * v7);
                        u32x4 w; w.x = cvt_pk_bf16(v0, v1); w.y = cvt_pk_bf16(v2, v3); w.z = cvt_pk_bf16(v4, v5); w.w = cvt_pk_bf16(v6, v7);
                        *(u32x4*)(hp + bj * HALF) = w;
                        if constexpr (H8OUT) { u32x2 q; q.x = pk_fp8x4(v0, v1, v2, v3); q.y = pk_fp8x4(v4, v5, v6, v7); *(u32x2*)(ws + WS_H8 + (size_t)row * D + col0 + bj * HALF) = q; } } }
                if constexpr (STATS) { s += __shfl_xor(s, 16); s += __shfl_xor(s, 32); if (fq == 0) red[rowl * 4 + wc] = s; }
                asm volatile("" ::: "memory"); }
        if constexpr (STATS) {
            asm volatile("s_waitcnt lgkmcnt(0)" ::: "memory"); __builtin_amdgcn_s_barrier(); asm volatile("" ::: "memory");
            if (tid < BM) { const f32x4 v = *(const LAS f32x4*)(red + tid * 4); int row; bool valid = true;
                if constexpr (LIST) { row = utok[ub * 256 + tid]; valid = row >= 0; } else row = u.pm * BM + tid;
                if (valid) ss[(size_t)row * 4 + u.pn] = (v.x + v.y) + (v.z + v.w); }
        }
    }
};
struct EpiUp {
    static constexpr bool PERM = false;
    unsigned char* ws; LAS unsigned char* lds;
    __device__ __forceinline__ void operator()(const f32x4 (&acc)[2][2][4][2], const Unit& u, int wr, int wc, int fr, int fq, int, int ub) const {
        const int col0 = u.pn * 128 + wc * 16 + 4 * fq;
        bf16_t* hid = (bf16_t*)(ws + WS_HID); const LAS float* urs = (const LAS float*)(lds + UROW_OFF) + 768;
#pragma unroll
        for (int ai = 0; ai < 2; ++ai)
#pragma unroll
            for (int m = 0; m < 4; ++m) { const int rowl = ai * HALF + wr * 64 + m * 16 + fr;
                const float rs = urs[ub * 256 + rowl] * 0.0625f, gw = urs[768 + ub * 256 + rowl];
                bf16_t* hp = hid + ((size_t)u.pm * BM + rowl) * DE + col0;
#pragma unroll
                for (int bj = 0; bj < 2; ++bj) { const f32x4 g = acc[ai][bj][m][0] * rs, up = acc[ai][bj][m][1] * rs; float o[4];
#pragma unroll
                    for (int j = 0; j < 4; ++j) o[j] = g[j] * __builtin_amdgcn_rcpf(1.f + __builtin_amdgcn_exp2f(g[j] * -1.4426950408889634f)) * up[j] * gw;
                    u32x2 w; w.x = cvt_pk_bf16(o[0], o[1]); w.y = cvt_pk_bf16(o[2], o[3]); *(u32x2*)(hp + bj * 64) = w; } }
    }
};
}

struct MoeTab { int cnt[64]; int rb0[65]; int pad[3]; unsigned short li[NBMAX]; unsigned short blk[NBMAX]; };
static_assert(sizeof(MoeTab) <= 4096, "MoeTab fits below RED_OFF");
__device__ __forceinline__ void moe_build_tab(LAS MoeTab* T, unsigned* gcnt) {
    const int tid = threadIdx.x;
    if (tid < 64) T->cnt[tid] = (int)__hip_atomic_load(gcnt + tid * 16, __ATOMIC_RELAXED, __HIP_MEMORY_SCOPE_AGENT);
    __syncthreads();
    if (tid == 0) { int run = 0; for (int i = 0; i < 64; ++i) { T->rb0[i] = run; run += (T->cnt[i] + 255) >> 8; } T->rb0[64] = run; }
    __syncthreads();
    if (tid < 64) { const int b0 = T->rb0[tid], nb = T->rb0[tid + 1] - b0;
#pragma clang loop vectorize(disable) unroll(disable)
        for (int b = 0; b < nb; ++b) { T->li[b0 + b] = (unsigned short)tid; T->blk[b0 + b] = (unsigned short)b; } }
    __syncthreads();
}
template <bool GATHER_, int NN, int LDA, int K, unsigned ESTEP> struct MoeOrder {
    static constexpr bool GATHER = GATHER_, LIST = true;
    LAS unsigned char* lds; unsigned char* ws; int rbLo, nwg, G, c;
    __device__ __forceinline__ bool next(int i, pg8::Unit& u, int ub, int tid) const {
        const int L = i * G + c; if (L >= nwg) return false;
        const LAS MoeTab* T = (const LAS MoeTab*)(lds + TAB_OFF); LAS int* urow = (LAS int*)(lds + UROW_OFF);
        const int wgid = pg8::xcd_remap(L, nwg), rb = rbLo + wgid / NN;
        const int li = T->li[rb], blk = T->blk[rb], cnt = T->cnt[li];
        u.pm = rb; u.pn = wgid % NN; u.ao = GATHER ? 0u : (unsigned)rb * (unsigned)(256 * LDA * 2); u.bo = (unsigned)(li & 31) * ESTEP + (unsigned)u.pn * (unsigned)(256 * K * 2);
        if (tid < 256) { const int slot = blk * 256 + tid; const bool valid = slot < cnt; const size_t idx = (size_t)li * CAPL + slot;
            urow[ub * 256 + tid] = valid ? ((const int*)(ws + WS_LTOK))[idx] : -1;
            if constexpr (GATHER) { ((LAS float*)urow)[768 + ub * 256 + tid] = valid ? ((const float*)(ws + WS_LRS))[idx] : 0.f; ((LAS float*)urow)[1536 + ub * 256 + tid] = valid ? ((const float*)(ws + WS_LW))[idx] : 0.f; } }
        return true;
    }
    __device__ __forceinline__ unsigned aoff(int ub, int rowl, int C) const {
        if constexpr (GATHER) { const int tok = ((const LAS int*)(lds + UROW_OFF))[ub * 256 + rowl]; return (unsigned)((tok < 0 ? 0 : tok) * LDA + C) * 2u; }
        else return (unsigned)(rowl * LDA + C) * 2u;
    }
};

__device__ __forceinline__ void route_phase(const P& p, int l, LAS unsigned char* lds, int G, int bid, unsigned* gcnt) {
    int tid_ = threadIdx.x; asm volatile("" : "+v"(tid_));
    const int tid = tid_, w = __builtin_amdgcn_readfirstlane(tid >> 6), lane = tid & 63, r = lane & 15, q = lane >> 4;
    const int per = (MP + G - 1) / G, r0 = bid * per, nrows = (r0 + per <= MP) ? per : (MP - r0 > 0 ? MP - r0 : 0);
    constexpr int WROW = 1040;
    LAS unsigned char* WHs = lds; LAS unsigned char* WLs = lds + 48 * WROW;
    LAS float* lg = (LAS float*)(lds + 2 * 48 * WROW);
    LAS int* lcnt = (LAS int*)(lds + TAB_OFF);
    LAS int* lbase = lcnt + 64;
    LAS int* rli = lbase + 64;
    LAS int* rpos = rli + 528;
    LAS float* rw = (LAS float*)(rpos + 528);
    LAS float* rrs = rw + 528;
    if (tid < 64) lcnt[tid] = 0;
    const bf16_t* WH = (const bf16_t*)(p.ws + WS_WRS) + (size_t)l * 48 * D; const bf16_t* WL = WH + (size_t)DEPTH * 48 * D;
    f32x4 acc[2][3];
#pragma unroll
    for (int gi = 0; gi < 2; ++gi)
#pragma unroll
        for (int tl = 0; tl < 3; ++tl) acc[gi][tl] = (f32x4){0.f, 0.f, 0.f, 0.f};
#pragma unroll 1
    for (int half = 0; half < 2; ++half) {
        __syncthreads();
        for (int idx = tid; idx < 48 * 64; idx += NTHR) { const int row = idx >> 6, pc = idx & 63;
            *(LAS pg8::u32x4*)(WHs + row * WROW + pc * 16) = *(const pg8::u32x4*)(WH + (size_t)row * D + half * 512 + pc * 8);
            *(LAS pg8::u32x4*)(WLs + row * WROW + pc * 16) = *(const pg8::u32x4*)(WL + (size_t)row * D + half * 512 + pc * 8); }
        __syncthreads();
#pragma unroll
        for (int gi = 0; gi < 2; ++gi) { const int g = w + gi * NWAVES;
            if (g * 16 < nrows) { const bool ina = (g * 16 + r) < nrows; const bf16_t* ap = p.H() + (size_t)(ina ? r0 + g * 16 + r : 0) * D + half * 512 + q * 8;
                pg8::bf16x8 a[16];
#pragma unroll
                for (int ks = 0; ks < 16; ++ks) a[ks] = *(const pg8::bf16x8*)(ap + ks * 32);
#pragma unroll
                for (int ks = 0; ks < 16; ++ks)
#pragma unroll
                    for (int tl = 0; tl < 3; ++tl) { const int wo = (tl * 16 + r) * WROW + (ks * 32 + q * 8) * 2;
                        acc[gi][tl] = __builtin_amdgcn_mfma_f32_16x16x32_bf16(a[ks], *(const LAS pg8::bf16x8*)(WHs + wo), acc[gi][tl], 0, 0, 0);
                        acc[gi][tl] = __builtin_amdgcn_mfma_f32_16x16x32_bf16(a[ks], *(const LAS pg8::bf16x8*)(WLs + wo), acc[gi][tl], 0, 0, 0); } } }
    }
#pragma unroll
    for (int gi = 0; gi < 2; ++gi) { const int g = w + gi * NWAVES;
        if (g * 16 < nrows) {
            LAS float* lgw = lg + w * 16 * 48;
#pragma unroll
            for (int tl = 0; tl < 3; ++tl)
#pragma unroll
                for (int j = 0; j < 4; ++j) lgw[(q * 4 + j) * 48 + tl * 16 + r] = acc[gi][tl][j];
            asm volatile("s_waitcnt lgkmcnt(0)" ::: "memory");
            if (lane < 16) { const int i = g * 16 + lane, rr = r0 + i;
                if (i < nrows) {
                    if ((rr % TP) < LEAD) { int neg = -1; asm volatile("" : "+v"(neg)); rli[2 * i] = neg; rli[2 * i + 1] = neg; }
                    else { const float rs = row_rs(p.SS2(), rr); const LAS float* x = lgw + lane * 48; float gl[4];
#pragma unroll
                        for (int j = 0; j < 4; ++j) gl[j] = x[j] * rs + p.br_g[l * 4 + j];
                        int gsel = 0; float gm = gl[0];
#pragma unroll
                        for (int j = 1; j < 4; ++j) if (gl[j] > gm) { gm = gl[j]; gsel = j; }
                        float se = 0.f;
#pragma unroll
                        for (int j = 0; j < 4; ++j) se += __expf(gl[j] - gm);
                        const float psel = 1.f / se;
                        int i0 = 0, i1 = -1; float v0 = -INFINITY, v1 = -INFINITY;
                        for (int j = 0; j < 8; ++j) { const float v = x[4 + gsel * 8 + j] * rs + p.br_e[l * 32 + gsel * 8 + j];
                            if (v > v0) { v1 = v0; i1 = i0; v0 = v; i0 = j; } else if (v > v1) { v1 = v; i1 = j; } }
                        const float w0 = 1.f / (1.f + __expf(v1 - v0));
                        const int li0 = gsel * 8 + i0, li1 = 32 + gsel * 8 + i1;
                        rli[2 * i] = li0; rli[2 * i + 1] = li1; rw[2 * i] = w0 * psel; rw[2 * i + 1] = (1.f - w0) * psel; rrs[i] = rs;
                        rpos[2 * i] = __hip_atomic_fetch_add(&lcnt[li0], 1, __ATOMIC_RELAXED, __HIP_MEMORY_SCOPE_WORKGROUP); rpos[2 * i + 1] = __hip_atomic_fetch_add(&lcnt[li1], 1, __ATOMIC_RELAXED, __HIP_MEMORY_SCOPE_WORKGROUP); } } }
            asm volatile("s_waitcnt lgkmcnt(0)" ::: "memory"); } }
    __syncthreads();
    if (tid < 64) { const int n = lcnt[tid]; lbase[tid] = n ? (int)__hip_atomic_fetch_add(gcnt + tid * 16, (unsigned)n, __ATOMIC_RELAXED, __HIP_MEMORY_SCOPE_AGENT) : 0; }
    __syncthreads();
    int* ltok = (int*)(p.ws + WS_LTOK); float* lrs = (float*)(p.ws + WS_LRS); float* lw = (float*)(p.ws + WS_LW);
    for (int i = tid; i < 2 * nrows; i += NTHR) { const int li = rli[i]; if (li >= 0) { const size_t idx = (size_t)li * CAPL + lbase[li] + rpos[i]; ltok[idx] = r0 + (i >> 1); lrs[idx] = rrs[i >> 1]; lw[idx] = rw[i]; } }
    __syncthreads();
}

namespace mx {
#define LDS_BARRIER() do { asm volatile("s_waitcnt lgkmcnt(0)" ::: "memory"); __builtin_amdgcn_s_barrier(); asm volatile("" ::: "memory"); } while (0)
using pg8::bf16x8; using pg8::u32x4; using pg8::u32x2; using pg8::cvt_pk_bf16; using pg8::bflo; using pg8::bfhi;
__device__ __forceinline__ f32x4 mfma16(bf16x8 a, bf16x8 b, f32x4 c) { return __builtin_amdgcn_mfma_f32_16x16x32_bf16(a, b, c, 0, 0, 0); }
__device__ __forceinline__ float wscan_add(float v, int lane) {
#pragma unroll
    for (int o = 1; o < 64; o <<= 1) { const float t = __shfl_up(v, o); if (lane >= o) v += t; }
    return v; }
__device__ __forceinline__ float wscan_max(float v, int lane) {
#pragma unroll
    for (int o = 1; o < 64; o <<= 1) { const float t = __shfl_up(v, o); if (lane >= o) v = fmaxf(v, t); }
    return v; }
__device__ __forceinline__ float wave_max(float v) {
#pragma unroll
    for (int o = 1; o < 64; o <<= 1) v = fmaxf(v, __shfl_xor(v, o));
    return v; }
__device__ __forceinline__ void unpack8(const u32x4 a, float (&x)[8]) { x[0] = bflo(a.x); x[1] = bfhi(a.x); x[2] = bflo(a.y); x[3] = bfhi(a.y); x[4] = bflo(a.z); x[5] = bfhi(a.z); x[6] = bflo(a.w); x[7] = bfhi(a.w); }
__device__ __forceinline__ u32x4 pack8(const float (&x)[8]) { u32x4 w; w.x = cvt_pk_bf16(x[0], x[1]); w.y = cvt_pk_bf16(x[2], x[3]); w.z = cvt_pk_bf16(x[4], x[5]); w.w = cvt_pk_bf16(x[6], x[7]); return w; }
__device__ __forceinline__ bf16x8 ldfrag(const LAS unsigned char* p) { return *(const LAS bf16x8*)p; }
__device__ __forceinline__ float fexp(float x) { return __builtin_amdgcn_exp2f(x * 1.4426950408889634f); }
__device__ __forceinline__ float frcp(float x) { return __builtin_amdgcn_rcpf(x); }
__device__ __forceinline__ float fsigm(float x) { return frcp(1.f + fexp(-x)); }
__device__ __forceinline__ float fsilu(float x) { return x * fsigm(x); }
__device__ __forceinline__ float flogsig(float x) { return fminf(x, 0.f) - __builtin_amdgcn_logf(1.f + fexp(-fabsf(x))) * 0.6931471805599453f; }
__device__ __forceinline__ float frsq(float x) { return __builtin_amdgcn_rsqf(x); }
constexpr int SQ = 272, ST = 144;
__device__ __forceinline__ int tsw(int row, int s) { return row * ST + ((((s >> 3) ^ (row >> 3)) & 7) << 4) + ((s & 7) << 1); }
__device__ __forceinline__ int tfr(int row, int chunk) { return row * ST + (((chunk ^ (row >> 3)) & 7) << 4); }

struct UC { int c, hd, b, r0; };
__device__ __forceinline__ UC ucoord(int u) { UC k; k.c = u % NCH; k.hd = (u / NCH) & 3; k.b = u / (NCH * 4); k.r0 = k.b * TP + k.c * 64; return k; }
template <int NS> struct PreM { u32x4 x[NS + 3]; u32x4 v[2]; pg8::f32x2_ g; };
struct PreO { u32x4 qk[4]; u32x4 v[2]; f32x4 g; pg8::f32x2_ n; };
struct PreG { u32x4 v[2]; u32x4 q, k; f32x4 ca; pg8::f32x2_ ab; };
template <int NS> __device__ __forceinline__ void load_m(const P& p, int u, PreM<NS>& R, int tid, int zvcol) {
    asm volatile("" : "+v"(tid));
    const UC k = ucoord(u); const bf16_t* z = p.Z(); const int lane = tid & 63, w = tid >> 6;
    { const size_t zr = (size_t)(k.r0 + lane) * NIN; pg8::f32x2_ g = {0.f, 0.f}; if (w == 0) { g.x = bf2f(z[zr + ZO_FG + k.hd]); g.y = bf2f(z[zr + ZO_IG + k.hd]); } R.g = g; }
    int zcol, s0;
    if (NS == 4) { const int which = tid >> 8; zcol = (which ? ZO_KM : ZO_QM) + k.hd * 128 + (tid & 15) * 8; s0 = ((tid >> 4) & 15) * 4; }
    else { zcol = ZO_KM + k.hd * 128 + (tid & 15) * 8; s0 = (tid >> 4) * 2; }
#pragma unroll
    for (int i = 0; i < NS + 3; ++i) { const int s = s0 - 3 + i, pp = k.c * 64 + s, row = k.r0 + (pp >= 0 ? s : 0);
        const u32x4 v = *(const u32x4*)(z + (size_t)row * NIN + zcol); const unsigned m = pp >= 0 ? 0xffffffffu : 0u; R.x[i] = (u32x4){v.x & m, v.y & m, v.z & m, v.w & m}; }
#pragma unroll
    for (int it = 0; it < 2; ++it) { const int s = 2 * (tid >> 4) + it, v8 = tid & 15; R.v[it] = *(const u32x4*)(z + (size_t)(k.r0 + s) * NIN + zvcol + k.hd * 128 + v8 * 8); }
}
__device__ __forceinline__ void load_o(const P& p, int u, PreO& R, int tid) {
    asm volatile("" : "+v"(tid));
    const UC k = ucoord(u); const bf16_t* z = p.Z(); const bf16_t* qkc = (const bf16_t*)(p.ws + WS_QKC);
#pragma unroll
    for (int it = 0; it < 4; ++it) { const int item = tid + it * NTHR, which = item >> 10, s = (item >> 4) & 63, ch8 = item & 15; R.qk[it] = *(const u32x4*)(qkc + (size_t)(k.r0 + s) * 1024 + which * 512 + k.hd * 128 + ch8 * 8); }
#pragma unroll
    for (int it = 0; it < 2; ++it) { const int s = 2 * (tid >> 4) + it, v8 = tid & 15; R.v[it] = *(const u32x4*)(z + (size_t)(k.r0 + s) * NIN + ZO_VM + k.hd * 128 + v8 * 8); }
    { f32x4 g = {0.f, 0.f, 0.f, 0.f}; if (tid < 64) { const float* ga = (const float*)((const unsigned char*)p.out + ST_GA) + (size_t)u * 192; g.x = ga[tid]; g.y = ga[64 + tid]; g.z = ga[128 + tid]; g.w = p.MSC()[(size_t)u * 4 + 2]; } R.g = g;
      pg8::f32x2_ n = {0.f, 0.f}; if (tid < 128) n.x = p.MN()[(size_t)u * 128 + tid]; R.n = n; }
}
__device__ __forceinline__ void load_g(const P& p, int l, int u, PreG& R, int tid, bool needq) {
    asm volatile("" : "+v"(tid));
    const UC k = ucoord(u); const bf16_t* z = p.Z();
#pragma unroll
    for (int it = 0; it < 2; ++it) { const int s = 2 * (tid >> 4) + it, v8 = tid & 15; R.v[it] = *(const u32x4*)(z + (size_t)(k.r0 + s) * NIN + ZO_VG + k.hd * 128 + v8 * 8); }
    const size_t zr = (size_t)(k.r0 + (tid >> 3)) * NIN; R.k = *(const u32x4*)(z + zr + ZO_KG + k.hd * 64 + (tid & 7) * 8); R.q = R.k;
    if (needq) R.q = *(const u32x4*)(z + zr + ZO_QG + k.hd * 64 + (tid & 7) * 8);
    { const int i0 = tid, i1 = tid + NTHR; f32x4 ca;
        ca.x = bf2f(z[(size_t)(k.r0 + (i0 >> 4)) * NIN + ZO_CODE + (i0 & 15)]); ca.y = bf2f(z[(size_t)(k.r0 + (i1 >> 4)) * NIN + ZO_CODE + (i1 & 15)]);
        ca.z = p.a_w2[(l * 16 + (i0 >> 6)) * 256 + k.hd * 64 + (i0 & 63)]; ca.w = p.a_w2[(l * 16 + (i1 >> 6)) * 256 + k.hd * 64 + (i1 & 63)]; R.ca = ca;
      pg8::f32x2_ ab = {0.f, 0.f}; if (tid < 64) ab.x = p.a_b[l * 256 + k.hd * 64 + tid]; R.ab = ab; }
}
template <int NS> __device__ __forceinline__ void conv8(const P& p, int l, const u32x4 (&xr)[NS + 3], int c, int s0, int cch, float scale, float (&o)[NS][8]) {
    float x[NS + 3][8];
#pragma unroll
    for (int i = 0; i < NS + 3; ++i) unpack8(xr[i], x[i]);
    float bias[8];
    { const f32x4 b0 = *(const f32x4*)(p.conv_b + l * D + cch), b1 = *(const f32x4*)(p.conv_b + l * D + cch + 4); bias[0] = b0.x; bias[1] = b0.y; bias[2] = b0.z; bias[3] = b0.w; bias[4] = b1.x; bias[5] = b1.y; bias[6] = b1.z; bias[7] = b1.w; }
#pragma unroll
    for (int i = 0; i < NS; ++i)
#pragma unroll
        for (int q = 0; q < 8; ++q) o[i][q] = bias[q];
#pragma unroll
    for (int j = 0; j < 4; ++j) { float w[8];
        { const f32x4 w0 = *(const f32x4*)(p.conv_w + (l * 4 + j) * D + cch), w1 = *(const f32x4*)(p.conv_w + (l * 4 + j) * D + cch + 4); w[0] = w0.x; w[1] = w0.y; w[2] = w0.z; w[3] = w0.w; w[4] = w1.x; w[5] = w1.y; w[6] = w1.z; w[7] = w1.w; }
#pragma unroll
        for (int i = 0; i < NS; ++i)
#pragma unroll
            for (int q = 0; q < 8; ++q) o[i][q] += w[q] * x[i + j][q]; }
#pragma unroll
    for (int i = 0; i < NS; ++i) { const bool valid = (c > 0) || (s0 + i >= LEAD);
#pragma unroll
        for (int q = 0; q < 8; ++q) o[i][q] = valid ? fsilu(o[i][q]) * scale : 0.f; }
}

__device__ __forceinline__ void gla_cumdecay(const P& p, int l, int hd, const PreG& R, int c, LAS float* LA, LAS float* segtot, LAS float* cod, LAS float* aw, LAS float* ab, int tid) {
    cod[tid] = R.ca.x; cod[tid + NTHR] = R.ca.y; aw[tid] = R.ca.z; aw[tid + NTHR] = R.ca.w;
    if (tid < 64) ab[tid] = p.a_b[l * 256 + hd * 64 + tid];
    LDS_BARRIER();
    const int j = tid & 63, seg = tid >> 6; float run = 0.f, v[8];
#pragma unroll
    for (int i = 0; i < 8; ++i) { const int s = seg * 8 + i; const bool valid = (c > 0) || (s >= LEAD); float a = ab[j];
#pragma unroll
        for (int q = 0; q < 16; ++q) a += cod[s * 16 + q] * aw[q * 64 + j];
        run += valid ? flogsig(a) * (1.f / 16.f) : 0.f; v[i] = run; }
    segtot[seg * 64 + j] = run;
    LDS_BARRIER();
    float pre = 0.f;
#pragma unroll
    for (int g = 0; g < 8; ++g) pre += (g < seg) ? segtot[g * 64 + j] : 0.f;
#pragma unroll
    for (int i = 0; i < 8; ++i) LA[(seg * 8 + i) * 65 + j] = v[i] + pre;
    LDS_BARRIER();
}
__device__ __forceinline__ void mlstm_local(const P& p, int l, int u, LAS unsigned char* lds, int tid, PreM<4>& R, int unext) {
    asm volatile("" : "+v"(tid));
    const int lane = tid & 63, w = __builtin_amdgcn_readfirstlane(tid >> 6), c = u % NCH, hd = (u / NCH) & 3, b = u / (NCH * 4), r0 = b * TP + c * 64;
    LAS unsigned char* KT = lds; LAS unsigned char* VT = lds + 18432; LAS float* wS = (LAS float*)(lds + 39168);
    if (w == 0) { const int s = lane; const bool valid = (c > 0) || (s >= LEAD);
        const float lf = valid ? flogsig(R.g.x + p.gate_b[(l * 2 + 1) * 4 + hd]) : 0.f;
        const float ig = valid ? R.g.y + p.gate_b[(l * 2 + 0) * 4 + hd] : -INFINITY;
        const float bb = wscan_add(lf, lane), be = __shfl(bb, 63), g = be - bb + ig, mg = wave_max(g), a = ig - bb, pm = wscan_max(a, lane);
        wS[s] = fexp(g - mg);
        float* ga = (float*)((unsigned char*)p.out + ST_GA) + (size_t)u * 192; ga[s] = bb; ga[64 + s] = a; ga[128 + s] = pm;
        if (lane == 0) { float* sc = p.MSC() + (size_t)u * 4; sc[0] = mg; sc[1] = be; } }
    { const int which = tid >> 8, ch8 = tid & 15, s0 = ((tid >> 4) & 15) * 4; float o[4][8];
        conv8<4>(p, l, R.x, c, s0, which * 512 + hd * 128 + ch8 * 8, which ? 0.08838834764831845f : 1.f, o);
        bf16_t* qkc = (bf16_t*)(p.ws + WS_QKC) + (size_t)(r0 + s0) * 1024 + which * 512 + hd * 128 + ch8 * 8;
#pragma unroll
        for (int i = 0; i < 4; ++i) *(u32x4*)(qkc + (size_t)i * 1024) = pack8(o[i]);
        if (which) {
#pragma unroll
            for (int q = 0; q < 8; ++q) { *(LAS unsigned*)(KT + tsw(ch8 * 8 + q, s0)) = cvt_pk_bf16(o[0][q], o[1][q]); *(LAS unsigned*)(KT + tsw(ch8 * 8 + q, s0 + 2)) = cvt_pk_bf16(o[2][q], o[3][q]); } } }
    LDS_BARRIER();
    { const int s0 = 2 * (tid >> 4), v8 = tid & 15; float x0[8], x1[8]; unpack8(R.v[0], x0); unpack8(R.v[1], x1);
        const float w0 = ((c > 0) || (s0 >= LEAD)) ? wS[s0] : 0.f, w1 = ((c > 0) || (s0 + 1 >= LEAD)) ? wS[s0 + 1] : 0.f;
#pragma unroll
        for (int q = 0; q < 8; ++q) *(LAS unsigned*)(VT + tsw(v8 * 8 + q, s0)) = cvt_pk_bf16(x0[q] * w0, x1[q] * w1); }
    for (int i = tid; i < 16 * 64; i += NTHR) { const int row = 128 + (i >> 6), s = i & 63; *(LAS bf16_t*)(VT + tsw(row, s)) = (row == 128) ? (bf16_t)(cvt_pk_bf16(wS[s], 0.f) & 0xffffu) : (bf16_t)0; }
    if (unext >= 0) load_m<4>(p, unext, R, tid, ZO_VM);
    LDS_BARRIER();
    { const int r = lane & 15, q = lane >> 4; bf16x8 afr[2];
#pragma unroll
        for (int ks = 0; ks < 2; ++ks) afr[ks] = ldfrag(KT + tfr(w * 16 + r, ks * 4 + q));
        bf16_t* Cd = p.MC() + (size_t)u * 16384;
#pragma unroll
        for (int vt = 0; vt < 9; ++vt) { f32x4 acc = {0.f, 0.f, 0.f, 0.f};
#pragma unroll
            for (int ks = 0; ks < 2; ++ks) acc = mfma16(afr[ks], ldfrag(VT + tfr(vt * 16 + r, ks * 4 + q)), acc);
            if (vt < 8) { u32x2 o; o.x = cvt_pk_bf16(acc[0], acc[1]); o.y = cvt_pk_bf16(acc[2], acc[3]); *(u32x2*)(Cd + (vt * 16 + r) * 128 + w * 16 + q * 4) = o; }
            else if (r == 0) *(f32x4*)(p.MN() + (size_t)u * 128 + w * 16 + q * 4) = acc; } }
    LDS_BARRIER();
}

__device__ __forceinline__ void gla_local(const P& p, int l, int u, LAS unsigned char* lds, int tid, PreG& R, int unext) {
    asm volatile("" : "+v"(tid));
    const int lane = tid & 63, w = __builtin_amdgcn_readfirstlane(tid >> 6), c = u % NCH, hd = (u / NCH) & 3, b = u / (NCH * 4), r0 = b * TP + c * 64;
    const bf16_t* z = p.Z();
    LAS float* LA = (LAS float*)lds; LAS float* segtot = (LAS float*)(lds + 16640); LAS unsigned char* KHT = lds + 18688; LAS unsigned char* VT = lds + 27904;
    LAS float* cod = (LAS float*)(lds + 46336); LAS float* aw = (LAS float*)(lds + 50432); LAS float* ab = (LAS float*)(lds + 54528);
    gla_cumdecay(p, l, hd, R, c, LA, segtot, cod, aw, ab, tid);
    if (tid < 64) p.GB()[(size_t)u * 64 + tid] = LA[63 * 65 + tid];
    { const int s = tid >> 3, j8 = tid & 7; const bool valid = (c > 0) || (s >= LEAD); float x[8];
        unpack8(R.k, x);
#pragma unroll
        for (int q = 0; q < 8; ++q) { const int j = j8 * 8 + q; *(LAS bf16_t*)(KHT + tsw(j, s)) = (bf16_t)(cvt_pk_bf16(valid ? x[q] * fexp(LA[63 * 65 + j] - LA[s * 65 + j]) : 0.f, 0.f) & 0xffffu); } }
    { const int s0 = 2 * (tid >> 4), v8 = tid & 15; float x0[8], x1[8]; unpack8(R.v[0], x0); unpack8(R.v[1], x1);
        const float w0 = ((c > 0) || (s0 >= LEAD)) ? 1.f : 0.f, w1 = ((c > 0) || (s0 + 1 >= LEAD)) ? 1.f : 0.f;
#pragma unroll
        for (int q = 0; q < 8; ++q) *(LAS unsigned*)(VT + tsw(v8 * 8 + q, s0)) = cvt_pk_bf16(x0[q] * w0, x1[q] * w1); }
    if (unext >= 0) load_g(p, l, unext, R, tid, false);
    LDS_BARRIER();
    { const int r = lane & 15, q = lane >> 4; bf16x8 bfr[2];
#pragma unroll
        for (int ks = 0; ks < 2; ++ks) bfr[ks] = ldfrag(VT + tfr(w * 16 + r, ks * 4 + q));
        bf16_t* Sd = p.GS() + (size_t)u * 8192;
#pragma unroll
        for (int jt = 0; jt < 4; ++jt) { f32x4 acc = {0.f, 0.f, 0.f, 0.f};
#pragma unroll
            for (int ks = 0; ks < 2; ++ks) acc = mfma16(ldfrag(KHT + tfr(jt * 16 + r, ks * 4 + q)), bfr[ks], acc);
            u32x2 o; o.x = cvt_pk_bf16(acc[0], acc[1]); o.y = cvt_pk_bf16(acc[2], acc[3]); *(u32x2*)(Sd + (w * 16 + r) * 64 + jt * 16 + q * 4) = o; } }
    LDS_BARRIER();
}

template <class LD, class FOLD> __device__ __forceinline__ void scan_stream(LD ld, FOLD fold) {
    u32x2 cur[16], nxt[16];
#pragma unroll
    for (int i = 0; i < 16; ++i) cur[i] = ld(i);
#pragma unroll 1
    for (int c0 = 0; c0 < 128; c0 += 16) {
#pragma unroll
        for (int i = 0; i < 16; ++i) nxt[i] = ld(c0 + 16 + i < NCH ? c0 + 16 + i : NCH - 1);
#pragma unroll
        for (int i = 0; i < 16; ++i) fold(c0 + i, cur[i]);
#pragma unroll
        for (int i = 0; i < 16; ++i) cur[i] = nxt[i];
    }
    fold(128, cur[0]);
}
__device__ __forceinline__ void scan_phase(const P& p, LAS unsigned char* lds, int G, int bid, int tid) {
    asm volatile("" : "+v"(tid));
    LAS float* dec = (LAS float*)lds; LAS float* wgt = dec + 132;
    for (int item = bid; item < 16 * 13; item += G) { const int bh = item / 13, sl = item % 13;
        __syncthreads();
        if (sl < 9 && tid < 64) {
            const int lane = tid; float* sc = p.MSC() + (size_t)bh * NCH * 4; const int c0 = 2 * lane, c1 = c0 + 1;
            const float a0 = sc[c0 * 4 + 1], b0 = sc[c0 * 4], a1 = sc[c1 * 4 + 1], b1 = sc[c1 * 4];
            float A = a0 + a1, Bv = fmaxf(b0 + a1, b1);
#pragma unroll
            for (int o = 1; o < 64; o <<= 1) { const float At = __shfl_up(A, o), Bt = __shfl_up(Bv, o); if (lane >= o) { Bv = fmaxf(Bt + A, Bv); A = At + A; } }
            float EA = __shfl_up(A, 1), EB = __shfl_up(Bv, 1); if (lane == 0) { EA = 0.f; EB = -INFINITY; }
            const float mp = fmaxf(EA, EB), m0 = fmaxf(mp + a0, b0), m1 = fmaxf(m0 + a1, b1);
            dec[c0] = fexp(a0 + mp - m0); wgt[c0] = fexp(b0 - m0); dec[c1] = fexp(a1 + m0 - m1); wgt[c1] = fexp(b1 - m1);
            if (sl == 0) { sc[c0 * 4 + 2] = mp; sc[c1 * 4 + 2] = m0; }
            if (lane == 63) { const float a2 = sc[128 * 4 + 1], b2 = sc[128 * 4], m2 = fmaxf(m1 + a2, b2); dec[128] = fexp(a2 + m1 - m2); wgt[128] = fexp(b2 - m2); if (sl == 0) sc[128 * 4 + 2] = m1; } }
        __syncthreads();
        if (sl < 8) { float C0 = 0.f, C1 = 0.f, C2 = 0.f, C3 = 0.f; u32x2* q = (u32x2*)(p.MC() + (size_t)bh * NCH * 16384 + sl * 2048 + tid * 4);
            scan_stream([&](int c) { return q[(size_t)c * 4096]; },
                        [&](int c, u32x2 dl) { u32x2 o; o.x = cvt_pk_bf16(C0, C1); o.y = cvt_pk_bf16(C2, C3); q[(size_t)c * 4096] = o; const float d = dec[c], g = wgt[c];
                            C0 = d * C0 + g * bflo(dl.x); C1 = d * C1 + g * bfhi(dl.x); C2 = d * C2 + g * bflo(dl.y); C3 = d * C3 + g * bfhi(dl.y); }); }
        else if (sl == 8) { if (tid < 128) { float C = 0.f; float* q = p.MN() + (size_t)bh * NCH * 128 + tid;
#pragma unroll 16
            for (int c = 0; c < NCH; ++c) { const float dl = q[(size_t)c * 128]; q[(size_t)c * 128] = C; C = dec[c] * C + wgt[c] * dl; } } }
        else { const int e = (sl - 9) * 2048 + tid * 4, j = e & 63; float S0 = 0.f, S1 = 0.f, S2 = 0.f, S3 = 0.f; u32x2* q = (u32x2*)(p.GS() + (size_t)bh * NCH * 8192 + e); const f32x4* gb = (const f32x4*)(p.GB() + (size_t)bh * NCH * 64 + j);
            scan_stream([&](int c) { return q[(size_t)c * 2048]; },
                        [&](int c, u32x2 dl) { const f32x4 bv = gb[(size_t)c * 16]; u32x2 o; o.x = cvt_pk_bf16(S0, S1); o.y = cvt_pk_bf16(S2, S3); q[(size_t)c * 2048] = o;
                            S0 = S0 * fexp(bv.x) + bflo(dl.x); S1 = S1 * fexp(bv.y) + bfhi(dl.x); S2 = S2 * fexp(bv.z) + bflo(dl.y); S3 = S3 * fexp(bv.w) + bfhi(dl.y); }); }
    }
    __syncthreads();
}

__device__ __forceinline__ void mlstm_out(const P& p, int l, int u, LAS unsigned char* lds, int tid, PreO& R, int unext) {
    asm volatile("" : "+v"(tid));
    const int lane = tid & 63, w = __builtin_amdgcn_readfirstlane(tid >> 6), c = u % NCH, hd = (u / NCH) & 3, b = u / (NCH * 4), r0 = b * TP + c * 64;
    const bf16_t* z = p.Z();
    LAS unsigned char* QS = lds; LAS unsigned char* KS = lds + 17408; LAS unsigned char* VT = lds + 34816; LAS unsigned char* SS = lds + 55552;
    LAS float* aS = (LAS float*)(lds + 64768); LAS float* MS = aS + 64; LAS float* wiS = MS + 64; LAS float* emtS = wiS + 64; LAS float* denS = emtS + 64; LAS float* part = denS + 64; LAS float* nS = part + 128;
    const int r = lane & 15, q = lane >> 4, tt = w & 3, vh = w >> 2, t = tt * 16 + r;
    const int nvt = vh ? 4 : 5;
    bf16x8 cfr[4][4];
    { const bf16_t* Cg = p.MC() + (size_t)u * 16384;
#pragma unroll
        for (int i = 0; i < 4; ++i)
#pragma unroll
            for (int ks = 0; ks < 4; ++ks) cfr[i][ks] = *(const bf16x8*)(Cg + ((vh * 4 + i) * 16 + r) * 128 + ks * 32 + q * 8); }
    if (tid < 128) nS[tid] = R.n.x;
    if (w == 0) { const int s = lane; const float bb = R.g.x, aa = R.g.y, pm = R.g.z, m0 = R.g.w, M = fmaxf(m0, pm);
        aS[s] = aa; MS[s] = M; wiS[s] = fexp(m0 - M); emtS[s] = fexp(-(bb + M)); }
#pragma unroll
    for (int it = 0; it < 4; ++it) { const int item = tid + it * NTHR, which = item >> 10, s = (item >> 4) & 63, ch8 = item & 15; *(LAS u32x4*)((which ? KS : QS) + s * SQ + ch8 * 16) = R.qk[it]; }
    { const int s0 = 2 * (tid >> 4), v8 = tid & 15; float x0[8], x1[8]; unpack8(R.v[0], x0); unpack8(R.v[1], x1);
        const float w0 = ((c > 0) || (s0 >= LEAD)) ? 1.f : 0.f, w1 = ((c > 0) || (s0 + 1 >= LEAD)) ? 1.f : 0.f;
#pragma unroll
        for (int q = 0; q < 8; ++q) *(LAS unsigned*)(VT + tsw(v8 * 8 + q, s0)) = cvt_pk_bf16(x0[q] * w0, x1[q] * w1); }
    for (int i = tid; i < 16 * 64; i += NTHR) { const int row = 128 + (i >> 6), s = i & 63; *(LAS bf16_t*)(VT + tsw(row, s)) = (row == 128) ? (bf16_t)0x3f80 : (bf16_t)0; }
    if (unext >= 0) load_o(p, unext, R, tid);
    LDS_BARRIER();
    f32x4 acc2[5];
    { bf16x8 qb[4];
#pragma unroll
        for (int ks = 0; ks < 4; ++ks) qb[ks] = ldfrag(QS + (tt * 16 + r) * SQ + (ks * 32 + q * 8) * 2);
#pragma unroll
        for (int i = 0; i < 5; ++i) { acc2[i] = (f32x4){0.f, 0.f, 0.f, 0.f}; if (i < nvt) {
#pragma unroll
            for (int ks = 0; ks < 4; ++ks) { bf16x8 afr;
                if (i < 4) afr = cfr[i][ks];
                else { const f32x4 n0 = *(const LAS f32x4*)(nS + ks * 32 + q * 8), n1 = *(const LAS f32x4*)(nS + ks * 32 + q * 8 + 4); const float mk = (r == 0) ? 1.f : 0.f;
                    const float nn[8] = {n0.x * mk, n0.y * mk, n0.z * mk, n0.w * mk, n1.x * mk, n1.y * mk, n1.z * mk, n1.w * mk};
                    afr = __builtin_bit_cast(bf16x8, pack8(nn)); }
                acc2[i] = mfma16(afr, qb[ks], acc2[i]); } } }
        const float Mt = MS[t];
#pragma unroll
        for (int cc = 0; cc < 2; ++cc) { const int st = vh * 2 + cc; f32x4 acc = {0.f, 0.f, 0.f, 0.f};
            if (st <= tt) {
#pragma unroll
                for (int ks = 0; ks < 4; ++ks) acc = mfma16(ldfrag(KS + (st * 16 + r) * SQ + (ks * 32 + q * 8) * 2), qb[ks], acc); }
            float sv[4];
#pragma unroll
            for (int j = 0; j < 4; ++j) { const int s = st * 16 + q * 4 + j; sv[j] = (s <= t) ? acc[j] * fexp(aS[s] - Mt) : 0.f; }
            u32x2 o; o.x = cvt_pk_bf16(sv[0], sv[1]); o.y = cvt_pk_bf16(sv[2], sv[3]); *(LAS u32x2*)(SS + t * ST + (st * 16 + q * 4) * 2) = o; } }
    LDS_BARRIER();
    f32x4 hv[5];
    { bf16x8 sb[2];
#pragma unroll
        for (int ks = 0; ks < 2; ++ks) sb[ks] = ldfrag(SS + (tt * 16 + r) * ST + (ks * 32 + q * 8) * 2);
        const float wi = wiS[t];
#pragma unroll
        for (int i = 0; i < 5; ++i) { if (i < nvt) { const int vt = (i < 4) ? vh * 4 + i : 8; f32x4 a1 = {0.f, 0.f, 0.f, 0.f};
#pragma unroll
            for (int ks = 0; ks < 2; ++ks) a1 = mfma16(ldfrag(VT + tfr(vt * 16 + r, ks * 4 + q)), sb[ks], a1);
            hv[i] = a1 + acc2[i] * wi; } }
        if (vh == 0 && q == 0) denS[t] = hv[4][0]; }
    u32x2 og[4]; f32x4 gn[4];
#pragma unroll
    for (int i = 0; i < 4; ++i) { const int v0 = (vh * 4 + i) * 16 + q * 4; og[i] = *(const u32x2*)(z + (size_t)(r0 + t) * NIN + ZO_OM + hd * 128 + v0); gn[i] = *(const f32x4*)(p.m_norm_g + l * 512 + hd * 128 + v0); }
    LDS_BARRIER();
    { const float dn = frcp(fmaxf(fabsf(denS[t]), emtS[t])); float ssq = 0.f;
#pragma unroll
        for (int i = 0; i < 4; ++i) { hv[i] = hv[i] * dn; ssq += hv[i][0] * hv[i][0] + hv[i][1] * hv[i][1] + hv[i][2] * hv[i][2] + hv[i][3] * hv[i][3]; }
        ssq += __shfl_xor(ssq, 16); ssq += __shfl_xor(ssq, 32); if (q == 0) part[t * 2 + vh] = ssq; }
    LDS_BARRIER();
    { const bool valid = (c > 0) || (t >= LEAD); const float sc = frsq((part[t * 2] + part[t * 2 + 1]) * (1.f / 128.f) + EPS); bf16_t* yp = p.Z() + (size_t)(r0 + t) * NIN + ZO_OM + hd * 128;
#pragma unroll
        for (int i = 0; i < 4; ++i) { const int v0 = (vh * 4 + i) * 16 + q * 4; float y[4];
            y[0] = hv[i][0] * sc * gn[i][0] * fsigm(bflo(og[i].x)); y[1] = hv[i][1] * sc * gn[i][1] * fsigm(bfhi(og[i].x)); y[2] = hv[i][2] * sc * gn[i][2] * fsigm(bflo(og[i].y)); y[3] = hv[i][3] * sc * gn[i][3] * fsigm(bfhi(og[i].y));
            u32x2 o; o.x = valid ? cvt_pk_bf16(y[0], y[1]) : 0u; o.y = valid ? cvt_pk_bf16(y[2], y[3]) : 0u; *(u32x2*)(yp + v0) = o; } }
    LDS_BARRIER();
}

__device__ __forceinline__ void gla_out(const P& p, int l, int u, LAS unsigned char* lds, int tid, PreG& R, int unext) {
    asm volatile("" : "+v"(tid));
    const int lane = tid & 63, w = __builtin_amdgcn_readfirstlane(tid >> 6), c = u % NCH, hd = (u / NCH) & 3, b = u / (NCH * 4), r0 = b * TP + c * 64;
    const bf16_t* z = p.Z();
    LAS float* LA = (LAS float*)lds; LAS float* segtot = (LAS float*)(lds + 16640); LAS unsigned char* QT = lds + 18688; LAS unsigned char* KT2 = lds + 27904; LAS unsigned char* VT = lds + 37120; LAS unsigned char* AS = lds + 55552;
    LAS float* cod = (LAS float*)(lds + 64768); LAS float* aw = (LAS float*)(lds + 68864); LAS float* ab = (LAS float*)(lds + 72960); LAS float* part = (LAS float*)(lds + 73216);
    const int r = lane & 15, q = lane >> 4, tt = w & 3, dh = w >> 2, t = tt * 16 + r;
    bf16x8 sfr[4][2];
    { const bf16_t* Sg = p.GS() + (size_t)u * 8192;
#pragma unroll
        for (int i = 0; i < 4; ++i)
#pragma unroll
            for (int ks = 0; ks < 2; ++ks) sfr[i][ks] = *(const bf16x8*)(Sg + ((dh * 4 + i) * 16 + r) * 64 + ks * 32 + q * 8); }
    gla_cumdecay(p, l, hd, R, c, LA, segtot, cod, aw, ab, tid);
    { const int s = tid >> 3, j8 = tid & 7; const bool valid = (c > 0) || (s >= LEAD); float xq[8], xk[8];
        unpack8(R.q, xq); unpack8(R.k, xk);
#pragma unroll
        for (int q = 0; q < 8; ++q) { const float bb = LA[s * 65 + j8 * 8 + q]; xq[q] = valid ? xq[q] * 0.125f * fexp(bb) : 0.f; xk[q] = valid ? xk[q] * fexp(-bb) : 0.f; }
        *(LAS u32x4*)(QT + s * ST + j8 * 16) = pack8(xq); *(LAS u32x4*)(KT2 + s * ST + j8 * 16) = pack8(xk); }
    { const int s0 = 2 * (tid >> 4), v8 = tid & 15; float x0[8], x1[8]; unpack8(R.v[0], x0); unpack8(R.v[1], x1);
        const float w0 = ((c > 0) || (s0 >= LEAD)) ? 1.f : 0.f, w1 = ((c > 0) || (s0 + 1 >= LEAD)) ? 1.f : 0.f;
#pragma unroll
        for (int q = 0; q < 8; ++q) *(LAS unsigned*)(VT + tsw(v8 * 8 + q, s0)) = cvt_pk_bf16(x0[q] * w0, x1[q] * w1); }
    if (unext >= 0) load_g(p, l, unext, R, tid, true);
    LDS_BARRIER();
    f32x4 hv[4];
    { bf16x8 qb[2];
#pragma unroll
        for (int ks = 0; ks < 2; ++ks) qb[ks] = ldfrag(QT + (tt * 16 + r) * ST + (ks * 32 + q * 8) * 2);
#pragma unroll
        for (int i = 0; i < 4; ++i) { hv[i] = (f32x4){0.f, 0.f, 0.f, 0.f};
#pragma unroll
            for (int ks = 0; ks < 2; ++ks) hv[i] = mfma16(sfr[i][ks], qb[ks], hv[i]); }
#pragma unroll
        for (int cc = 0; cc < 2; ++cc) { const int st = dh * 2 + cc; f32x4 acc = {0.f, 0.f, 0.f, 0.f};
            if (st <= tt) {
#pragma unroll
                for (int ks = 0; ks < 2; ++ks) acc = mfma16(ldfrag(KT2 + (st * 16 + r) * ST + (ks * 32 + q * 8) * 2), qb[ks], acc); }
            float sv[4];
#pragma unroll
            for (int j = 0; j < 4; ++j) { const int s = st * 16 + q * 4 + j; sv[j] = (s <= t) ? acc[j] : 0.f; }
            u32x2 o; o.x = cvt_pk_bf16(sv[0], sv[1]); o.y = cvt_pk_bf16(sv[2], sv[3]); *(LAS u32x2*)(AS + t * ST + (st * 16 + q * 4) * 2) = o; } }
    u32x2 og[4]; f32x4 gn[4];
#pragma unroll
    for (int i = 0; i < 4; ++i) { const int d0 = (dh * 4 + i) * 16 + q * 4; og[i] = *(const u32x2*)(z + (size_t)(r0 + t) * NIN + ZO_GG + hd * 128 + d0); gn[i] = *(const f32x4*)(p.g_norm_g + l * 512 + hd * 128 + d0); }
    LDS_BARRIER();
    { bf16x8 ab2[2];
#pragma unroll
        for (int ks = 0; ks < 2; ++ks) ab2[ks] = ldfrag(AS + (tt * 16 + r) * ST + (ks * 32 + q * 8) * 2);
        float ssq = 0.f;
#pragma unroll
        for (int i = 0; i < 4; ++i) { const int dt = dh * 4 + i;
#pragma unroll
            for (int ks = 0; ks < 2; ++ks) hv[i] = mfma16(ldfrag(VT + tfr(dt * 16 + r, ks * 4 + q)), ab2[ks], hv[i]);
            ssq += hv[i][0] * hv[i][0] + hv[i][1] * hv[i][1] + hv[i][2] * hv[i][2] + hv[i][3] * hv[i][3]; }
        ssq += __shfl_xor(ssq, 16); ssq += __shfl_xor(ssq, 32); if (q == 0) part[t * 2 + dh] = ssq; }
    LDS_BARRIER();
    { const bool valid = (c > 0) || (t >= LEAD); const float sc = frsq((part[t * 2] + part[t * 2 + 1]) * (1.f / 128.f) + EPS); bf16_t* yp = p.Z() + (size_t)(r0 + t) * NIN + ZO_GG + hd * 128;
#pragma unroll
        for (int i = 0; i < 4; ++i) { const int d0 = (dh * 4 + i) * 16 + q * 4; float y[4];
            y[0] = hv[i][0] * sc * gn[i][0] * fsilu(bflo(og[i].x)); y[1] = hv[i][1] * sc * gn[i][1] * fsilu(bfhi(og[i].x)); y[2] = hv[i][2] * sc * gn[i][2] * fsilu(bflo(og[i].y)); y[3] = hv[i][3] * sc * gn[i][3] * fsilu(bfhi(og[i].y));
            u32x2 o; o.x = valid ? cvt_pk_bf16(y[0], y[1]) : 0u; o.y = valid ? cvt_pk_bf16(y[2], y[3]) : 0u; *(u32x2*)(yp + d0) = o; } }
    LDS_BARRIER();
}
}

namespace pro {
#define PRO_TILE(LD4, GK, OUTROW) do { \
        f32x4 v_[8]; \
        _Pragma("unroll") for (int i = 0; i < 8; ++i) { const int kk = 8 * i + (lane >> 3); v_[i] = (LD4); } \
        _Pragma("unroll") for (int i = 0; i < 8; ++i) { const int kk = 8 * i + (lane >> 3); const float g_ = (GK); LAS float* d_ = scr + kk * 33 + (lane & 7) * 4; d_[0] = v_[i].x * g_; d_[1] = v_[i].y * g_; d_[2] = v_[i].z * g_; d_[3] = v_[i].w * g_; } \
        asm volatile("s_waitcnt lgkmcnt(0)" ::: "memory"); \
        { const int c8 = lane & 7; _Pragma("unroll") for (int j = 0; j < 4; ++j) { const int nn = (lane >> 3) + 8 * j; const LAS float* s_ = scr + (8 * c8) * 33 + nn; \
            pg8::u32x4 o_; o_.x = pg8::cvt_pk_bf16(s_[0], s_[33]); o_.y = pg8::cvt_pk_bf16(s_[66], s_[99]); o_.z = pg8::cvt_pk_bf16(s_[132], s_[165]); o_.w = pg8::cvt_pk_bf16(s_[198], s_[231]); \
            *(pg8::u32x4*)((OUTROW) + 8 * c8) = o_; } } \
        asm volatile("s_waitcnt lgkmcnt(0)" ::: "memory"); } while (0)
#define PRO_TILE8(LD4, GK, OUTROW8) do { \
        f32x4 v_[8]; \
        _Pragma("unroll") for (int i = 0; i < 8; ++i) { const int kk = 8 * i + (lane >> 3); v_[i] = (LD4); } \
        _Pragma("unroll") for (int i = 0; i < 8; ++i) { const int kk = 8 * i + (lane >> 3); const float g_ = (GK); LAS float* d_ = scr + kk * 33 + (lane & 7) * 4; d_[0] = v_[i].x * g_; d_[1] = v_[i].y * g_; d_[2] = v_[i].z * g_; d_[3] = v_[i].w * g_; } \
        asm volatile("s_waitcnt lgkmcnt(0)" ::: "memory"); \
        { const int c8 = lane & 7; _Pragma("unroll") for (int j = 0; j < 4; ++j) { const int nn = (lane >> 3) + 8 * j; const LAS float* s_ = scr + (8 * c8) * 33 + nn; \
            pg8::u32x2 o_; o_.x = pg8::pk_fp8x4(s_[0], s_[33], s_[66], s_[99]); o_.y = pg8::pk_fp8x4(s_[132], s_[165], s_[198], s_[231]); \
            *(pg8::u32x2*)((OUTROW8) + 8 * c8) = o_; } } \
        asm volatile("s_waitcnt lgkmcnt(0)" ::: "memory"); } while (0)
__device__ __forceinline__ void prologue_phase(const P& p, LAS unsigned char* lds, int G, int bid, int tid) {
    asm volatile("" : "+v"(tid));
    const int lane = tid & 63, w = __builtin_amdgcn_readfirstlane(tid >> 6), gw = bid * NWAVES + w, NGW = G * NWAVES;
    LAS float* scr = (LAS float*)(lds + w * 8448);
    constexpr int I_IN = DEPTH * 16 * (NZP / 32), I_OUT = DEPTH * 16 * (D / 32), I_GU = DEPTH * NE * 16 * (512 / 32), I_D = DEPTH * NE * (DE / 64) * (D / 32);
    const f32x4 zero4 = {0.f, 0.f, 0.f, 0.f};
    for (int it = gw; it < I_IN + I_OUT + I_GU + I_D; it += NGW) {
        int r = it;
        if (r < I_IN) { const int nb = r % (NZP / 32), kb = (r / (NZP / 32)) % 16, l = r / (16 * (NZP / 32)), k0 = kb * 64, n0 = nb * 32;
            const int n = n0 + (lane & 7) * 4; const float* src = p.w_in + ((size_t)l * D + k0) * NIN + zsrc(n); const float* g = p.norm1_g + l * D + k0;
            bf16_t* ob = (bf16_t*)(p.ws + WS_WIN) + ((size_t)l * NZP + n0) * D + k0;
            PRO_TILE((n < NIN) ? *(const f32x4*)(src + (size_t)kk * NIN) : zero4, g[kk], ob + (size_t)nn * D);
            continue; }
        r -= I_IN;
        if (r < I_OUT) { const int nb = r % 32, kb = (r / 32) % 16, l = r / 512, k0 = kb * 64, n0 = nb * 32;
            const float* src = p.w_out + ((size_t)l * D + k0) * D + n0 + (lane & 7) * 4; bf16_t* ob = (bf16_t*)(p.ws + WS_WOUT) + ((size_t)l * D + n0) * D + k0;
            PRO_TILE(*(const f32x4*)(src + (size_t)kk * D), 1.f, ob + (size_t)nn * D);
            continue; }
        r -= I_OUT;
        if (r < I_GU) { const int nb = r % 16, kb = (r / 16) % 16, bz = r / 256, k0 = kb * 64, n0 = nb * 32;
            const int i4 = (lane & 7) * 4; const float* src = ((i4 < 16) ? p.w_gate : p.w_up) + ((size_t)bz * D + k0) * DE + 16 * nb + (i4 & 15); const float* g = p.norm2_g + (bz >> 5) * D + k0;
            unsigned char* ob8 = p.ws + WS_WGU + ((size_t)bz * 512 + n0) * D + k0;
            PRO_TILE8(*(const f32x4*)(src + (size_t)kk * DE), g[kk] * 16.f, ob8 + (size_t)nn * D);
            continue; }
        r -= I_GU;
        { const int nb = r % 32, kb = (r / 32) % 4, bz = r / 128, k0 = kb * 64, n0 = nb * 32;
            const float* src = p.w_down + ((size_t)bz * DE + k0) * D + n0 + (lane & 7) * 4; bf16_t* ob = (bf16_t*)(p.ws + WS_WD) + ((size_t)bz * D + n0) * DE + k0;
            PRO_TILE(*(const f32x4*)(src + (size_t)kk * D), 1.f, ob + (size_t)nn * DE); }
    }
    for (int idx = bid * NTHR + tid; idx < DEPTH * 48 * D; idx += G * NTHR) { const int k = idx % D, o = (idx / D) % 48, l = idx / (D * 48); float v = 0.f;
        if (o < 4) v = p.wr_g[((size_t)l * D + k) * 4 + o]; else if (o < 36) v = p.wr_e[((size_t)l * D + k) * 32 + (o - 4)];
        v *= p.norm2_g[l * D + k]; const bf16_t hi = f2bf(v), lo = f2bf(v - bf2f(hi));
        bf16_t* wh = (bf16_t*)(p.ws + WS_WRS); wh[idx] = hi; wh[(size_t)DEPTH * 48 * D + idx] = lo; }
    for (int r = gw; r < MP; r += NGW) { const int b = r / TP, pp = r % TP; const float* src = nullptr;
        if (pp >= 64) src = p.x + ((size_t)b * SEQ + (pp - 64)) * D; else if (pp >= LEAD) src = p.meta + (size_t)(pp - LEAD) * D;
        float s = 0.f; bf16_t* hr = p.H() + (size_t)r * D;
#pragma unroll
        for (int j = 0; j < 4; ++j) { f32x4 v = {0.f, 0.f, 0.f, 0.f}; if (src) v = ((const f32x4*)src)[lane + 64 * j];
            s += v.x * v.x + v.y * v.y + v.z * v.z + v.w * v.w;
            pg8::u32x2 o; o.x = pg8::cvt_pk_bf16(v.x, v.y); o.y = pg8::cvt_pk_bf16(v.z, v.w); ((pg8::u32x2*)hr)[lane + 64 * j] = o; }
        s = wave_sum(s);
        if (lane == 0) { f32x4 q = {s, 0.f, 0.f, 0.f}; *(f32x4*)(p.SS1() + (size_t)r * 4) = q; } }
}
#undef PRO_TILE
#undef PRO_TILE8
__device__ __forceinline__ void final_phase(const P& p, int G, int bid, int tid) {
    asm volatile("" : "+v"(tid));
    const int lane = tid & 63, w = tid >> 6;
    for (int t = bid * NWAVES + w; t < B * SEQ; t += G * NWAVES) { const int b = t / SEQ, s = t % SEQ, r = b * TP + 64 + s;
        const float rs = row_rs(p.SS1(), r); const bf16_t* hr = p.H() + (size_t)r * D; float* o = p.out + (size_t)t * D;
#pragma unroll
        for (int j = 0; j < 4; ++j) { const pg8::u32x2 hv = ((const pg8::u32x2*)hr)[lane + 64 * j]; const f32x4 g = ((const f32x4*)p.final_g)[lane + 64 * j];
            f32x4 v; v.x = pg8::bflo(hv.x) * rs * g.x; v.y = pg8::bfhi(hv.x) * rs * g.y; v.z = pg8::bflo(hv.y) * rs * g.z; v.w = pg8::bfhi(hv.y) * rs * g.w;
            ((f32x4*)o)[lane + 64 * j] = v; } }
}
}

struct Args { P p; int ph_lo, ph_hi; };
__global__ void __launch_bounds__(NTHR, 2) fwd(Args a) {
    extern __shared__ __attribute__((aligned(16))) unsigned char lds_raw[];
    LAS unsigned char* lds = (LAS unsigned char*)lds_raw;
    const P& p = a.p;
    const int tid = threadIdx.x, G = gridDim.x, bid = blockIdx.x;
    unsigned* ctl = (unsigned*)(p.ws + WS_CTL);
    volatile LAS unsigned* MISC = (volatile LAS unsigned*)(lds + MISC_OFF);
    if (tid < 128) MISC[tid] = 0u;
    __syncthreads();
    const bool multi = (a.ph_hi - a.ph_lo) > 1;
    XcdBarrier bar; bar.bar = ctl + CW_BAR; bar.x = 0; bar.st = nullptr;
    if (multi) bar = xcd_barrier_post(ctl + CW_BAR, MISC + 8);
#define IN(k) (a.ph_lo <= (k) && (k) < a.ph_hi)
#define SEAM(k) do { if (IN(k) && IN((k) + 1)) xcd_barrier(bar); } while (0)
    if (IN(PH_PRO)) {
pro::prologue_phase(p, lds, G, bid, tid); }
    SEAM(PH_PRO);
    for (int l = 0; l < DEPTH; ++l) {
        const int pb = PH_LAYER0 + l * PH_PER_LAYER;
        unsigned* gcnt = ctl + CW_CNT + l * 64 * 16;
        if (IN(pb + 0)) {
{
            pg8::DenseOrderRS<D, D> S; S.init(MP, NZP, G, bid); S.lds = lds; S.ws = p.ws;
            pg8::EpiZ E{p.ws, lds};
            pg8::gemm_phase<pg8::EpiZ, pg8::DenseOrderRS<D, D>, true, D, D>(lds + RING_OFF, (const char*)(p.ws + WS_H), (const char*)(p.ws + WS_WIN) + (size_t)l * NZP * D * 2, S, E);
            }
        }
        SEAM(pb + 0);
        if (IN(pb + 1)) {
{ { const int ulo = (int)((long)bid * NU / G), uhi = (int)((long)(bid + 1) * NU / G);
                if (ulo < uhi) { mx::PreM<4> pre; mx::load_m<4>(p, ulo, pre, tid, ZO_VM); for (int u = ulo; u < uhi; ++u) mx::mlstm_local(p, l, u, lds, tid, pre, u + 1 < uhi ? u + 1 : -1); }
                { const int glo = (int)((long)(G - 1 - bid) * NU / G), ghi = (int)((long)(G - bid) * NU / G);
                if (glo < ghi) { mx::PreG pre; mx::load_g(p, l, glo, pre, tid, false); for (int u = glo; u < ghi; ++u) mx::gla_local(p, l, u, lds, tid, pre, u + 1 < ghi ? u + 1 : -1); } } } } }
        SEAM(pb + 1);
        if (IN(pb + 2)) mx::scan_phase(p, lds, G, bid, tid);
        SEAM(pb + 2);
        if (IN(pb + 3)) { { const int ulo = (int)((long)bid * NU / G), uhi = (int)((long)(bid + 1) * NU / G);
                if (ulo < uhi) { mx::PreO pre; mx::load_o(p, ulo, pre, tid); for (int u = ulo; u < uhi; ++u) mx::mlstm_out(p, l, u, lds, tid, pre, u + 1 < uhi ? u + 1 : -1); }
                { const int glo = (int)((long)(G - 1 - bid) * NU / G), ghi = (int)((long)(G - bid) * NU / G);
                if (glo < ghi) { mx::PreG pre; mx::load_g(p, l, glo, pre, tid, true); for (int u = glo; u < ghi; ++u) mx::gla_out(p, l, u, lds, tid, pre, u + 1 < ghi ? u + 1 : -1); } } } }
        SEAM(pb + 3);
        if (IN(pb + 4)) {
            pg8::DenseOrder<NIN, D> S; S.init(MP, D, G, bid);
            pg8::EpiRes<false, true, WS_SS2, true> E{p.ws, lds};
            pg8::gemm_phase<pg8::EpiRes<false, true, WS_SS2, true>, pg8::DenseOrder<NIN, D>, true, NIN, D>(lds + RING_OFF, (const char*)(p.ws + WS_Z), (const char*)(p.ws + WS_WOUT) + (size_t)l * D * D * 2, S, E);
        }
        SEAM(pb + 4);
        if (IN(pb + 5)) route_phase(p, l, lds, G, bid, gcnt);
        SEAM(pb + 5);
        if (IN(pb + 6)) {
{
            moe_build_tab((LAS MoeTab*)(lds + TAB_OFF), gcnt);
            typedef MoeOrder<true, 2, D / 2, D / 2, 512u * D> Ord;
            Ord S; S.lds = lds; S.ws = p.ws; S.rbLo = 0; S.nwg = ((const LAS MoeTab*)(lds + TAB_OFF))->rb0[64] * 2; S.G = G; S.c = bid;
            pg8::EpiUp E{p.ws, lds};
            pg8::gemm_phase<pg8::EpiUp, Ord, true, D / 2, D / 2, true>(lds + RING_OFF, (const char*)(p.ws + WS_H8), (const char*)(p.ws + WS_WGU) + (size_t)l * NE * 512 * D, S, E);
            }
        }
        SEAM(pb + 6);
#pragma unroll
        for (int rank = 0; rank < 2; ++rank) {
            if (IN(pb + 7 + rank)) {
                moe_build_tab((LAS MoeTab*)(lds + TAB_OFF), gcnt);
                const LAS MoeTab* T = (const LAS MoeTab*)(lds + TAB_OFF);
                typedef MoeOrder<false, 4, DE, DE, (unsigned)D * DE * 2u> Ord;
                Ord S; S.lds = lds; S.ws = p.ws; S.rbLo = T->rb0[32 * rank]; S.nwg = (T->rb0[32 * rank + 32] - T->rb0[32 * rank]) * 4; S.G = G; S.c = bid;
                const char* Ab = (const char*)(p.ws + WS_HID); const char* Bb = (const char*)(p.ws + WS_WD) + (size_t)l * NE * D * DE * 2;
                if (rank == 0) { pg8::EpiRes<true, false, WS_SS1> E{p.ws, lds}; pg8::gemm_phase<pg8::EpiRes<true, false, WS_SS1>, Ord, true, DE, DE>(lds + RING_OFF, Ab, Bb, S, E); }
                else { pg8::EpiRes<true, true, WS_SS1> E{p.ws, lds}; pg8::gemm_phase<pg8::EpiRes<true, true, WS_SS1>, Ord, true, DE, DE>(lds + RING_OFF, Ab, Bb, S, E); }
            }
            SEAM(pb + 7 + rank);
        }
    }
    if (IN(PH_FINAL)) pro::final_phase(p, G, bid, tid);
#undef IN
#undef SEAM
}

extern "C" void kernel_launch(void* const* d_in, const int* in_sizes, int n_in, void* d_out, int out_size, void* d_ws, size_t ws_size, hipStream_t stream) {
    if (n_in != 21 || ws_size < WS_END || out_size != B * SEQ * D) { fprintf(stderr, "kernel_launch: unexpected sizes n_in %d ws %zu (need %zu) out %d\n", n_in, ws_size, (size_t)WS_END, out_size); return; }
    P p{};
    const float** f = (const float**)&p.x;
    for (int i = 0; i < 21; ++i) f[i] = (const float*)d_in[i];
    p.out = (float*)d_out; p.ws = (unsigned char*)d_ws;
    static int grid = 0;
    if (!grid) {
        (void)hipFuncSetAttribute((const void*)fwd, hipFuncAttributeMaxDynamicSharedMemorySize, LDS_BYTES);
        int dev = 0, cus = 0, per_cu = 0;
        (void)hipGetDevice(&dev); (void)hipDeviceGetAttribute(&cus, hipDeviceAttributeMultiprocessorCount, dev);
        (void)hipOccupancyMaxActiveBlocksPerMultiprocessor(&per_cu, (const void*)fwd, NTHR, LDS_BYTES);
        (void)hipGetLastError();
        grid = cus > 0 ? cus : 256;
        if (per_cu < 1) fprintf(stderr, "kernel_launch: occupancy query reports %d blocks/CU for fwd\n", per_cu);
    }
    (void)hipMemsetAsync(d_ws, 0, CTL_BYTES, stream);
    Args a{}; a.p = p; a.ph_lo = 0; a.ph_hi = PH_COUNT;
    hipLaunchKernelGGL(fwd, dim3(grid), dim3(NTHR), LDS_BYTES, stream, a);
}
```

```cpp
#include <hip/hip_runtime.h>
#include <cstdio>
#include <cstdint>

typedef unsigned short bf16_t;
typedef float f32x4 __attribute__((ext_vector_type(4)));

namespace cfg {
constexpr int B = 4, SEQ = 8192, D = 1024, DEPTH = 2;
constexpr int CH = 64, NMETA = 16, LEAD = 48;
constexpr int TP = LEAD + NMETA + SEQ;
constexpr int NCH = TP / CH;
constexpr int MP = B * TP;
constexpr int XR = B * SEQ;
constexpr int NIN = 3608, NZP = 3840;
constexpr int ZO_OM = 0, ZO_GG = 512, ZO_QM = 1024, ZO_KM = 1536, ZO_VM = 2048, ZO_QG = 2560, ZO_KG = 2816, ZO_VG = 3072, ZO_IG = 3584, ZO_FG = 3588, ZO_CODE = 3592;
constexpr int NE = 32, DE = 256, NR = 40;
constexpr float EPS = 1e-6f;
constexpr int NU = B * 4 * NCH;

constexpr size_t al(size_t x) { return (x + 255) & ~(size_t)255; }
constexpr size_t WS_CTL = 0, CTL_BYTES = 4u << 20;
constexpr size_t WS_WIN = WS_CTL + CTL_BYTES;
constexpr size_t WS_WOUT = WS_WIN + al((size_t)DEPTH * NZP * D * 2);
constexpr size_t WS_WGU = WS_WOUT + al((size_t)DEPTH * D * D * 2);
constexpr size_t WS_H8 = WS_WGU + al((size_t)DEPTH * NE * 512 * D);
constexpr size_t WS_WD = WS_H8 + al((size_t)MP * D);
constexpr size_t WS_WR = WS_WD + al((size_t)DEPTH * NE * D * DE * 2);
constexpr size_t WS_H = WS_WR + al((size_t)DEPTH * NR * D * 4);
constexpr size_t WS_Z = WS_H + al((size_t)MP * D * 2);
constexpr size_t WS_SS1 = WS_Z + al((size_t)MP * NIN * 2);
constexpr size_t WS_SS2 = WS_SS1 + al((size_t)MP * 16);
constexpr size_t WS_TOKE = WS_SS2 + al((size_t)MP * 16);
constexpr size_t WS_TOKW = WS_TOKE + al((size_t)MP * 8);
constexpr int CAPL = MP, NBMAX = 352;
constexpr size_t WS_LTOK = WS_TOKW + al((size_t)MP * 8);
constexpr size_t WS_LRS = WS_LTOK + al((size_t)64 * CAPL * 4);
constexpr size_t WS_LW = WS_LRS + al((size_t)64 * CAPL * 4);
constexpr size_t WS_WRS = WS_LW + al((size_t)64 * CAPL * 4);
constexpr size_t WS_QKC = WS_WRS + al((size_t)2 * DEPTH * 48 * D * 2);
constexpr size_t WS_END = WS_QKC + al((size_t)MP * 1024 * 2);
constexpr size_t WS_HID = WS_QKC;
static_assert((size_t)NBMAX * 256 * 256 * 2 <= (size_t)MP * 1024 * 2, "hid fits in the q|k buffer");
constexpr size_t ST_MC = 0;
constexpr size_t ST_GS = ST_MC + al((size_t)NU * 16384 * 2);
constexpr size_t ST_MN = ST_GS + al((size_t)NU * 8192 * 2);
constexpr size_t ST_MSC = ST_MN + al((size_t)NU * 128 * 4);
constexpr size_t ST_GB = ST_MSC + al((size_t)NU * 16);
constexpr size_t ST_GA = ST_GB + al((size_t)NU * 64 * 4);
constexpr size_t ST_END = ST_GA + al((size_t)NU * 192 * 4);
static_assert(ST_END <= (size_t)B * SEQ * D * 4, "state scratch fits d_out");
}
using namespace cfg;

__device__ __forceinline__ float bf2f(bf16_t v) { return __uint_as_float(((unsigned)v) << 16); }
__device__ __forceinline__ bf16_t f2bf(float f) { unsigned u = __float_as_uint(f); u += 0x7fffu + ((u >> 16) & 1u); return (bf16_t)(u >> 16); }
__device__ __forceinline__ float wave_sum(float v) {
#pragma unroll
    for (int o = 1; o < 64; o <<= 1) v += __shfl_xor(v, o);
    return v;
}
__device__ __forceinline__ float logsig(float x) { return fminf(x, 0.f) - log1pf(__expf(-fabsf(x))); }
__device__ __forceinline__ float sigm(float x) { return 1.f / (1.f + __expf(-x)); }
__device__ __forceinline__ float silu(float x) { return x * sigm(x); }

__host__ __device__ __forceinline__ int zsrc(int n) {
    if (n < 512) return 1536 + n;
    if (n < 1024) return 3080 + (n - 512);
    if (n < 2048) return n - 1024;
    if (n < 2560) return 1024 + (n - 2048);
    if (n < 2816) return 2056 + (n - 2560);
    if (n < 3072) return 2312 + (n - 2816);
    if (n < 3584) return 2568 + (n - 3072);
    if (n < 3588) return 2048 + (n - 3584);
    if (n < 3592) return 2052 + (n - 3588);
    return n;
}

struct P {
    const float *x, *meta, *norm1_g, *w_in, *conv_w, *conv_b, *gate_b, *m_norm_g, *a_w2, *a_b, *g_norm_g, *w_out, *norm2_g, *wr_g, *br_g, *wr_e, *br_e, *w_gate, *w_up, *w_down, *final_g;
    float* out; unsigned char* ws;
    __device__ __forceinline__ bf16_t* Win() const { return (bf16_t*)(ws + WS_WIN); }
    __device__ __forceinline__ bf16_t* Wout() const { return (bf16_t*)(ws + WS_WOUT); }
    __device__ __forceinline__ bf16_t* Wgu() const { return (bf16_t*)(ws + WS_WGU); }
    __device__ __forceinline__ bf16_t* Wd() const { return (bf16_t*)(ws + WS_WD); }
    __device__ __forceinline__ float* Wr() const { return (float*)(ws + WS_WR); }
    __device__ __forceinline__ bf16_t* H() const { return (bf16_t*)(ws + WS_H); }
    __device__ __forceinline__ bf16_t* Z() const { return (bf16_t*)(ws + WS_Z); }
    __device__ __forceinline__ float* SS1() const { return (float*)(ws + WS_SS1); }
    __device__ __forceinline__ float* SS2() const { return (float*)(ws + WS_SS2); }
    __device__ __forceinline__ int* TokE() const { return (int*)(ws + WS_TOKE); }
    __device__ __forceinline__ float* TokW() const { return (float*)(ws + WS_TOKW); }
    __device__ __forceinline__ bf16_t* MC() const { return (bf16_t*)((unsigned char*)out + ST_MC); }
    __device__ __forceinline__ bf16_t* GS() const { return (bf16_t*)((unsigned char*)out + ST_GS); }
    __device__ __forceinline__ float* MN() const { return (float*)((unsigned char*)out + ST_MN); }
    __device__ __forceinline__ float* MSC() const { return (float*)((unsigned char*)out + ST_MSC); }
    __device__ __forceinline__ float* GB() const { return (float*)((unsigned char*)out + ST_GB); }
};

__host__ __device__ __forceinline__ bool is_pad_row(int r) { return r >= XR && ((r - XR) & 63) < LEAD; }
__host__ __device__ __forceinline__ int chunk_row0(int b, int c) { return c == 0 ? XR + b * 64 : b * SEQ + (c - 1) * 64; }
__device__ __forceinline__ float row_rs(const float* ss, int r) {
    if (is_pad_row(r)) return 0.f;
    const f32x4 v = *(const f32x4*)(ss + (size_t)r * 4);
    return rsqrtf((v.x + v.y + v.z + v.w) * (1.f / D) + EPS);
}

#define LAS __attribute__((address_space(3)))
constexpr int NWAVES = 8, NTHR = 512;
constexpr int RING_OFF = 0, RING_BYTES = 131072, TAB_OFF = 131072, TAB_BYTES = 24576, MISC_OFF = TAB_OFF + TAB_BYTES, LDS_BYTES = MISC_OFF + 512;
constexpr int RED_OFF = TAB_OFF + 4096;
constexpr int UROW_OFF = TAB_OFF + 8192;
constexpr int CW_BAR = 4096, CW_CNT = 16384;
constexpr int PH_PRO = 0, PH_LAYER0 = 1, PH_PER_LAYER = 9, PH_FINAL = 1 + 9 * DEPTH, PH_COUNT = PH_FINAL + 1;

#define XB_TMO      128
#define XB_XCNT(j)  (256  + 64 * (j))
#define XB_XSUB(j)  (1280 + 64 * (j))
#define XB_XGEN(j)  (2304 + 64 * (j))
#define XB_TOP      3328
#define XB_TOPGEN   3392
#define XCD_BAR_WORDS 3456
#define XB_SPIN_CAP (1u << 18)
__device__ __forceinline__ unsigned xb_ld(unsigned* p)              { return __hip_atomic_load(p, __ATOMIC_RELAXED, __HIP_MEMORY_SCOPE_AGENT); }
__device__ __forceinline__ unsigned xb_add(unsigned* p, unsigned v) { return __hip_atomic_fetch_add(p, v, __ATOMIC_RELAXED, __HIP_MEMORY_SCOPE_AGENT); }
__device__ __forceinline__ unsigned xb_xcc_id() { return (unsigned)__builtin_amdgcn_s_getreg((3 << 11) | 20) & 0xFu; }
#define XB_SPIN(cond, bar) do { unsigned _sp = 0; while (cond) { __builtin_amdgcn_s_sleep(1); \
    if ((++_sp & 255u) == 0u) { if (xb_ld(&(bar)[XB_TMO])) break; if (_sp > XB_SPIN_CAP) { atomicAdd(&(bar)[XB_TMO], 1u); break; } } } } while (0)
struct XcdBarrier { unsigned* bar; unsigned x; volatile LAS unsigned* st; };
__device__ __forceinline__ XcdBarrier xcd_barrier_post(unsigned* bar, volatile LAS unsigned* st) {
    XcdBarrier b; b.bar = bar; b.x = xb_xcc_id(); b.st = st;
    if (threadIdx.x == 0) (void)xb_add(&bar[XB_XCNT(b.x)], 1u);
    return b;
}
__device__ __forceinline__ void xcd_barrier_complete(unsigned* bar, unsigned x, unsigned& nloc, unsigned& nx) {
    const unsigned G = gridDim.x * gridDim.y * gridDim.z;
    unsigned sum, cnt, mine, sp = 0u;
    for (;;) {
        sum = 0u; cnt = 0u; mine = 0u;
#pragma unroll
        for (unsigned j = 0; j < 16; ++j) { const unsigned c = xb_ld(&bar[XB_XCNT(j)]); sum += c; cnt += (c > 0u) ? 1u : 0u; mine = (j == x) ? c : mine; }
        if (sum == G) break;
        __builtin_amdgcn_s_sleep(1);
        if ((++sp & 255u) == 0u) { if (xb_ld(&bar[XB_TMO])) break; if (sp > XB_SPIN_CAP) { atomicAdd(&bar[XB_TMO], 1u); break; } }
    }
    nloc = mine > 0u ? mine : 1u; nx = cnt > 0u ? cnt : 1u;
}
__device__ __forceinline__ void xcd_barrier(const XcdBarrier& b) {
    asm volatile("s_waitcnt vmcnt(0)" ::: "memory");
    __syncthreads();
    if (threadIdx.x == 0) {
        unsigned* bar = b.bar;
        __builtin_amdgcn_s_waitcnt(0);
        unsigned nloc = b.st[0], nx = b.st[1];
        if (nloc == 0u) { xcd_barrier_complete(bar, b.x, nloc, nx); b.st[0] = nloc; b.st[1] = nx; }
        const unsigned old = xb_add(&bar[XB_XSUB(b.x)], 1u);
        const unsigned gen = old / nloc;
        if (old + 1u == (gen + 1u) * nloc) {
            __builtin_amdgcn_fence(__ATOMIC_RELEASE, "agent");
            asm volatile("s_waitcnt vmcnt(0)" ::: "memory");
            const unsigned og = xb_add(&bar[XB_TOP], 1u);
            const unsigned tg = og / nx;
            if (og + 1u == (tg + 1u) * nx) xb_add(&bar[XB_TOPGEN], 1u);
            else XB_SPIN(xb_ld(&bar[XB_TOPGEN]) == tg, bar);
            __builtin_amdgcn_fence(__ATOMIC_ACQUIRE, "agent");
            xb_add(&bar[XB_XGEN(b.x)], 1u);
            asm volatile("s_waitcnt vmcnt(0)" ::: "memory");
        } else {
            XB_SPIN(xb_ld(&bar[XB_XGEN(b.x)]) == gen, bar);
            __builtin_amdgcn_fence(__ATOMIC_ACQUIRE, "agent");
            asm volatile("s_waitcnt vmcnt(0)" ::: "memory");
        }
    }
    __syncthreads();
}

namespace pg8 {
typedef short bf16x8 __attribute__((ext_vector_type(8)));
typedef unsigned u32x4 __attribute__((ext_vector_type(4)));
typedef unsigned u32x2 __attribute__((ext_vector_type(2)));
constexpr int BM = 256, BK = 64, HALF = 128, HTB = HALF * BK * 2, STAGE_BYTES = 8 * HTB, NXCD = 8, WGM = 8;
__host__ __device__ __forceinline__ int lds_byte(int r, int c) { const int st = (r >> 4) * 2 + (c >> 5), rr = r & 15, cc = c & 31, ob = rr * 64 + cc * 2; return st * 1024 + (ob ^ (((ob >> 9) & 1) << 5)); }
__host__ __device__ __forceinline__ void stage_rc(int b, int& R, int& C) { const int st = b / 1024, sb = b % 1024, swz = sb ^ (((sb >> 9) & 1) << 5); R = (st >> 1) * 16 + swz / 64; C = (st & 1) * 32 + (swz % 64) / 2; }
__host__ __device__ __forceinline__ int perm32(int rho) { const int n = rho >> 4, i = rho & 15; return 8 * (i >> 2) + 4 * n + (i & 3); }
typedef float f32x2_ __attribute__((ext_vector_type(2))); typedef __bf16 bf16x2_ __attribute__((ext_vector_type(2)));
__device__ __forceinline__ unsigned cvt_pk_bf16(float lo, float hi) { const f32x2_ v = {lo, hi}; return __builtin_bit_cast(unsigned, __builtin_convertvector(v, bf16x2_)); }
__device__ __forceinline__ float bflo(unsigned w) { return __uint_as_float(w << 16); }
__device__ __forceinline__ float bfhi(unsigned w) { return __uint_as_float(w & 0xffff0000u); }

struct Unit { int pm, pn; unsigned ao, bo; };

__device__ __forceinline__ int xcd_remap(int L, int nwg) { const int q = nwg / NXCD, r = nwg % NXCD, xcd = L % NXCD, off = L / NXCD; return (xcd < r ? xcd * (q + 1) : r * (q + 1) + (xcd - r) * q) + off; }

template <int LDA, int K> struct DenseOrder {
    static constexpr bool GATHER = false, LIST = false;
    int nM, nN, nwg, G, c;
    __device__ __forceinline__ void init(int M, int N, int G_, int c_) { nM = M / BM; nN = N / BM; nwg = nM * nN; G = G_; c = c_; }
    __device__ __forceinline__ bool next(int i, Unit& u, int, int) const {
        const int L = i * G + c; if (L >= nwg) return false;
        const int wgid = xcd_remap(L, nwg);
        const int nig = WGM * nN, gid = wgid / nig, fm = gid * WGM, gsz = (nM - fm) < WGM ? (nM - fm) : WGM;
        u.pm = fm + ((wgid % nig) % gsz); u.pn = (wgid % nig) / gsz; u.ao = (unsigned)u.pm * (unsigned)(BM * LDA * 2); u.bo = (unsigned)u.pn * (unsigned)(BM * K * 2); return true;
    }
    __device__ __forceinline__ unsigned aoff(int, int rowl, int C) const { return (unsigned)(rowl * LDA + C) * 2u; }
};
template <int LDA, int K> struct DenseOrderRS : DenseOrder<LDA, K> {
    static constexpr bool GATHER = false, LIST = true;
    LAS unsigned char* lds; unsigned char* ws;
    __device__ __forceinline__ bool next(int i, Unit& u, int ub, int tid) const {
        if (!DenseOrder<LDA, K>::next(i, u, 0, 0)) return false;
        if (tid < 256) ((LAS float*)(lds + UROW_OFF))[ub * 256 + tid] = row_rs((const float*)(ws + WS_SS1), u.pm * BM + tid);
        return true;
    }
};

template <class Epi, class Sched, bool ALIGN_EPI, int LDA, int K, bool FP8 = false>
__device__ __forceinline__ void gemm_phase(LAS unsigned char* lds, const char* Abase, const char* Bbase, const Sched& S, const Epi& E) {
    int tid_ = threadIdx.x; asm volatile("" : "+v"(tid_));
    const int tid = tid_, wid = __builtin_amdgcn_readfirstlane(tid >> 6), lane = tid & 63, wr = wid >> 2, wc = wid & 3, fr = lane & 15, fq = lane >> 4;
    constexpr int nt = K / BK;
    int Rr[2], Cc[2]; unsigned voffB[2];
#pragma unroll
    for (int i = 0; i < 2; ++i) { stage_rc(tid * 16 + i * 8192, Rr[i], Cc[i]); const int Rb = Epi::PERM ? ((Rr[i] & ~31) + perm32(Rr[i] & 31)) : Rr[i]; voffB[i] = (unsigned)(Rb * K + Cc[i]) * 2u; }
    constexpr unsigned kstep = BK * 2, hstepB = HALF * K * 2;
    const unsigned ldsw = (unsigned)wid * 1024u;
    int aofs[2], bofs[2];
#pragma unroll
    for (int e = 0; e < 2; ++e) { aofs[e] = FP8 ? lds_byte(wr * 64 + fr, (2 * fq + e) * 8) : lds_byte(wr * 64 + fr, fq * 8) + e * 1024; bofs[e] = FP8 ? lds_byte(wc * 32 + fr, (2 * fq + e) * 8) : lds_byte(wc * 32 + fr, fq * 8) + e * 1024; }
#define PG8_SA(b, h) (((b) * 2 + (h)) * HTB)
#define PG8_SB(b, h) ((4 + (b) * 2 + (h)) * HTB)
#define PG8_STAGE(bufoff, gbase, uoff, voff) do { _Pragma("unroll") for (int _i = 0; _i < 2; ++_i) \
        __builtin_amdgcn_global_load_lds((const unsigned*)((gbase) + (size_t)(unsigned)((uoff) + (voff)[_i])), (LAS unsigned*)(lds + (bufoff) + ldsw + _i * 8192), 16, 0, 0); } while (0)
#define PG8_LDA(dst, b, h) do { _Pragma("unroll") for (int m = 0; m < 4; ++m) _Pragma("unroll") for (int k = 0; k < 2; ++k) dst[m][k] = *(const LAS bf16x8*)(lds + PG8_SA(b, h) + aofs[k] + m * 2048); } while (0)
#define PG8_LDB(dst, b, h) do { _Pragma("unroll") for (int n = 0; n < 2; ++n) _Pragma("unroll") for (int k = 0; k < 2; ++k) dst[n][k] = *(const LAS bf16x8*)(lds + PG8_SB(b, h) + bofs[k] + n * 2048); } while (0)
#define PG8_MMA(ai, bj, At, Bt) do { __builtin_amdgcn_s_setprio(1); _Pragma("unroll") for (int m = 0; m < 4; ++m) _Pragma("unroll") for (int n = 0; n < 2; ++n) { \
        if constexpr (FP8) { typedef int i32x4_ __attribute__((ext_vector_type(4))); typedef int i32x8_ __attribute__((ext_vector_type(8))); \
            const i32x8_ b8_ = __builtin_shufflevector(__builtin_bit_cast(i32x4_, Bt[n][0]), __builtin_bit_cast(i32x4_, Bt[n][1]), 0, 1, 2, 3, 4, 5, 6, 7), a8_ = __builtin_shufflevector(__builtin_bit_cast(i32x4_, At[m][0]), __builtin_bit_cast(i32x4_, At[m][1]), 0, 1, 2, 3, 4, 5, 6, 7); \
            acc[ai][bj][m][n] = __builtin_amdgcn_mfma_scale_f32_16x16x128_f8f6f4(b8_, a8_, acc[ai][bj][m][n], 0, 0, 0, 0x7F7F7F7F, 0, 0x7F7F7F7F); } \
        else { _Pragma("unroll") for (int k = 0; k < 2; ++k) acc[ai][bj][m][n] = __builtin_amdgcn_mfma_f32_16x16x32_bf16(Bt[n][k], At[m][k], acc[ai][bj][m][n], 0, 0, 0); } } __builtin_amdgcn_s_setprio(0); } while (0)
#define PG8_WAIT_V(n) asm volatile("s_waitcnt vmcnt(" #n ")" ::: "memory")
#define PG8_WAIT_L(n) asm volatile("s_waitcnt lgkmcnt(" #n ")" ::: "memory")
#define PG8_BAR __builtin_amdgcn_s_barrier()
#define PG8_SCHED __builtin_amdgcn_sched_barrier(0)
    Unit cur, nxt; int ui = 0, ub = 0;
    if (!S.next(0, cur, 0, tid)) return;
    if constexpr (Sched::LIST) { asm volatile("s_waitcnt lgkmcnt(0)" ::: "memory"); __builtin_amdgcn_s_barrier(); asm volatile("" ::: "memory"); }
    unsigned voffA[2][2];
#pragma unroll
    for (int h = 0; h < 2; ++h)
#pragma unroll
        for (int i = 0; i < 2; ++i) voffA[h][i] = S.aoff(0, h * HALF + Rr[i], Cc[i]);
    f32x4 acc[2][2][4][2];
#pragma unroll
    for (int a = 0; a < 2; ++a)
#pragma unroll
        for (int b = 0; b < 2; ++b)
#pragma unroll
            for (int m = 0; m < 4; ++m)
#pragma unroll
                for (int n = 0; n < 2; ++n) acc[a][b][m][n] = (f32x4){0.f, 0.f, 0.f, 0.f};
    bf16x8 At[4][2], B0[2][2], B1[2][2];
    unsigned cA = cur.ao, cB = cur.bo;
    PG8_STAGE(PG8_SB(0, 0), Bbase, cB, voffB); PG8_STAGE(PG8_SB(0, 1), Bbase, cB + hstepB, voffB); PG8_STAGE(PG8_SA(0, 0), Abase, cA, voffA[0]); PG8_STAGE(PG8_SA(0, 1), Abase, cA, voffA[1]);
    if (wr == 1) PG8_BAR;
    PG8_WAIT_V(2); PG8_BAR;
    PG8_STAGE(PG8_SB(1, 0), Bbase, cB + kstep, voffB); PG8_STAGE(PG8_SA(1, 0), Abase, cA + kstep, voffA[0]); PG8_STAGE(PG8_SB(1, 1), Bbase, cB + hstepB + kstep, voffB);
    PG8_WAIT_V(6); PG8_BAR;
    for (;;) {
        const int nub = (ub == 2) ? 0 : ub + 1;
        const bool has_next = S.next(ui + 1, nxt, nub, tid);
        const unsigned nA = has_next ? nxt.ao : cA, nB = has_next ? nxt.bo : cB;
#pragma unroll 1
        for (int t = 0; t < nt; t += 2) {
            const bool last = (t == nt - 2);
            const unsigned a1 = cA + (unsigned)(t + 1) * kstep;
            const unsigned a2 = last ? nA : cA + (unsigned)(t + 2) * kstep, b2 = last ? nB : cB + (unsigned)(t + 2) * kstep;
            const unsigned a3 = a2 + kstep, b3 = b2 + kstep;
            PG8_LDB(B0, 0, 0); PG8_LDB(B1, 0, 1); PG8_SCHED; PG8_LDA(At, 0, 0); PG8_STAGE(PG8_SA(1, 1), Abase, a1, voffA[1]);
            if constexpr (Sched::GATHER) { if (last && has_next) {
#pragma unroll
                for (int h = 0; h < 2; ++h)
#pragma unroll
                    for (int i = 0; i < 2; ++i) voffA[h][i] = S.aoff(nub, h * HALF + Rr[i], Cc[i]); } }
            PG8_WAIT_V(8); PG8_WAIT_L(0); PG8_BAR; PG8_MMA(0, 0, At, B0); PG8_MMA(0, 1, At, B1); PG8_BAR; PG8_SCHED;
            PG8_LDA(At, 0, 1); PG8_STAGE(PG8_SB(0, 0), Bbase, b2, voffB); PG8_STAGE(PG8_SB(0, 1), Bbase, b2 + hstepB, voffB); PG8_STAGE(PG8_SA(0, 0), Abase, a2, voffA[0]);
            PG8_WAIT_V(8); PG8_WAIT_L(0); PG8_BAR; PG8_MMA(1, 0, At, B0); PG8_MMA(1, 1, At, B1); PG8_BAR; PG8_SCHED;
            PG8_LDB(B0, 1, 0); PG8_LDB(B1, 1, 1); PG8_SCHED; PG8_LDA(At, 1, 0); PG8_STAGE(PG8_SA(0, 1), Abase, a2, voffA[1]);
            PG8_WAIT_V(8); PG8_WAIT_L(0); PG8_BAR; PG8_MMA(0, 0, At, B0); PG8_MMA(0, 1, At, B1); PG8_BAR; PG8_SCHED;
            PG8_LDA(At, 1, 1); PG8_STAGE(PG8_SB(1, 0), Bbase, b3, voffB); PG8_STAGE(PG8_SB(1, 1), Bbase, b3 + hstepB, voffB); PG8_STAGE(PG8_SA(1, 0), Abase, a3, voffA[0]);
            PG8_WAIT_V(8); PG8_WAIT_L(0); PG8_BAR; PG8_MMA(1, 0, At, B0); PG8_MMA(1, 1, At, B1); PG8_BAR; PG8_SCHED;
        }
        if constexpr (ALIGN_EPI) { if (wr == 0) PG8_BAR; }
        E(acc, cur, wr, wc, fr, fq, tid, ub);
        if (!has_next) break;
#pragma unroll
        for (int a = 0; a < 2; ++a)
#pragma unroll
            for (int b = 0; b < 2; ++b)
#pragma unroll
                for (int m = 0; m < 4; ++m)
#pragma unroll
                    for (int n = 0; n < 2; ++n) acc[a][b][m][n] = (f32x4){0.f, 0.f, 0.f, 0.f};
        cur = nxt; cA = nA; cB = nB; ++ui; ub = nub;
        if constexpr (ALIGN_EPI) { if (wr == 1) PG8_BAR; }
    }
    PG8_WAIT_V(0);
    if constexpr (!ALIGN_EPI) { if (wr == 0) PG8_BAR; }
    PG8_BAR;
#undef PG8_SA
#undef PG8_SB
#undef PG8_STAGE
#undef PG8_LDA
#undef PG8_LDB
#undef PG8_MMA
#undef PG8_WAIT_V
#undef PG8_WAIT_L
#undef PG8_BAR
#undef PG8_SCHED
}

struct EpiZ {
    static constexpr bool PERM = true;
    unsigned char* ws; LAS unsigned char* lds;
    __device__ __forceinline__ void operator()(const f32x4 (&acc)[2][2][4][2], const Unit& u, int wr, int wc, int fr, int fq, int, int ub) const {
        const int row0 = u.pm * BM + wr * 64 + fr, col0 = u.pn * BM + wc * 32 + 8 * fq;
        bf16_t* z = (bf16_t*)(ws + WS_Z); const LAS float* rsb = (const LAS float*)(lds + UROW_OFF) + ub * 256 + wr * 64 + fr;
#pragma unroll
        for (int ai = 0; ai < 2; ++ai)
#pragma unroll
            for (int m = 0; m < 4; ++m) { const int row = row0 + ai * HALF + m * 16; const float rs = rsb[ai * HALF + m * 16]; bf16_t* rowp = z + (size_t)row * NIN + col0;
#pragma unroll
                for (int bj = 0; bj < 2; ++bj) if (col0 + bj * HALF < NIN) { const f32x4 v0 = acc[ai][bj][m][0] * rs, v1 = acc[ai][bj][m][1] * rs;
                    u32x4 w; w.x = cvt_pk_bf16(v0[0], v0[1]); w.y = cvt_pk_bf16(v0[2], v0[3]); w.z = cvt_pk_bf16(v1[0], v1[1]); w.w = cvt_pk_bf16(v1[2], v1[3]);
                    *(u32x4*)(rowp + bj * HALF) = w; } }
    }
};
__device__ __forceinline__ unsigned pk_fp8x4(float a, float b, float c, float d) { int r = __builtin_amdgcn_cvt_pk_fp8_f32(a, b, 0, false); r = __builtin_amdgcn_cvt_pk_fp8_f32(c, d, r, true); return (unsigned)r; }
template <bool LIST, bool STATS, size_t SS_OFF, bool H8OUT = false> struct EpiRes {
    static constexpr bool PERM = true;
    unsigned char* ws; LAS unsigned char* lds;
    __device__ __forceinline__ void operator()(const f32x4 (&acc)[2][2][4][2], const Unit& u, int wr, int wc, int fr, int fq, int tid, int ub) const {
        const int col0 = u.pn * BM + wc * 32 + 8 * fq;
        bf16_t* h = (bf16_t*)(ws + WS_H); float* ss = (float*)(ws + SS_OFF); LAS float* red = (LAS float*)(lds + RED_OFF); const LAS int* utok = (const LAS int*)(lds + UROW_OFF);
#pragma unroll
        for (int ai = 0; ai < 2; ++ai)
#pragma unroll
            for (int m = 0; m < 4; ++m) { const int rowl = ai * HALF + wr * 64 + m * 16 + fr; int row; bool valid = true;
                if constexpr (LIST) { row = utok[ub * 256 + rowl]; valid = row >= 0; } else row = u.pm * BM + rowl;
                float s = 0.f;
                if (valid) { bf16_t* hp = h + (size_t)row * D + col0;
#pragma unroll
                    for (int bj = 0; bj < 2; ++bj) { const u32x4 o = *(const u32x4*)(hp + bj * HALF); const f32x4 a0 = acc[ai][bj][m][0] * (LIST ? 0.0078125f : 1.f), a1 = acc[ai][bj][m][1] * (LIST ? 0.0078125f : 1.f);
                        const float v0 = bflo(o.x) + a0[0], v1 = bfhi(o.x) + a0[1], v2 = bflo(o.y) + a0[2], v3 = bfhi(o.y) + a0[3], v4 = bflo(o.z) + a1[0], v5 = bfhi(o.z) + a1[1], v6 = bflo(o.w) + a1[2], v7 = bfhi(o.w) + a1[3];
                        s += (v0 * v0 + v1 * v1) + (v2 * v2 + v3 * v3) + (v4 * v4 + v5 * v5) + (v6 * v6 + v7 * v7);
                        u32x4 w; w.x = cvt_pk_bf16(v0, v1); w.y = cvt_pk_bf16(v2, v3); w.z = cvt_pk_bf16(v4, v5); w.w = cvt_pk_bf16(v6, v7);
                        *(u32x4*)(hp + bj * HALF) = w;
                        if constexpr (H8OUT) { u32x2 q; q.x = pk_fp8x4(v0, v1, v2, v3); q.y = pk_fp8x4(v4, v5, v6, v7); *(u32x2*)(ws + WS_H8 + (size_t)row * D + col0 + bj * HALF) = q; } } }
                if constexpr (STATS) { s += __shfl_xor(s, 16); s += __shfl_xor(s, 32); if (fq == 0) red[rowl * 4 + wc] = s; }
                asm volatile("" ::: "memory"); }
        if constexpr (STATS) {
            asm volatile("s_waitcnt lgkmcnt(0)" ::: "memory"); __builtin_amdgcn_s_barrier(); asm volatile("" ::: "memory");
            if (tid < BM) { const f32x4 v = *(const LAS f32x4*)(red + tid * 4); int row; bool valid = true;
                if constexpr (LIST) { row = utok[ub * 256 + tid]; valid = row >= 0; } else row = u.pm * BM + tid;
                if (valid) ss[(size_t)row * 4 + u.pn] = (v.x + v.y) + (v.z + v.w); }
        }
    }
};
struct EpiUp {
    static constexpr bool PERM = false;
    unsigned char* ws; LAS unsigned char* lds;
    __device__ __forceinline__ void operator()(const f32x4 (&acc)[2][2][4][2], const Unit& u, int wr, int wc, int fr, int fq, int, int ub) const {
        const int col0 = u.pn * 128 + wc * 16 + 4 * fq;
        unsigned char* hid = ws + WS_HID; const LAS float* urs = (const LAS float*)(lds + UROW_OFF) + 768;
#pragma unroll
        for (int ai = 0; ai < 2; ++ai)
#pragma unroll
            for (int m = 0; m < 4; ++m) { const int rowl = ai * HALF + wr * 64 + m * 16 + fr;
                const float rs = urs[ub * 256 + rowl] * 0.0625f, gw = urs[768 + ub * 256 + rowl] * 16.f;
                unsigned char* hp = hid + ((size_t)u.pm * BM + rowl) * DE + col0;
#pragma unroll
                for (int bj = 0; bj < 2; ++bj) { const f32x4 g = acc[ai][bj][m][0] * rs, up = acc[ai][bj][m][1] * rs; float o[4];
#pragma unroll
                    for (int j = 0; j < 4; ++j) o[j] = g[j] * __builtin_amdgcn_rcpf(1.f + __builtin_amdgcn_exp2f(g[j] * -1.4426950408889634f)) * up[j] * gw;
                    *(unsigned*)(hp + bj * 64) = pk_fp8x4(o[0], o[1], o[2], o[3]); } }
    }
};
}

struct MoeTab { int cnt[64]; int rb0[65]; int pad[3]; unsigned short li[NBMAX]; unsigned short blk[NBMAX]; };
static_assert(sizeof(MoeTab) <= 4096, "MoeTab fits below RED_OFF");
__device__ __forceinline__ void moe_build_tab(LAS MoeTab* T, unsigned* gcnt) {
    const int tid = threadIdx.x;
    if (tid < 64) T->cnt[tid] = (int)__hip_atomic_load(gcnt + tid * 16, __ATOMIC_RELAXED, __HIP_MEMORY_SCOPE_AGENT);
    __syncthreads();
    if (tid == 0) { int run = 0; for (int i = 0; i < 64; ++i) { T->rb0[i] = run; run += (T->cnt[i] + 255) >> 8; } T->rb0[64] = run; }
    __syncthreads();
    if (tid < 64) { const int b0 = T->rb0[tid], nb = T->rb0[tid + 1] - b0;
#pragma clang loop vectorize(disable) unroll(disable)
        for (int b = 0; b < nb; ++b) { T->li[b0 + b] = (unsigned short)tid; T->blk[b0 + b] = (unsigned short)b; } }
    __syncthreads();
}
template <bool GATHER_, int NN, int LDA, int K, unsigned ESTEP> struct MoeOrder {
    static constexpr bool GATHER = GATHER_, LIST = true;
    LAS unsigned char* lds; unsigned char* ws; int rbLo, nwg, G, c;
    __device__ __forceinline__ bool next(int i, pg8::Unit& u, int ub, int tid) const {
        const int L = i * G + c; if (L >= nwg) return false;
        const LAS MoeTab* T = (const LAS MoeTab*)(lds + TAB_OFF); LAS int* urow = (LAS int*)(lds + UROW_OFF);
        const int wgid = pg8::xcd_remap(L, nwg), rb = rbLo + wgid / NN;
        const int li = T->li[rb], blk = T->blk[rb], cnt = T->cnt[li];
        u.pm = rb; u.pn = wgid % NN; u.ao = GATHER ? 0u : (unsigned)rb * (unsigned)(256 * LDA * 2); u.bo = (unsigned)(li & 31) * ESTEP + (unsigned)u.pn * (unsigned)(256 * K * 2);
        if (tid < 256) { const int slot = blk * 256 + tid; const bool valid = slot < cnt; const size_t idx = (size_t)li * CAPL + slot;
            urow[ub * 256 + tid] = valid ? ((const int*)(ws + WS_LTOK))[idx] : -1;
            if constexpr (GATHER) { ((LAS float*)urow)[768 + ub * 256 + tid] = valid ? ((const float*)(ws + WS_LRS))[idx] : 0.f; ((LAS float*)urow)[1536 + ub * 256 + tid] = valid ? ((const float*)(ws + WS_LW))[idx] : 0.f; } }
        return true;
    }
    __device__ __forceinline__ unsigned aoff(int ub, int rowl, int C) const {
        if constexpr (GATHER) { const int tok = ((const LAS int*)(lds + UROW_OFF))[ub * 256 + rowl]; return (unsigned)((tok < 0 ? 0 : tok) * LDA + C) * 2u; }
        else return (unsigned)(rowl * LDA + C) * 2u;
    }
};

__device__ __forceinline__ void route_phase(const P& p, int l, LAS unsigned char* lds, int G, int bid, unsigned* gcnt) {
    int tid_ = threadIdx.x; asm volatile("" : "+v"(tid_));
    const int tid = tid_, w = __builtin_amdgcn_readfirstlane(tid >> 6), lane = tid & 63, r = lane & 15, q = lane >> 4;
    const int per = (MP + G - 1) / G, r0 = bid * per, nrows = (r0 + per <= MP) ? per : (MP - r0 > 0 ? MP - r0 : 0);
    constexpr int WROW = 1040;
    LAS unsigned char* WHs = lds; LAS unsigned char* WLs = lds + 48 * WROW;
    LAS float* lg = (LAS float*)(lds + 2 * 48 * WROW);
    LAS int* lcnt = (LAS int*)(lds + TAB_OFF);
    LAS int* lbase = lcnt + 64;
    LAS int* rli = lbase + 64;
    LAS int* rpos = rli + 528;
    LAS float* rw = (LAS float*)(rpos + 528);
    LAS float* rrs = rw + 528;
    if (tid < 64) lcnt[tid] = 0;
    const bf16_t* WH = (const bf16_t*)(p.ws + WS_WRS) + (size_t)l * 48 * D; const bf16_t* WL = WH + (size_t)DEPTH * 48 * D;
    f32x4 acc[2][3]; float ssq[2] = {0.f, 0.f};
#pragma unroll
    for (int gi = 0; gi < 2; ++gi)
#pragma unroll
        for (int tl = 0; tl < 3; ++tl) acc[gi][tl] = (f32x4){0.f, 0.f, 0.f, 0.f};
#pragma unroll 1
    for (int half = 0; half < 2; ++half) {
        __syncthreads();
        for (int idx = tid; idx < 48 * 64; idx += NTHR) { const int row = idx >> 6, pc = idx & 63;
            *(LAS pg8::u32x4*)(WHs + row * WROW + pc * 16) = *(const pg8::u32x4*)(WH + (size_t)row * D + half * 512 + pc * 8);
            *(LAS pg8::u32x4*)(WLs + row * WROW + pc * 16) = *(const pg8::u32x4*)(WL + (size_t)row * D + half * 512 + pc * 8); }
        __syncthreads();
#pragma unroll
        for (int gi = 0; gi < 2; ++gi) { const int g = w + gi * NWAVES;
            if (g * 16 < nrows) { const bool ina = (g * 16 + r) < nrows; const bf16_t* ap = p.H() + (size_t)(ina ? r0 + g * 16 + r : 0) * D + half * 512 + q * 8;
                pg8::bf16x8 a[16];
#pragma unroll
                for (int ks = 0; ks < 16; ++ks) a[ks] = *(const pg8::bf16x8*)(ap + ks * 32);
#pragma unroll
                for (int ks = 0; ks < 16; ++ks) { const pg8::u32x4 w4 = __builtin_bit_cast(pg8::u32x4, a[ks]); const float x0 = pg8::bflo(w4.x), x1 = pg8::bfhi(w4.x), x2 = pg8::bflo(w4.y), x3 = pg8::bfhi(w4.y), x4 = pg8::bflo(w4.z), x5 = pg8::bfhi(w4.z), x6 = pg8::bflo(w4.w), x7 = pg8::bfhi(w4.w);
                    ssq[gi] += (x0 * x0 + x1 * x1) + (x2 * x2 + x3 * x3) + (x4 * x4 + x5 * x5) + (x6 * x6 + x7 * x7); }
#pragma unroll
                for (int ks = 0; ks < 16; ++ks)
#pragma unroll
                    for (int tl = 0; tl < 3; ++tl) { const int wo = (tl * 16 + r) * WROW + (ks * 32 + q * 8) * 2;
                        acc[gi][tl] = __builtin_amdgcn_mfma_f32_16x16x32_bf16(a[ks], *(const LAS pg8::bf16x8*)(WHs + wo), acc[gi][tl], 0, 0, 0);
                        acc[gi][tl] = __builtin_amdgcn_mfma_f32_16x16x32_bf16(a[ks], *(const LAS pg8::bf16x8*)(WLs + wo), acc[gi][tl], 0, 0, 0); } } }
    }
#pragma unroll
    for (int gi = 0; gi < 2; ++gi) { const int g = w + gi * NWAVES;
        if (g * 16 < nrows) {
            LAS float* lgw = lg + w * 16 * 48;
#pragma unroll
            for (int tl = 0; tl < 3; ++tl)
#pragma unroll
                for (int j = 0; j < 4; ++j) lgw[(q * 4 + j) * 48 + tl * 16 + r] = acc[gi][tl][j];
            asm volatile("s_waitcnt lgkmcnt(0)" ::: "memory");
            float rtot = ssq[gi]; rtot += __shfl_xor(rtot, 16); rtot += __shfl_xor(rtot, 32);
            if (lane < 16) { const int i = g * 16 + lane, rr = r0 + i;
                if (i < nrows) {
                    if (is_pad_row(rr)) { int neg = -1; asm volatile("" : "+v"(neg)); rli[2 * i] = neg; rli[2 * i + 1] = neg; }
                    else { const float rs = __builtin_amdgcn_rsqf(rtot * (1.f / D) + EPS); const LAS float* x = lgw + lane * 48; float gl[4];
#pragma unroll
                        for (int j = 0; j < 4; ++j) gl[j] = x[j] * rs + p.br_g[l * 4 + j];
                        int gsel = 0; float gm = gl[0];
#pragma unroll
                        for (int j = 1; j < 4; ++j) if (gl[j] > gm) { gm = gl[j]; gsel = j; }
                        float se = 0.f;
#pragma unroll
                        for (int j = 0; j < 4; ++j) se += __expf(gl[j] - gm);
                        const float psel = 1.f / se;
                        int i0 = 0, i1 = -1; float v0 = -INFINITY, v1 = -INFINITY;
                        for (int j = 0; j < 8; ++j) { const float v = x[4 + gsel * 8 + j] * rs + p.br_e[l * 32 + gsel * 8 + j];
                            if (v > v0) { v1 = v0; i1 = i0; v0 = v; i0 = j; } else if (v > v1) { v1 = v; i1 = j; } }
                        const float w0 = 1.f / (1.f + __expf(v1 - v0));
                        const int li0 = gsel * 8 + i0, li1 = 32 + gsel * 8 + i1;
                        rli[2 * i] = li0; rli[2 * i + 1] = li1; rw[2 * i] = w0 * psel; rw[2 * i + 1] = (1.f - w0) * psel; rrs[i] = rs;
                        rpos[2 * i] = __hip_atomic_fetch_add(&lcnt[li0], 1, __ATOMIC_RELAXED, __HIP_MEMORY_SCOPE_WORKGROUP); rpos[2 * i + 1] = __hip_atomic_fetch_add(&lcnt[li1], 1, __ATOMIC_RELAXED, __HIP_MEMORY_SCOPE_WORKGROUP); } } }
            asm volatile("s_waitcnt lgkmcnt(0)" ::: "memory"); } }
    __syncthreads();
    if (tid < 64) { const int n = lcnt[tid]; lbase[tid] = n ? (int)__hip_atomic_fetch_add(gcnt + tid * 16, (unsigned)n, __ATOMIC_RELAXED, __HIP_MEMORY_SCOPE_AGENT) : 0; }
    __syncthreads();
    int* ltok = (int*)(p.ws + WS_LTOK); float* lrs = (float*)(p.ws + WS_LRS); float* lw = (float*)(p.ws + WS_LW);
    for (int i = tid; i < 2 * nrows; i += NTHR) { const int li = rli[i]; if (li >= 0) { const size_t idx = (size_t)li * CAPL + lbase[li] + rpos[i]; ltok[idx] = r0 + (i >> 1); lrs[idx] = rrs[i >> 1]; lw[idx] = rw[i]; } }
    __syncthreads();
}

namespace mx {
#define LDS_BARRIER() do { asm volatile("s_waitcnt lgkmcnt(0)" ::: "memory"); __builtin_amdgcn_s_barrier(); asm volatile("" ::: "memory"); } while (0)
using pg8::bf16x8; using pg8::u32x4; using pg8::u32x2; using pg8::cvt_pk_bf16; using pg8::bflo; using pg8::bfhi;
__device__ __forceinline__ f32x4 mfma16(bf16x8 a, bf16x8 b, f32x4 c) { return __builtin_amdgcn_mfma_f32_16x16x32_bf16(a, b, c, 0, 0, 0); }
__device__ __forceinline__ float wscan_add(float v, int lane) {
#pragma unroll
    for (int o = 1; o < 64; o <<= 1) { const float t = __shfl_up(v, o); if (lane >= o) v += t; }
    return v; }
__device__ __forceinline__ float wscan_max(float v, int lane) {
#pragma unroll
    for (int o = 1; o < 64; o <<= 1) { const float t = __shfl_up(v, o); if (lane >= o) v = fmaxf(v, t); }
    return v; }
__device__ __forceinline__ float wave_max(float v) {
#pragma unroll
    for (int o = 1; o < 64; o <<= 1) v = fmaxf(v, __shfl_xor(v, o));
    return v; }
__device__ __forceinline__ void unpack8(const u32x4 a, float (&x)[8]) { x[0] = bflo(a.x); x[1] = bfhi(a.x); x[2] = bflo(a.y); x[3] = bfhi(a.y); x[4] = bflo(a.z); x[5] = bfhi(a.z); x[6] = bflo(a.w); x[7] = bfhi(a.w); }
__device__ __forceinline__ u32x4 pack8(const float (&x)[8]) { u32x4 w; w.x = cvt_pk_bf16(x[0], x[1]); w.y = cvt_pk_bf16(x[2], x[3]); w.z = cvt_pk_bf16(x[4], x[5]); w.w = cvt_pk_bf16(x[6], x[7]); return w; }
__device__ __forceinline__ bf16x8 ldfrag(const LAS unsigned char* p) { return *(const LAS bf16x8*)p; }
__device__ __forceinline__ float fexp(float x) { return __builtin_amdgcn_exp2f(x * 1.4426950408889634f); }
__device__ __forceinline__ float frcp(float x) { return __builtin_amdgcn_rcpf(x); }
__device__ __forceinline__ float fsigm(float x) { return frcp(1.f + fexp(-x)); }
__device__ __forceinline__ float fsilu(float x) { return x * fsigm(x); }
__device__ __forceinline__ float flogsig(float x) { return fminf(x, 0.f) - __builtin_amdgcn_logf(1.f + fexp(-fabsf(x))) * 0.6931471805599453f; }
__device__ __forceinline__ float frsq(float x) { return __builtin_amdgcn_rsqf(x); }
constexpr int SQ = 272, ST = 144;
__device__ __forceinline__ int tsw(int row, int s) { return row * ST + ((((s >> 3) ^ (row >> 3)) & 7) << 4) + ((s & 7) << 1); }
__device__ __forceinline__ int tfr(int row, int chunk) { return row * ST + (((chunk ^ (row >> 3)) & 7) << 4); }

struct UC { int c, hd, b, r0; };
__device__ __forceinline__ UC ucoord(int u) { UC k; k.c = u % NCH; k.hd = (u / NCH) & 3; k.b = u / (NCH * 4); k.r0 = chunk_row0(k.b, k.c); return k; }
template <int NS> struct PreM { u32x4 x[NS + 3]; u32x4 v[2]; pg8::f32x2_ g; };
struct PreO { u32x4 qk[4]; u32x4 v[2]; f32x4 g; pg8::f32x2_ n; };
struct PreG { u32x4 v[2]; u32x4 q, k; f32x4 ca; pg8::f32x2_ ab; };
template <int NS> __device__ __forceinline__ void load_m(const P& p, int u, PreM<NS>& R, int tid, int zvcol) {
    asm volatile("" : "+v"(tid));
    const UC k = ucoord(u); const bf16_t* z = p.Z(); const int lane = tid & 63, w = tid >> 6;
    { const size_t zr = (size_t)(k.r0 + lane) * NIN; pg8::f32x2_ g = {0.f, 0.f}; if (w == 0) { g.x = bf2f(z[zr + ZO_FG + k.hd]); g.y = bf2f(z[zr + ZO_IG + k.hd]); } R.g = g; }
    int zcol, s0;
    if (NS == 4) { const int which = tid >> 8; zcol = (which ? ZO_KM : ZO_QM) + k.hd * 128 + (tid & 15) * 8; s0 = ((tid >> 4) & 15) * 4; }
    else { zcol = ZO_KM + k.hd * 128 + (tid & 15) * 8; s0 = (tid >> 4) * 2; }
#pragma unroll
    for (int i = 0; i < NS + 3; ++i) { const int s = s0 - 3 + i, pp = k.c * 64 + s;
        const int row = (s < 0 && k.c == 1) ? XR + k.b * 64 + 64 + s : k.r0 + (pp >= 0 ? s : 0);
        const u32x4 v = *(const u32x4*)(z + (size_t)row * NIN + zcol); const unsigned m = pp >= 0 ? 0xffffffffu : 0u; R.x[i] = (u32x4){v.x & m, v.y & m, v.z & m, v.w & m}; }
#pragma unroll
    for (int it = 0; it < 2; ++it) { const int s = 2 * (tid >> 4) + it, v8 = tid & 15; R.v[it] = *(const u32x4*)(z + (size_t)(k.r0 + s) * NIN + zvcol + k.hd * 128 + v8 * 8); }
}
__device__ __forceinline__ void load_o(const P& p, int u, PreO& R, int tid) {
    asm volatile("" : "+v"(tid));
    const UC k = ucoord(u); const bf16_t* z = p.Z(); const bf16_t* qkc = (const bf16_t*)(p.ws + WS_QKC);
#pragma unroll
    for (int it = 0; it < 4; ++it) { const int item = tid + it * NTHR, which = item >> 10, s = (item >> 4) & 63, ch8 = item & 15; R.qk[it] = *(const u32x4*)(qkc + (size_t)(k.r0 + s) * 1024 + which * 512 + k.hd * 128 + ch8 * 8); }
#pragma unroll
    for (int it = 0; it < 2; ++it) { const int s = 2 * (tid >> 4) + it, v8 = tid & 15; R.v[it] = *(const u32x4*)(z + (size_t)(k.r0 + s) * NIN + ZO_VM + k.hd * 128 + v8 * 8); }
    { f32x4 g = {0.f, 0.f, 0.f, 0.f}; if (tid < 64) { const float* ga = (const float*)((const unsigned char*)p.out + ST_GA) + (size_t)u * 192; g.x = ga[tid]; g.y = ga[64 + tid]; g.z = ga[128 + tid]; g.w = p.MSC()[(size_t)u * 4 + 2]; } R.g = g;
      pg8::f32x2_ n = {0.f, 0.f}; if (tid < 128) n.x = p.MN()[(size_t)u * 128 + tid]; R.n = n; }
}
__device__ __forceinline__ void load_g(const P& p, int l, int u, PreG& R, int tid, bool needq) {
    asm volatile("" : "+v"(tid));
    const UC k = ucoord(u); const bf16_t* z = p.Z();
#pragma unroll
    for (int it = 0; it < 2; ++it) { const int s = 2 * (tid >> 4) + it, v8 = tid & 15; R.v[it] = *(const u32x4*)(z + (size_t)(k.r0 + s) * NIN + ZO_VG + k.hd * 128 + v8 * 8); }
    const size_t zr = (size_t)(k.r0 + (tid >> 3)) * NIN; R.k = *(const u32x4*)(z + zr + ZO_KG + k.hd * 64 + (tid & 7) * 8); R.q = R.k;
    if (needq) R.q = *(const u32x4*)(z + zr + ZO_QG + k.hd * 64 + (tid & 7) * 8);
    { const int i0 = tid, i1 = tid + NTHR; f32x4 ca;
        ca.x = bf2f(z[(size_t)(k.r0 + (i0 >> 4)) * NIN + ZO_CODE + (i0 & 15)]); ca.y = bf2f(z[(size_t)(k.r0 + (i1 >> 4)) * NIN + ZO_CODE + (i1 & 15)]);
        ca.z = p.a_w2[(l * 16 + (i0 >> 6)) * 256 + k.hd * 64 + (i0 & 63)]; ca.w = p.a_w2[(l * 16 + (i1 >> 6)) * 256 + k.hd * 64 + (i1 & 63)]; R.ca = ca;
      pg8::f32x2_ ab = {0.f, 0.f}; if (tid < 64) ab.x = p.a_b[l * 256 + k.hd * 64 + tid]; R.ab = ab; }
}
template <int NS> __device__ __forceinline__ void conv8(const P& p, int l, const u32x4 (&xr)[NS + 3], int c, int s0, int cch, float scale, float (&o)[NS][8]) {
    float x[NS + 3][8];
#pragma unroll
    for (int i = 0; i < NS + 3; ++i) unpack8(xr[i], x[i]);
    float bias[8];
    { const f32x4 b0 = *(const f32x4*)(p.conv_b + l * D + cch), b1 = *(const f32x4*)(p.conv_b + l * D + cch + 4); bias[0] = b0.x; bias[1] = b0.y; bias[2] = b0.z; bias[3] = b0.w; bias[4] = b1.x; bias[5] = b1.y; bias[6] = b1.z; bias[7] = b1.w; }
#pragma unroll
    for (int i = 0; i < NS; ++i)
#pragma unroll
        for (int q = 0; q < 8; ++q) o[i][q] = bias[q];
#pragma unroll
    for (int j = 0; j < 4; ++j) { float w[8];
        { const f32x4 w0 = *(const f32x4*)(p.conv_w + (l * 4 + j) * D + cch), w1 = *(const f32x4*)(p.conv_w + (l * 4 + j) * D + cch + 4); w[0] = w0.x; w[1] = w0.y; w[2] = w0.z; w[3] = w0.w; w[4] = w1.x; w[5] = w1.y; w[6] = w1.z; w[7] = w1.w; }
#pragma unroll
        for (int i = 0; i < NS; ++i)
#pragma unroll
            for (int q = 0; q < 8; ++q) o[i][q] += w[q] * x[i + j][q]; }
#pragma unroll
    for (int i = 0; i < NS; ++i) { const bool valid = (c > 0) || (s0 + i >= LEAD);
#pragma unroll
        for (int q = 0; q < 8; ++q) o[i][q] = valid ? fsilu(o[i][q]) * scale : 0.f; }
}

__device__ __forceinline__ void gla_cumdecay(const P& p, int l, int hd, const PreG& R, int c, LAS float* LA, LAS float* segtot, LAS float* cod, LAS float* aw, LAS float* ab, int tid) {
    cod[tid] = R.ca.x; cod[tid + NTHR] = R.ca.y; aw[tid] = R.ca.z; aw[tid + NTHR] = R.ca.w;
    if (tid < 64) ab[tid] = p.a_b[l * 256 + hd * 64 + tid];
    LDS_BARRIER();
    const int j = tid & 63, seg = tid >> 6; float run = 0.f, v[8];
#pragma unroll
    for (int i = 0; i < 8; ++i) { const int s = seg * 8 + i; const bool valid = (c > 0) || (s >= LEAD); float a = ab[j];
#pragma unroll
        for (int q = 0; q < 16; ++q) a += cod[s * 16 + q] * aw[q * 64 + j];
        run += valid ? flogsig(a) * (1.f / 16.f) : 0.f; v[i] = run; }
    segtot[seg * 64 + j] = run;
    LDS_BARRIER();
    float pre = 0.f;
#pragma unroll
    for (int g = 0; g < 8; ++g) pre += (g < seg) ? segtot[g * 64 + j] : 0.f;
#pragma unroll
    for (int i = 0; i < 8; ++i) LA[(seg * 8 + i) * 65 + j] = v[i] + pre;
    LDS_BARRIER();
}
__device__ __forceinline__ void mlstm_local(const P& p, int l, int u, LAS unsigned char* lds, int tid, PreM<4>& R, int unext) {
    asm volatile("" : "+v"(tid));
    const int lane = tid & 63, w = __builtin_amdgcn_readfirstlane(tid >> 6), c = u % NCH, hd = (u / NCH) & 3, b = u / (NCH * 4), r0 = chunk_row0(b, c);
    LAS unsigned char* KT = lds; LAS unsigned char* VT = lds + 18432; LAS float* wS = (LAS float*)(lds + 39168);
    if (w == 0) { const int s = lane; const bool valid = (c > 0) || (s >= LEAD);
        const float lf = valid ? flogsig(R.g.x + p.gate_b[(l * 2 + 1) * 4 + hd]) : 0.f;
        const float ig = valid ? R.g.y + p.gate_b[(l * 2 + 0) * 4 + hd] : -INFINITY;
        const float bb = wscan_add(lf, lane), be = __shfl(bb, 63), g = be - bb + ig, mg = wave_max(g), a = ig - bb, pm = wscan_max(a, lane);
        wS[s] = fexp(g - mg);
        float* ga = (float*)((unsigned char*)p.out + ST_GA) + (size_t)u * 192; ga[s] = bb; ga[64 + s] = a; ga[128 + s] = pm;
        if (lane == 0) { float* sc = p.MSC() + (size_t)u * 4; sc[0] = mg; sc[1] = be; } }
    { const int which = tid >> 8, ch8 = tid & 15, s0 = ((tid >> 4) & 15) * 4; float o[4][8];
        conv8<4>(p, l, R.x, c, s0, which * 512 + hd * 128 + ch8 * 8, which ? 0.08838834764831845f : 1.f, o);
        bf16_t* qkc = (bf16_t*)(p.ws + WS_QKC) + (size_t)(r0 + s0) * 1024 + which * 512 + hd * 128 + ch8 * 8;
#pragma unroll
        for (int i = 0; i < 4; ++i) *(u32x4*)(qkc + (size_t)i * 1024) = pack8(o[i]);
        if (which) {
#pragma unroll
            for (int q = 0; q < 8; ++q) { *(LAS unsigned*)(KT + tsw(ch8 * 8 + q, s0)) = cvt_pk_bf16(o[0][q], o[1][q]); *(LAS unsigned*)(KT + tsw(ch8 * 8 + q, s0 + 2)) = cvt_pk_bf16(o[2][q], o[3][q]); } } }
    LDS_BARRIER();
    { const int s0 = 2 * (tid >> 4), v8 = tid & 15; float x0[8], x1[8]; unpack8(R.v[0], x0); unpack8(R.v[1], x1);
        const float w0 = ((c > 0) || (s0 >= LEAD)) ? wS[s0] : 0.f, w1 = ((c > 0) || (s0 + 1 >= LEAD)) ? wS[s0 + 1] : 0.f;
#pragma unroll
        for (int q = 0; q < 8; ++q) *(LAS unsigned*)(VT + tsw(v8 * 8 + q, s0)) = cvt_pk_bf16(x0[q] * w0, x1[q] * w1); }
    for (int i = tid; i < 16 * 64; i += NTHR) { const int row = 128 + (i >> 6), s = i & 63; *(LAS bf16_t*)(VT + tsw(row, s)) = (row == 128) ? (bf16_t)(cvt_pk_bf16(wS[s], 0.f) & 0xffffu) : (bf16_t)0; }
    if (unext >= 0) load_m<4>(p, unext, R, tid, ZO_VM);
    LDS_BARRIER();
    { const int r = lane & 15, q = lane >> 4; bf16x8 afr[2];
#pragma unroll
        for (int ks = 0; ks < 2; ++ks) afr[ks] = ldfrag(KT + tfr(w * 16 + r, ks * 4 + q));
        bf16_t* Cd = p.MC() + (size_t)u * 16384;
#pragma unroll
        for (int vt = 0; vt < 9; ++vt) { f32x4 acc = {0.f, 0.f, 0.f, 0.f};
#pragma unroll
            for (int ks = 0; ks < 2; ++ks) acc = mfma16(afr[ks], ldfrag(VT + tfr(vt * 16 + r, ks * 4 + q)), acc);
            if (vt < 8) { u32x2 o; o.x = cvt_pk_bf16(acc[0], acc[1]); o.y = cvt_pk_bf16(acc[2], acc[3]); *(u32x2*)(Cd + (vt * 16 + r) * 128 + w * 16 + q * 4) = o; }
            else if (r == 0) *(f32x4*)(p.MN() + (size_t)u * 128 + w * 16 + q * 4) = acc; } }
    LDS_BARRIER();
}

__device__ __forceinline__ void gla_local(const P& p, int l, int u, LAS unsigned char* lds, int tid, PreG& R, int unext) {
    asm volatile("" : "+v"(tid));
    const int lane = tid & 63, w = __builtin_amdgcn_readfirstlane(tid >> 6), c = u % NCH, hd = (u / NCH) & 3, b = u / (NCH * 4), r0 = chunk_row0(b, c);
    const bf16_t* z = p.Z();
    LAS float* LA = (LAS float*)lds; LAS float* segtot = (LAS float*)(lds + 16640); LAS unsigned char* KHT = lds + 18688; LAS unsigned char* VT = lds + 27904;
    LAS float* cod = (LAS float*)(lds + 46336); LAS float* aw = (LAS float*)(lds + 50432); LAS float* ab = (LAS float*)(lds + 54528);
    gla_cumdecay(p, l, hd, R, c, LA, segtot, cod, aw, ab, tid);
    if (tid < 64) p.GB()[(size_t)u * 64 + tid] = LA[63 * 65 + tid];
    { const int s = tid >> 3, j8 = tid & 7; const bool valid = (c > 0) || (s >= LEAD); float x[8];
        unpack8(R.k, x);
#pragma unroll
        for (int q = 0; q < 8; ++q) { const int j = j8 * 8 + q; *(LAS bf16_t*)(KHT + tsw(j, s)) = (bf16_t)(cvt_pk_bf16(valid ? x[q] * fexp(LA[63 * 65 + j] - LA[s * 65 + j]) : 0.f, 0.f) & 0xffffu); } }
    { const int s0 = 2 * (tid >> 4), v8 = tid & 15; float x0[8], x1[8]; unpack8(R.v[0], x0); unpack8(R.v[1], x1);
        const float w0 = ((c > 0) || (s0 >= LEAD)) ? 1.f : 0.f, w1 = ((c > 0) || (s0 + 1 >= LEAD)) ? 1.f : 0.f;
#pragma unroll
        for (int q = 0; q < 8; ++q) *(LAS unsigned*)(VT + tsw(v8 * 8 + q, s0)) = cvt_pk_bf16(x0[q] * w0, x1[q] * w1); }
    if (unext >= 0) load_g(p, l, unext, R, tid, false);
    LDS_BARRIER();
    { const int r = lane & 15, q = lane >> 4; bf16x8 bfr[2];
#pragma unroll
        for (int ks = 0; ks < 2; ++ks) bfr[ks] = ldfrag(VT + tfr(w * 16 + r, ks * 4 + q));
        bf16_t* Sd = p.GS() + (size_t)u * 8192;
#pragma unroll
        for (int jt = 0; jt < 4; ++jt) { f32x4 acc = {0.f, 0.f, 0.f, 0.f};
#pragma unroll
            for (int ks = 0; ks < 2; ++ks) acc = mfma16(ldfrag(KHT + tfr(jt * 16 + r, ks * 4 + q)), bfr[ks], acc);
            u32x2 o; o.x = cvt_pk_bf16(acc[0], acc[1]); o.y = cvt_pk_bf16(acc[2], acc[3]); *(u32x2*)(Sd + (w * 16 + r) * 64 + jt * 16 + q * 4) = o; } }
    LDS_BARRIER();
}

template <class LD, class FOLD> __device__ __forceinline__ void scan_stream(LD ld, FOLD fold) {
    u32x2 cur[16], nxt[16];
#pragma unroll
    for (int i = 0; i < 16; ++i) cur[i] = ld(i);
#pragma unroll 1
    for (int c0 = 0; c0 < 128; c0 += 16) {
#pragma unroll
        for (int i = 0; i < 16; ++i) nxt[i] = ld(c0 + 16 + i < NCH ? c0 + 16 + i : NCH - 1);
#pragma unroll
        for (int i = 0; i < 16; ++i) fold(c0 + i, cur[i]);
#pragma unroll
        for (int i = 0; i < 16; ++i) cur[i] = nxt[i];
    }
    fold(128, cur[0]);
}
__device__ __forceinline__ void scan_phase(const P& p, LAS unsigned char* lds, int G, int bid, int tid) {
    asm volatile("" : "+v"(tid));
    LAS float* dec = (LAS float*)lds; LAS float* wgt = dec + 132;
    for (int item = bid; item < 16 * 13; item += G) { const int bh = item / 13, sl = item % 13;
        __syncthreads();
        if (sl < 9 && tid < 64) {
            const int lane = tid; float* sc = p.MSC() + (size_t)bh * NCH * 4; const int c0 = 2 * lane, c1 = c0 + 1;
            const float a0 = sc[c0 * 4 + 1], b0 = sc[c0 * 4], a1 = sc[c1 * 4 + 1], b1 = sc[c1 * 4];
            float A = a0 + a1, Bv = fmaxf(b0 + a1, b1);
#pragma unroll
            for (int o = 1; o < 64; o <<= 1) { const float At = __shfl_up(A, o), Bt = __shfl_up(Bv, o); if (lane >= o) { Bv = fmaxf(Bt + A, Bv); A = At + A; } }
            float EA = __shfl_up(A, 1), EB = __shfl_up(Bv, 1); if (lane == 0) { EA = 0.f; EB = -INFINITY; }
            const float mp = fmaxf(EA, EB), m0 = fmaxf(mp + a0, b0), m1 = fmaxf(m0 + a1, b1);
            dec[c0] = fexp(a0 + mp - m0); wgt[c0] = fexp(b0 - m0); dec[c1] = fexp(a1 + m0 - m1); wgt[c1] = fexp(b1 - m1);
            if (sl == 0) { sc[c0 * 4 + 2] = mp; sc[c1 * 4 + 2] = m0; }
            if (lane == 63) { const float a2 = sc[128 * 4 + 1], b2 = sc[128 * 4], m2 = fmaxf(m1 + a2, b2); dec[128] = fexp(a2 + m1 - m2); wgt[128] = fexp(b2 - m2); if (sl == 0) sc[128 * 4 + 2] = m1; } }
        __syncthreads();
        if (sl < 8) { float C0 = 0.f, C1 = 0.f, C2 = 0.f, C3 = 0.f; u32x2* q = (u32x2*)(p.MC() + (size_t)bh * NCH * 16384 + sl * 2048 + tid * 4);
            scan_stream([&](int c) { return q[(size_t)c * 4096]; },
                        [&](int c, u32x2 dl) { u32x2 o; o.x = cvt_pk_bf16(C0, C1); o.y = cvt_pk_bf16(C2, C3); q[(size_t)c * 4096] = o; const float d = dec[c], g = wgt[c];
                            C0 = d * C0 + g * bflo(dl.x); C1 = d * C1 + g * bfhi(dl.x); C2 = d * C2 + g * bflo(dl.y); C3 = d * C3 + g * bfhi(dl.y); }); }
        else if (sl == 8) { if (tid < 128) { float C = 0.f; float* q = p.MN() + (size_t)bh * NCH * 128 + tid;
#pragma unroll 16
            for (int c = 0; c < NCH; ++c) { const float dl = q[(size_t)c * 128]; q[(size_t)c * 128] = C; C = dec[c] * C + wgt[c] * dl; } } }
        else { const int e = (sl - 9) * 2048 + tid * 4, j = e & 63; float S0 = 0.f, S1 = 0.f, S2 = 0.f, S3 = 0.f; u32x2* q = (u32x2*)(p.GS() + (size_t)bh * NCH * 8192 + e); const f32x4* gb = (const f32x4*)(p.GB() + (size_t)bh * NCH * 64 + j);
            scan_stream([&](int c) { return q[(size_t)c * 2048]; },
                        [&](int c, u32x2 dl) { const f32x4 bv = gb[(size_t)c * 16]; u32x2 o; o.x = cvt_pk_bf16(S0, S1); o.y = cvt_pk_bf16(S2, S3); q[(size_t)c * 2048] = o;
                            S0 = S0 * fexp(bv.x) + bflo(dl.x); S1 = S1 * fexp(bv.y) + bfhi(dl.x); S2 = S2 * fexp(bv.z) + bflo(dl.y); S3 = S3 * fexp(bv.w) + bfhi(dl.y); }); }
    }
    __syncthreads();
}

__device__ __forceinline__ void mlstm_out(const P& p, int l, int u, LAS unsigned char* lds, int tid, PreO& R, int unext) {
    asm volatile("" : "+v"(tid));
    const int lane = tid & 63, w = __builtin_amdgcn_readfirstlane(tid >> 6), c = u % NCH, hd = (u / NCH) & 3, b = u / (NCH * 4), r0 = chunk_row0(b, c);
    const bf16_t* z = p.Z();
    LAS unsigned char* QS = lds; LAS unsigned char* KS = lds + 17408; LAS unsigned char* VT = lds + 34816; LAS unsigned char* SS = lds + 55552;
    LAS float* aS = (LAS float*)(lds + 64768); LAS float* MS = aS + 64; LAS float* wiS = MS + 64; LAS float* emtS = wiS + 64; LAS float* denS = emtS + 64; LAS float* part = denS + 64; LAS float* nS = part + 128;
    const int r = lane & 15, q = lane >> 4, tt = w & 3, vh = w >> 2, t = tt * 16 + r;
    const int nvt = vh ? 4 : 5;
    bf16x8 cfr[4][4];
    { const bf16_t* Cg = p.MC() + (size_t)u * 16384;
#pragma unroll
        for (int i = 0; i < 4; ++i)
#pragma unroll
            for (int ks = 0; ks < 4; ++ks) cfr[i][ks] = *(const bf16x8*)(Cg + ((vh * 4 + i) * 16 + r) * 128 + ks * 32 + q * 8); }
    if (tid < 128) nS[tid] = R.n.x;
    if (w == 0) { const int s = lane; const float bb = R.g.x, aa = R.g.y, pm = R.g.z, m0 = R.g.w, M = fmaxf(m0, pm);
        aS[s] = aa; MS[s] = M; wiS[s] = fexp(m0 - M); emtS[s] = fexp(-(bb + M)); }
#pragma unroll
    for (int it = 0; it < 4; ++it) { const int item = tid + it * NTHR, which = item >> 10, s = (item >> 4) & 63, ch8 = item & 15; *(LAS u32x4*)((which ? KS : QS) + s * SQ + ch8 * 16) = R.qk[it]; }
    { const int s0 = 2 * (tid >> 4), v8 = tid & 15; float x0[8], x1[8]; unpack8(R.v[0], x0); unpack8(R.v[1], x1);
        const float w0 = ((c > 0) || (s0 >= LEAD)) ? 1.f : 0.f, w1 = ((c > 0) || (s0 + 1 >= LEAD)) ? 1.f : 0.f;
#pragma unroll
        for (int q = 0; q < 8; ++q) *(LAS unsigned*)(VT + tsw(v8 * 8 + q, s0)) = cvt_pk_bf16(x0[q] * w0, x1[q] * w1); }
    for (int i = tid; i < 16 * 64; i += NTHR) { const int row = 128 + (i >> 6), s = i & 63; *(LAS bf16_t*)(VT + tsw(row, s)) = (row == 128) ? (bf16_t)0x3f80 : (bf16_t)0; }
    if (unext >= 0) load_o(p, unext, R, tid);
    LDS_BARRIER();
    f32x4 acc2[5];
    { bf16x8 qb[4];
#pragma unroll
        for (int ks = 0; ks < 4; ++ks) qb[ks] = ldfrag(QS + (tt * 16 + r) * SQ + (ks * 32 + q * 8) * 2);
#pragma unroll
        for (int i = 0; i < 5; ++i) { acc2[i] = (f32x4){0.f, 0.f, 0.f, 0.f}; if (i < nvt) {
#pragma unroll
            for (int ks = 0; ks < 4; ++ks) { bf16x8 afr;
                if (i < 4) afr = cfr[i][ks];
                else { const f32x4 n0 = *(const LAS f32x4*)(nS + ks * 32 + q * 8), n1 = *(const LAS f32x4*)(nS + ks * 32 + q * 8 + 4); const float mk = (r == 0) ? 1.f : 0.f;
                    const float nn[8] = {n0.x * mk, n0.y * mk, n0.z * mk, n0.w * mk, n1.x * mk, n1.y * mk, n1.z * mk, n1.w * mk};
                    afr = __builtin_bit_cast(bf16x8, pack8(nn)); }
                acc2[i] = mfma16(afr, qb[ks], acc2[i]); } } }
        const float Mt = MS[t];
#pragma unroll
        for (int cc = 0; cc < 2; ++cc) { const int st = vh * 2 + cc; f32x4 acc = {0.f, 0.f, 0.f, 0.f};
            if (st <= tt) {
#pragma unroll
                for (int ks = 0; ks < 4; ++ks) acc = mfma16(ldfrag(KS + (st * 16 + r) * SQ + (ks * 32 + q * 8) * 2), qb[ks], acc); }
            float sv[4];
#pragma unroll
            for (int j = 0; j < 4; ++j) { const int s = st * 16 + q * 4 + j; sv[j] = (s <= t) ? acc[j] * fexp(aS[s] - Mt) : 0.f; }
            u32x2 o; o.x = cvt_pk_bf16(sv[0], sv[1]); o.y = cvt_pk_bf16(sv[2], sv[3]); *(LAS u32x2*)(SS + t * ST + (st * 16 + q * 4) * 2) = o; } }
    LDS_BARRIER();
    f32x4 hv[5];
    { bf16x8 sb[2];
#pragma unroll
        for (int ks = 0; ks < 2; ++ks) sb[ks] = ldfrag(SS + (tt * 16 + r) * ST + (ks * 32 + q * 8) * 2);
        const float wi = wiS[t];
#pragma unroll
        for (int i = 0; i < 5; ++i) { if (i < nvt) { const int vt = (i < 4) ? vh * 4 + i : 8; f32x4 a1 = {0.f, 0.f, 0.f, 0.f};
#pragma unroll
            for (int ks = 0; ks < 2; ++ks) a1 = mfma16(ldfrag(VT + tfr(vt * 16 + r, ks * 4 + q)), sb[ks], a1);
            hv[i] = a1 + acc2[i] * wi; } }
        if (vh == 0 && q == 0) denS[t] = hv[4][0]; }
    u32x2 og[4]; f32x4 gn[4];
#pragma unroll
    for (int i = 0; i < 4; ++i) { const int v0 = (vh * 4 + i) * 16 + q * 4; og[i] = *(const u32x2*)(z + (size_t)(r0 + t) * NIN + ZO_OM + hd * 128 + v0); gn[i] = *(const f32x4*)(p.m_norm_g + l * 512 + hd * 128 + v0); }
    LDS_BARRIER();
    { const float dn = frcp(fmaxf(fabsf(denS[t]), emtS[t])); float ssq = 0.f;
#pragma unroll
        for (int i = 0; i < 4; ++i) { hv[i] = hv[i] * dn; ssq += hv[i][0] * hv[i][0] + hv[i][1] * hv[i][1] + hv[i][2] * hv[i][2] + hv[i][3] * hv[i][3]; }
        ssq += __shfl_xor(ssq, 16); ssq += __shfl_xor(ssq, 32); if (q == 0) part[t * 2 + vh] = ssq; }
    LDS_BARRIER();
    { const bool valid = (c > 0) || (t >= LEAD); const float sc = frsq((part[t * 2] + part[t * 2 + 1]) * (1.f / 128.f) + EPS); bf16_t* yp = p.Z() + (size_t)(r0 + t) * NIN + ZO_OM + hd * 128;
#pragma unroll
        for (int i = 0; i < 4; ++i) { const int v0 = (vh * 4 + i) * 16 + q * 4; float y[4];
            y[0] = hv[i][0] * sc * gn[i][0] * fsigm(bflo(og[i].x)); y[1] = hv[i][1] * sc * gn[i][1] * fsigm(bfhi(og[i].x)); y[2] = hv[i][2] * sc * gn[i][2] * fsigm(bflo(og[i].y)); y[3] = hv[i][3] * sc * gn[i][3] * fsigm(bfhi(og[i].y));
            u32x2 o; o.x = valid ? cvt_pk_bf16(y[0], y[1]) : 0u; o.y = valid ? cvt_pk_bf16(y[2], y[3]) : 0u; *(u32x2*)(yp + v0) = o; } }
    LDS_BARRIER();
}

__device__ __forceinline__ void gla_out(const P& p, int l, int u, LAS unsigned char* lds, int tid, PreG& R, int unext) {
    asm volatile("" : "+v"(tid));
    const int lane = tid & 63, w = __builtin_amdgcn_readfirstlane(tid >> 6), c = u % NCH, hd = (u / NCH) & 3, b = u / (NCH * 4), r0 = chunk_row0(b, c);
    const bf16_t* z = p.Z();
    LAS float* LA = (LAS float*)lds; LAS float* segtot = (LAS float*)(lds + 16640); LAS unsigned char* QT = lds + 18688; LAS unsigned char* KT2 = lds + 27904; LAS unsigned char* VT = lds + 37120; LAS unsigned char* AS = lds + 55552;
    LAS float* cod = (LAS float*)(lds + 64768); LAS float* aw = (LAS float*)(lds + 68864); LAS float* ab = (LAS float*)(lds + 72960); LAS float* part = (LAS float*)(lds + 73216);
    const int r = lane & 15, q = lane >> 4, tt = w & 3, dh = w >> 2, t = tt * 16 + r;
    bf16x8 sfr[4][2];
    { const bf16_t* Sg = p.GS() + (size_t)u * 8192;
#pragma unroll
        for (int i = 0; i < 4; ++i)
#pragma unroll
            for (int ks = 0; ks < 2; ++ks) sfr[i][ks] = *(const bf16x8*)(Sg + ((dh * 4 + i) * 16 + r) * 64 + ks * 32 + q * 8); }
    gla_cumdecay(p, l, hd, R, c, LA, segtot, cod, aw, ab, tid);
    { const int s = tid >> 3, j8 = tid & 7; const bool valid = (c > 0) || (s >= LEAD); float xq[8], xk[8];
        unpack8(R.q, xq); unpack8(R.k, xk);
#pragma unroll
        for (int q = 0; q < 8; ++q) { const float bb = LA[s * 65 + j8 * 8 + q]; xq[q] = valid ? xq[q] * 0.125f * fexp(bb) : 0.f; xk[q] = valid ? xk[q] * fexp(-bb) : 0.f; }
        *(LAS u32x4*)(QT + s * ST + j8 * 16) = pack8(xq); *(LAS u32x4*)(KT2 + s * ST + j8 * 16) = pack8(xk); }
    { const int s0 = 2 * (tid >> 4), v8 = tid & 15; float x0[8], x1[8]; unpack8(R.v[0], x0); unpack8(R.v[1], x1);
        const float w0 = ((c > 0) || (s0 >= LEAD)) ? 1.f : 0.f, w1 = ((c > 0) || (s0 + 1 >= LEAD)) ? 1.f : 0.f;
#pragma unroll
        for (int q = 0; q < 8; ++q) *(LAS unsigned*)(VT + tsw(v8 * 8 + q, s0)) = cvt_pk_bf16(x0[q] * w0, x1[q] * w1); }
    if (unext >= 0) load_g(p, l, unext, R, tid, true);
    LDS_BARRIER();
    f32x4 hv[4];
    { bf16x8 qb[2];
#pragma unroll
        for (int ks = 0; ks < 2; ++ks) qb[ks] = ldfrag(QT + (tt * 16 + r) * ST + (ks * 32 + q * 8) * 2);
#pragma unroll
        for (int i = 0; i < 4; ++i) { hv[i] = (f32x4){0.f, 0.f, 0.f, 0.f};
#pragma unroll
            for (int ks = 0; ks < 2; ++ks) hv[i] = mfma16(sfr[i][ks], qb[ks], hv[i]); }
#pragma unroll
        for (int cc = 0; cc < 2; ++cc) { const int st = dh * 2 + cc; f32x4 acc = {0.f, 0.f, 0.f, 0.f};
            if (st <= tt) {
#pragma unroll
                for (int ks = 0; ks < 2; ++ks) acc = mfma16(ldfrag(KT2 + (st * 16 + r) * ST + (ks * 32 + q * 8) * 2), qb[ks], acc); }
            float sv[4];
#pragma unroll
            for (int j = 0; j < 4; ++j) { const int s = st * 16 + q * 4 + j; sv[j] = (s <= t) ? acc[j] : 0.f; }
            u32x2 o; o.x = cvt_pk_bf16(sv[0], sv[1]); o.y = cvt_pk_bf16(sv[2], sv[3]); *(LAS u32x2*)(AS + t * ST + (st * 16 + q * 4) * 2) = o; } }
    u32x2 og[4]; f32x4 gn[4];
#pragma unroll
    for (int i = 0; i < 4; ++i) { const int d0 = (dh * 4 + i) * 16 + q * 4; og[i] = *(const u32x2*)(z + (size_t)(r0 + t) * NIN + ZO_GG + hd * 128 + d0); gn[i] = *(const f32x4*)(p.g_norm_g + l * 512 + hd * 128 + d0); }
    LDS_BARRIER();
    { bf16x8 ab2[2];
#pragma unroll
        for (int ks = 0; ks < 2; ++ks) ab2[ks] = ldfrag(AS + (tt * 16 + r) * ST + (ks * 32 + q * 8) * 2);
        float ssq = 0.f;
#pragma unroll
        for (int i = 0; i < 4; ++i) { const int dt = dh * 4 + i;
#pragma unroll
            for (int ks = 0; ks < 2; ++ks) hv[i] = mfma16(ldfrag(VT + tfr(dt * 16 + r, ks * 4 + q)), ab2[ks], hv[i]);
            ssq += hv[i][0] * hv[i][0] + hv[i][1] * hv[i][1] + hv[i][2] * hv[i][2] + hv[i][3] * hv[i][3]; }
        ssq += __shfl_xor(ssq, 16); ssq += __shfl_xor(ssq, 32); if (q == 0) part[t * 2 + dh] = ssq; }
    LDS_BARRIER();
    { const bool valid = (c > 0) || (t >= LEAD); const float sc = frsq((part[t * 2] + part[t * 2 + 1]) * (1.f / 128.f) + EPS); bf16_t* yp = p.Z() + (size_t)(r0 + t) * NIN + ZO_GG + hd * 128;
#pragma unroll
        for (int i = 0; i < 4; ++i) { const int d0 = (dh * 4 + i) * 16 + q * 4; float y[4];
            y[0] = hv[i][0] * sc * gn[i][0] * fsilu(bflo(og[i].x)); y[1] = hv[i][1] * sc * gn[i][1] * fsilu(bfhi(og[i].x)); y[2] = hv[i][2] * sc * gn[i][2] * fsilu(bflo(og[i].y)); y[3] = hv[i][3] * sc * gn[i][3] * fsilu(bfhi(og[i].y));
            u32x2 o; o.x = valid ? cvt_pk_bf16(y[0], y[1]) : 0u; o.y = valid ? cvt_pk_bf16(y[2], y[3]) : 0u; *(u32x2*)(yp + d0) = o; } }
    LDS_BARRIER();
}
}

namespace pro {
#define PRO_TILE(LD4, GK, OUTROW) do { \
        f32x4 v_[8]; \
        _Pragma("unroll") for (int i = 0; i < 8; ++i) { const int kk = 8 * i + (lane >> 3); v_[i] = (LD4); } \
        _Pragma("unroll") for (int i = 0; i < 8; ++i) { const int kk = 8 * i + (lane >> 3); const float g_ = (GK); LAS float* d_ = scr + kk * 33 + (lane & 7) * 4; d_[0] = v_[i].x * g_; d_[1] = v_[i].y * g_; d_[2] = v_[i].z * g_; d_[3] = v_[i].w * g_; } \
        asm volatile("s_waitcnt lgkmcnt(0)" ::: "memory"); \
        { const int c8 = lane & 7; _Pragma("unroll") for (int j = 0; j < 4; ++j) { const int nn = (lane >> 3) + 8 * j; const LAS float* s_ = scr + (8 * c8) * 33 + nn; \
            pg8::u32x4 o_; o_.x = pg8::cvt_pk_bf16(s_[0], s_[33]); o_.y = pg8::cvt_pk_bf16(s_[66], s_[99]); o_.z = pg8::cvt_pk_bf16(s_[132], s_[165]); o_.w = pg8::cvt_pk_bf16(s_[198], s_[231]); \
            *(pg8::u32x4*)((OUTROW) + 8 * c8) = o_; } } \
        asm volatile("s_waitcnt lgkmcnt(0)" ::: "memory"); } while (0)
#define PRO_TILE8(LD4, GK, OUTROW8) do { \
        f32x4 v_[8]; \
        _Pragma("unroll") for (int i = 0; i < 8; ++i) { const int kk = 8 * i + (lane >> 3); v_[i] = (LD4); } \
        _Pragma("unroll") for (int i = 0; i < 8; ++i) { const int kk = 8 * i + (lane >> 3); const float g_ = (GK); LAS float* d_ = scr + kk * 33 + (lane & 7) * 4; d_[0] = v_[i].x * g_; d_[1] = v_[i].y * g_; d_[2] = v_[i].z * g_; d_[3] = v_[i].w * g_; } \
        asm volatile("s_waitcnt lgkmcnt(0)" ::: "memory"); \
        { const int c8 = lane & 7; _Pragma("unroll") for (int j = 0; j < 4; ++j) { const int nn = (lane >> 3) + 8 * j; const LAS float* s_ = scr + (8 * c8) * 33 + nn; \
            pg8::u32x2 o_; o_.x = pg8::pk_fp8x4(s_[0], s_[33], s_[66], s_[99]); o_.y = pg8::pk_fp8x4(s_[132], s_[165], s_[198], s_[231]); \
            *(pg8::u32x2*)((OUTROW8) + 8 * c8) = o_; } } \
        asm volatile("s_waitcnt lgkmcnt(0)" ::: "memory"); } while (0)
__device__ __forceinline__ void prologue_phase(const P& p, LAS unsigned char* lds, int G, int bid, int tid) {
    asm volatile("" : "+v"(tid));
    const int lane = tid & 63, w = __builtin_amdgcn_readfirstlane(tid >> 6), gw = bid * NWAVES + w, NGW = G * NWAVES;
    LAS float* scr = (LAS float*)(lds + w * 8448);
    constexpr int I_IN = DEPTH * 16 * (NZP / 32), I_OUT = DEPTH * 16 * (D / 32), I_GU = DEPTH * NE * 16 * (512 / 32), I_D = DEPTH * NE * (DE / 64) * (D / 32);
    const f32x4 zero4 = {0.f, 0.f, 0.f, 0.f};
    for (int it = gw; it < I_IN + I_OUT + I_GU + I_D; it += NGW) {
        int r = it;
        if (r < I_IN) { const int nb = r % (NZP / 32), kb = (r / (NZP / 32)) % 16, l = r / (16 * (NZP / 32)), k0 = kb * 64, n0 = nb * 32;
            const int n = n0 + (lane & 7) * 4; const float* src = p.w_in + ((size_t)l * D + k0) * NIN + zsrc(n); const float* g = p.norm1_g + l * D + k0;
            bf16_t* ob = (bf16_t*)(p.ws + WS_WIN) + ((size_t)l * NZP + n0) * D + k0;
            PRO_TILE((n < NIN) ? *(const f32x4*)(src + (size_t)kk * NIN) : zero4, g[kk], ob + (size_t)nn * D);
            continue; }
        r -= I_IN;
        if (r < I_OUT) { const int nb = r % 32, kb = (r / 32) % 16, l = r / 512, k0 = kb * 64, n0 = nb * 32;
            const float* src = p.w_out + ((size_t)l * D + k0) * D + n0 + (lane & 7) * 4; bf16_t* ob = (bf16_t*)(p.ws + WS_WOUT) + ((size_t)l * D + n0) * D + k0;
            PRO_TILE(*(const f32x4*)(src + (size_t)kk * D), 1.f, ob + (size_t)nn * D);
            continue; }
        r -= I_OUT;
        if (r < I_GU) { const int nb = r % 16, kb = (r / 16) % 16, bz = r / 256, k0 = kb * 64, n0 = nb * 32;
            const int i4 = (lane & 7) * 4; const float* src = ((i4 < 16) ? p.w_gate : p.w_up) + ((size_t)bz * D + k0) * DE + 16 * nb + (i4 & 15); const float* g = p.norm2_g + (bz >> 5) * D + k0;
            unsigned char* ob8 = p.ws + WS_WGU + ((size_t)bz * 512 + n0) * D + k0;
            PRO_TILE8(*(const f32x4*)(src + (size_t)kk * DE), g[kk] * 16.f, ob8 + (size_t)nn * D);
            continue; }
        r -= I_GU;
        { const int nb = r % 32, kb = (r / 32) % 4, bz = r / 128, k0 = kb * 64, n0 = nb * 32;
            const float* src = p.w_down + ((size_t)bz * DE + k0) * D + n0 + (lane & 7) * 4; unsigned char* ob8 = p.ws + WS_WD + ((size_t)bz * D + n0) * DE + k0;
            PRO_TILE8(*(const f32x4*)(src + (size_t)kk * D), 8.f, ob8 + (size_t)nn * DE); }
    }
    for (int idx = bid * NTHR + tid; idx < DEPTH * 48 * D; idx += G * NTHR) { const int k = idx % D, o = (idx / D) % 48, l = idx / (D * 48); float v = 0.f;
        if (o < 4) v = p.wr_g[((size_t)l * D + k) * 4 + o]; else if (o < 36) v = p.wr_e[((size_t)l * D + k) * 32 + (o - 4)];
        v *= p.norm2_g[l * D + k]; const bf16_t hi = f2bf(v), lo = f2bf(v - bf2f(hi));
        bf16_t* wh = (bf16_t*)(p.ws + WS_WRS); wh[idx] = hi; wh[(size_t)DEPTH * 48 * D + idx] = lo; }
    for (int r = gw; r < MP; r += NGW) { const float* src = nullptr;
        if (r < XR) src = p.x + (size_t)r * D; else if (((r - XR) & 63) >= LEAD) src = p.meta + (size_t)(((r - XR) & 63) - LEAD) * D;
        float s = 0.f; bf16_t* hr = p.H() + (size_t)r * D;
#pragma unroll
        for (int j = 0; j < 4; ++j) { f32x4 v = {0.f, 0.f, 0.f, 0.f}; if (src) v = ((const f32x4*)src)[lane + 64 * j];
            s += v.x * v.x + v.y * v.y + v.z * v.z + v.w * v.w;
            pg8::u32x2 o; o.x = pg8::cvt_pk_bf16(v.x, v.y); o.y = pg8::cvt_pk_bf16(v.z, v.w); ((pg8::u32x2*)hr)[lane + 64 * j] = o; }
        s = wave_sum(s);
        if (lane == 0) { f32x4 q = {s, 0.f, 0.f, 0.f}; *(f32x4*)(p.SS1() + (size_t)r * 4) = q; } }
}
#undef PRO_TILE
#undef PRO_TILE8
__device__ __forceinline__ void final_phase(const P& p, int G, int bid, int tid) {
    asm volatile("" : "+v"(tid));
    const int lane = tid & 63, w = tid >> 6;
    for (int t = bid * NWAVES + w; t < B * SEQ; t += G * NWAVES) { const int r = t;
        const float rs = row_rs(p.SS1(), r); const bf16_t* hr = p.H() + (size_t)r * D; float* o = p.out + (size_t)t * D;
#pragma unroll
        for (int j = 0; j < 4; ++j) { const pg8::u32x2 hv = ((const pg8::u32x2*)hr)[lane + 64 * j]; const f32x4 g = ((const f32x4*)p.final_g)[lane + 64 * j];
            f32x4 v; v.x = pg8::bflo(hv.x) * rs * g.x; v.y = pg8::bfhi(hv.x) * rs * g.y; v.z = pg8::bflo(hv.y) * rs * g.z; v.w = pg8::bfhi(hv.y) * rs * g.w;
            ((f32x4*)o)[lane + 64 * j] = v; } }
}
}

struct Args { P p; int ph_lo, ph_hi; };
__global__ void __launch_bounds__(NTHR, 2) fwd(Args a) {
    extern __shared__ __attribute__((aligned(16))) unsigned char lds_raw[];
    LAS unsigned char* lds = (LAS unsigned char*)lds_raw;
    const P& p = a.p;
    const int tid = threadIdx.x, G = gridDim.x, bid = blockIdx.x;
    unsigned* ctl = (unsigned*)(p.ws + WS_CTL);
    volatile LAS unsigned* MISC = (volatile LAS unsigned*)(lds + MISC_OFF);
    if (tid < 128) MISC[tid] = 0u;
    __syncthreads();
    const bool multi = (a.ph_hi - a.ph_lo) > 1;
    XcdBarrier bar; bar.bar = ctl + CW_BAR; bar.x = 0; bar.st = nullptr;
    if (multi) bar = xcd_barrier_post(ctl + CW_BAR, MISC + 8);
#define IN(k) (a.ph_lo <= (k) && (k) < a.ph_hi)
#define SEAM(k) do { if (IN(k) && IN((k) + 1)) xcd_barrier(bar); } while (0)
    if (IN(PH_PRO)) {
pro::prologue_phase(p, lds, G, bid, tid); }
    SEAM(PH_PRO);
    for (int l = 0; l < DEPTH; ++l) {
        const int pb = PH_LAYER0 + l * PH_PER_LAYER;
        unsigned* gcnt = ctl + CW_CNT + l * 64 * 16;
        if (IN(pb + 0)) {
{
            pg8::DenseOrderRS<D, D> S; S.init(MP, NZP, G, bid); S.lds = lds; S.ws = p.ws;
            pg8::EpiZ E{p.ws, lds};
            pg8::gemm_phase<pg8::EpiZ, pg8::DenseOrderRS<D, D>, true, D, D>(lds + RING_OFF, (const char*)(p.ws + WS_H), (const char*)(p.ws + WS_WIN) + (size_t)l * NZP * D * 2, S, E);
            }
        }
        SEAM(pb + 0);
        if (IN(pb + 1)) {
{ { const int ulo = (int)((long)bid * NU / G), uhi = (int)((long)(bid + 1) * NU / G);
                if (ulo < uhi) { mx::PreM<4> pre; mx::load_m<4>(p, ulo, pre, tid, ZO_VM); for (int u = ulo; u < uhi; ++u) mx::mlstm_local(p, l, u, lds, tid, pre, u + 1 < uhi ? u + 1 : -1); }
                { const int glo = (int)((long)(G - 1 - bid) * NU / G), ghi = (int)((long)(G - bid) * NU / G);
                if (glo < ghi) { mx::PreG pre; mx::load_g(p, l, glo, pre, tid, false); for (int u = glo; u < ghi; ++u) mx::gla_local(p, l, u, lds, tid, pre, u + 1 < ghi ? u + 1 : -1); } } } } }
        SEAM(pb + 1);
        if (IN(pb + 2)) mx::scan_phase(p, lds, G, bid, tid);
        SEAM(pb + 2);
        if (IN(pb + 3)) { { const int ulo = (int)((long)bid * NU / G), uhi = (int)((long)(bid + 1) * NU / G);
                if (ulo < uhi) { mx::PreO pre; mx::load_o(p, ulo, pre, tid); for (int u = ulo; u < uhi; ++u) mx::mlstm_out(p, l, u, lds, tid, pre, u + 1 < uhi ? u + 1 : -1); }
                { const int glo = (int)((long)(G - 1 - bid) * NU / G), ghi = (int)((long)(G - bid) * NU / G);
                if (glo < ghi) { mx::PreG pre; mx::load_g(p, l, glo, pre, tid, true); for (int u = glo; u < ghi; ++u) mx::gla_out(p, l, u, lds, tid, pre, u + 1 < ghi ? u + 1 : -1); } } } }
        SEAM(pb + 3);
        if (IN(pb + 4)) {
            pg8::DenseOrder<NIN, D> S; S.init(XR, D, G, bid);
            pg8::EpiRes<false, false, WS_SS2, true> E{p.ws, lds};
            pg8::gemm_phase<pg8::EpiRes<false, false, WS_SS2, true>, pg8::DenseOrder<NIN, D>, true, NIN, D>(lds + RING_OFF, (const char*)(p.ws + WS_Z), (const char*)(p.ws + WS_WOUT) + (size_t)l * D * D * 2, S, E);
            int tl_ = tid; asm volatile("" : "+v"(tl_));
            if (tl_ < 64) { const int lane = tl_, r = lane & 15, q = lane >> 4; const bf16_t* wo = p.Wout() + (size_t)l * D * D;
                for (int tt = bid; tt < 4 * (D / 16); tt += G) { const int b4 = tt / (D / 16), ct = tt % (D / 16), row0 = XR + b4 * 64 + LEAD;
                    const bf16_t* ap = p.Z() + (size_t)(row0 + r) * NIN + q * 8; const bf16_t* bp = wo + (size_t)(ct * 16 + r) * D + q * 8; f32x4 acc = {0.f, 0.f, 0.f, 0.f};
#pragma unroll 8
                    for (int ks = 0; ks < 32; ++ks) acc = __builtin_amdgcn_mfma_f32_16x16x32_bf16(*(const pg8::bf16x8*)(ap + ks * 32), *(const pg8::bf16x8*)(bp + ks * 32), acc, 0, 0, 0);
#pragma unroll
                    for (int j = 0; j < 4; ++j) { const size_t o = (size_t)(row0 + q * 4 + j) * D + ct * 16 + r; const float v = bf2f(p.H()[o]) + acc[j];
                        p.H()[o] = (bf16_t)(pg8::cvt_pk_bf16(v, 0.f) & 0xffffu); (p.ws + WS_H8)[o] = (unsigned char)(pg8::pk_fp8x4(v, 0.f, 0.f, 0.f) & 0xffu); } } }
        }
        SEAM(pb + 4);
        if (IN(pb + 5)) route_phase(p, l, lds, G, bid, gcnt);
        SEAM(pb + 5);
        if (IN(pb + 6)) {
{
            moe_build_tab((LAS MoeTab*)(lds + TAB_OFF), gcnt);
            typedef MoeOrder<true, 2, D / 2, D / 2, 512u * D> Ord;
            Ord S; S.lds = lds; S.ws = p.ws; S.rbLo = 0; S.nwg = ((const LAS MoeTab*)(lds + TAB_OFF))->rb0[64] * 2; S.G = G; S.c = bid;
            pg8::EpiUp E{p.ws, lds};
            pg8::gemm_phase<pg8::EpiUp, Ord, true, D / 2, D / 2, true>(lds + RING_OFF, (const char*)(p.ws + WS_H8), (const char*)(p.ws + WS_WGU) + (size_t)l * NE * 512 * D, S, E);
            }
        }
        SEAM(pb + 6);
#pragma unroll
        for (int rank = 0; rank < 2; ++rank) {
            if (IN(pb + 7 + rank)) {
                moe_build_tab((LAS MoeTab*)(lds + TAB_OFF), gcnt);
                const LAS MoeTab* T = (const LAS MoeTab*)(lds + TAB_OFF);
                typedef MoeOrder<false, 4, DE / 2, DE / 2, (unsigned)D * DE> Ord;
                Ord S; S.lds = lds; S.ws = p.ws; S.rbLo = T->rb0[32 * rank]; S.nwg = (T->rb0[32 * rank + 32] - T->rb0[32 * rank]) * 4; S.G = G; S.c = bid;
                const char* Ab = (const char*)(p.ws + WS_HID); const char* Bb = (const char*)(p.ws + WS_WD) + (size_t)l * NE * D * DE;
                if (rank == 0) { pg8::EpiRes<true, false, WS_SS1> E{p.ws, lds}; pg8::gemm_phase<pg8::EpiRes<true, false, WS_SS1>, Ord, true, DE / 2, DE / 2, true>(lds + RING_OFF, Ab, Bb, S, E); }
                else { pg8::EpiRes<true, true, WS_SS1> E{p.ws, lds}; pg8::gemm_phase<pg8::EpiRes<true, true, WS_SS1>, Ord, true, DE / 2, DE / 2, true>(lds + RING_OFF, Ab, Bb, S, E); }
            }
            SEAM(pb + 7 + rank);
        }
    }
    if (IN(PH_FINAL)) pro::final_phase(p, G, bid, tid);
#undef IN
#undef SEAM
}

extern "C" void kernel_launch(void* const* d_in, const int* in_sizes, int n_in, void* d_out, int out_size, void* d_ws, size_t ws_size, hipStream_t stream) {
    if (n_in != 21 || ws_size < WS_END || out_size != B * SEQ * D) { fprintf(stderr, "kernel_launch: unexpected sizes n_in %d ws %zu (need %zu) out %d\n", n_in, ws_size, (size_t)WS_END, out_size); return; }
    P p{};
    const float** f = (const float**)&p.x;
    for (int i = 0; i < 21; ++i) f[i] = (const float*)d_in[i];
    p.out = (float*)d_out; p.ws = (unsigned char*)d_ws;
    static int grid = 0;
    if (!grid) {
        (void)hipFuncSetAttribute((const void*)fwd, hipFuncAttributeMaxDynamicSharedMemorySize, LDS_BYTES);
        int dev = 0, cus = 0, per_cu = 0;
        (void)hipGetDevice(&dev); (void)hipDeviceGetAttribute(&cus, hipDeviceAttributeMultiprocessorCount, dev);
        (void)hipOccupancyMaxActiveBlocksPerMultiprocessor(&per_cu, (const void*)fwd, NTHR, LDS_BYTES);
        (void)hipGetLastError();
        grid = cus > 0 ? cus : 256;
        if (per_cu < 1) fprintf(stderr, "kernel_launch: occupancy query reports %d blocks/CU for fwd\n", per_cu);
    }
    (void)hipMemsetAsync(d_ws, 0, CTL_BYTES, stream);
    Args a{}; a.p = p; a.ph_lo = 0; a.ph_hi = PH_COUNT;
    hipLaunchKernelGGL(fwd, dim3(grid), dim3(NTHR), LDS_BYTES, stream, a);
}
```

```cpp
#include <hip/hip_runtime.h>
#include <cstdio>
#include <cstdint>

typedef unsigned short bf16_t;
typedef float f32x4 __attribute__((ext_vector_type(4)));

namespace cfg {
constexpr int B = 4, SEQ = 8192, D = 1024, DEPTH = 2;
constexpr int CH = 64, NMETA = 16, LEAD = 48;
constexpr int TP = LEAD + NMETA + SEQ;
constexpr int NCH = TP / CH;
constexpr int MP = B * TP;
constexpr int XR = B * SEQ;
constexpr int NIN = 3608, NZP = 3840;
constexpr int ZO_OM = 0, ZO_GG = 512, ZO_QM = 1024, ZO_KM = 1536, ZO_VM = 2048, ZO_QG = 2560, ZO_KG = 2816, ZO_VG = 3072, ZO_IG = 3584, ZO_FG = 3588, ZO_CODE = 3592;
constexpr int NE = 32, DE = 256, NR = 40;
constexpr float EPS = 1e-6f;
constexpr int NU = B * 4 * NCH;

constexpr size_t al(size_t x) { return (x + 255) & ~(size_t)255; }
constexpr size_t WS_CTL = 0, CTL_BYTES = 4u << 20;
constexpr size_t WS_WIN = WS_CTL + CTL_BYTES;
constexpr size_t WS_WOUT = WS_WIN + al((size_t)DEPTH * NZP * D * 2);
constexpr size_t WS_WGU = WS_WOUT + al((size_t)DEPTH * D * D * 2);
constexpr size_t WS_H8 = WS_WGU + al((size_t)DEPTH * NE * 512 * D);
constexpr size_t WS_WD = WS_H8 + al((size_t)MP * D);
constexpr size_t WS_WR = WS_WD + al((size_t)DEPTH * NE * D * DE * 2);
constexpr size_t WS_H = WS_WR + al((size_t)DEPTH * NR * D * 4);
constexpr size_t WS_Z = WS_H + al((size_t)MP * D * 2);
constexpr size_t WS_SS1 = WS_Z + al((size_t)MP * NIN * 2);
constexpr size_t WS_SS2 = WS_SS1 + al((size_t)MP * 16);
constexpr size_t WS_TOKE = WS_SS2 + al((size_t)MP * 16);
constexpr size_t WS_TOKW = WS_TOKE + al((size_t)MP * 8);
constexpr int CAPL = MP, NBMAX = 352;
constexpr size_t WS_LTOK = WS_TOKW + al((size_t)MP * 8);
constexpr size_t WS_LRS = WS_LTOK + al((size_t)64 * CAPL * 4);
constexpr size_t WS_LW = WS_LRS + al((size_t)64 * CAPL * 4);
constexpr size_t WS_WRS = WS_LW + al((size_t)64 * CAPL * 4);
constexpr size_t WS_QKC = WS_WRS + al((size_t)2 * DEPTH * 48 * D * 2);
constexpr size_t WS_END = WS_QKC + al((size_t)MP * 1024 * 2);
constexpr size_t WS_HID = WS_QKC;
static_assert((size_t)NBMAX * 256 * 256 * 2 <= (size_t)MP * 1024 * 2, "hid fits in the q|k buffer");
constexpr size_t ST_MC = 0;
constexpr size_t ST_GS = ST_MC + al((size_t)NU * 16384 * 2);
constexpr size_t ST_MN = ST_GS + al((size_t)NU * 8192 * 2);
constexpr size_t ST_MSC = ST_MN + al((size_t)NU * 128 * 4);
constexpr size_t ST_GB = ST_MSC + al((size_t)NU * 16);
constexpr size_t ST_GA = ST_GB + al((size_t)NU * 64 * 4);
constexpr size_t ST_END = ST_GA + al((size_t)NU * 192 * 4);
static_assert(ST_END <= (size_t)B * SEQ * D * 4, "state scratch fits d_out");
}
using namespace cfg;

__device__ __forceinline__ float bf2f(bf16_t v) { return __uint_as_float(((unsigned)v) << 16); }
__device__ __forceinline__ bf16_t f2bf(float f) { unsigned u = __float_as_uint(f); u += 0x7fffu + ((u >> 16) & 1u); return (bf16_t)(u >> 16); }
__device__ __forceinline__ float wave_sum(float v) {
#pragma unroll
    for (int o = 1; o < 64; o <<= 1) v += __shfl_xor(v, o);
    return v;
}
__device__ __forceinline__ float logsig(float x) { return fminf(x, 0.f) - log1pf(__expf(-fabsf(x))); }
__device__ __forceinline__ float sigm(float x) { return 1.f / (1.f + __expf(-x)); }
__device__ __forceinline__ float silu(float x) { return x * sigm(x); }

__host__ __device__ __forceinline__ int zsrc(int n) {
    if (n < 512) return 1536 + n;
    if (n < 1024) return 3080 + (n - 512);
    if (n < 2048) return n - 1024;
    if (n < 2560) return 1024 + (n - 2048);
    if (n < 2816) return 2056 + (n - 2560);
    if (n < 3072) return 2312 + (n - 2816);
    if (n < 3584) return 2568 + (n - 3072);
    if (n < 3588) return 2048 + (n - 3584);
    if (n < 3592) return 2052 + (n - 3588);
    return n;
}

struct P {
    const float *x, *meta, *norm1_g, *w_in, *conv_w, *conv_b, *gate_b, *m_norm_g, *a_w2, *a_b, *g_norm_g, *w_out, *norm2_g, *wr_g, *br_g, *wr_e, *br_e, *w_gate, *w_up, *w_down, *final_g;
    float* out; unsigned char* ws;
    __device__ __forceinline__ bf16_t* Win() const { return (bf16_t*)(ws + WS_WIN); }
    __device__ __forceinline__ bf16_t* Wout() const { return (bf16_t*)(ws + WS_WOUT); }
    __device__ __forceinline__ bf16_t* Wgu() const { return (bf16_t*)(ws + WS_WGU); }
    __device__ __forceinline__ bf16_t* Wd() const { return (bf16_t*)(ws + WS_WD); }
    __device__ __forceinline__ bf16_t* H() const { return (bf16_t*)(ws + WS_H); }
    __device__ __forceinline__ bf16_t* Z() const { return (bf16_t*)(ws + WS_Z); }
    __device__ __forceinline__ float* SS1() const { return (float*)(ws + WS_SS1); }
    __device__ __forceinline__ float* SS2() const { return (float*)(ws + WS_SS2); }
    __device__ __forceinline__ bf16_t* MC() const { return (bf16_t*)((unsigned char*)out + ST_MC); }
    __device__ __forceinline__ bf16_t* GS() const { return (bf16_t*)((unsigned char*)out + ST_GS); }
    __device__ __forceinline__ float* MN() const { return (float*)((unsigned char*)out + ST_MN); }
    __device__ __forceinline__ float* MSC() const { return (float*)((unsigned char*)out + ST_MSC); }
    __device__ __forceinline__ float* GB() const { return (float*)((unsigned char*)out + ST_GB); }
};

__host__ __device__ __forceinline__ bool is_pad_row(int r) { return r >= XR && ((r - XR) & 63) < LEAD; }
__host__ __device__ __forceinline__ int chunk_row0(int b, int c) { return c == 0 ? XR + b * 64 : b * SEQ + (c - 1) * 64; }
__device__ __forceinline__ float row_rs(const float* ss, int r) {
    if (is_pad_row(r)) return 0.f;
    const f32x4 v = *(const f32x4*)(ss + (size_t)r * 4);
    return rsqrtf((v.x + v.y + v.z + v.w) * (1.f / D) + EPS);
}

#define LAS __attribute__((address_space(3)))
constexpr int NWAVES = 8, NTHR = 512;
constexpr int RING_OFF = 0, RING_BYTES = 131072, TAB_OFF = 131072, TAB_BYTES = 24576, MISC_OFF = TAB_OFF + TAB_BYTES, LDS_BYTES = MISC_OFF + 512;
constexpr int RED_OFF = TAB_OFF + 4096;
constexpr int UROW_OFF = TAB_OFF + 8192;
constexpr int CW_BAR = 4096, CW_CNT = 16384;
constexpr int PH_PRO = 0, PH_LAYER0 = 1, PH_PER_LAYER = 9, PH_FINAL = 1 + 9 * DEPTH, PH_COUNT = PH_FINAL + 1;

#define XB_TMO      128
#define XB_XCNT(j)  (256  + 64 * (j))
#define XB_XSUB(j)  (1280 + 64 * (j))
#define XB_XGEN(j)  (2304 + 64 * (j))
#define XB_TOP      3328
#define XB_TOPGEN   3392
#define XCD_BAR_WORDS 3456
#define XB_SPIN_CAP (1u << 18)
__device__ __forceinline__ unsigned xb_ld(unsigned* p)              { return __hip_atomic_load(p, __ATOMIC_RELAXED, __HIP_MEMORY_SCOPE_AGENT); }
__device__ __forceinline__ unsigned xb_add(unsigned* p, unsigned v) { return __hip_atomic_fetch_add(p, v, __ATOMIC_RELAXED, __HIP_MEMORY_SCOPE_AGENT); }
__device__ __forceinline__ unsigned xb_xcc_id() { return (unsigned)__builtin_amdgcn_s_getreg((3 << 11) | 20) & 0xFu; }
#define XB_SPIN(cond, bar) do { unsigned _sp = 0; while (cond) { __builtin_amdgcn_s_sleep(1); \
    if ((++_sp & 255u) == 0u) { if (xb_ld(&(bar)[XB_TMO])) break; if (_sp > XB_SPIN_CAP) { atomicAdd(&(bar)[XB_TMO], 1u); break; } } } } while (0)
struct XcdBarrier { unsigned* bar; unsigned x; volatile LAS unsigned* st; };
__device__ __forceinline__ XcdBarrier xcd_barrier_post(unsigned* bar, volatile LAS unsigned* st) {
    XcdBarrier b; b.bar = bar; b.x = xb_xcc_id(); b.st = st;
    if (threadIdx.x == 0) (void)xb_add(&bar[XB_XCNT(b.x)], 1u);
    return b;
}
__device__ __forceinline__ void xcd_barrier_complete(unsigned* bar, unsigned x, unsigned& nloc, unsigned& nx) {
    const unsigned G = gridDim.x * gridDim.y * gridDim.z;
    unsigned sum, cnt, mine, sp = 0u;
    for (;;) {
        sum = 0u; cnt = 0u; mine = 0u;
#pragma unroll
        for (unsigned j = 0; j < 16; ++j) { const unsigned c = xb_ld(&bar[XB_XCNT(j)]); sum += c; cnt += (c > 0u) ? 1u : 0u; mine = (j == x) ? c : mine; }
        if (sum == G) break;
        __builtin_amdgcn_s_sleep(1);
        if ((++sp & 255u) == 0u) { if (xb_ld(&bar[XB_TMO])) break; if (sp > XB_SPIN_CAP) { atomicAdd(&bar[XB_TMO], 1u); break; } }
    }
    nloc = mine > 0u ? mine : 1u; nx = cnt > 0u ? cnt : 1u;
}
__device__ __forceinline__ void xcd_barrier(const XcdBarrier& b) {
    asm volatile("s_waitcnt vmcnt(0)" ::: "memory");
    __syncthreads();
    if (threadIdx.x == 0) {
        unsigned* bar = b.bar;
        __builtin_amdgcn_s_waitcnt(0);
        unsigned nloc = b.st[0], nx = b.st[1];
        if (nloc == 0u) { xcd_barrier_complete(bar, b.x, nloc, nx); b.st[0] = nloc; b.st[1] = nx; }
        const unsigned old = xb_add(&bar[XB_XSUB(b.x)], 1u);
        const unsigned gen = old / nloc;
        if (old + 1u == (gen + 1u) * nloc) {
            __builtin_amdgcn_fence(__ATOMIC_RELEASE, "agent");
            asm volatile("s_waitcnt vmcnt(0)" ::: "memory");
            const unsigned og = xb_add(&bar[XB_TOP], 1u);
            const unsigned tg = og / nx;
            if (og + 1u == (tg + 1u) * nx) xb_add(&bar[XB_TOPGEN], 1u);
            else XB_SPIN(xb_ld(&bar[XB_TOPGEN]) == tg, bar);
            __builtin_amdgcn_fence(__ATOMIC_ACQUIRE, "agent");
            xb_add(&bar[XB_XGEN(b.x)], 1u);
            asm volatile("s_waitcnt vmcnt(0)" ::: "memory");
        } else {
            XB_SPIN(xb_ld(&bar[XB_XGEN(b.x)]) == gen, bar);
            __builtin_amdgcn_fence(__ATOMIC_ACQUIRE, "agent");
            asm volatile("s_waitcnt vmcnt(0)" ::: "memory");
        }
    }
    __syncthreads();
}

namespace pg8 {
typedef short bf16x8 __attribute__((ext_vector_type(8)));
typedef unsigned u32x4 __attribute__((ext_vector_type(4)));
typedef unsigned u32x2 __attribute__((ext_vector_type(2)));
constexpr int BM = 256, BK = 64, HALF = 128, HTB = HALF * BK * 2, STAGE_BYTES = 8 * HTB, NXCD = 8, WGM = 8;
__host__ __device__ __forceinline__ int lds_byte(int r, int c) { const int st = (r >> 4) * 2 + (c >> 5), rr = r & 15, cc = c & 31, ob = rr * 64 + cc * 2; return st * 1024 + (ob ^ (((ob >> 9) & 1) << 5)); }
__host__ __device__ __forceinline__ void stage_rc(int b, int& R, int& C) { const int st = b / 1024, sb = b % 1024, swz = sb ^ (((sb >> 9) & 1) << 5); R = (st >> 1) * 16 + swz / 64; C = (st & 1) * 32 + (swz % 64) / 2; }
__host__ __device__ __forceinline__ int perm32(int rho) { const int n = rho >> 4, i = rho & 15; return 8 * (i >> 2) + 4 * n + (i & 3); }
typedef float f32x2_ __attribute__((ext_vector_type(2))); typedef __bf16 bf16x2_ __attribute__((ext_vector_type(2)));
__device__ __forceinline__ unsigned cvt_pk_bf16(float lo, float hi) { const f32x2_ v = {lo, hi}; return __builtin_bit_cast(unsigned, __builtin_convertvector(v, bf16x2_)); }
__device__ __forceinline__ float bflo(unsigned w) { return __uint_as_float(w << 16); }
__device__ __forceinline__ float bfhi(unsigned w) { return __uint_as_float(w & 0xffff0000u); }

struct Unit { int pm, pn; unsigned ao, bo; };

__device__ __forceinline__ int xcd_remap(int L, int nwg) { const int q = nwg / NXCD, r = nwg % NXCD, xcd = L % NXCD, off = L / NXCD; return (xcd < r ? xcd * (q + 1) : r * (q + 1) + (xcd - r) * q) + off; }

template <int LDA, int K> struct DenseOrder {
    static constexpr bool GATHER = false, LIST = false;
    int nM, nN, nwg, G, c;
    __device__ __forceinline__ void init(int M, int N, int G_, int c_) { nM = M / BM; nN = N / BM; nwg = nM * nN; G = G_; c = c_; }
    __device__ __forceinline__ bool next(int i, Unit& u, int, int) const {
        const int L = i * G + c; if (L >= nwg) return false;
        const int wgid = xcd_remap(L, nwg);
        const int nig = WGM * nN, gid = wgid / nig, fm = gid * WGM, gsz = (nM - fm) < WGM ? (nM - fm) : WGM;
        u.pm = fm + ((wgid % nig) % gsz); u.pn = (wgid % nig) / gsz; u.ao = (unsigned)u.pm * (unsigned)(BM * LDA * 2); u.bo = (unsigned)u.pn * (unsigned)(BM * K * 2); return true;
    }
    __device__ __forceinline__ unsigned aoff(int, int rowl, int C) const { return (unsigned)(rowl * LDA + C) * 2u; }
};
template <int LDA, int K> struct DenseOrderRS : DenseOrder<LDA, K> {
    static constexpr bool GATHER = false, LIST = true;
    LAS unsigned char* lds; unsigned char* ws;
    __device__ __forceinline__ bool next(int i, Unit& u, int ub, int tid) const {
        if (!DenseOrder<LDA, K>::next(i, u, 0, 0)) return false;
        if (tid < 256) ((LAS float*)(lds + UROW_OFF))[ub * 256 + tid] = row_rs((const float*)(ws + WS_SS1), u.pm * BM + tid);
        return true;
    }
};

template <class Epi, class Sched, bool ALIGN_EPI, int LDA, int K, bool FP8 = false>
__device__ __forceinline__ void gemm_phase(LAS unsigned char* lds, const char* Abase, const char* Bbase, const Sched& S, const Epi& E) {
    int tid_ = threadIdx.x; asm volatile("" : "+v"(tid_));
    const int tid = tid_, wid = __builtin_amdgcn_readfirstlane(tid >> 6), lane = tid & 63, wr = wid >> 2, wc = wid & 3, fr = lane & 15, fq = lane >> 4;
    constexpr int nt = K / BK;
    int Rr[2], Cc[2]; unsigned voffB[2];
#pragma unroll
    for (int i = 0; i < 2; ++i) { stage_rc(tid * 16 + i * 8192, Rr[i], Cc[i]); const int Rb = Epi::PERM ? ((Rr[i] & ~31) + perm32(Rr[i] & 31)) : Rr[i]; voffB[i] = (unsigned)(Rb * K + Cc[i]) * 2u; }
    constexpr unsigned kstep = BK * 2, hstepB = HALF * K * 2;
    const unsigned ldsw = (unsigned)wid * 1024u;
    int aofs[2], bofs[2];
#pragma unroll
    for (int e = 0; e < 2; ++e) { aofs[e] = FP8 ? lds_byte(wr * 64 + fr, (2 * fq + e) * 8) : lds_byte(wr * 64 + fr, fq * 8) + e * 1024; bofs[e] = FP8 ? lds_byte(wc * 32 + fr, (2 * fq + e) * 8) : lds_byte(wc * 32 + fr, fq * 8) + e * 1024; }
#define PG8_SA(b, h) (((b) * 2 + (h)) * HTB)
#define PG8_SB(b, h) ((4 + (b) * 2 + (h)) * HTB)
#define PG8_STAGE(bufoff, gbase, uoff, voff) do { _Pragma("unroll") for (int _i = 0; _i < 2; ++_i) \
        __builtin_amdgcn_global_load_lds((const unsigned*)((gbase) + (size_t)(unsigned)((uoff) + (voff)[_i])), (LAS unsigned*)(lds + (bufoff) + ldsw + _i * 8192), 16, 0, 0); } while (0)
#define PG8_LDA(dst, b, h) do { _Pragma("unroll") for (int m = 0; m < 4; ++m) _Pragma("unroll") for (int k = 0; k < 2; ++k) dst[m][k] = *(const LAS bf16x8*)(lds + PG8_SA(b, h) + aofs[k] + m * 2048); } while (0)
#define PG8_LDB(dst, b, h) do { _Pragma("unroll") for (int n = 0; n < 2; ++n) _Pragma("unroll") for (int k = 0; k < 2; ++k) dst[n][k] = *(const LAS bf16x8*)(lds + PG8_SB(b, h) + bofs[k] + n * 2048); } while (0)
#define PG8_MMA(ai, bj, At, Bt) do { __builtin_amdgcn_s_setprio(1); _Pragma("unroll") for (int m = 0; m < 4; ++m) _Pragma("unroll") for (int n = 0; n < 2; ++n) { \
        if constexpr (FP8) { typedef int i32x4_ __attribute__((ext_vector_type(4))); typedef int i32x8_ __attribute__((ext_vector_type(8))); \
            const i32x8_ b8_ = __builtin_shufflevector(__builtin_bit_cast(i32x4_, Bt[n][0]), __builtin_bit_cast(i32x4_, Bt[n][1]), 0, 1, 2, 3, 4, 5, 6, 7), a8_ = __builtin_shufflevector(__builtin_bit_cast(i32x4_, At[m][0]), __builtin_bit_cast(i32x4_, At[m][1]), 0, 1, 2, 3, 4, 5, 6, 7); \
            acc[ai][bj][m][n] = __builtin_amdgcn_mfma_scale_f32_16x16x128_f8f6f4(b8_, a8_, acc[ai][bj][m][n], 0, 0, 0, 0x7F7F7F7F, 0, 0x7F7F7F7F); } \
        else { _Pragma("unroll") for (int k = 0; k < 2; ++k) acc[ai][bj][m][n] = __builtin_amdgcn_mfma_f32_16x16x32_bf16(Bt[n][k], At[m][k], acc[ai][bj][m][n], 0, 0, 0); } } __builtin_amdgcn_s_setprio(0); } while (0)
#define PG8_WAIT_V(n) asm volatile("s_waitcnt vmcnt(" #n ")" ::: "memory")
#define PG8_WAIT_L(n) asm volatile("s_waitcnt lgkmcnt(" #n ")" ::: "memory")
#define PG8_BAR __builtin_amdgcn_s_barrier()
#define PG8_SCHED __builtin_amdgcn_sched_barrier(0)
    Unit cur, nxt; int ui = 0, ub = 0;
    if (!S.next(0, cur, 0, tid)) return;
    if constexpr (Sched::LIST) { asm volatile("s_waitcnt lgkmcnt(0)" ::: "memory"); __builtin_amdgcn_s_barrier(); asm volatile("" ::: "memory"); }
    unsigned voffA[2][2];
#pragma unroll
    for (int h = 0; h < 2; ++h)
#pragma unroll
        for (int i = 0; i < 2; ++i) voffA[h][i] = S.aoff(0, h * HALF + Rr[i], Cc[i]);
    f32x4 acc[2][2][4][2];
#pragma unroll
    for (int a = 0; a < 2; ++a)
#pragma unroll
        for (int b = 0; b < 2; ++b)
#pragma unroll
            for (int m = 0; m < 4; ++m)
#pragma unroll
                for (int n = 0; n < 2; ++n) acc[a][b][m][n] = (f32x4){0.f, 0.f, 0.f, 0.f};
    bf16x8 At[4][2], B0[2][2], B1[2][2];
    unsigned cA = cur.ao, cB = cur.bo;
    PG8_STAGE(PG8_SB(0, 0), Bbase, cB, voffB); PG8_STAGE(PG8_SB(0, 1), Bbase, cB + hstepB, voffB); PG8_STAGE(PG8_SA(0, 0), Abase, cA, voffA[0]); PG8_STAGE(PG8_SA(0, 1), Abase, cA, voffA[1]);
    if (wr == 1) PG8_BAR;
    PG8_WAIT_V(2); PG8_BAR;
    PG8_STAGE(PG8_SB(1, 0), Bbase, cB + kstep, voffB); PG8_STAGE(PG8_SA(1, 0), Abase, cA + kstep, voffA[0]); PG8_STAGE(PG8_SB(1, 1), Bbase, cB + hstepB + kstep, voffB);
    PG8_WAIT_V(6); PG8_BAR;
    for (;;) {
        const int nub = (ub == 2) ? 0 : ub + 1;
        const bool has_next = S.next(ui + 1, nxt, nub, tid);
        const unsigned nA = has_next ? nxt.ao : cA, nB = has_next ? nxt.bo : cB;
#pragma unroll 1
        for (int t = 0; t < nt; t += 2) {
            const bool last = (t == nt - 2);
            const unsigned a1 = cA + (unsigned)(t + 1) * kstep;
            const unsigned a2 = last ? nA : cA + (unsigned)(t + 2) * kstep, b2 = last ? nB : cB + (unsigned)(t + 2) * kstep;
            const unsigned a3 = a2 + kstep, b3 = b2 + kstep;
            PG8_LDB(B0, 0, 0); PG8_LDB(B1, 0, 1); PG8_SCHED; PG8_LDA(At, 0, 0); PG8_STAGE(PG8_SA(1, 1), Abase, a1, voffA[1]);
            if constexpr (Sched::GATHER) { if (last && has_next) {
#pragma unroll
                for (int h = 0; h < 2; ++h)
#pragma unroll
                    for (int i = 0; i < 2; ++i) voffA[h][i] = S.aoff(nub, h * HALF + Rr[i], Cc[i]); } }
            PG8_WAIT_V(8); PG8_WAIT_L(0); PG8_BAR; PG8_MMA(0, 0, At, B0); PG8_MMA(0, 1, At, B1); PG8_BAR; PG8_SCHED;
            PG8_LDA(At, 0, 1); PG8_STAGE(PG8_SB(0, 0), Bbase, b2, voffB); PG8_STAGE(PG8_SB(0, 1), Bbase, b2 + hstepB, voffB); PG8_STAGE(PG8_SA(0, 0), Abase, a2, voffA[0]);
            PG8_WAIT_V(8); PG8_WAIT_L(0); PG8_BAR; PG8_MMA(1, 0, At, B0); PG8_MMA(1, 1, At, B1); PG8_BAR; PG8_SCHED;
            PG8_LDB(B0, 1, 0); PG8_LDB(B1, 1, 1); PG8_SCHED; PG8_LDA(At, 1, 0); PG8_STAGE(PG8_SA(0, 1), Abase, a2, voffA[1]);
            PG8_WAIT_V(8); PG8_WAIT_L(0); PG8_BAR; PG8_MMA(0, 0, At, B0); PG8_MMA(0, 1, At, B1); PG8_BAR; PG8_SCHED;
            PG8_LDA(At, 1, 1); PG8_STAGE(PG8_SB(1, 0), Bbase, b3, voffB); PG8_STAGE(PG8_SB(1, 1), Bbase, b3 + hstepB, voffB); PG8_STAGE(PG8_SA(1, 0), Abase, a3, voffA[0]);
            PG8_WAIT_V(8); PG8_WAIT_L(0); PG8_BAR; PG8_MMA(1, 0, At, B0); PG8_MMA(1, 1, At, B1); PG8_BAR; PG8_SCHED;
        }
        if constexpr (ALIGN_EPI) { if (wr == 0) PG8_BAR; }
        E(acc, cur, wr, wc, fr, fq, tid, ub);
        if (!has_next) break;
#pragma unroll
        for (int a = 0; a < 2; ++a)
#pragma unroll
            for (int b = 0; b < 2; ++b)
#pragma unroll
                for (int m = 0; m < 4; ++m)
#pragma unroll
                    for (int n = 0; n < 2; ++n) acc[a][b][m][n] = (f32x4){0.f, 0.f, 0.f, 0.f};
        cur = nxt; cA = nA; cB = nB; ++ui; ub = nub;
        if constexpr (ALIGN_EPI) { if (wr == 1) PG8_BAR; }
    }
    PG8_WAIT_V(0);
    if constexpr (!ALIGN_EPI) { if (wr == 0) PG8_BAR; }
    PG8_BAR;
#undef PG8_SA
#undef PG8_SB
#undef PG8_STAGE
#undef PG8_LDA
#undef PG8_LDB
#undef PG8_MMA
#undef PG8_WAIT_V
#undef PG8_WAIT_L
#undef PG8_BAR
#undef PG8_SCHED
}

struct EpiZ {
    static constexpr bool PERM = true;
    unsigned char* ws; LAS unsigned char* lds;
    __device__ __forceinline__ void operator()(const f32x4 (&acc)[2][2][4][2], const Unit& u, int wr, int wc, int fr, int fq, int, int ub) const {
        const int row0 = u.pm * BM + wr * 64 + fr, col0 = u.pn * BM + wc * 32 + 8 * fq;
        bf16_t* z = (bf16_t*)(ws + WS_Z); const LAS float* rsb = (const LAS float*)(lds + UROW_OFF) + ub * 256 + wr * 64 + fr;
#pragma unroll
        for (int ai = 0; ai < 2; ++ai)
#pragma unroll
            for (int m = 0; m < 4; ++m) { const int row = row0 + ai * HALF + m * 16; const float rs = rsb[ai * HALF + m * 16]; bf16_t* rowp = z + (size_t)row * NIN + col0;
#pragma unroll
                for (int bj = 0; bj < 2; ++bj) if (col0 + bj * HALF < NIN) { const f32x4 v0 = acc[ai][bj][m][0] * rs, v1 = acc[ai][bj][m][1] * rs;
                    u32x4 w; w.x = cvt_pk_bf16(v0[0], v0[1]); w.y = cvt_pk_bf16(v0[2], v0[3]); w.z = cvt_pk_bf16(v1[0], v1[1]); w.w = cvt_pk_bf16(v1[2], v1[3]);
                    *(u32x4*)(rowp + bj * HALF) = w; } }
    }
};
__device__ __forceinline__ unsigned pk_fp8x4(float a, float b, float c, float d) { int r = __builtin_amdgcn_cvt_pk_fp8_f32(a, b, 0, false); r = __builtin_amdgcn_cvt_pk_fp8_f32(c, d, r, true); return (unsigned)r; }
template <bool LIST, bool STATS, size_t SS_OFF, bool H8OUT = false> struct EpiRes {
    static constexpr bool PERM = true;
    unsigned char* ws; LAS unsigned char* lds;
    __device__ __forceinline__ void operator()(const f32x4 (&acc)[2][2][4][2], const Unit& u, int wr, int wc, int fr, int fq, int tid, int ub) const {
        const int col0 = u.pn * BM + wc * 32 + 8 * fq;
        bf16_t* h = (bf16_t*)(ws + WS_H); float* ss = (float*)(ws + SS_OFF); LAS float* red = (LAS float*)(lds + RED_OFF); const LAS int* utok = (const LAS int*)(lds + UROW_OFF);
#pragma unroll
        for (int ai = 0; ai < 2; ++ai)
#pragma unroll
            for (int m = 0; m < 4; ++m) { const int rowl = ai * HALF + wr * 64 + m * 16 + fr; int row; bool valid = true;
                if constexpr (LIST) { row = utok[ub * 256 + rowl]; valid = row >= 0; } else row = u.pm * BM + rowl;
                float s = 0.f;
                if (valid) { bf16_t* hp = h + (size_t)row * D + col0;
#pragma unroll
                    for (int bj = 0; bj < 2; ++bj) { const u32x4 o = *(const u32x4*)(hp + bj * HALF); const f32x4 a0 = acc[ai][bj][m][0] * (LIST ? 0.0078125f : 1.f), a1 = acc[ai][bj][m][1] * (LIST ? 0.0078125f : 1.f);
                        const float v0 = bflo(o.x) + a0[0], v1 = bfhi(o.x) + a0[1], v2 = bflo(o.y) + a0[2], v3 = bfhi(o.y) + a0[3], v4 = bflo(o.z) + a1[0], v5 = bfhi(o.z) + a1[1], v6 = bflo(o.w) + a1[2], v7 = bfhi(o.w) + a1[3];
                        s += (v0 * v0 + v1 * v1) + (v2 * v2 + v3 * v3) + (v4 * v4 + v5 * v5) + (v6 * v6 + v7 * v7);
                        u32x4 w; w.x = cvt_pk_bf16(v0, v1); w.y = cvt_pk_bf16(v2, v3); w.z = cvt_pk_bf16(v4, v5); w.w = cvt_pk_bf16(v6, v7);
                        *(u32x4*)(hp + bj * HALF) = w;
                        if constexpr (H8OUT) { u32x2 q; q.x = pk_fp8x4(v0, v1, v2, v3); q.y = pk_fp8x4(v4, v5, v6, v7); *(u32x2*)(ws + WS_H8 + (size_t)row * D + col0 + bj * HALF) = q; } } }
                if constexpr (STATS) { s += __shfl_xor(s, 16); s += __shfl_xor(s, 32); if (fq == 0) red[rowl * 4 + wc] = s; }
                asm volatile("" ::: "memory"); }
        if constexpr (STATS) {
            asm volatile("s_waitcnt lgkmcnt(0)" ::: "memory"); __builtin_amdgcn_s_barrier(); asm volatile("" ::: "memory");
            if (tid < BM) { const f32x4 v = *(const LAS f32x4*)(red + tid * 4); int row; bool valid = true;
                if constexpr (LIST) { row = utok[ub * 256 + tid]; valid = row >= 0; } else row = u.pm * BM + tid;
                if (valid) ss[(size_t)row * 4 + u.pn] = (v.x + v.y) + (v.z + v.w); }
        }
    }
};
struct EpiUp {
    static constexpr bool PERM = false;
    unsigned char* ws; LAS unsigned char* lds;
    __device__ __forceinline__ void operator()(const f32x4 (&acc)[2][2][4][2], const Unit& u, int wr, int wc, int fr, int fq, int, int ub) const {
        const int col0 = u.pn * 128 + wc * 16 + 4 * fq;
        unsigned char* hid = ws + WS_HID; const LAS float* urs = (const LAS float*)(lds + UROW_OFF) + 768;
#pragma unroll
        for (int ai = 0; ai < 2; ++ai)
#pragma unroll
            for (int m = 0; m < 4; ++m) { const int rowl = ai * HALF + wr * 64 + m * 16 + fr;
                const float rs = urs[ub * 256 + rowl] * 0.0625f, gw = urs[768 + ub * 256 + rowl] * 16.f;
                unsigned char* hp = hid + ((size_t)u.pm * BM + rowl) * DE + col0;
#pragma unroll
                for (int bj = 0; bj < 2; ++bj) { const f32x4 g = acc[ai][bj][m][0] * rs, up = acc[ai][bj][m][1] * rs; float o[4];
#pragma unroll
                    for (int j = 0; j < 4; ++j) o[j] = g[j] * __builtin_amdgcn_rcpf(1.f + __builtin_amdgcn_exp2f(g[j] * -1.4426950408889634f)) * up[j] * gw;
                    *(unsigned*)(hp + bj * 64) = pk_fp8x4(o[0], o[1], o[2], o[3]); } }
    }
};
}

struct MoeTab { int cnt[64]; int rb0[65]; int pad[3]; unsigned short li[NBMAX]; unsigned short blk[NBMAX]; };
static_assert(sizeof(MoeTab) <= 4096, "MoeTab fits below RED_OFF");
__device__ __forceinline__ void moe_build_tab(LAS MoeTab* T, unsigned* gcnt) {
    const int tid = threadIdx.x;
    if (tid < 64) T->cnt[tid] = (int)__hip_atomic_load(gcnt + tid * 16, __ATOMIC_RELAXED, __HIP_MEMORY_SCOPE_AGENT);
    __syncthreads();
    if (tid == 0) { int run = 0; for (int i = 0; i < 64; ++i) { T->rb0[i] = run; run += (T->cnt[i] + 255) >> 8; } T->rb0[64] = run; }
    __syncthreads();
    if (tid < 64) { const int b0 = T->rb0[tid], nb = T->rb0[tid + 1] - b0;
#pragma clang loop vectorize(disable) unroll(disable)
        for (int b = 0; b < nb; ++b) { T->li[b0 + b] = (unsigned short)tid; T->blk[b0 + b] = (unsigned short)b; } }
    __syncthreads();
}
template <bool GATHER_, int NN, int LDA, int K, unsigned ESTEP> struct MoeOrder {
    static constexpr bool GATHER = GATHER_, LIST = true;
    LAS unsigned char* lds; unsigned char* ws; int rbLo, nwg, G, c;
    __device__ __forceinline__ bool next(int i, pg8::Unit& u, int ub, int tid) const {
        const int L = i * G + c; if (L >= nwg) return false;
        const LAS MoeTab* T = (const LAS MoeTab*)(lds + TAB_OFF); LAS int* urow = (LAS int*)(lds + UROW_OFF);
        const int wgid = pg8::xcd_remap(L, nwg), rb = rbLo + wgid / NN;
        const int li = T->li[rb], blk = T->blk[rb], cnt = T->cnt[li];
        u.pm = rb; u.pn = wgid % NN; u.ao = GATHER ? 0u : (unsigned)rb * (unsigned)(256 * LDA * 2); u.bo = (unsigned)(li & 31) * ESTEP + (unsigned)u.pn * (unsigned)(256 * K * 2);
        if (tid < 256) { const int slot = blk * 256 + tid; const bool valid = slot < cnt; const size_t idx = (size_t)li * CAPL + slot;
            urow[ub * 256 + tid] = valid ? ((const int*)(ws + WS_LTOK))[idx] : -1;
            if constexpr (GATHER) { ((LAS float*)urow)[768 + ub * 256 + tid] = valid ? ((const float*)(ws + WS_LRS))[idx] : 0.f; ((LAS float*)urow)[1536 + ub * 256 + tid] = valid ? ((const float*)(ws + WS_LW))[idx] : 0.f; } }
        return true;
    }
    __device__ __forceinline__ unsigned aoff(int ub, int rowl, int C) const {
        if constexpr (GATHER) { const int tok = ((const LAS int*)(lds + UROW_OFF))[ub * 256 + rowl]; return (unsigned)((tok < 0 ? 0 : tok) * LDA + C) * 2u; }
        else return (unsigned)(rowl * LDA + C) * 2u;
    }
};

__device__ __forceinline__ void route_phase(const P& p, int l, LAS unsigned char* lds, int G, int bid, unsigned* gcnt) {
    int tid_ = threadIdx.x; asm volatile("" : "+v"(tid_));
    const int tid = tid_, w = __builtin_amdgcn_readfirstlane(tid >> 6), lane = tid & 63, r = lane & 15, q = lane >> 4;
    const int per = (MP + G - 1) / G, r0 = bid * per, nrows = (r0 + per <= MP) ? per : (MP - r0 > 0 ? MP - r0 : 0);
    constexpr int WROW = 1040;
    LAS unsigned char* WHs = lds; LAS unsigned char* WLs = lds + 48 * WROW;
    LAS float* lg = (LAS float*)(lds + 2 * 48 * WROW);
    LAS int* lcnt = (LAS int*)(lds + TAB_OFF);
    LAS int* lbase = lcnt + 64;
    LAS int* rli = lbase + 64;
    LAS int* rpos = rli + 528;
    LAS float* rw = (LAS float*)(rpos + 528);
    LAS float* rrs = rw + 528;
    if (tid < 64) lcnt[tid] = 0;
    const bf16_t* WH = (const bf16_t*)(p.ws + WS_WRS) + (size_t)l * 48 * D; const bf16_t* WL = WH + (size_t)DEPTH * 48 * D;
    f32x4 acc[2][3]; float ssq[2] = {0.f, 0.f};
#pragma unroll
    for (int gi = 0; gi < 2; ++gi)
#pragma unroll
        for (int tl = 0; tl < 3; ++tl) acc[gi][tl] = (f32x4){0.f, 0.f, 0.f, 0.f};
#pragma unroll 1
    for (int half = 0; half < 2; ++half) {
        __syncthreads();
        for (int idx = tid; idx < 48 * 64; idx += NTHR) { const int row = idx >> 6, pc = idx & 63;
            *(LAS pg8::u32x4*)(WHs + row * WROW + pc * 16) = *(const pg8::u32x4*)(WH + (size_t)row * D + half * 512 + pc * 8);
            *(LAS pg8::u32x4*)(WLs + row * WROW + pc * 16) = *(const pg8::u32x4*)(WL + (size_t)row * D + half * 512 + pc * 8); }
        __syncthreads();
#pragma unroll
        for (int gi = 0; gi < 2; ++gi) { const int g = w + gi * NWAVES;
            if (g * 16 < nrows) { const bool ina = (g * 16 + r) < nrows; const bf16_t* ap = p.H() + (size_t)(ina ? r0 + g * 16 + r : 0) * D + half * 512 + q * 8;
                pg8::bf16x8 a[16];
#pragma unroll
                for (int ks = 0; ks < 16; ++ks) a[ks] = *(const pg8::bf16x8*)(ap + ks * 32);
#pragma unroll
                for (int ks = 0; ks < 16; ++ks) { const pg8::u32x4 w4 = __builtin_bit_cast(pg8::u32x4, a[ks]); const float x0 = pg8::bflo(w4.x), x1 = pg8::bfhi(w4.x), x2 = pg8::bflo(w4.y), x3 = pg8::bfhi(w4.y), x4 = pg8::bflo(w4.z), x5 = pg8::bfhi(w4.z), x6 = pg8::bflo(w4.w), x7 = pg8::bfhi(w4.w);
                    ssq[gi] += (x0 * x0 + x1 * x1) + (x2 * x2 + x3 * x3) + (x4 * x4 + x5 * x5) + (x6 * x6 + x7 * x7); }
#pragma unroll
                for (int ks = 0; ks < 16; ++ks)
#pragma unroll
                    for (int tl = 0; tl < 3; ++tl) { const int wo = (tl * 16 + r) * WROW + (ks * 32 + q * 8) * 2;
                        acc[gi][tl] = __builtin_amdgcn_mfma_f32_16x16x32_bf16(a[ks], *(const LAS pg8::bf16x8*)(WHs + wo), acc[gi][tl], 0, 0, 0);
                        acc[gi][tl] = __builtin_amdgcn_mfma_f32_16x16x32_bf16(a[ks], *(const LAS pg8::bf16x8*)(WLs + wo), acc[gi][tl], 0, 0, 0); } } }
    }
#pragma unroll
    for (int gi = 0; gi < 2; ++gi) { const int g = w + gi * NWAVES;
        if (g * 16 < nrows) {
            LAS float* lgw = lg + w * 16 * 48;
#pragma unroll
            for (int tl = 0; tl < 3; ++tl)
#pragma unroll
                for (int j = 0; j < 4; ++j) lgw[(q * 4 + j) * 48 + tl * 16 + r] = acc[gi][tl][j];
            asm volatile("s_waitcnt lgkmcnt(0)" ::: "memory");
            float rtot = ssq[gi]; rtot += __shfl_xor(rtot, 16); rtot += __shfl_xor(rtot, 32);
            if (lane < 16) { const int i = g * 16 + lane, rr = r0 + i;
                if (i < nrows) {
                    if (is_pad_row(rr)) { int neg = -1; asm volatile("" : "+v"(neg)); rli[2 * i] = neg; rli[2 * i + 1] = neg; }
                    else { const float rs = __builtin_amdgcn_rsqf(rtot * (1.f / D) + EPS); const LAS float* x = lgw + lane * 48; float gl[4];
#pragma unroll
                        for (int j = 0; j < 4; ++j) gl[j] = x[j] * rs + p.br_g[l * 4 + j];
                        int gsel = 0; float gm = gl[0];
#pragma unroll
                        for (int j = 1; j < 4; ++j) if (gl[j] > gm) { gm = gl[j]; gsel = j; }
                        float se = 0.f;
#pragma unroll
                        for (int j = 0; j < 4; ++j) se += __expf(gl[j] - gm);
                        const float psel = 1.f / se;
                        int i0 = 0, i1 = -1; float v0 = -INFINITY, v1 = -INFINITY;
                        for (int j = 0; j < 8; ++j) { const float v = x[4 + gsel * 8 + j] * rs + p.br_e[l * 32 + gsel * 8 + j];
                            if (v > v0) { v1 = v0; i1 = i0; v0 = v; i0 = j; } else if (v > v1) { v1 = v; i1 = j; } }
                        const float w0 = 1.f / (1.f + __expf(v1 - v0));
                        const int li0 = gsel * 8 + i0, li1 = 32 + gsel * 8 + i1;
                        rli[2 * i] = li0; rli[2 * i + 1] = li1; rw[2 * i] = w0 * psel; rw[2 * i + 1] = (1.f - w0) * psel; rrs[i] = rs;
                        rpos[2 * i] = __hip_atomic_fetch_add(&lcnt[li0], 1, __ATOMIC_RELAXED, __HIP_MEMORY_SCOPE_WORKGROUP); rpos[2 * i + 1] = __hip_atomic_fetch_add(&lcnt[li1], 1, __ATOMIC_RELAXED, __HIP_MEMORY_SCOPE_WORKGROUP); } } }
            asm volatile("s_waitcnt lgkmcnt(0)" ::: "memory"); } }
    __syncthreads();
    if (tid < 64) { const int n = lcnt[tid]; lbase[tid] = n ? (int)__hip_atomic_fetch_add(gcnt + tid * 16, (unsigned)n, __ATOMIC_RELAXED, __HIP_MEMORY_SCOPE_AGENT) : 0; }
    __syncthreads();
    int* ltok = (int*)(p.ws + WS_LTOK); float* lrs = (float*)(p.ws + WS_LRS); float* lw = (float*)(p.ws + WS_LW);
    for (int i = tid; i < 2 * nrows; i += NTHR) { const int li = rli[i]; if (li >= 0) { const size_t idx = (size_t)li * CAPL + lbase[li] + rpos[i]; ltok[idx] = r0 + (i >> 1); lrs[idx] = rrs[i >> 1]; lw[idx] = rw[i]; } }
    __syncthreads();
}

namespace mx {
#define LDS_BARRIER() do { asm volatile("s_waitcnt lgkmcnt(0)" ::: "memory"); __builtin_amdgcn_s_barrier(); asm volatile("" ::: "memory"); } while (0)
using pg8::bf16x8; using pg8::u32x4; using pg8::u32x2; using pg8::cvt_pk_bf16; using pg8::bflo; using pg8::bfhi;
__device__ __forceinline__ f32x4 mfma16(bf16x8 a, bf16x8 b, f32x4 c) { return __builtin_amdgcn_mfma_f32_16x16x32_bf16(a, b, c, 0, 0, 0); }
__device__ __forceinline__ float wscan_add(float v, int lane) {
#pragma unroll
    for (int o = 1; o < 64; o <<= 1) { const float t = __shfl_up(v, o); if (lane >= o) v += t; }
    return v; }
__device__ __forceinline__ float wscan_max(float v, int lane) {
#pragma unroll
    for (int o = 1; o < 64; o <<= 1) { const float t = __shfl_up(v, o); if (lane >= o) v = fmaxf(v, t); }
    return v; }
__device__ __forceinline__ float wave_max(float v) {
#pragma unroll
    for (int o = 1; o < 64; o <<= 1) v = fmaxf(v, __shfl_xor(v, o));
    return v; }
__device__ __forceinline__ void unpack8(const u32x4 a, float (&x)[8]) { x[0] = bflo(a.x); x[1] = bfhi(a.x); x[2] = bflo(a.y); x[3] = bfhi(a.y); x[4] = bflo(a.z); x[5] = bfhi(a.z); x[6] = bflo(a.w); x[7] = bfhi(a.w); }
__device__ __forceinline__ u32x4 pack8(const float (&x)[8]) { u32x4 w; w.x = cvt_pk_bf16(x[0], x[1]); w.y = cvt_pk_bf16(x[2], x[3]); w.z = cvt_pk_bf16(x[4], x[5]); w.w = cvt_pk_bf16(x[6], x[7]); return w; }
__device__ __forceinline__ bf16x8 ldfrag(const LAS unsigned char* p) { return *(const LAS bf16x8*)p; }
__device__ __forceinline__ float fexp(float x) { return __builtin_amdgcn_exp2f(x * 1.4426950408889634f); }
__device__ __forceinline__ float frcp(float x) { return __builtin_amdgcn_rcpf(x); }
__device__ __forceinline__ float fsigm(float x) { return frcp(1.f + fexp(-x)); }
__device__ __forceinline__ float fsilu(float x) { return x * fsigm(x); }
__device__ __forceinline__ float flogsig(float x) { return fminf(x, 0.f) - __builtin_amdgcn_logf(1.f + fexp(-fabsf(x))) * 0.6931471805599453f; }
__device__ __forceinline__ float frsq(float x) { return __builtin_amdgcn_rsqf(x); }
constexpr int SQ = 272, ST = 144;
__device__ __forceinline__ int tsw(int row, int s) { return row * ST + ((((s >> 3) ^ (row >> 3)) & 7) << 4) + ((s & 7) << 1); }
__device__ __forceinline__ int tfr(int row, int chunk) { return row * ST + (((chunk ^ (row >> 3)) & 7) << 4); }

struct UC { int c, hd, b, r0; };
__device__ __forceinline__ UC ucoord(int u) { UC k; k.c = u % NCH; k.hd = (u / NCH) & 3; k.b = u / (NCH * 4); k.r0 = chunk_row0(k.b, k.c); return k; }
template <int NS> struct PreM { u32x4 x[NS + 3]; u32x4 v[2]; pg8::f32x2_ g; };
struct PreO { u32x4 qk[4]; u32x4 v[2]; f32x4 g; pg8::f32x2_ n; };
struct PreG { u32x4 v[2]; u32x4 q, k; f32x4 ca; pg8::f32x2_ ab; };
template <int NS> __device__ __forceinline__ void load_m(const P& p, int u, PreM<NS>& R, int tid, int zvcol) {
    asm volatile("" : "+v"(tid));
    const UC k = ucoord(u); const bf16_t* z = p.Z(); const int lane = tid & 63, w = tid >> 6;
    { const size_t zr = (size_t)(k.r0 + lane) * NIN; pg8::f32x2_ g = {0.f, 0.f}; if (w == 0) { g.x = bf2f(z[zr + ZO_FG + k.hd]); g.y = bf2f(z[zr + ZO_IG + k.hd]); } R.g = g; }
    int zcol, s0;
    if (NS == 4) { const int which = tid >> 8; zcol = (which ? ZO_KM : ZO_QM) + k.hd * 128 + (tid & 15) * 8; s0 = ((tid >> 4) & 15) * 4; }
    else { zcol = ZO_KM + k.hd * 128 + (tid & 15) * 8; s0 = (tid >> 4) * 2; }
#pragma unroll
    for (int i = 0; i < NS + 3; ++i) { const int s = s0 - 3 + i, pp = k.c * 64 + s;
        const int row = (s < 0 && k.c == 1) ? XR + k.b * 64 + 64 + s : k.r0 + (pp >= 0 ? s : 0);
        const u32x4 v = *(const u32x4*)(z + (size_t)row * NIN + zcol); const unsigned m = pp >= 0 ? 0xffffffffu : 0u; R.x[i] = (u32x4){v.x & m, v.y & m, v.z & m, v.w & m}; }
#pragma unroll
    for (int it = 0; it < 2; ++it) { const int s = 2 * (tid >> 4) + it, v8 = tid & 15; R.v[it] = *(const u32x4*)(z + (size_t)(k.r0 + s) * NIN + zvcol + k.hd * 128 + v8 * 8); }
}
__device__ __forceinline__ void load_o(const P& p, int u, PreO& R, int tid) {
    asm volatile("" : "+v"(tid));
    const UC k = ucoord(u); const bf16_t* z = p.Z(); const bf16_t* qkc = (const bf16_t*)(p.ws + WS_QKC);
#pragma unroll
    for (int it = 0; it < 4; ++it) { const int item = tid + it * NTHR, which = item >> 10, s = (item >> 4) & 63, ch8 = item & 15; R.qk[it] = *(const u32x4*)(qkc + (size_t)(k.r0 + s) * 1024 + which * 512 + k.hd * 128 + ch8 * 8); }
#pragma unroll
    for (int it = 0; it < 2; ++it) { const int s = 2 * (tid >> 4) + it, v8 = tid & 15; R.v[it] = *(const u32x4*)(z + (size_t)(k.r0 + s) * NIN + ZO_VM + k.hd * 128 + v8 * 8); }
    { f32x4 g = {0.f, 0.f, 0.f, 0.f}; if (tid < 64) { const float* ga = (const float*)((const unsigned char*)p.out + ST_GA) + (size_t)u * 192; g.x = ga[tid]; g.y = ga[64 + tid]; g.z = ga[128 + tid]; g.w = p.MSC()[(size_t)u * 4 + 2]; } R.g = g;
      pg8::f32x2_ n = {0.f, 0.f}; if (tid < 128) n.x = p.MN()[(size_t)u * 128 + tid]; R.n = n; }
}
__device__ __forceinline__ void load_g(const P& p, int l, int u, PreG& R, int tid, bool needq) {
    asm volatile("" : "+v"(tid));
    const UC k = ucoord(u); const bf16_t* z = p.Z();
#pragma unroll
    for (int it = 0; it < 2; ++it) { const int s = 2 * (tid >> 4) + it, v8 = tid & 15; R.v[it] = *(const u32x4*)(z + (size_t)(k.r0 + s) * NIN + ZO_VG + k.hd * 128 + v8 * 8); }
    const size_t zr = (size_t)(k.r0 + (tid >> 3)) * NIN; R.k = *(const u32x4*)(z + zr + ZO_KG + k.hd * 64 + (tid & 7) * 8); R.q = R.k;
    if (needq) R.q = *(const u32x4*)(z + zr + ZO_QG + k.hd * 64 + (tid & 7) * 8);
    { const int i0 = tid, i1 = tid + NTHR; f32x4 ca;
        ca.x = bf2f(z[(size_t)(k.r0 + (i0 >> 4)) * NIN + ZO_CODE + (i0 & 15)]); ca.y = bf2f(z[(size_t)(k.r0 + (i1 >> 4)) * NIN + ZO_CODE + (i1 & 15)]);
        ca.z = p.a_w2[(l * 16 + (i0 >> 6)) * 256 + k.hd * 64 + (i0 & 63)]; ca.w = p.a_w2[(l * 16 + (i1 >> 6)) * 256 + k.hd * 64 + (i1 & 63)]; R.ca = ca;
      pg8::f32x2_ ab = {0.f, 0.f}; if (tid < 64) ab.x = p.a_b[l * 256 + k.hd * 64 + tid]; R.ab = ab; }
}
template <int NS> __device__ __forceinline__ void conv8(const P& p, int l, const u32x4 (&xr)[NS + 3], int c, int s0, int cch, float scale, float (&o)[NS][8]) {
    float x[NS + 3][8];
#pragma unroll
    for (int i = 0; i < NS + 3; ++i) unpack8(xr[i], x[i]);
    float bias[8];
    { const f32x4 b0 = *(const f32x4*)(p.conv_b + l * D + cch), b1 = *(const f32x4*)(p.conv_b + l * D + cch + 4); bias[0] = b0.x; bias[1] = b0.y; bias[2] = b0.z; bias[3] = b0.w; bias[4] = b1.x; bias[5] = b1.y; bias[6] = b1.z; bias[7] = b1.w; }
#pragma unroll
    for (int i = 0; i < NS; ++i)
#pragma unroll
        for (int q = 0; q < 8; ++q) o[i][q] = bias[q];
#pragma unroll
    for (int j = 0; j < 4; ++j) { float w[8];
        { const f32x4 w0 = *(const f32x4*)(p.conv_w + (l * 4 + j) * D + cch), w1 = *(const f32x4*)(p.conv_w + (l * 4 + j) * D + cch + 4); w[0] = w0.x; w[1] = w0.y; w[2] = w0.z; w[3] = w0.w; w[4] = w1.x; w[5] = w1.y; w[6] = w1.z; w[7] = w1.w; }
#pragma unroll
        for (int i = 0; i < NS; ++i)
#pragma unroll
            for (int q = 0; q < 8; ++q) o[i][q] += w[q] * x[i + j][q]; }
#pragma unroll
    for (int i = 0; i < NS; ++i) { const bool valid = (c > 0) || (s0 + i >= LEAD);
#pragma unroll
        for (int q = 0; q < 8; ++q) o[i][q] = valid ? fsilu(o[i][q]) * scale : 0.f; }
}

__device__ __forceinline__ void gla_cumdecay(const P& p, int l, int hd, const PreG& R, int c, LAS float* LA, LAS float* segtot, LAS float* cod, LAS float* aw, LAS float* ab, int tid) {
    cod[tid] = R.ca.x; cod[tid + NTHR] = R.ca.y; aw[tid] = R.ca.z; aw[tid + NTHR] = R.ca.w;
    if (tid < 64) ab[tid] = p.a_b[l * 256 + hd * 64 + tid];
    LDS_BARRIER();
    const int j = tid & 63, seg = tid >> 6; float run = 0.f, v[8];
#pragma unroll
    for (int i = 0; i < 8; ++i) { const int s = seg * 8 + i; const bool valid = (c > 0) || (s >= LEAD); float a = ab[j];
#pragma unroll
        for (int q = 0; q < 16; ++q) a += cod[s * 16 + q] * aw[q * 64 + j];
        run += valid ? flogsig(a) * (1.f / 16.f) : 0.f; v[i] = run; }
    segtot[seg * 64 + j] = run;
    LDS_BARRIER();
    float pre = 0.f;
#pragma unroll
    for (int g = 0; g < 8; ++g) pre += (g < seg) ? segtot[g * 64 + j] : 0.f;
#pragma unroll
    for (int i = 0; i < 8; ++i) LA[(seg * 8 + i) * 65 + j] = v[i] + pre;
    LDS_BARRIER();
}
__device__ __forceinline__ void mlstm_local(const P& p, int l, int u, LAS unsigned char* lds, int tid, PreM<4>& R, int unext) {
    asm volatile("" : "+v"(tid));
    const int lane = tid & 63, w = __builtin_amdgcn_readfirstlane(tid >> 6), c = u % NCH, hd = (u / NCH) & 3, b = u / (NCH * 4), r0 = chunk_row0(b, c);
    LAS unsigned char* KT = lds; LAS unsigned char* VT = lds + 18432; LAS float* wS = (LAS float*)(lds + 39168);
    if (w == 0) { const int s = lane; const bool valid = (c > 0) || (s >= LEAD);
        const float lf = valid ? flogsig(R.g.x + p.gate_b[(l * 2 + 1) * 4 + hd]) : 0.f;
        const float ig = valid ? R.g.y + p.gate_b[(l * 2 + 0) * 4 + hd] : -INFINITY;
        const float bb = wscan_add(lf, lane), be = __shfl(bb, 63), g = be - bb + ig, mg = wave_max(g), a = ig - bb, pm = wscan_max(a, lane);
        wS[s] = fexp(g - mg);
        float* ga = (float*)((unsigned char*)p.out + ST_GA) + (size_t)u * 192; ga[s] = bb; ga[64 + s] = a; ga[128 + s] = pm;
        if (lane == 0) { float* sc = p.MSC() + (size_t)u * 4; sc[0] = mg; sc[1] = be; } }
    { const int which = tid >> 8, ch8 = tid & 15, s0 = ((tid >> 4) & 15) * 4; float o[4][8];
        conv8<4>(p, l, R.x, c, s0, which * 512 + hd * 128 + ch8 * 8, which ? 0.08838834764831845f : 1.f, o);
        bf16_t* qkc = (bf16_t*)(p.ws + WS_QKC) + (size_t)(r0 + s0) * 1024 + which * 512 + hd * 128 + ch8 * 8;
#pragma unroll
        for (int i = 0; i < 4; ++i) *(u32x4*)(qkc + (size_t)i * 1024) = pack8(o[i]);
        if (which) {
#pragma unroll
            for (int q = 0; q < 8; ++q) { *(LAS unsigned*)(KT + tsw(ch8 * 8 + q, s0)) = cvt_pk_bf16(o[0][q], o[1][q]); *(LAS unsigned*)(KT + tsw(ch8 * 8 + q, s0 + 2)) = cvt_pk_bf16(o[2][q], o[3][q]); } } }
    LDS_BARRIER();
    { const int s0 = 2 * (tid >> 4), v8 = tid & 15; float x0[8], x1[8]; unpack8(R.v[0], x0); unpack8(R.v[1], x1);
        const float w0 = ((c > 0) || (s0 >= LEAD)) ? wS[s0] : 0.f, w1 = ((c > 0) || (s0 + 1 >= LEAD)) ? wS[s0 + 1] : 0.f;
#pragma unroll
        for (int q = 0; q < 8; ++q) *(LAS unsigned*)(VT + tsw(v8 * 8 + q, s0)) = cvt_pk_bf16(x0[q] * w0, x1[q] * w1); }
    for (int i = tid; i < 16 * 64; i += NTHR) { const int row = 128 + (i >> 6), s = i & 63; *(LAS bf16_t*)(VT + tsw(row, s)) = (row == 128) ? (bf16_t)(cvt_pk_bf16(wS[s], 0.f) & 0xffffu) : (bf16_t)0; }
    if (unext >= 0) load_m<4>(p, unext, R, tid, ZO_VM);
    LDS_BARRIER();
    { const int r = lane & 15, q = lane >> 4; bf16x8 afr[2];
#pragma unroll
        for (int ks = 0; ks < 2; ++ks) afr[ks] = ldfrag(KT + tfr(w * 16 + r, ks * 4 + q));
        bf16_t* Cd = p.MC() + (size_t)u * 16384;
#pragma unroll
        for (int vt = 0; vt < 9; ++vt) { f32x4 acc = {0.f, 0.f, 0.f, 0.f};
#pragma unroll
            for (int ks = 0; ks < 2; ++ks) acc = mfma16(afr[ks], ldfrag(VT + tfr(vt * 16 + r, ks * 4 + q)), acc);
            if (vt < 8) { u32x2 o; o.x = cvt_pk_bf16(acc[0], acc[1]); o.y = cvt_pk_bf16(acc[2], acc[3]); *(u32x2*)(Cd + (vt * 16 + r) * 128 + w * 16 + q * 4) = o; }
            else if (r == 0) *(f32x4*)(p.MN() + (size_t)u * 128 + w * 16 + q * 4) = acc; } }
    LDS_BARRIER();
}

__device__ __forceinline__ void gla_local(const P& p, int l, int u, LAS unsigned char* lds, int tid, PreG& R, int unext) {
    asm volatile("" : "+v"(tid));
    const int lane = tid & 63, w = __builtin_amdgcn_readfirstlane(tid >> 6), c = u % NCH, hd = (u / NCH) & 3, b = u / (NCH * 4), r0 = chunk_row0(b, c);
    const bf16_t* z = p.Z();
    LAS float* LA = (LAS float*)lds; LAS float* segtot = (LAS float*)(lds + 16640); LAS unsigned char* KHT = lds + 18688; LAS unsigned char* VT = lds + 27904;
    LAS float* cod = (LAS float*)(lds + 46336); LAS float* aw = (LAS float*)(lds + 50432); LAS float* ab = (LAS float*)(lds + 54528);
    gla_cumdecay(p, l, hd, R, c, LA, segtot, cod, aw, ab, tid);
    if (tid < 64) p.GB()[(size_t)u * 64 + tid] = LA[63 * 65 + tid];
    { const int s = tid >> 3, j8 = tid & 7; const bool valid = (c > 0) || (s >= LEAD); float x[8];
        unpack8(R.k, x);
#pragma unroll
        for (int q = 0; q < 8; ++q) { const int j = j8 * 8 + q; *(LAS bf16_t*)(KHT + tsw(j, s)) = (bf16_t)(cvt_pk_bf16(valid ? x[q] * fexp(LA[63 * 65 + j] - LA[s * 65 + j]) : 0.f, 0.f) & 0xffffu); } }
    { const int s0 = 2 * (tid >> 4), v8 = tid & 15; float x0[8], x1[8]; unpack8(R.v[0], x0); unpack8(R.v[1], x1);
        const float w0 = ((c > 0) || (s0 >= LEAD)) ? 1.f : 0.f, w1 = ((c > 0) || (s0 + 1 >= LEAD)) ? 1.f : 0.f;
#pragma unroll
        for (int q = 0; q < 8; ++q) *(LAS unsigned*)(VT + tsw(v8 * 8 + q, s0)) = cvt_pk_bf16(x0[q] * w0, x1[q] * w1); }
    if (unext >= 0) load_g(p, l, unext, R, tid, false);
    LDS_BARRIER();
    { const int r = lane & 15, q = lane >> 4; bf16x8 bfr[2];
#pragma unroll
        for (int ks = 0; ks < 2; ++ks) bfr[ks] = ldfrag(VT + tfr(w * 16 + r, ks * 4 + q));
        bf16_t* Sd = p.GS() + (size_t)u * 8192;
#pragma unroll
        for (int jt = 0; jt < 4; ++jt) { f32x4 acc = {0.f, 0.f, 0.f, 0.f};
#pragma unroll
            for (int ks = 0; ks < 2; ++ks) acc = mfma16(ldfrag(KHT + tfr(jt * 16 + r, ks * 4 + q)), bfr[ks], acc);
            u32x2 o; o.x = cvt_pk_bf16(acc[0], acc[1]); o.y = cvt_pk_bf16(acc[2], acc[3]); *(u32x2*)(Sd + (w * 16 + r) * 64 + jt * 16 + q * 4) = o; } }
    LDS_BARRIER();
}

template <class LD, class FOLD> __device__ __forceinline__ void scan_stream(LD ld, FOLD fold) {
    u32x2 cur[16], nxt[16];
#pragma unroll
    for (int i = 0; i < 16; ++i) cur[i] = ld(i);
#pragma unroll 1
    for (int c0 = 0; c0 < 128; c0 += 16) {
#pragma unroll
        for (int i = 0; i < 16; ++i) nxt[i] = ld(c0 + 16 + i < NCH ? c0 + 16 + i : NCH - 1);
#pragma unroll
        for (int i = 0; i < 16; ++i) fold(c0 + i, cur[i]);
#pragma unroll
        for (int i = 0; i < 16; ++i) cur[i] = nxt[i];
    }
    fold(128, cur[0]);
}
__device__ __forceinline__ void scan_phase(const P& p, LAS unsigned char* lds, int G, int bid, int tid) {
    asm volatile("" : "+v"(tid));
    LAS float* dec = (LAS float*)lds; LAS float* wgt = dec + 132;
    for (int item = bid; item < 16 * 13; item += G) { const int bh = item / 13, sl = item % 13;
        __syncthreads();
        if (sl < 9 && tid < 64) {
            const int lane = tid; float* sc = p.MSC() + (size_t)bh * NCH * 4; const int c0 = 2 * lane, c1 = c0 + 1;
            const float a0 = sc[c0 * 4 + 1], b0 = sc[c0 * 4], a1 = sc[c1 * 4 + 1], b1 = sc[c1 * 4];
            float A = a0 + a1, Bv = fmaxf(b0 + a1, b1);
#pragma unroll
            for (int o = 1; o < 64; o <<= 1) { const float At = __shfl_up(A, o), Bt = __shfl_up(Bv, o); if (lane >= o) { Bv = fmaxf(Bt + A, Bv); A = At + A; } }
            float EA = __shfl_up(A, 1), EB = __shfl_up(Bv, 1); if (lane == 0) { EA = 0.f; EB = -INFINITY; }
            const float mp = fmaxf(EA, EB), m0 = fmaxf(mp + a0, b0), m1 = fmaxf(m0 + a1, b1);
            dec[c0] = fexp(a0 + mp - m0); wgt[c0] = fexp(b0 - m0); dec[c1] = fexp(a1 + m0 - m1); wgt[c1] = fexp(b1 - m1);
            if (sl == 0) { sc[c0 * 4 + 2] = mp; sc[c1 * 4 + 2] = m0; }
            if (lane == 63) { const float a2 = sc[128 * 4 + 1], b2 = sc[128 * 4], m2 = fmaxf(m1 + a2, b2); dec[128] = fexp(a2 + m1 - m2); wgt[128] = fexp(b2 - m2); if (sl == 0) sc[128 * 4 + 2] = m1; } }
        __syncthreads();
        if (sl < 8) { float C0 = 0.f, C1 = 0.f, C2 = 0.f, C3 = 0.f; u32x2* q = (u32x2*)(p.MC() + (size_t)bh * NCH * 16384 + sl * 2048 + tid * 4);
            scan_stream([&](int c) { return q[(size_t)c * 4096]; },
                        [&](int c, u32x2 dl) { u32x2 o; o.x = cvt_pk_bf16(C0, C1); o.y = cvt_pk_bf16(C2, C3); q[(size_t)c * 4096] = o; const float d = dec[c], g = wgt[c];
                            C0 = d * C0 + g * bflo(dl.x); C1 = d * C1 + g * bfhi(dl.x); C2 = d * C2 + g * bflo(dl.y); C3 = d * C3 + g * bfhi(dl.y); }); }
        else if (sl == 8) { if (tid < 128) { float C = 0.f; float* q = p.MN() + (size_t)bh * NCH * 128 + tid;
#pragma unroll 16
            for (int c = 0; c < NCH; ++c) { const float dl = q[(size_t)c * 128]; q[(size_t)c * 128] = C; C = dec[c] * C + wgt[c] * dl; } } }
        else { const int e = (sl - 9) * 2048 + tid * 4, j = e & 63; float S0 = 0.f, S1 = 0.f, S2 = 0.f, S3 = 0.f; u32x2* q = (u32x2*)(p.GS() + (size_t)bh * NCH * 8192 + e); const f32x4* gb = (const f32x4*)(p.GB() + (size_t)bh * NCH * 64 + j);
            scan_stream([&](int c) { return q[(size_t)c * 2048]; },
                        [&](int c, u32x2 dl) { const f32x4 bv = gb[(size_t)c * 16]; u32x2 o; o.x = cvt_pk_bf16(S0, S1); o.y = cvt_pk_bf16(S2, S3); q[(size_t)c * 2048] = o;
                            S0 = S0 * fexp(bv.x) + bflo(dl.x); S1 = S1 * fexp(bv.y) + bfhi(dl.x); S2 = S2 * fexp(bv.z) + bflo(dl.y); S3 = S3 * fexp(bv.w) + bfhi(dl.y); }); }
    }
    __syncthreads();
}

__device__ __forceinline__ void mlstm_out(const P& p, int l, int u, LAS unsigned char* lds, int tid, PreO& R, int unext) {
    asm volatile("" : "+v"(tid));
    const int lane = tid & 63, w = __builtin_amdgcn_readfirstlane(tid >> 6), c = u % NCH, hd = (u / NCH) & 3, b = u / (NCH * 4), r0 = chunk_row0(b, c);
    const bf16_t* z = p.Z();
    LAS unsigned char* QS = lds; LAS unsigned char* KS = lds + 17408; LAS unsigned char* VT = lds + 34816; LAS unsigned char* SS = lds + 55552;
    LAS float* aS = (LAS float*)(lds + 64768); LAS float* MS = aS + 64; LAS float* wiS = MS + 64; LAS float* emtS = wiS + 64; LAS float* denS = emtS + 64; LAS float* part = denS + 64; LAS float* nS = part + 128;
    const int r = lane & 15, q = lane >> 4, tt = w & 3, vh = w >> 2, t = tt * 16 + r;
    const int nvt = vh ? 4 : 5;
    bf16x8 cfr[4][4];
    { const bf16_t* Cg = p.MC() + (size_t)u * 16384;
#pragma unroll
        for (int i = 0; i < 4; ++i)
#pragma unroll
            for (int ks = 0; ks < 4; ++ks) cfr[i][ks] = *(const bf16x8*)(Cg + ((vh * 4 + i) * 16 + r) * 128 + ks * 32 + q * 8); }
    if (tid < 128) nS[tid] = R.n.x;
    if (w == 0) { const int s = lane; const float bb = R.g.x, aa = R.g.y, pm = R.g.z, m0 = R.g.w, M = fmaxf(m0, pm);
        aS[s] = aa; MS[s] = M; wiS[s] = fexp(m0 - M); emtS[s] = fexp(-(bb + M)); }
#pragma unroll
    for (int it = 0; it < 4; ++it) { const int item = tid + it * NTHR, which = item >> 10, s = (item >> 4) & 63, ch8 = item & 15; *(LAS u32x4*)((which ? KS : QS) + s * SQ + ch8 * 16) = R.qk[it]; }
    { const int s0 = 2 * (tid >> 4), v8 = tid & 15; float x0[8], x1[8]; unpack8(R.v[0], x0); unpack8(R.v[1], x1);
        const float w0 = ((c > 0) || (s0 >= LEAD)) ? 1.f : 0.f, w1 = ((c > 0) || (s0 + 1 >= LEAD)) ? 1.f : 0.f;
#pragma unroll
        for (int q = 0; q < 8; ++q) *(LAS unsigned*)(VT + tsw(v8 * 8 + q, s0)) = cvt_pk_bf16(x0[q] * w0, x1[q] * w1); }
    for (int i = tid; i < 16 * 64; i += NTHR) { const int row = 128 + (i >> 6), s = i & 63; *(LAS bf16_t*)(VT + tsw(row, s)) = (row == 128) ? (bf16_t)0x3f80 : (bf16_t)0; }
    if (unext >= 0) load_o(p, unext, R, tid);
    LDS_BARRIER();
    f32x4 acc2[5];
    { bf16x8 qb[4];
#pragma unroll
        for (int ks = 0; ks < 4; ++ks) qb[ks] = ldfrag(QS + (tt * 16 + r) * SQ + (ks * 32 + q * 8) * 2);
#pragma unroll
        for (int i = 0; i < 5; ++i) { acc2[i] = (f32x4){0.f, 0.f, 0.f, 0.f}; if (i < nvt) {
#pragma unroll
            for (int ks = 0; ks < 4; ++ks) { bf16x8 afr;
                if (i < 4) afr = cfr[i][ks];
                else { const f32x4 n0 = *(const LAS f32x4*)(nS + ks * 32 + q * 8), n1 = *(const LAS f32x4*)(nS + ks * 32 + q * 8 + 4); const float mk = (r == 0) ? 1.f : 0.f;
                    const float nn[8] = {n0.x * mk, n0.y * mk, n0.z * mk, n0.w * mk, n1.x * mk, n1.y * mk, n1.z * mk, n1.w * mk};
                    afr = __builtin_bit_cast(bf16x8, pack8(nn)); }
                acc2[i] = mfma16(afr, qb[ks], acc2[i]); } } }
        const float Mt = MS[t];
#pragma unroll
        for (int cc = 0; cc < 2; ++cc) { const int st = vh * 2 + cc; f32x4 acc = {0.f, 0.f, 0.f, 0.f};
            if (st <= tt) {
#pragma unroll
                for (int ks = 0; ks < 4; ++ks) acc = mfma16(ldfrag(KS + (st * 16 + r) * SQ + (ks * 32 + q * 8) * 2), qb[ks], acc); }
            float sv[4];
#pragma unroll
            for (int j = 0; j < 4; ++j) { const int s = st * 16 + q * 4 + j; sv[j] = (s <= t) ? acc[j] * fexp(aS[s] - Mt) : 0.f; }
            u32x2 o; o.x = cvt_pk_bf16(sv[0], sv[1]); o.y = cvt_pk_bf16(sv[2], sv[3]); *(LAS u32x2*)(SS + t * ST + (st * 16 + q * 4) * 2) = o; } }
    LDS_BARRIER();
    f32x4 hv[5];
    { bf16x8 sb[2];
#pragma unroll
        for (int ks = 0; ks < 2; ++ks) sb[ks] = ldfrag(SS + (tt * 16 + r) * ST + (ks * 32 + q * 8) * 2);
        const float wi = wiS[t];
#pragma unroll
        for (int i = 0; i < 5; ++i) { if (i < nvt) { const int vt = (i < 4) ? vh * 4 + i : 8; f32x4 a1 = {0.f, 0.f, 0.f, 0.f};
#pragma unroll
            for (int ks = 0; ks < 2; ++ks) a1 = mfma16(ldfrag(VT + tfr(vt * 16 + r, ks * 4 + q)), sb[ks], a1);
            hv[i] = a1 + acc2[i] * wi; } }
        if (vh == 0 && q == 0) denS[t] = hv[4][0]; }
    u32x2 og[4]; f32x4 gn[4];
#pragma unroll
    for (int i = 0; i < 4; ++i) { const int v0 = (vh * 4 + i) * 16 + q * 4; og[i] = *(const u32x2*)(z + (size_t)(r0 + t) * NIN + ZO_OM + hd * 128 + v0); gn[i] = *(const f32x4*)(p.m_norm_g + l * 512 + hd * 128 + v0); }
    LDS_BARRIER();
    { const float dn = frcp(fmaxf(fabsf(denS[t]), emtS[t])); float ssq = 0.f;
#pragma unroll
        for (int i = 0; i < 4; ++i) { hv[i] = hv[i] * dn; ssq += hv[i][0] * hv[i][0] + hv[i][1] * hv[i][1] + hv[i][2] * hv[i][2] + hv[i][3] * hv[i][3]; }
        ssq += __shfl_xor(ssq, 16); ssq += __shfl_xor(ssq, 32); if (q == 0) part[t * 2 + vh] = ssq; }
    LDS_BARRIER();
    { const bool valid = (c > 0) || (t >= LEAD); const float sc = frsq((part[t * 2] + part[t * 2 + 1]) * (1.f / 128.f) + EPS); bf16_t* yp = p.Z() + (size_t)(r0 + t) * NIN + ZO_OM + hd * 128;
#pragma unroll
        for (int i = 0; i < 4; ++i) { const int v0 = (vh * 4 + i) * 16 + q * 4; float y[4];
            y[0] = hv[i][0] * sc * gn[i][0] * fsigm(bflo(og[i].x)); y[1] = hv[i][1] * sc * gn[i][1] * fsigm(bfhi(og[i].x)); y[2] = hv[i][2] * sc * gn[i][2] * fsigm(bflo(og[i].y)); y[3] = hv[i][3] * sc * gn[i][3] * fsigm(bfhi(og[i].y));
            u32x2 o; o.x = valid ? cvt_pk_bf16(y[0], y[1]) : 0u; o.y = valid ? cvt_pk_bf16(y[2], y[3]) : 0u; *(u32x2*)(yp + v0) = o; } }
    LDS_BARRIER();
}

__device__ __forceinline__ void gla_out(const P& p, int l, int u, LAS unsigned char* lds, int tid, PreG& R, int unext) {
    asm volatile("" : "+v"(tid));
    const int lane = tid & 63, w = __builtin_amdgcn_readfirstlane(tid >> 6), c = u % NCH, hd = (u / NCH) & 3, b = u / (NCH * 4), r0 = chunk_row0(b, c);
    const bf16_t* z = p.Z();
    LAS float* LA = (LAS float*)lds; LAS float* segtot = (LAS float*)(lds + 16640); LAS unsigned char* QT = lds + 18688; LAS unsigned char* KT2 = lds + 27904; LAS unsigned char* VT = lds + 37120; LAS unsigned char* AS = lds + 55552;
    LAS float* cod = (LAS float*)(lds + 64768); LAS float* aw = (LAS float*)(lds + 68864); LAS float* ab = (LAS float*)(lds + 72960); LAS float* part = (LAS float*)(lds + 73216);
    const int r = lane & 15, q = lane >> 4, tt = w & 3, dh = w >> 2, t = tt * 16 + r;
    bf16x8 sfr[4][2];
    { const bf16_t* Sg = p.GS() + (size_t)u * 8192;
#pragma unroll
        for (int i = 0; i < 4; ++i)
#pragma unroll
            for (int ks = 0; ks < 2; ++ks) sfr[i][ks] = *(const bf16x8*)(Sg + ((dh * 4 + i) * 16 + r) * 64 + ks * 32 + q * 8); }
    gla_cumdecay(p, l, hd, R, c, LA, segtot, cod, aw, ab, tid);
    { const int s = tid >> 3, j8 = tid & 7; const bool valid = (c > 0) || (s >= LEAD); float xq[8], xk[8];
        unpack8(R.q, xq); unpack8(R.k, xk);
#pragma unroll
        for (int q = 0; q < 8; ++q) { const float bb = LA[s * 65 + j8 * 8 + q]; xq[q] = valid ? xq[q] * 0.125f * fexp(bb) : 0.f; xk[q] = valid ? xk[q] * fexp(-bb) : 0.f; }
        *(LAS u32x4*)(QT + s * ST + j8 * 16) = pack8(xq); *(LAS u32x4*)(KT2 + s * ST + j8 * 16) = pack8(xk); }
    { const int s0 = 2 * (tid >> 4), v8 = tid & 15; float x0[8], x1[8]; unpack8(R.v[0], x0); unpack8(R.v[1], x1);
        const float w0 = ((c > 0) || (s0 >= LEAD)) ? 1.f : 0.f, w1 = ((c > 0) || (s0 + 1 >= LEAD)) ? 1.f : 0.f;
#pragma unroll
        for (int q = 0; q < 8; ++q) *(LAS unsigned*)(VT + tsw(v8 * 8 + q, s0)) = cvt_pk_bf16(x0[q] * w0, x1[q] * w1); }
    if (unext >= 0) load_g(p, l, unext, R, tid, true);
    LDS_BARRIER();
    f32x4 hv[4];
    { bf16x8 qb[2];
#pragma unroll
        for (int ks = 0; ks < 2; ++ks) qb[ks] = ldfrag(QT + (tt * 16 + r) * ST + (ks * 32 + q * 8) * 2);
#pragma unroll
        for (int i = 0; i < 4; ++i) { hv[i] = (f32x4){0.f, 0.f, 0.f, 0.f};
#pragma unroll
            for (int ks = 0; ks < 2; ++ks) hv[i] = mfma16(sfr[i][ks], qb[ks], hv[i]); }
#pragma unroll
        for (int cc = 0; cc < 2; ++cc) { const int st = dh * 2 + cc; f32x4 acc = {0.f, 0.f, 0.f, 0.f};
            if (st <= tt) {
#pragma unroll
                for (int ks = 0; ks < 2; ++ks) acc = mfma16(ldfrag(KT2 + (st * 16 + r) * ST + (ks * 32 + q * 8) * 2), qb[ks], acc); }
            float sv[4];
#pragma unroll
            for (int j = 0; j < 4; ++j) { const int s = st * 16 + q * 4 + j; sv[j] = (s <= t) ? acc[j] : 0.f; }
            u32x2 o; o.x = cvt_pk_bf16(sv[0], sv[1]); o.y = cvt_pk_bf16(sv[2], sv[3]); *(LAS u32x2*)(AS + t * ST + (st * 16 + q * 4) * 2) = o; } }
    u32x2 og[4]; f32x4 gn[4];
#pragma unroll
    for (int i = 0; i < 4; ++i) { const int d0 = (dh * 4 + i) * 16 + q * 4; og[i] = *(const u32x2*)(z + (size_t)(r0 + t) * NIN + ZO_GG + hd * 128 + d0); gn[i] = *(const f32x4*)(p.g_norm_g + l * 512 + hd * 128 + d0); }
    LDS_BARRIER();
    { bf16x8 ab2[2];
#pragma unroll
        for (int ks = 0; ks < 2; ++ks) ab2[ks] = ldfrag(AS + (tt * 16 + r) * ST + (ks * 32 + q * 8) * 2);
        float ssq = 0.f;
#pragma unroll
        for (int i = 0; i < 4; ++i) { const int dt = dh * 4 + i;
#pragma unroll
            for (int ks = 0; ks < 2; ++ks) hv[i] = mfma16(ldfrag(VT + tfr(dt * 16 + r, ks * 4 + q)), ab2[ks], hv[i]);
            ssq += hv[i][0] * hv[i][0] + hv[i][1] * hv[i][1] + hv[i][2] * hv[i][2] + hv[i][3] * hv[i][3]; }
        ssq += __shfl_xor(ssq, 16); ssq += __shfl_xor(ssq, 32); if (q == 0) part[t * 2 + dh] = ssq; }
    LDS_BARRIER();
    { const bool valid = (c > 0) || (t >= LEAD); const float sc = frsq((part[t * 2] + part[t * 2 + 1]) * (1.f / 128.f) + EPS); bf16_t* yp = p.Z() + (size_t)(r0 + t) * NIN + ZO_GG + hd * 128;
#pragma unroll
        for (int i = 0; i < 4; ++i) { const int d0 = (dh * 4 + i) * 16 + q * 4; float y[4];
            y[0] = hv[i][0] * sc * gn[i][0] * fsilu(bflo(og[i].x)); y[1] = hv[i][1] * sc * gn[i][1] * fsilu(bfhi(og[i].x)); y[2] = hv[i][2] * sc * gn[i][2] * fsilu(bflo(og[i].y)); y[3] = hv[i][3] * sc * gn[i][3] * fsilu(bfhi(og[i].y));
            u32x2 o; o.x = valid ? cvt_pk_bf16(y[0], y[1]) : 0u; o.y = valid ? cvt_pk_bf16(y[2], y[3]) : 0u; *(u32x2*)(yp + d0) = o; } }
    LDS_BARRIER();
}
}

namespace pro {
#define PRO_TILE(LD4, GK, OUTROW) do { \
        f32x4 v_[8]; \
        _Pragma("unroll") for (int i = 0; i < 8; ++i) { const int kk = 8 * i + (lane >> 3); v_[i] = (LD4); } \
        _Pragma("unroll") for (int i = 0; i < 8; ++i) { const int kk = 8 * i + (lane >> 3); const float g_ = (GK); LAS float* d_ = scr + kk * 33 + (lane & 7) * 4; d_[0] = v_[i].x * g_; d_[1] = v_[i].y * g_; d_[2] = v_[i].z * g_; d_[3] = v_[i].w * g_; } \
        asm volatile("s_waitcnt lgkmcnt(0)" ::: "memory"); \
        { const int c8 = lane & 7; _Pragma("unroll") for (int j = 0; j < 4; ++j) { const int nn = (lane >> 3) + 8 * j; const LAS float* s_ = scr + (8 * c8) * 33 + nn; \
            pg8::u32x4 o_; o_.x = pg8::cvt_pk_bf16(s_[0], s_[33]); o_.y = pg8::cvt_pk_bf16(s_[66], s_[99]); o_.z = pg8::cvt_pk_bf16(s_[132], s_[165]); o_.w = pg8::cvt_pk_bf16(s_[198], s_[231]); \
            *(pg8::u32x4*)((OUTROW) + 8 * c8) = o_; } } \
        asm volatile("s_waitcnt lgkmcnt(0)" ::: "memory"); } while (0)
#define PRO_TILE8(LD4, GK, OUTROW8) do { \
        f32x4 v_[8]; \
        _Pragma("unroll") for (int i = 0; i < 8; ++i) { const int kk = 8 * i + (lane >> 3); v_[i] = (LD4); } \
        _Pragma("unroll") for (int i = 0; i < 8; ++i) { const int kk = 8 * i + (lane >> 3); const float g_ = (GK); LAS float* d_ = scr + kk * 33 + (lane & 7) * 4; d_[0] = v_[i].x * g_; d_[1] = v_[i].y * g_; d_[2] = v_[i].z * g_; d_[3] = v_[i].w * g_; } \
        asm volatile("s_waitcnt lgkmcnt(0)" ::: "memory"); \
        { const int c8 = lane & 7; _Pragma("unroll") for (int j = 0; j < 4; ++j) { const int nn = (lane >> 3) + 8 * j; const LAS float* s_ = scr + (8 * c8) * 33 + nn; \
            pg8::u32x2 o_; o_.x = pg8::pk_fp8x4(s_[0], s_[33], s_[66], s_[99]); o_.y = pg8::pk_fp8x4(s_[132], s_[165], s_[198], s_[231]); \
            *(pg8::u32x2*)((OUTROW8) + 8 * c8) = o_; } } \
        asm volatile("s_waitcnt lgkmcnt(0)" ::: "memory"); } while (0)
__device__ __forceinline__ void prologue_phase(const P& p, LAS unsigned char* lds, int G, int bid, int tid) {
    asm volatile("" : "+v"(tid));
    const int lane = tid & 63, w = __builtin_amdgcn_readfirstlane(tid >> 6), gw = bid * NWAVES + w, NGW = G * NWAVES;
    LAS float* scr = (LAS float*)(lds + w * 8448);
    constexpr int I_IN = DEPTH * 16 * (NZP / 32), I_OUT = DEPTH * 16 * (D / 32), I_GU = DEPTH * NE * 16 * (512 / 32), I_D = DEPTH * NE * (DE / 64) * (D / 32);
    const f32x4 zero4 = {0.f, 0.f, 0.f, 0.f};
    for (int it = gw; it < I_IN + I_OUT + I_GU + I_D; it += NGW) {
        int r = it;
        if (r < I_IN) { const int nb = r % (NZP / 32), kb = (r / (NZP / 32)) % 16, l = r / (16 * (NZP / 32)), k0 = kb * 64, n0 = nb * 32;
            const int n = n0 + (lane & 7) * 4; const float* src = p.w_in + ((size_t)l * D + k0) * NIN + zsrc(n); const float* g = p.norm1_g + l * D + k0;
            bf16_t* ob = (bf16_t*)(p.ws + WS_WIN) + ((size_t)l * NZP + n0) * D + k0;
            PRO_TILE((n < NIN) ? *(const f32x4*)(src + (size_t)kk * NIN) : zero4, g[kk], ob + (size_t)nn * D);
            continue; }
        r -= I_IN;
        if (r < I_OUT) { const int nb = r % 32, kb = (r / 32) % 16, l = r / 512, k0 = kb * 64, n0 = nb * 32;
            const float* src = p.w_out + ((size_t)l * D + k0) * D + n0 + (lane & 7) * 4; bf16_t* ob = (bf16_t*)(p.ws + WS_WOUT) + ((size_t)l * D + n0) * D + k0;
            PRO_TILE(*(const f32x4*)(src + (size_t)kk * D), 1.f, ob + (size_t)nn * D);
            continue; }
        r -= I_OUT;
        if (r < I_GU) { const int nb = r % 16, kb = (r / 16) % 16, bz = r / 256, k0 = kb * 64, n0 = nb * 32;
            const int i4 = (lane & 7) * 4; const float* src = ((i4 < 16) ? p.w_gate : p.w_up) + ((size_t)bz * D + k0) * DE + 16 * nb + (i4 & 15); const float* g = p.norm2_g + (bz >> 5) * D + k0;
            unsigned char* ob8 = p.ws + WS_WGU + ((size_t)bz * 512 + n0) * D + k0;
            PRO_TILE8(*(const f32x4*)(src + (size_t)kk * DE), g[kk] * 16.f, ob8 + (size_t)nn * D);
            continue; }
        r -= I_GU;
        { const int nb = r % 32, kb = (r / 32) % 4, bz = r / 128, k0 = kb * 64, n0 = nb * 32;
            const float* src = p.w_down + ((size_t)bz * DE + k0) * D + n0 + (lane & 7) * 4; unsigned char* ob8 = p.ws + WS_WD + ((size_t)bz * D + n0) * DE + k0;
            PRO_TILE8(*(const f32x4*)(src + (size_t)kk * D), 8.f, ob8 + (size_t)nn * DE); }
    }
    for (int idx = bid * NTHR + tid; idx < DEPTH * 48 * D; idx += G * NTHR) { const int k = idx % D, o = (idx / D) % 48, l = idx / (D * 48); float v = 0.f;
        if (o < 4) v = p.wr_g[((size_t)l * D + k) * 4 + o]; else if (o < 36) v = p.wr_e[((size_t)l * D + k) * 32 + (o - 4)];
        v *= p.norm2_g[l * D + k]; const bf16_t hi = f2bf(v), lo = f2bf(v - bf2f(hi));
        bf16_t* wh = (bf16_t*)(p.ws + WS_WRS); wh[idx] = hi; wh[(size_t)DEPTH * 48 * D + idx] = lo; }
    for (int r = gw; r < MP; r += NGW) { const float* src = nullptr;
        if (r < XR) src = p.x + (size_t)r * D; else if (((r - XR) & 63) >= LEAD) src = p.meta + (size_t)(((r - XR) & 63) - LEAD) * D;
        float s = 0.f; bf16_t* hr = p.H() + (size_t)r * D;
#pragma unroll
        for (int j = 0; j < 4; ++j) { f32x4 v = {0.f, 0.f, 0.f, 0.f}; if (src) v = ((const f32x4*)src)[lane + 64 * j];
            s += v.x * v.x + v.y * v.y + v.z * v.z + v.w * v.w;
            pg8::u32x2 o; o.x = pg8::cvt_pk_bf16(v.x, v.y); o.y = pg8::cvt_pk_bf16(v.z, v.w); ((pg8::u32x2*)hr)[lane + 64 * j] = o; }
        s = wave_sum(s);
        if (lane == 0) { f32x4 q = {s, 0.f, 0.f, 0.f}; *(f32x4*)(p.SS1() + (size_t)r * 4) = q; } }
}
#undef PRO_TILE
#undef PRO_TILE8
__device__ __forceinline__ void final_phase(const P& p, int G, int bid, int tid) {
    asm volatile("" : "+v"(tid));
    const int lane = tid & 63, w = tid >> 6;
    for (int t = bid * NWAVES + w; t < B * SEQ; t += G * NWAVES) { const int r = t;
        const float rs = row_rs(p.SS1(), r); const bf16_t* hr = p.H() + (size_t)r * D; float* o = p.out + (size_t)t * D;
#pragma unroll
        for (int j = 0; j < 4; ++j) { const pg8::u32x2 hv = ((const pg8::u32x2*)hr)[lane + 64 * j]; const f32x4 g = ((const f32x4*)p.final_g)[lane + 64 * j];
            f32x4 v; v.x = pg8::bflo(hv.x) * rs * g.x; v.y = pg8::bfhi(hv.x) * rs * g.y; v.z = pg8::bflo(hv.y) * rs * g.z; v.w = pg8::bfhi(hv.y) * rs * g.w;
            ((f32x4*)o)[lane + 64 * j] = v; } }
}
}

struct Args { P p; int ph_lo, ph_hi; };
__global__ void __launch_bounds__(NTHR, 2) fwd(Args a) {
    extern __shared__ __attribute__((aligned(16))) unsigned char lds_raw[];
    LAS unsigned char* lds = (LAS unsigned char*)lds_raw;
    const P& p = a.p;
    const int tid = threadIdx.x, G = gridDim.x, bid = blockIdx.x;
    unsigned* ctl = (unsigned*)(p.ws + WS_CTL);
    volatile LAS unsigned* MISC = (volatile LAS unsigned*)(lds + MISC_OFF);
    if (tid < 128) MISC[tid] = 0u;
    __syncthreads();
    const bool multi = (a.ph_hi - a.ph_lo) > 1;
    XcdBarrier bar; bar.bar = ctl + CW_BAR; bar.x = 0; bar.st = nullptr;
    if (multi) bar = xcd_barrier_post(ctl + CW_BAR, MISC + 8);
#define IN(k) (a.ph_lo <= (k) && (k) < a.ph_hi)
#define SEAM(k) do { if (IN(k) && IN((k) + 1)) xcd_barrier(bar); } while (0)
    if (IN(PH_PRO)) {
pro::prologue_phase(p, lds, G, bid, tid); }
    SEAM(PH_PRO);
    for (int l = 0; l < DEPTH; ++l) {
        const int pb = PH_LAYER0 + l * PH_PER_LAYER;
        unsigned* gcnt = ctl + CW_CNT + l * 64 * 16;
        if (IN(pb + 0)) {
{
            pg8::DenseOrderRS<D, D> S; S.init(MP, NZP, G, bid); S.lds = lds; S.ws = p.ws;
            pg8::EpiZ E{p.ws, lds};
            pg8::gemm_phase<pg8::EpiZ, pg8::DenseOrderRS<D, D>, true, D, D>(lds + RING_OFF, (const char*)(p.ws + WS_H), (const char*)(p.ws + WS_WIN) + (size_t)l * NZP * D * 2, S, E);
            }
        }
        SEAM(pb + 0);
        if (IN(pb + 1)) {
{ { const int ulo = (int)((long)bid * NU / G), uhi = (int)((long)(bid + 1) * NU / G);
                if (ulo < uhi) { mx::PreM<4> pre; mx::load_m<4>(p, ulo, pre, tid, ZO_VM); for (int u = ulo; u < uhi; ++u) mx::mlstm_local(p, l, u, lds, tid, pre, u + 1 < uhi ? u + 1 : -1); }
                { const int glo = (int)((long)(G - 1 - bid) * NU / G), ghi = (int)((long)(G - bid) * NU / G);
                if (glo < ghi) { mx::PreG pre; mx::load_g(p, l, glo, pre, tid, false); for (int u = glo; u < ghi; ++u) mx::gla_local(p, l, u, lds, tid, pre, u + 1 < ghi ? u + 1 : -1); } } } } }
        SEAM(pb + 1);
        if (IN(pb + 2)) mx::scan_phase(p, lds, G, bid, tid);
        SEAM(pb + 2);
        if (IN(pb + 3)) { { const int ulo = (int)((long)bid * NU / G), uhi = (int)((long)(bid + 1) * NU / G);
                if (ulo < uhi) { mx::PreO pre; mx::load_o(p, ulo, pre, tid); for (int u = ulo; u < uhi; ++u) mx::mlstm_out(p, l, u, lds, tid, pre, u + 1 < uhi ? u + 1 : -1); }
                { const int glo = (int)((long)(G - 1 - bid) * NU / G), ghi = (int)((long)(G - bid) * NU / G);
                if (glo < ghi) { mx::PreG pre; mx::load_g(p, l, glo, pre, tid, true); for (int u = glo; u < ghi; ++u) mx::gla_out(p, l, u, lds, tid, pre, u + 1 < ghi ? u + 1 : -1); } } } }
        SEAM(pb + 3);
        if (IN(pb + 4)) {
            pg8::DenseOrder<NIN, D> S; S.init(XR, D, G, bid);
            pg8::EpiRes<false, false, WS_SS2, true> E{p.ws, lds};
            pg8::gemm_phase<pg8::EpiRes<false, false, WS_SS2, true>, pg8::DenseOrder<NIN, D>, true, NIN, D>(lds + RING_OFF, (const char*)(p.ws + WS_Z), (const char*)(p.ws + WS_WOUT) + (size_t)l * D * D * 2, S, E);
            int tl_ = tid; asm volatile("" : "+v"(tl_));
            if (tl_ < 64) { const int lane = tl_, r = lane & 15, q = lane >> 4; const bf16_t* wo = p.Wout() + (size_t)l * D * D;
                for (int tt = bid; tt < 4 * (D / 16); tt += G) { const int b4 = tt / (D / 16), ct = tt % (D / 16), row0 = XR + b4 * 64 + LEAD;
                    const bf16_t* ap = p.Z() + (size_t)(row0 + r) * NIN + q * 8; const bf16_t* bp = wo + (size_t)(ct * 16 + r) * D + q * 8; f32x4 acc = {0.f, 0.f, 0.f, 0.f};
#pragma unroll 8
                    for (int ks = 0; ks < 32; ++ks) acc = __builtin_amdgcn_mfma_f32_16x16x32_bf16(*(const pg8::bf16x8*)(ap + ks * 32), *(const pg8::bf16x8*)(bp + ks * 32), acc, 0, 0, 0);
#pragma unroll
                    for (int j = 0; j < 4; ++j) { const size_t o = (size_t)(row0 + q * 4 + j) * D + ct * 16 + r; const float v = bf2f(p.H()[o]) + acc[j];
                        p.H()[o] = (bf16_t)(pg8::cvt_pk_bf16(v, 0.f) & 0xffffu); (p.ws + WS_H8)[o] = (unsigned char)(pg8::pk_fp8x4(v, 0.f, 0.f, 0.f) & 0xffu); } } }
        }
        SEAM(pb + 4);
        if (IN(pb + 5)) route_phase(p, l, lds, G, bid, gcnt);
        SEAM(pb + 5);
        if (IN(pb + 6)) {
{
            moe_build_tab((LAS MoeTab*)(lds + TAB_OFF), gcnt);
            typedef MoeOrder<true, 2, D / 2, D / 2, 512u * D> Ord;
            Ord S; S.lds = lds; S.ws = p.ws; S.rbLo = 0; S.nwg = ((const LAS MoeTab*)(lds + TAB_OFF))->rb0[64] * 2; S.G = G; S.c = bid;
            pg8::EpiUp E{p.ws, lds};
            pg8::gemm_phase<pg8::EpiUp, Ord, true, D / 2, D / 2, true>(lds + RING_OFF, (const char*)(p.ws + WS_H8), (const char*)(p.ws + WS_WGU) + (size_t)l * NE * 512 * D, S, E);
            }
        }
        SEAM(pb + 6);
#pragma unroll
        for (int rank = 0; rank < 2; ++rank) {
            if (IN(pb + 7 + rank)) {
                moe_build_tab((LAS MoeTab*)(lds + TAB_OFF), gcnt);
                const LAS MoeTab* T = (const LAS MoeTab*)(lds + TAB_OFF);
                typedef MoeOrder<false, 4, DE / 2, DE / 2, (unsigned)D * DE> Ord;
                Ord S; S.lds = lds; S.ws = p.ws; S.rbLo = T->rb0[32 * rank]; S.nwg = (T->rb0[32 * rank + 32] - T->rb0[32 * rank]) * 4; S.G = G; S.c = bid;
                const char* Ab = (const char*)(p.ws + WS_HID); const char* Bb = (const char*)(p.ws + WS_WD) + (size_t)l * NE * D * DE;
                if (rank == 0) { pg8::EpiRes<true, false, WS_SS1> E{p.ws, lds}; pg8::gemm_phase<pg8::EpiRes<true, false, WS_SS1>, Ord, true, DE / 2, DE / 2, true>(lds + RING_OFF, Ab, Bb, S, E); }
                else { pg8::EpiRes<true, true, WS_SS1> E{p.ws, lds}; pg8::gemm_phase<pg8::EpiRes<true, true, WS_SS1>, Ord, true, DE / 2, DE / 2, true>(lds + RING_OFF, Ab, Bb, S, E); }
            }
            SEAM(pb + 7 + rank);
        }
    }
    if (IN(PH_FINAL)) pro::final_phase(p, G, bid, tid);
#undef IN
#undef SEAM
}

extern "C" void kernel_launch(void* const* d_in, const int* in_sizes, int n_in, void* d_out, int out_size, void* d_ws, size_t ws_size, hipStream_t stream) {
    if (n_in != 21 || ws_size < WS_END || out_size != B * SEQ * D) { fprintf(stderr, "kernel_launch: unexpected sizes n_in %d ws %zu (need %zu) out %d\n", n_in, ws_size, (size_t)WS_END, out_size); return; }
    P p{};
    const float** f = (const float**)&p.x;
    for (int i = 0; i < 21; ++i) f[i] = (const float*)d_in[i];
    p.out = (float*)d_out; p.ws = (unsigned char*)d_ws;
    static int grid = 0;
    if (!grid) {
        (void)hipFuncSetAttribute((const void*)fwd, hipFuncAttributeMaxDynamicSharedMemorySize, LDS_BYTES);
        int dev = 0, cus = 0, per_cu = 0;
        (void)hipGetDevice(&dev); (void)hipDeviceGetAttribute(&cus, hipDeviceAttributeMultiprocessorCount, dev);
        (void)hipOccupancyMaxActiveBlocksPerMultiprocessor(&per_cu, (const void*)fwd, NTHR, LDS_BYTES);
        (void)hipGetLastError();
        grid = cus > 0 ? cus : 256;
        if (per_cu < 1) fprintf(stderr, "kernel_launch: occupancy query reports %d blocks/CU for fwd\n", per_cu);
    }
    (void)hipMemsetAsync(d_ws, 0, CTL_BYTES, stream);
    Args a{}; a.p = p; a.ph_lo = 0; a.ph_hi = PH_COUNT;
    hipLaunchKernelGGL(fwd, dim3(grid), dim3(NTHR), LDS_BYTES, stream, a);
}
```

```cpp
#include <hip/hip_runtime.h>
#include <cstdio>
#include <cstdint>

typedef unsigned short bf16_t;
typedef float f32x4 __attribute__((ext_vector_type(4)));

namespace cfg {
constexpr int B = 4, SEQ = 8192, D = 1024, DEPTH = 2;
constexpr int CH = 64, NMETA = 16, LEAD = 48;
constexpr int TP = LEAD + NMETA + SEQ;
constexpr int NCH = TP / CH;
constexpr int MP = B * TP;
constexpr int XR = B * SEQ;
constexpr int NIN = 3608, NZP = 3840;
constexpr int ZO_OM = 0, ZO_GG = 512, ZO_QM = 1024, ZO_KM = 1536, ZO_VM = 2048, ZO_QG = 2560, ZO_KG = 2816, ZO_VG = 3072, ZO_IG = 3584, ZO_FG = 3588, ZO_CODE = 3592;
constexpr int NE = 32, DE = 256, NR = 40;
constexpr float EPS = 1e-6f;
constexpr int NU = B * 4 * NCH;

constexpr size_t al(size_t x) { return (x + 255) & ~(size_t)255; }
constexpr size_t WS_CTL = 0, CTL_BYTES = 4u << 20;
constexpr size_t WS_WIN = WS_CTL + CTL_BYTES;
constexpr size_t WS_WOUT = WS_WIN + al((size_t)DEPTH * NZP * D * 2);
constexpr size_t WS_WGU = WS_WOUT + al((size_t)DEPTH * D * D * 2);
constexpr size_t WS_H8 = WS_WGU + al((size_t)DEPTH * NE * 512 * D);
constexpr size_t WS_WD = WS_H8 + al((size_t)MP * D);
constexpr size_t WS_WR = WS_WD + al((size_t)DEPTH * NE * D * DE * 2);
constexpr size_t WS_H = WS_WR + al((size_t)DEPTH * NR * D * 4);
constexpr size_t WS_Z = WS_H + al((size_t)MP * D * 2);
constexpr size_t WS_SS1 = WS_Z + al((size_t)MP * NIN * 2);
constexpr size_t WS_SS2 = WS_SS1 + al((size_t)MP * 16);
constexpr size_t WS_TOKE = WS_SS2 + al((size_t)MP * 16);
constexpr size_t WS_TOKW = WS_TOKE + al((size_t)MP * 8);
constexpr int CAPL = MP, NBMAX = 352;
constexpr size_t WS_LTOK = WS_TOKW + al((size_t)MP * 8);
constexpr size_t WS_LRS = WS_LTOK + al((size_t)64 * CAPL * 4);
constexpr size_t WS_LW = WS_LRS + al((size_t)64 * CAPL * 4);
constexpr size_t WS_WRS = WS_LW + al((size_t)64 * CAPL * 4);
constexpr size_t WS_QKC = WS_WRS + al((size_t)2 * DEPTH * 48 * D * 2);
constexpr size_t WS_END = WS_QKC + al((size_t)MP * 1024 * 2);
constexpr size_t WS_HID = WS_QKC;
static_assert((size_t)NBMAX * 256 * 256 * 2 <= (size_t)MP * 1024 * 2, "hid fits in the q|k buffer");
constexpr size_t ST_MC = 0;
constexpr size_t ST_GS = ST_MC + al((size_t)NU * 16384 * 2);
constexpr size_t ST_MN = ST_GS + al((size_t)NU * 8192 * 2);
constexpr size_t ST_MSC = ST_MN + al((size_t)NU * 128 * 4);
constexpr size_t ST_GB = ST_MSC + al((size_t)NU * 16);
constexpr size_t ST_GA = ST_GB + al((size_t)NU * 64 * 4);
constexpr size_t ST_END = ST_GA + al((size_t)NU * 192 * 4);
static_assert(ST_END <= (size_t)B * SEQ * D * 4, "state scratch fits d_out");
}
using namespace cfg;

__device__ __forceinline__ float bf2f(bf16_t v) { return __uint_as_float(((unsigned)v) << 16); }
__device__ __forceinline__ bf16_t f2bf(float f) { unsigned u = __float_as_uint(f); u += 0x7fffu + ((u >> 16) & 1u); return (bf16_t)(u >> 16); }
__device__ __forceinline__ float wave_sum(float v) {
#pragma unroll
    for (int o = 1; o < 64; o <<= 1) v += __shfl_xor(v, o);
    return v;
}
__device__ __forceinline__ float logsig(float x) { return fminf(x, 0.f) - log1pf(__expf(-fabsf(x))); }
__device__ __forceinline__ float sigm(float x) { return 1.f / (1.f + __expf(-x)); }
__device__ __forceinline__ float silu(float x) { return x * sigm(x); }

__host__ __device__ __forceinline__ int zsrc(int n) {
    if (n < 512) return 1536 + n;
    if (n < 1024) return 3080 + (n - 512);
    if (n < 2048) return n - 1024;
    if (n < 2560) return 1024 + (n - 2048);
    if (n < 2816) return 2056 + (n - 2560);
    if (n < 3072) return 2312 + (n - 2816);
    if (n < 3584) return 2568 + (n - 3072);
    if (n < 3588) return 2048 + (n - 3584);
    if (n < 3592) return 2052 + (n - 3588);
    return n;
}

struct P {
    const float *x, *meta, *norm1_g, *w_in, *conv_w, *conv_b, *gate_b, *m_norm_g, *a_w2, *a_b, *g_norm_g, *w_out, *norm2_g, *wr_g, *br_g, *wr_e, *br_e, *w_gate, *w_up, *w_down, *final_g;
    float* out; unsigned char* ws;
    __device__ __forceinline__ bf16_t* Win() const { return (bf16_t*)(ws + WS_WIN); }
    __device__ __forceinline__ bf16_t* Wout() const { return (bf16_t*)(ws + WS_WOUT); }
    __device__ __forceinline__ bf16_t* Wgu() const { return (bf16_t*)(ws + WS_WGU); }
    __device__ __forceinline__ bf16_t* Wd() const { return (bf16_t*)(ws + WS_WD); }
    __device__ __forceinline__ bf16_t* H() const { return (bf16_t*)(ws + WS_H); }
    __device__ __forceinline__ bf16_t* Z() const { return (bf16_t*)(ws + WS_Z); }
    __device__ __forceinline__ float* SS1() const { return (float*)(ws + WS_SS1); }
    __device__ __forceinline__ float* SS2() const { return (float*)(ws + WS_SS2); }
    __device__ __forceinline__ bf16_t* MC() const { return (bf16_t*)((unsigned char*)out + ST_MC); }
    __device__ __forceinline__ float* RA(int slot) const { return (float*)((unsigned char*)out + ST_MC) + (size_t)slot * 16512; }
    __device__ __forceinline__ float* RS(int slot) const { return (float*)((unsigned char*)out + ST_MC) + (size_t)(512 + slot) * 16512; }
    __device__ __forceinline__ float* RAg(int slot) const { return (float*)((unsigned char*)out + ST_GS) + (size_t)slot * 8192; }
    __device__ __forceinline__ float* RSg(int slot) const { return (float*)((unsigned char*)out + ST_GS) + (size_t)(512 + slot) * 8192; }
    __device__ __forceinline__ float* RBg(int slot) const { return (float*)((unsigned char*)out + ST_GB) + (size_t)slot * 64; }
    __device__ __forceinline__ float* RQ(int slot) const { return (float*)((unsigned char*)out + ST_MSC) + (size_t)slot * 4; }
    __device__ __forceinline__ bf16_t* GS() const { return (bf16_t*)((unsigned char*)out + ST_GS); }
    __device__ __forceinline__ float* MN() const { return (float*)((unsigned char*)out + ST_MN); }
    __device__ __forceinline__ float* MSC() const { return (float*)((unsigned char*)out + ST_MSC); }
    __device__ __forceinline__ float* GB() const { return (float*)((unsigned char*)out + ST_GB); }
};

__host__ __device__ __forceinline__ bool is_pad_row(int r) { return r >= XR && ((r - XR) & 63) < LEAD; }
__host__ __device__ __forceinline__ int chunk_row0(int b, int c) { return c == 0 ? XR + b * 64 : b * SEQ + (c - 1) * 64; }
__device__ __forceinline__ float row_rs(const float* ss, int r) {
    if (is_pad_row(r)) return 0.f;
    const f32x4 v = *(const f32x4*)(ss + (size_t)r * 4);
    return rsqrtf((v.x + v.y + v.z + v.w) * (1.f / D) + EPS);
}

#define LAS __attribute__((address_space(3)))
constexpr int NWAVES = 8, NTHR = 512;
constexpr int RING_OFF = 0, RING_BYTES = 131072, TAB_OFF = 131072, TAB_BYTES = 24576, MISC_OFF = TAB_OFF + TAB_BYTES, LDS_BYTES = MISC_OFF + 512;
constexpr int RED_OFF = TAB_OFF + 4096;
constexpr int UROW_OFF = TAB_OFF + 8192;
constexpr int CW_BAR = 4096, CW_CNT = 16384;
constexpr int PH_PRO = 0, PH_LAYER0 = 1, PH_PER_LAYER = 9, PH_FINAL = 1 + 9 * DEPTH, PH_COUNT = PH_FINAL + 1;

#define XB_TMO      128
#define XB_XCNT(j)  (256  + 64 * (j))
#define XB_XSUB(j)  (1280 + 64 * (j))
#define XB_XGEN(j)  (2304 + 64 * (j))
#define XB_TOP      3328
#define XB_TOPGEN   3392
#define XCD_BAR_WORDS 3456
#define XB_SPIN_CAP (1u << 18)
__device__ __forceinline__ unsigned xb_ld(unsigned* p)              { return __hip_atomic_load(p, __ATOMIC_RELAXED, __HIP_MEMORY_SCOPE_AGENT); }
__device__ __forceinline__ unsigned xb_add(unsigned* p, unsigned v) { return __hip_atomic_fetch_add(p, v, __ATOMIC_RELAXED, __HIP_MEMORY_SCOPE_AGENT); }
__device__ __forceinline__ unsigned xb_xcc_id() { return (unsigned)__builtin_amdgcn_s_getreg((3 << 11) | 20) & 0xFu; }
#define XB_SPIN(cond, bar) do { unsigned _sp = 0; while (cond) { __builtin_amdgcn_s_sleep(1); \
    if ((++_sp & 255u) == 0u) { if (xb_ld(&(bar)[XB_TMO])) break; if (_sp > XB_SPIN_CAP) { atomicAdd(&(bar)[XB_TMO], 1u); break; } } } } while (0)
struct XcdBarrier { unsigned* bar; unsigned x; volatile LAS unsigned* st; };
__device__ __forceinline__ XcdBarrier xcd_barrier_post(unsigned* bar, volatile LAS unsigned* st) {
    XcdBarrier b; b.bar = bar; b.x = xb_xcc_id(); b.st = st;
    if (threadIdx.x == 0) (void)xb_add(&bar[XB_XCNT(b.x)], 1u);
    return b;
}
__device__ __forceinline__ void xcd_barrier_complete(unsigned* bar, unsigned x, unsigned& nloc, unsigned& nx) {
    const unsigned G = gridDim.x * gridDim.y * gridDim.z;
    unsigned sum, cnt, mine, sp = 0u;
    for (;;) {
        sum = 0u; cnt = 0u; mine = 0u;
#pragma unroll
        for (unsigned j = 0; j < 16; ++j) { const unsigned c = xb_ld(&bar[XB_XCNT(j)]); sum += c; cnt += (c > 0u) ? 1u : 0u; mine = (j == x) ? c : mine; }
        if (sum == G) break;
        __builtin_amdgcn_s_sleep(1);
        if ((++sp & 255u) == 0u) { if (xb_ld(&bar[XB_TMO])) break; if (sp > XB_SPIN_CAP) { atomicAdd(&bar[XB_TMO], 1u); break; } }
    }
    nloc = mine > 0u ? mine : 1u; nx = cnt > 0u ? cnt : 1u;
}
__device__ __forceinline__ void xcd_barrier(const XcdBarrier& b) {
    asm volatile("s_waitcnt vmcnt(0)" ::: "memory");
    __syncthreads();
    if (threadIdx.x == 0) {
        unsigned* bar = b.bar; unsigned bx = b.x; asm volatile("" : "+s"(bx));
        __builtin_amdgcn_s_waitcnt(0);
        unsigned nloc = b.st[0], nx = b.st[1];
        if (nloc == 0u) { xcd_barrier_complete(bar, bx, nloc, nx); b.st[0] = nloc; b.st[1] = nx; }
        const unsigned old = xb_add(&bar[XB_XSUB(bx)], 1u);
        const unsigned gen = old / nloc;
        if (old + 1u == (gen + 1u) * nloc) {
            __builtin_amdgcn_fence(__ATOMIC_RELEASE, "agent");
            asm volatile("s_waitcnt vmcnt(0)" ::: "memory");
            const unsigned og = xb_add(&bar[XB_TOP], 1u);
            const unsigned tg = og / nx;
            if (og + 1u == (tg + 1u) * nx) xb_add(&bar[XB_TOPGEN], 1u);
            else XB_SPIN(xb_ld(&bar[XB_TOPGEN]) == tg, bar);
            __builtin_amdgcn_fence(__ATOMIC_ACQUIRE, "agent");
            xb_add(&bar[XB_XGEN(bx)], 1u);
            asm volatile("s_waitcnt vmcnt(0)" ::: "memory");
        } else {
            XB_SPIN(xb_ld(&bar[XB_XGEN(bx)]) == gen, bar);
            __builtin_amdgcn_fence(__ATOMIC_ACQUIRE, "agent");
            asm volatile("s_waitcnt vmcnt(0)" ::: "memory");
        }
    }
    __syncthreads();
}

namespace pg8 {
typedef short bf16x8 __attribute__((ext_vector_type(8)));
typedef unsigned u32x4 __attribute__((ext_vector_type(4)));
typedef unsigned u32x2 __attribute__((ext_vector_type(2)));
constexpr int BM = 256, BK = 64, HALF = 128, HTB = HALF * BK * 2, STAGE_BYTES = 8 * HTB, NXCD = 8, WGM = 8;
__host__ __device__ __forceinline__ int lds_byte(int r, int c) { const int st = (r >> 4) * 2 + (c >> 5), rr = r & 15, cc = c & 31, ob = rr * 64 + cc * 2; return st * 1024 + (ob ^ (((ob >> 9) & 1) << 5)); }
__host__ __device__ __forceinline__ void stage_rc(int b, int& R, int& C) { const int st = b / 1024, sb = b % 1024, swz = sb ^ (((sb >> 9) & 1) << 5); R = (st >> 1) * 16 + swz / 64; C = (st & 1) * 32 + (swz % 64) / 2; }
__host__ __device__ __forceinline__ int perm32(int rho) { const int n = rho >> 4, i = rho & 15; return 8 * (i >> 2) + 4 * n + (i & 3); }
typedef float f32x2_ __attribute__((ext_vector_type(2))); typedef __bf16 bf16x2_ __attribute__((ext_vector_type(2)));
__device__ __forceinline__ unsigned cvt_pk_bf16(float lo, float hi) { const f32x2_ v = {lo, hi}; return __builtin_bit_cast(unsigned, __builtin_convertvector(v, bf16x2_)); }
__device__ __forceinline__ float bflo(unsigned w) { return __uint_as_float(w << 16); }
__device__ __forceinline__ float bfhi(unsigned w) { return __uint_as_float(w & 0xffff0000u); }

struct Unit { int pm, pn; unsigned bo; };

__device__ __forceinline__ int xcd_remap(int L, int nwg) { const int q = nwg / NXCD, r = nwg % NXCD, xcd = L % NXCD, off = L / NXCD; return (xcd < r ? xcd * (q + 1) : r * (q + 1) + (xcd - r) * q) + off; }

template <int LDA, int K> struct DenseOrder {
    static constexpr bool GATHER = false, LIST = false;
    typedef int Row;
    int nM, nN, nwg, G, c;
    __device__ __forceinline__ void init(int M, int N, int G_, int c_) { nM = M / BM; nN = N / BM; nwg = nM * nN; G = G_; c = c_; }
    __device__ __forceinline__ bool unit(int i, Unit& u) const {
        const int L = i * G + c; if (L >= nwg) return false;
        const int wgid = xcd_remap(L, nwg);
        const int nig = WGM * nN, gid = wgid / nig, fm = gid * WGM, gsz = (nM - fm) < WGM ? (nM - fm) : WGM;
        u.pm = fm + ((wgid % nig) % gsz); u.pn = (wgid % nig) / gsz; u.bo = (unsigned)u.pn * (unsigned)(BM * K * 2); return true;
    }
    __device__ __forceinline__ unsigned aofs(const Unit& u) const { return (unsigned)u.pm * (unsigned)(BM * LDA * 2); }
    __device__ __forceinline__ void fetch(const Unit&, int, Row&) const {}
    __device__ __forceinline__ void stash(const Unit&, const Row&, int, int) const {}
    __device__ __forceinline__ unsigned aoff(int, int rowl, int C) const { return (unsigned)(rowl * LDA + C) * 2u; }
};
template <int LDA, int K> struct DenseOrderRS : DenseOrder<LDA, K> {
    static constexpr bool GATHER = false, LIST = true;
    typedef f32x4 Row;
    LAS unsigned char* lds; unsigned char* ws;
    __device__ __forceinline__ void fetch(const Unit& u, int tid, Row& r) const { if (tid < 256) r = *(const f32x4*)((const float*)(ws + WS_SS1) + (size_t)(u.pm * BM + tid) * 4); }
    __device__ __forceinline__ void stash(const Unit& u, const Row& r, int ub, int tid) const {
        if (tid < 256) ((LAS float*)(lds + UROW_OFF))[ub * 256 + tid] = is_pad_row(u.pm * BM + tid) ? 0.f : __builtin_amdgcn_rsqf(((r.x + r.y) + (r.z + r.w)) * (1.f / D) + EPS); }
};

template <class Epi, class Sched, bool ALIGN_EPI, int LDA, int K, bool FP8 = false>
__device__ __forceinline__ void gemm_phase(LAS unsigned char* lds, const char* Abase, const char* Bbase, const Sched& S, const Epi& E) {
    int tid_ = threadIdx.x; asm volatile("" : "+v"(tid_));
    const int tid = tid_, wid = __builtin_amdgcn_readfirstlane(tid >> 6), lane = tid & 63, wr = wid >> 2, wc = wid & 3, fr = lane & 15, fq = lane >> 4;
    constexpr int nt = K / BK;
    int Rr[2], Cc[2]; unsigned voffB[2];
#pragma unroll
    for (int i = 0; i < 2; ++i) { stage_rc(tid * 16 + i * 8192, Rr[i], Cc[i]); const int Rb = Epi::PERM ? ((Rr[i] & ~31) + perm32(Rr[i] & 31)) : Rr[i]; voffB[i] = (unsigned)(Rb * K + Cc[i]) * 2u; }
    constexpr unsigned kstep = BK * 2, hstepB = HALF * K * 2;
    const unsigned ldsw = (unsigned)wid * 1024u;
    int aofs[2], bofs[2];
#pragma unroll
    for (int e = 0; e < 2; ++e) { aofs[e] = FP8 ? lds_byte(wr * 64 + fr, (2 * fq + e) * 8) : lds_byte(wr * 64 + fr, fq * 8) + e * 1024; bofs[e] = FP8 ? lds_byte(wc * 32 + fr, (2 * fq + e) * 8) : lds_byte(wc * 32 + fr, fq * 8) + e * 1024; }
#define PG8_SA(b, h) (((b) * 2 + (h)) * HTB)
#define PG8_SB(b, h) ((4 + (b) * 2 + (h)) * HTB)
#define PG8_STAGE(bufoff, gbase, uoff, voff) do { _Pragma("unroll") for (int _i = 0; _i < 2; ++_i) \
        __builtin_amdgcn_global_load_lds((const unsigned*)((gbase) + (size_t)(unsigned)((uoff) + (voff)[_i])), (LAS unsigned*)(lds + (bufoff) + ldsw + _i * 8192), 16, 0, 0); } while (0)
#define PG8_LDA(dst, b, h) do { _Pragma("unroll") for (int m = 0; m < 4; ++m) _Pragma("unroll") for (int k = 0; k < 2; ++k) dst[m][k] = *(const LAS bf16x8*)(lds + PG8_SA(b, h) + aofs[k] + m * 2048); } while (0)
#define PG8_LDB(dst, b, h) do { _Pragma("unroll") for (int n = 0; n < 2; ++n) _Pragma("unroll") for (int k = 0; k < 2; ++k) dst[n][k] = *(const LAS bf16x8*)(lds + PG8_SB(b, h) + bofs[k] + n * 2048); } while (0)
#define PG8_MMA(ai, bj, At, Bt) do { __builtin_amdgcn_s_setprio(1); _Pragma("unroll") for (int m = 0; m < 4; ++m) _Pragma("unroll") for (int n = 0; n < 2; ++n) { \
        if constexpr (FP8) { typedef int i32x4_ __attribute__((ext_vector_type(4))); typedef int i32x8_ __attribute__((ext_vector_type(8))); \
            const i32x8_ b8_ = __builtin_shufflevector(__builtin_bit_cast(i32x4_, Bt[n][0]), __builtin_bit_cast(i32x4_, Bt[n][1]), 0, 1, 2, 3, 4, 5, 6, 7), a8_ = __builtin_shufflevector(__builtin_bit_cast(i32x4_, At[m][0]), __builtin_bit_cast(i32x4_, At[m][1]), 0, 1, 2, 3, 4, 5, 6, 7); \
            acc[ai][bj][m][n] = __builtin_amdgcn_mfma_scale_f32_16x16x128_f8f6f4(b8_, a8_, acc[ai][bj][m][n], 0, 0, 0, 0x7F7F7F7F, 0, 0x7F7F7F7F); } \
        else { _Pragma("unroll") for (int k = 0; k < 2; ++k) acc[ai][bj][m][n] = __builtin_amdgcn_mfma_f32_16x16x32_bf16(Bt[n][k], At[m][k], acc[ai][bj][m][n], 0, 0, 0); } } __builtin_amdgcn_s_setprio(0); } while (0)
#define PG8_WAIT_V(n) asm volatile("s_waitcnt vmcnt(" #n ")" ::: "memory")
#define PG8_WAIT_L(n) asm volatile("s_waitcnt lgkmcnt(" #n ")" ::: "memory")
#define PG8_BAR __builtin_amdgcn_s_barrier()
#define PG8_SCHED __builtin_amdgcn_sched_barrier(0)
    Unit cur, nxt, nx2; int ui = 0, ub = 0;
    if (!S.unit(0, cur)) return;
    typename Sched::Row rowr;
    if constexpr (Sched::LIST) { S.fetch(cur, tid, rowr); S.stash(cur, rowr, 0, tid); asm volatile("s_waitcnt lgkmcnt(0)" ::: "memory"); __builtin_amdgcn_s_barrier(); asm volatile("" ::: "memory"); }
    bool has_next = S.unit(1, nxt);
    if constexpr (Sched::LIST) { if (has_next) S.fetch(nxt, tid, rowr); }
    unsigned voffA[2][2];
#pragma unroll
    for (int h = 0; h < 2; ++h)
#pragma unroll
        for (int i = 0; i < 2; ++i) voffA[h][i] = S.aoff(0, h * HALF + Rr[i], Cc[i]);
    f32x4 acc[2][2][4][2];
#pragma unroll
    for (int a = 0; a < 2; ++a)
#pragma unroll
        for (int b = 0; b < 2; ++b)
#pragma unroll
            for (int m = 0; m < 4; ++m)
#pragma unroll
                for (int n = 0; n < 2; ++n) acc[a][b][m][n] = (f32x4){0.f, 0.f, 0.f, 0.f};
    bf16x8 At[4][2], B0[2][2], B1[2][2];
    unsigned cA = S.aofs(cur), cB = cur.bo;
    PG8_STAGE(PG8_SB(0, 0), Bbase, cB, voffB); PG8_STAGE(PG8_SB(0, 1), Bbase, cB + hstepB, voffB); PG8_STAGE(PG8_SA(0, 0), Abase, cA, voffA[0]); PG8_STAGE(PG8_SA(0, 1), Abase, cA, voffA[1]);
    if (wr == 1) PG8_BAR;
    PG8_WAIT_V(2); PG8_BAR;
    PG8_STAGE(PG8_SB(1, 0), Bbase, cB + kstep, voffB); PG8_STAGE(PG8_SA(1, 0), Abase, cA + kstep, voffA[0]); PG8_STAGE(PG8_SB(1, 1), Bbase, cB + hstepB + kstep, voffB);
    PG8_WAIT_V(6); PG8_BAR;
    for (;;) {
        const int nub = (ub == 2) ? 0 : ub + 1;
        if constexpr (Sched::LIST) { if (has_next) S.stash(nxt, rowr, nub, tid); }
        const bool has_nx2 = has_next && S.unit(ui + 2, nx2);
        if constexpr (Sched::LIST) { if (has_nx2) S.fetch(nx2, tid, rowr); }
        const unsigned nA = has_next ? S.aofs(nxt) : cA, nB = has_next ? nxt.bo : cB;
#pragma unroll 1
        for (int t = 0; t < nt; t += 2) {
            const bool last = (t == nt - 2);
            const unsigned a1 = cA + (unsigned)(t + 1) * kstep;
            const unsigned a2 = last ? nA : cA + (unsigned)(t + 2) * kstep, b2 = last ? nB : cB + (unsigned)(t + 2) * kstep;
            const unsigned a3 = a2 + kstep, b3 = b2 + kstep;
            PG8_LDB(B0, 0, 0); PG8_LDB(B1, 0, 1); PG8_SCHED; PG8_LDA(At, 0, 0); PG8_STAGE(PG8_SA(1, 1), Abase, a1, voffA[1]);
            if constexpr (Sched::GATHER) { if (last && has_next) {
#pragma unroll
                for (int i = 0; i < 2; ++i) { int R2, C2; stage_rc(tid * 16 + i * 8192, R2, C2);
#pragma unroll
                    for (int h = 0; h < 2; ++h) voffA[h][i] = S.aoff(nub, h * HALF + R2, C2); } } }
            PG8_WAIT_V(8); PG8_WAIT_L(0); PG8_BAR; PG8_MMA(0, 0, At, B0); PG8_MMA(0, 1, At, B1); PG8_BAR; PG8_SCHED;
            PG8_LDA(At, 0, 1); PG8_STAGE(PG8_SB(0, 0), Bbase, b2, voffB); PG8_STAGE(PG8_SB(0, 1), Bbase, b2 + hstepB, voffB); PG8_STAGE(PG8_SA(0, 0), Abase, a2, voffA[0]);
            PG8_WAIT_V(8); PG8_WAIT_L(0); PG8_BAR; PG8_MMA(1, 0, At, B0); PG8_MMA(1, 1, At, B1); PG8_BAR; PG8_SCHED;
            PG8_LDB(B0, 1, 0); PG8_LDB(B1, 1, 1); PG8_SCHED; PG8_LDA(At, 1, 0); PG8_STAGE(PG8_SA(0, 1), Abase, a2, voffA[1]);
            PG8_WAIT_V(8); PG8_WAIT_L(0); PG8_BAR; PG8_MMA(0, 0, At, B0); PG8_MMA(0, 1, At, B1); PG8_BAR; PG8_SCHED;
            PG8_LDA(At, 1, 1); PG8_STAGE(PG8_SB(1, 0), Bbase, b3, voffB); PG8_STAGE(PG8_SB(1, 1), Bbase, b3 + hstepB, voffB); PG8_STAGE(PG8_SA(1, 0), Abase, a3, voffA[0]);
            PG8_WAIT_V(8); PG8_WAIT_L(0); PG8_BAR; PG8_MMA(1, 0, At, B0); PG8_MMA(1, 1, At, B1); PG8_BAR; PG8_SCHED;
        }
        if constexpr (ALIGN_EPI) { if (wr == 0) PG8_BAR; }
        E(acc, cur, wr, wc, fr, fq, tid, ub);
        if (!has_next) break;
#pragma unroll
        for (int a = 0; a < 2; ++a)
#pragma unroll
            for (int b = 0; b < 2; ++b)
#pragma unroll
                for (int m = 0; m < 4; ++m)
#pragma unroll
                    for (int n = 0; n < 2; ++n) acc[a][b][m][n] = (f32x4){0.f, 0.f, 0.f, 0.f};
        cur = nxt; nxt = nx2; has_next = has_nx2; cA = nA; cB = nB; ++ui; ub = nub;
        if constexpr (ALIGN_EPI) { if (wr == 1) PG8_BAR; }
    }
    PG8_WAIT_V(0);
    if constexpr (!ALIGN_EPI) { if (wr == 0) PG8_BAR; }
    PG8_BAR;
#undef PG8_SA
#undef PG8_SB
#undef PG8_STAGE
#undef PG8_LDA
#undef PG8_LDB
#undef PG8_MMA
#undef PG8_WAIT_V
#undef PG8_WAIT_L
#undef PG8_BAR
#undef PG8_SCHED
}

struct EpiZ {
    static constexpr bool PERM = true;
    unsigned char* ws; LAS unsigned char* lds;
    __device__ __forceinline__ void operator()(const f32x4 (&acc)[2][2][4][2], const Unit& u, int wr, int wc, int fr, int fq, int, int ub) const {
        const int row0 = u.pm * BM + wr * 64 + fr, col0 = u.pn * BM + wc * 32 + 8 * fq;
        bf16_t* z = (bf16_t*)(ws + WS_Z); const LAS float* rsb = (const LAS float*)(lds + UROW_OFF) + ub * 256 + wr * 64 + fr;
#pragma unroll
        for (int ai = 0; ai < 2; ++ai)
#pragma unroll
            for (int m = 0; m < 4; ++m) { const int row = row0 + ai * HALF + m * 16; const float rs = rsb[ai * HALF + m * 16]; bf16_t* rowp = z + (size_t)row * NIN + col0;
#pragma unroll
                for (int bj = 0; bj < 2; ++bj) if (col0 + bj * HALF < NIN) { const f32x4 v0 = acc[ai][bj][m][0] * rs, v1 = acc[ai][bj][m][1] * rs;
                    u32x4 w; w.x = cvt_pk_bf16(v0[0], v0[1]); w.y = cvt_pk_bf16(v0[2], v0[3]); w.z = cvt_pk_bf16(v1[0], v1[1]); w.w = cvt_pk_bf16(v1[2], v1[3]);
                    *(u32x4*)(rowp + bj * HALF) = w; } }
    }
};
__device__ __forceinline__ unsigned pk_fp8x4(float a, float b, float c, float d) { int r = __builtin_amdgcn_cvt_pk_fp8_f32(a, b, 0, false); r = __builtin_amdgcn_cvt_pk_fp8_f32(c, d, r, true); return (unsigned)r; }
template <bool LIST, bool STATS, size_t SS_OFF, bool H8OUT = false> struct EpiRes {
    static constexpr bool PERM = true;
    unsigned char* ws; LAS unsigned char* lds;
    __device__ __forceinline__ void operator()(const f32x4 (&acc)[2][2][4][2], const Unit& u, int wr, int wc, int fr, int fq, int tid, int ub) const {
        const int col0 = u.pn * BM + wc * 32 + 8 * fq;
        bf16_t* h = (bf16_t*)(ws + WS_H); float* ss = (float*)(ws + SS_OFF); LAS float* red = (LAS float*)(lds + RED_OFF); const LAS int* utok = (const LAS int*)(lds + UROW_OFF);
#pragma unroll
        for (int ai = 0; ai < 2; ++ai)
#pragma unroll
            for (int m = 0; m < 4; ++m) { const int rowl = ai * HALF + wr * 64 + m * 16 + fr; int row; bool valid = true;
                if constexpr (LIST) { row = utok[ub * 256 + rowl]; valid = row >= 0; } else row = u.pm * BM + rowl;
                float s = 0.f;
                if (valid) { bf16_t* hp = h + (size_t)row * D + col0;
#pragma unroll
                    for (int bj = 0; bj < 2; ++bj) { const u32x4 o = *(const u32x4*)(hp + bj * HALF); const f32x4 a0 = acc[ai][bj][m][0] * (LIST ? 0.0078125f : 1.f), a1 = acc[ai][bj][m][1] * (LIST ? 0.0078125f : 1.f);
                        const float v0 = bflo(o.x) + a0[0], v1 = bfhi(o.x) + a0[1], v2 = bflo(o.y) + a0[2], v3 = bfhi(o.y) + a0[3], v4 = bflo(o.z) + a1[0], v5 = bfhi(o.z) + a1[1], v6 = bflo(o.w) + a1[2], v7 = bfhi(o.w) + a1[3];
                        s += (v0 * v0 + v1 * v1) + (v2 * v2 + v3 * v3) + (v4 * v4 + v5 * v5) + (v6 * v6 + v7 * v7);
                        u32x4 w; w.x = cvt_pk_bf16(v0, v1); w.y = cvt_pk_bf16(v2, v3); w.z = cvt_pk_bf16(v4, v5); w.w = cvt_pk_bf16(v6, v7);
                        *(u32x4*)(hp + bj * HALF) = w;
                        if constexpr (H8OUT) { u32x2 q; q.x = pk_fp8x4(v0, v1, v2, v3); q.y = pk_fp8x4(v4, v5, v6, v7); *(u32x2*)(ws + WS_H8 + (size_t)row * D + col0 + bj * HALF) = q; } } }
                if constexpr (STATS) { s += __shfl_xor(s, 16); s += __shfl_xor(s, 32); if (fq == 0) red[rowl * 4 + wc] = s; }
                asm volatile("" ::: "memory"); }
        if constexpr (STATS) {
            asm volatile("s_waitcnt lgkmcnt(0)" ::: "memory"); __builtin_amdgcn_s_barrier(); asm volatile("" ::: "memory");
            if (tid < BM) { const f32x4 v = *(const LAS f32x4*)(red + tid * 4); int row; bool valid = true;
                if constexpr (LIST) { row = utok[ub * 256 + tid]; valid = row >= 0; } else row = u.pm * BM + tid;
                if (valid) ss[(size_t)row * 4 + u.pn] = (v.x + v.y) + (v.z + v.w); }
        }
    }
};
struct EpiUp {
    static constexpr bool PERM = false;
    unsigned char* ws; LAS unsigned char* lds;
    __device__ __forceinline__ void operator()(const f32x4 (&acc)[2][2][4][2], const Unit& u, int wr, int wc, int fr, int fq, int, int ub) const {
        const int col0 = u.pn * 128 + wc * 16 + 4 * fq;
        unsigned char* hid = ws + WS_HID; const LAS float* urs = (const LAS float*)(lds + UROW_OFF) + 768;
#pragma unroll
        for (int ai = 0; ai < 2; ++ai)
#pragma unroll
            for (int m = 0; m < 4; ++m) { const int rowl = ai * HALF + wr * 64 + m * 16 + fr;
                const float rs = urs[ub * 256 + rowl] * 0.0625f, gw = urs[768 + ub * 256 + rowl] * 16.f;
                unsigned char* hp = hid + ((size_t)u.pm * BM + rowl) * DE + col0;
#pragma unroll
                for (int bj = 0; bj < 2; ++bj) { const f32x4 g = acc[ai][bj][m][0] * rs, up = acc[ai][bj][m][1] * rs; float o[4];
#pragma unroll
                    for (int j = 0; j < 4; ++j) o[j] = g[j] * __builtin_amdgcn_rcpf(1.f + __builtin_amdgcn_exp2f(g[j] * -1.4426950408889634f)) * up[j] * gw;
                    *(unsigned*)(hp + bj * 64) = pk_fp8x4(o[0], o[1], o[2], o[3]); } }
    }
};
}

struct MoeTab { int cnt[64]; int rb0[65]; int pad[3]; unsigned short li[NBMAX]; unsigned short blk[NBMAX]; };
static_assert(sizeof(MoeTab) <= 4096, "MoeTab fits below RED_OFF");
__device__ __forceinline__ void moe_build_tab(LAS MoeTab* T, unsigned* gcnt) {
    int tid = threadIdx.x; asm volatile("" : "+v"(tid));
    if (tid < 64) T->cnt[tid] = (int)__hip_atomic_load(gcnt + tid * 16, __ATOMIC_RELAXED, __HIP_MEMORY_SCOPE_AGENT);
    __syncthreads();
    if (tid == 0) { int run = 0; for (int i = 0; i < 64; ++i) { T->rb0[i] = run; run += (T->cnt[i] + 255) >> 8; } T->rb0[64] = run; }
    __syncthreads();
    if (tid < 64) { const int b0 = T->rb0[tid], nb = T->rb0[tid + 1] - b0;
#pragma clang loop vectorize(disable) unroll(disable)
        for (int b = 0; b < nb; ++b) { T->li[b0 + b] = (unsigned short)tid; T->blk[b0 + b] = (unsigned short)b; } }
    __syncthreads();
}
template <bool GATHER_, int NN, int LDA, int K, unsigned ESTEP> struct MoeOrder {
    static constexpr bool GATHER = GATHER_, LIST = true;
    LAS unsigned char* lds; unsigned char* ws; int rbLo, nwg, G, c;
    typedef f32x4 Row;
    __device__ __forceinline__ bool unit(int i, pg8::Unit& u) const {
        const int L = i * G + c; if (L >= nwg) return false;
        const LAS MoeTab* T = (const LAS MoeTab*)(lds + TAB_OFF);
        const int wgid = pg8::xcd_remap(L, nwg), rb = rbLo + wgid / NN;
        u.pm = rb; u.pn = wgid % NN; u.bo = (unsigned)(T->li[rb] & 31) * ESTEP + (unsigned)u.pn * (unsigned)(256 * K * 2);
        return true;
    }
    __device__ __forceinline__ unsigned aofs(const pg8::Unit& u) const { return GATHER ? 0u : (unsigned)u.pm * (unsigned)(256 * LDA * 2); }
    __device__ __forceinline__ void fetch(const pg8::Unit& u, int tid, Row& r) const {
        const LAS MoeTab* T = (const LAS MoeTab*)(lds + TAB_OFF);
        if (tid < 256) { const int li = T->li[u.pm], slot = T->blk[u.pm] * 256 + tid; const bool valid = slot < T->cnt[li]; const size_t idx = (size_t)li * CAPL + slot;
            f32x4 v = {__int_as_float(-1), 0.f, 0.f, 0.f};
            if (valid) { v.x = __int_as_float(((const int*)(ws + WS_LTOK))[idx]); if constexpr (GATHER) { v.y = ((const float*)(ws + WS_LRS))[idx]; v.z = ((const float*)(ws + WS_LW))[idx]; } }
            r = v; }
    }
    __device__ __forceinline__ void stash(const pg8::Unit&, const Row& r, int ub, int tid) const {
        LAS int* urow = (LAS int*)(lds + UROW_OFF);
        if (tid < 256) { urow[ub * 256 + tid] = __float_as_int(r.x); if constexpr (GATHER) { ((LAS float*)urow)[768 + ub * 256 + tid] = r.y; ((LAS float*)urow)[1536 + ub * 256 + tid] = r.z; } }
    }
    __device__ __forceinline__ unsigned aoff(int ub, int rowl, int C) const {
        if constexpr (GATHER) { const int tok = ((const LAS int*)(lds + UROW_OFF))[ub * 256 + rowl]; return (unsigned)((tok < 0 ? 0 : tok) * LDA + C) * 2u; }
        else return (unsigned)(rowl * LDA + C) * 2u;
    }
};

__device__ __forceinline__ void route_phase(const P& p, int l, LAS unsigned char* lds, int G, int bid, unsigned* gcnt) {
    int tid_ = threadIdx.x; asm volatile("" : "+v"(tid_));
    const int tid = tid_, w = __builtin_amdgcn_readfirstlane(tid >> 6), lane = tid & 63, r = lane & 15, q = lane >> 4;
    const int per = (MP + G - 1) / G, r0 = bid * per, nrows = (r0 + per <= MP) ? per : (MP - r0 > 0 ? MP - r0 : 0);
    constexpr int WROW = 1040;
    LAS unsigned char* WHs = lds; LAS unsigned char* WLs = lds + 48 * WROW;
    LAS float* lg = (LAS float*)(lds + 2 * 48 * WROW);
    LAS int* lcnt = (LAS int*)(lds + TAB_OFF);
    LAS int* lbase = lcnt + 64;
    LAS int* rli = lbase + 64;
    LAS int* rpos = rli + 528;
    LAS float* rw = (LAS float*)(rpos + 528);
    LAS float* rrs = rw + 528;
    if (tid < 64) lcnt[tid] = 0;
    const bf16_t* WH = (const bf16_t*)(p.ws + WS_WRS) + (size_t)l * 48 * D; const bf16_t* WL = WH + (size_t)DEPTH * 48 * D;
    f32x4 acc[2][3]; float ssq[2] = {0.f, 0.f};
#pragma unroll
    for (int gi = 0; gi < 2; ++gi)
#pragma unroll
        for (int tl = 0; tl < 3; ++tl) acc[gi][tl] = (f32x4){0.f, 0.f, 0.f, 0.f};
#pragma unroll 1
    for (int half = 0; half < 2; ++half) {
        __syncthreads();
        for (int idx = tid; idx < 48 * 64; idx += NTHR) { const int row = idx >> 6, pc = idx & 63;
            *(LAS pg8::u32x4*)(WHs + row * WROW + pc * 16) = *(const pg8::u32x4*)(WH + (size_t)row * D + half * 512 + pc * 8);
            *(LAS pg8::u32x4*)(WLs + row * WROW + pc * 16) = *(const pg8::u32x4*)(WL + (size_t)row * D + half * 512 + pc * 8); }
        __syncthreads();
#pragma unroll
        for (int gi = 0; gi < 2; ++gi) { const int g = w + gi * NWAVES;
            if (g * 16 < nrows) { const bool ina = (g * 16 + r) < nrows; const bf16_t* ap = p.H() + (size_t)(ina ? r0 + g * 16 + r : 0) * D + half * 512 + q * 8;
                pg8::bf16x8 a[16];
#pragma unroll
                for (int ks = 0; ks < 16; ++ks) a[ks] = *(const pg8::bf16x8*)(ap + ks * 32);
#pragma unroll
                for (int ks = 0; ks < 16; ++ks) { const pg8::u32x4 w4 = __builtin_bit_cast(pg8::u32x4, a[ks]); const float x0 = pg8::bflo(w4.x), x1 = pg8::bfhi(w4.x), x2 = pg8::bflo(w4.y), x3 = pg8::bfhi(w4.y), x4 = pg8::bflo(w4.z), x5 = pg8::bfhi(w4.z), x6 = pg8::bflo(w4.w), x7 = pg8::bfhi(w4.w);
                    ssq[gi] += (x0 * x0 + x1 * x1) + (x2 * x2 + x3 * x3) + (x4 * x4 + x5 * x5) + (x6 * x6 + x7 * x7); }
#pragma unroll
                for (int ks = 0; ks < 16; ++ks)
#pragma unroll
                    for (int tl = 0; tl < 3; ++tl) { const int wo = (tl * 16 + r) * WROW + (ks * 32 + q * 8) * 2;
                        acc[gi][tl] = __builtin_amdgcn_mfma_f32_16x16x32_bf16(a[ks], *(const LAS pg8::bf16x8*)(WHs + wo), acc[gi][tl], 0, 0, 0);
                        acc[gi][tl] = __builtin_amdgcn_mfma_f32_16x16x32_bf16(a[ks], *(const LAS pg8::bf16x8*)(WLs + wo), acc[gi][tl], 0, 0, 0); } } }
    }
#pragma unroll
    for (int gi = 0; gi < 2; ++gi) { const int g = w + gi * NWAVES;
        if (g * 16 < nrows) {
            LAS float* lgw = lg + w * 16 * 48;
#pragma unroll
            for (int tl = 0; tl < 3; ++tl)
#pragma unroll
                for (int j = 0; j < 4; ++j) lgw[(q * 4 + j) * 48 + tl * 16 + r] = acc[gi][tl][j];
            asm volatile("s_waitcnt lgkmcnt(0)" ::: "memory");
            float rtot = ssq[gi]; rtot += __shfl_xor(rtot, 16); rtot += __shfl_xor(rtot, 32);
            if (lane < 16) { const int i = g * 16 + lane, rr = r0 + i;
                if (i < nrows) {
                    if (is_pad_row(rr)) { int neg = -1; asm volatile("" : "+v"(neg)); rli[2 * i] = neg; rli[2 * i + 1] = neg; }
                    else { const float rs = __builtin_amdgcn_rsqf(rtot * (1.f / D) + EPS); const LAS float* x = lgw + lane * 48; float gl[4];
#pragma unroll
                        for (int j = 0; j < 4; ++j) gl[j] = x[j] * rs + p.br_g[l * 4 + j];
                        int gsel = 0; float gm = gl[0];
#pragma unroll
                        for (int j = 1; j < 4; ++j) if (gl[j] > gm) { gm = gl[j]; gsel = j; }
                        float se = 0.f;
#pragma unroll
                        for (int j = 0; j < 4; ++j) se += __expf(gl[j] - gm);
                        const float psel = 1.f / se;
                        int i0 = 0, i1 = -1; float v0 = -INFINITY, v1 = -INFINITY;
                        for (int j = 0; j < 8; ++j) { const float v = x[4 + gsel * 8 + j] * rs + p.br_e[l * 32 + gsel * 8 + j];
                            if (v > v0) { v1 = v0; i1 = i0; v0 = v; i0 = j; } else if (v > v1) { v1 = v; i1 = j; } }
                        const float w0 = 1.f / (1.f + __expf(v1 - v0));
                        const int li0 = gsel * 8 + i0, li1 = 32 + gsel * 8 + i1;
                        rli[2 * i] = li0; rli[2 * i + 1] = li1; rw[2 * i] = w0 * psel; rw[2 * i + 1] = (1.f - w0) * psel; rrs[i] = rs;
                        rpos[2 * i] = __hip_atomic_fetch_add(&lcnt[li0], 1, __ATOMIC_RELAXED, __HIP_MEMORY_SCOPE_WORKGROUP); rpos[2 * i + 1] = __hip_atomic_fetch_add(&lcnt[li1], 1, __ATOMIC_RELAXED, __HIP_MEMORY_SCOPE_WORKGROUP); } } }
            asm volatile("s_waitcnt lgkmcnt(0)" ::: "memory"); } }
    __syncthreads();
    if (tid < 64) { const int n = lcnt[tid]; lbase[tid] = n ? (int)__hip_atomic_fetch_add(gcnt + tid * 16, (unsigned)n, __ATOMIC_RELAXED, __HIP_MEMORY_SCOPE_AGENT) : 0; }
    __syncthreads();
    int* ltok = (int*)(p.ws + WS_LTOK); float* lrs = (float*)(p.ws + WS_LRS); float* lw = (float*)(p.ws + WS_LW);
    for (int i = tid; i < 2 * nrows; i += NTHR) { const int li = rli[i]; if (li >= 0) { const size_t idx = (size_t)li * CAPL + lbase[li] + rpos[i]; ltok[idx] = r0 + (i >> 1); lrs[idx] = rrs[i >> 1]; lw[idx] = rw[i]; } }
    __syncthreads();
}

namespace mx {
#define LDS_BARRIER() do { asm volatile("s_waitcnt lgkmcnt(0)" ::: "memory"); __builtin_amdgcn_s_barrier(); asm volatile("" ::: "memory"); } while (0)
using pg8::bf16x8; using pg8::u32x4; using pg8::u32x2; using pg8::cvt_pk_bf16; using pg8::bflo; using pg8::bfhi;
__device__ __forceinline__ f32x4 mfma16(bf16x8 a, bf16x8 b, f32x4 c) { return __builtin_amdgcn_mfma_f32_16x16x32_bf16(a, b, c, 0, 0, 0); }
__device__ __forceinline__ float wscan_add(float v, int lane) {
#pragma unroll
    for (int o = 1; o < 64; o <<= 1) { const float t = __shfl_up(v, o); if (lane >= o) v += t; }
    return v; }
__device__ __forceinline__ float wscan_max(float v, int lane) {
#pragma unroll
    for (int o = 1; o < 64; o <<= 1) { const float t = __shfl_up(v, o); if (lane >= o) v = fmaxf(v, t); }
    return v; }
__device__ __forceinline__ float wave_max(float v) {
#pragma unroll
    for (int o = 1; o < 64; o <<= 1) v = fmaxf(v, __shfl_xor(v, o));
    return v; }
__device__ __forceinline__ void unpack8(const u32x4 a, float (&x)[8]) { x[0] = bflo(a.x); x[1] = bfhi(a.x); x[2] = bflo(a.y); x[3] = bfhi(a.y); x[4] = bflo(a.z); x[5] = bfhi(a.z); x[6] = bflo(a.w); x[7] = bfhi(a.w); }
__device__ __forceinline__ u32x4 pack8(const float (&x)[8]) { u32x4 w; w.x = cvt_pk_bf16(x[0], x[1]); w.y = cvt_pk_bf16(x[2], x[3]); w.z = cvt_pk_bf16(x[4], x[5]); w.w = cvt_pk_bf16(x[6], x[7]); return w; }
__device__ __forceinline__ bf16x8 ldfrag(const LAS unsigned char* p) { return *(const LAS bf16x8*)p; }
__device__ __forceinline__ float fexp(float x) { return __builtin_amdgcn_exp2f(x * 1.4426950408889634f); }
__device__ __forceinline__ float frcp(float x) { return __builtin_amdgcn_rcpf(x); }
__device__ __forceinline__ float fsigm(float x) { return frcp(1.f + fexp(-x)); }
__device__ __forceinline__ float fsilu(float x) { return x * fsigm(x); }
__device__ __forceinline__ float flogsig(float x) { return fminf(x, 0.f) - __builtin_amdgcn_logf(1.f + fexp(-fabsf(x))) * 0.6931471805599453f; }
__device__ __forceinline__ float frsq(float x) { return __builtin_amdgcn_rsqf(x); }
typedef short s16x4 __attribute__((ext_vector_type(4)));
__device__ __forceinline__ s16x4 tr_read(const LAS unsigned char* p) { s16x4 r; asm volatile("ds_read_b64_tr_b16 %0, %1\n\ts_waitcnt lgkmcnt(0)" : "=&v"(r) : "v"((unsigned)(size_t)p) : "memory"); return r; }
__device__ __forceinline__ bf16x8 tr_frag(const LAS unsigned char* img, int stride, int krow0, int col0, int lane) {
    const int i16 = lane & 15, g = lane >> 4; const LAS unsigned char* a = img + (krow0 + 8 * g + (i16 >> 2)) * stride + (col0 + 4 * (i16 & 3)) * 2;
    const s16x4 lo = tr_read(a), hi = tr_read(a + 4 * stride); return __builtin_shufflevector(lo, hi, 0, 1, 2, 3, 4, 5, 6, 7); }
constexpr int SQ = 272, ST = 144;
__device__ __forceinline__ int tsw(int row, int s) { return row * ST + ((((s >> 3) ^ (row >> 3)) & 7) << 4) + ((s & 7) << 1); }
__device__ __forceinline__ int tfr(int row, int chunk) { return row * ST + (((chunk ^ (row >> 3)) & 7) << 4); }

struct UC { int c, hd, b, r0; };
__device__ __forceinline__ UC ucoord(int u) { UC k; k.c = u % NCH; k.hd = (u / NCH) & 3; k.b = u / (NCH * 4); k.r0 = chunk_row0(k.b, k.c); return k; }
template <int NS> struct PreM { u32x4 x[NS + 3]; u32x4 v[2]; pg8::f32x2_ g; };
struct PreO { u32x4 qk[4]; u32x4 v[2]; f32x4 g; f32x4 gw; };
struct PreG { u32x4 v[2]; u32x4 q, k; f32x4 ca; pg8::f32x2_ ab; };
template <int NS> __device__ __forceinline__ void load_m(const P& p, int u, PreM<NS>& R, int tid, int zvcol) {
    asm volatile("" : "+v"(tid));
    const UC k = ucoord(u); const bf16_t* z = p.Z(); const int lane = tid & 63, w = tid >> 6;
    { const size_t zr = (size_t)(k.r0 + lane) * NIN; pg8::f32x2_ g = {0.f, 0.f}; if (w == 0) { g.x = bf2f(z[zr + ZO_FG + k.hd]); g.y = bf2f(z[zr + ZO_IG + k.hd]); } R.g = g; }
    int zcol, s0;
    if (NS == 4) { const int which = tid >> 8; zcol = (which ? ZO_KM : ZO_QM) + k.hd * 128 + (tid & 15) * 8; s0 = ((tid >> 4) & 15) * 4; }
    else { zcol = ZO_KM + k.hd * 128 + (tid & 15) * 8; s0 = (tid >> 4) * 2; }
#pragma unroll
    for (int i = 0; i < NS + 3; ++i) { const int s = s0 - 3 + i, pp = k.c * 64 + s;
        const int row = (s < 0 && k.c == 1) ? XR + k.b * 64 + 64 + s : k.r0 + (pp >= 0 ? s : 0);
        const u32x4 v = *(const u32x4*)(z + (size_t)row * NIN + zcol); const unsigned m = pp >= 0 ? 0xffffffffu : 0u; R.x[i] = (u32x4){v.x & m, v.y & m, v.z & m, v.w & m}; }
#pragma unroll
    for (int it = 0; it < 2; ++it) { const int s = 2 * (tid >> 4) + it, v8 = tid & 15; R.v[it] = *(const u32x4*)(z + (size_t)(k.r0 + s) * NIN + zvcol + k.hd * 128 + v8 * 8); }
}
__device__ __forceinline__ void load_o(const P& p, int u, PreO& R, int tid) {
    asm volatile("" : "+v"(tid));
    const UC k = ucoord(u); const bf16_t* z = p.Z(); const bf16_t* qkc = (const bf16_t*)(p.ws + WS_QKC);
#pragma unroll
    for (int it = 0; it < 4; ++it) { const int item = tid + it * NTHR, which = item >> 10, s = (item >> 4) & 63, ch8 = item & 15; R.qk[it] = *(const u32x4*)(qkc + (size_t)(k.r0 + s) * 1024 + which * 512 + k.hd * 128 + ch8 * 8); }
#pragma unroll
    for (int it = 0; it < 2; ++it) { const int s = 2 * (tid >> 4) + it, v8 = tid & 15; R.v[it] = *(const u32x4*)(z + (size_t)(k.r0 + s) * NIN + ZO_VM + k.hd * 128 + v8 * 8); }
    { const float* ga = (const float*)((const unsigned char*)p.out + ST_GA) + (size_t)u * 192; f32x4 g = {0.f, 0.f, 0.f, 0.f}; if (tid < 64) { g.x = ga[tid]; g.y = ga[64 + tid]; g.z = ga[128 + tid]; } R.g = g;
      f32x4 gw; gw.x = ga[64 + (tid >> 4)]; gw.y = ga[64 + (tid >> 4) + 32]; gw.z = ga[63]; gw.w = ga[191]; R.gw = gw; }
}
__device__ __forceinline__ void load_g(const P& p, int l, int u, PreG& R, int tid, bool needq) {
    asm volatile("" : "+v"(tid));
    const UC k = ucoord(u); const bf16_t* z = p.Z();
#pragma unroll
    for (int it = 0; it < 2; ++it) { const int s = 2 * (tid >> 4) + it, v8 = tid & 15; R.v[it] = *(const u32x4*)(z + (size_t)(k.r0 + s) * NIN + ZO_VG + k.hd * 128 + v8 * 8); }
    const size_t zr = (size_t)(k.r0 + (tid >> 3)) * NIN; R.k = *(const u32x4*)(z + zr + ZO_KG + k.hd * 64 + (tid & 7) * 8); R.q = R.k;
    if (needq) R.q = *(const u32x4*)(z + zr + ZO_QG + k.hd * 64 + (tid & 7) * 8);
    { const int i0 = tid, i1 = tid + NTHR; f32x4 ca;
        ca.x = bf2f(z[(size_t)(k.r0 + (i0 >> 4)) * NIN + ZO_CODE + (i0 & 15)]); ca.y = bf2f(z[(size_t)(k.r0 + (i1 >> 4)) * NIN + ZO_CODE + (i1 & 15)]);
        ca.z = p.a_w2[(l * 16 + (i0 >> 6)) * 256 + k.hd * 64 + (i0 & 63)]; ca.w = p.a_w2[(l * 16 + (i1 >> 6)) * 256 + k.hd * 64 + (i1 & 63)]; R.ca = ca;
      pg8::f32x2_ ab = {0.f, 0.f}; if (tid < 64) ab.x = p.a_b[l * 256 + k.hd * 64 + tid]; R.ab = ab; }
}
template <int NS> __device__ __forceinline__ void conv8(const LAS float* cw, const u32x4 (&xr)[NS + 3], int c, int s0, int cch, float scale, float (&o)[NS][8]) {
    float x[NS + 3][8];
#pragma unroll
    for (int i = 0; i < NS + 3; ++i) unpack8(xr[i], x[i]);
    float bias[8];
    { const f32x4 b0 = *(const LAS f32x4*)(cw + 4096 + cch), b1 = *(const LAS f32x4*)(cw + 4096 + cch + 4); bias[0] = b0.x; bias[1] = b0.y; bias[2] = b0.z; bias[3] = b0.w; bias[4] = b1.x; bias[5] = b1.y; bias[6] = b1.z; bias[7] = b1.w; }
#pragma unroll
    for (int i = 0; i < NS; ++i)
#pragma unroll
        for (int q = 0; q < 8; ++q) o[i][q] = bias[q];
#pragma unroll
    for (int j = 0; j < 4; ++j) { float w[8];
        { const f32x4 w0 = *(const LAS f32x4*)(cw + j * 1024 + cch), w1 = *(const LAS f32x4*)(cw + j * 1024 + cch + 4); w[0] = w0.x; w[1] = w0.y; w[2] = w0.z; w[3] = w0.w; w[4] = w1.x; w[5] = w1.y; w[6] = w1.z; w[7] = w1.w; }
#pragma unroll
        for (int i = 0; i < NS; ++i)
#pragma unroll
            for (int q = 0; q < 8; ++q) o[i][q] += w[q] * x[i + j][q]; }
#pragma unroll
    for (int i = 0; i < NS; ++i) { const bool valid = (c > 0) || (s0 + i >= LEAD);
#pragma unroll
        for (int q = 0; q < 8; ++q) o[i][q] = valid ? fsilu(o[i][q]) * scale : 0.f; }
}

__device__ __forceinline__ void gla_cumdecay(const P& p, int l, int hd, const PreG& R, int c, LAS float* LA, LAS float* segtot, LAS float* cod, LAS float* aw, LAS float* ab, int tid) {
    cod[tid] = R.ca.x; cod[tid + NTHR] = R.ca.y; aw[tid] = R.ca.z; aw[tid + NTHR] = R.ca.w;
    if (tid < 64) ab[tid] = p.a_b[l * 256 + hd * 64 + tid];
    LDS_BARRIER();
    const int j = tid & 63, seg = tid >> 6; float run = 0.f, v[8];
#pragma unroll
    for (int i = 0; i < 8; ++i) { const int s = seg * 8 + i; const bool valid = (c > 0) || (s >= LEAD); float a = ab[j];
#pragma unroll
        for (int q = 0; q < 16; ++q) a += cod[s * 16 + q] * aw[q * 64 + j];
        run += valid ? flogsig(a) * (1.f / 16.f) : 0.f; v[i] = run; }
    segtot[seg * 64 + j] = run;
    LDS_BARRIER();
    float pre = 0.f;
#pragma unroll
    for (int g = 0; g < 8; ++g) pre += (g < seg) ? segtot[g * 64 + j] : 0.f;
#pragma unroll
    for (int i = 0; i < 8; ++i) LA[(seg * 8 + i) * 65 + j] = v[i] + pre;
    LDS_BARRIER();
}
__device__ __forceinline__ void mlstm_local(const P& p, int l, int u, LAS unsigned char* lds, int tid, PreM<4>& R, int unext, f32x4 (&Dm)[9], float& mD, float& BE, int endslot) {
    asm volatile("" : "+v"(tid));
    const int lane = tid & 63, w = __builtin_amdgcn_readfirstlane(tid >> 6), c = u % NCH, hd = (u / NCH) & 3, b = u / (NCH * 4), r0 = chunk_row0(b, c);
    LAS unsigned char* KT = lds; LAS unsigned char* VT = lds + 18432; LAS float* wS = (LAS float*)(lds + 39168);
    if (w == 0) { const int s = lane; const bool valid = (c > 0) || (s >= LEAD);
        const float lf = valid ? flogsig(R.g.x + p.gate_b[(l * 2 + 1) * 4 + hd]) : 0.f;
        const float ig = valid ? R.g.y + p.gate_b[(l * 2 + 0) * 4 + hd] : -INFINITY;
        const float bb = wscan_add(lf, lane), be = __shfl(bb, 63), g = be - bb + ig, mg = wave_max(g), a = ig - bb, pm = wscan_max(a, lane);
        wS[s] = fexp(g - mg);
        float* ga = (float*)((unsigned char*)p.out + ST_GA) + (size_t)u * 192; ga[s] = bb; ga[64 + s] = a; ga[128 + s] = pm;
        if (lane == 0) { wS[64] = mg; wS[65] = be; } }
    { const int which = tid >> 8, ch8 = tid & 15, s0 = ((tid >> 4) & 15) * 4; float o[4][8];
        conv8<4>((const LAS float*)(lds + 65536), R.x, c, s0, which * 512 + hd * 128 + ch8 * 8, which ? 0.08838834764831845f : 1.f, o);
        bf16_t* qkc = (bf16_t*)(p.ws + WS_QKC) + (size_t)(r0 + s0) * 1024 + which * 512 + hd * 128 + ch8 * 8;
#pragma unroll
        for (int i = 0; i < 4; ++i) *(u32x4*)(qkc + (size_t)i * 1024) = pack8(o[i]);
        if (which) {
#pragma unroll
            for (int q = 0; q < 8; ++q) { *(LAS unsigned*)(KT + tsw(ch8 * 8 + q, s0)) = cvt_pk_bf16(o[0][q], o[1][q]); *(LAS unsigned*)(KT + tsw(ch8 * 8 + q, s0 + 2)) = cvt_pk_bf16(o[2][q], o[3][q]); } } }
    LDS_BARRIER();
    { const int s0 = 2 * (tid >> 4), v8 = tid & 15; float x0[8], x1[8]; unpack8(R.v[0], x0); unpack8(R.v[1], x1);
        const float w0 = ((c > 0) || (s0 >= LEAD)) ? wS[s0] : 0.f, w1 = ((c > 0) || (s0 + 1 >= LEAD)) ? wS[s0 + 1] : 0.f;
#pragma unroll
        for (int q = 0; q < 8; ++q) *(LAS unsigned*)(VT + tsw(v8 * 8 + q, s0)) = cvt_pk_bf16(x0[q] * w0, x1[q] * w1); }
    for (int i = tid; i < 16 * 64; i += NTHR) { const int row = 128 + (i >> 6), s = i & 63; *(LAS bf16_t*)(VT + tsw(row, s)) = (row == 128) ? (bf16_t)(cvt_pk_bf16(wS[s], 0.f) & 0xffffu) : (bf16_t)0; }
    if (unext >= 0) load_m<4>(p, unext, R, tid, ZO_VM);
    LDS_BARRIER();
    { const int r = lane & 15, q = lane >> 4; bf16x8 afr[2];
#pragma unroll
        for (int ks = 0; ks < 2; ++ks) afr[ks] = ldfrag(KT + tfr(w * 16 + r, ks * 4 + q));
        const float mg = wS[64], be = wS[65], mn = fmaxf(be + mD, mg), dec = fexp(be + mD - mn), wg = fexp(mg - mn);
#pragma unroll
        for (int vt = 0; vt < 9; ++vt) { f32x4 acc = {0.f, 0.f, 0.f, 0.f};
#pragma unroll
            for (int ks = 0; ks < 2; ++ks) acc = mfma16(afr[ks], ldfrag(VT + tfr(vt * 16 + r, ks * 4 + q)), acc);
            Dm[vt] = Dm[vt] * dec + acc * wg; }
        mD = mn; BE += be;
        if (endslot >= 0) { float* ra = p.RA(endslot);
#pragma unroll
            for (int vt = 0; vt < 8; ++vt) *(f32x4*)(ra + (vt * 16 + r) * 128 + w * 16 + q * 4) = Dm[vt];
            if (r == 0) *(f32x4*)(ra + 16384 + w * 16 + q * 4) = Dm[8];
            if (tid == 0) { float* rq = p.RQ(endslot); rq[0] = mD; rq[1] = BE; }
#pragma unroll
            for (int vt = 0; vt < 9; ++vt) Dm[vt] = (f32x4){0.f, 0.f, 0.f, 0.f};
            mD = -INFINITY; BE = 0.f; } }
    LDS_BARRIER();
}

__device__ __forceinline__ void gla_local(const P& p, int l, int u, LAS unsigned char* lds, int tid, PreG& R, int unext, f32x4 (&Dg)[4], float& bej, int endslot) {
    asm volatile("" : "+v"(tid));
    const int lane = tid & 63, w = __builtin_amdgcn_readfirstlane(tid >> 6), c = u % NCH, hd = (u / NCH) & 3, b = u / (NCH * 4), r0 = chunk_row0(b, c);
    const bf16_t* z = p.Z();
    LAS float* LA = (LAS float*)lds; LAS float* segtot = (LAS float*)(lds + 16640); LAS unsigned char* KHT = lds + 18688; LAS unsigned char* VT = lds + 27904;
    LAS float* cod = (LAS float*)(lds + 46336); LAS float* aw = (LAS float*)(lds + 50432); LAS float* ab = (LAS float*)(lds + 54528);
    gla_cumdecay(p, l, hd, R, c, LA, segtot, cod, aw, ab, tid);
    if (tid < 64) bej += LA[63 * 65 + tid];
    { const int s = tid >> 3, j8 = tid & 7; const bool valid = (c > 0) || (s >= LEAD); float x[8];
        unpack8(R.k, x);
#pragma unroll
        for (int q = 0; q < 8; ++q) { const int j = j8 * 8 + q; *(LAS bf16_t*)(KHT + tsw(j, s)) = (bf16_t)(cvt_pk_bf16(valid ? x[q] * fexp(LA[63 * 65 + j] - LA[s * 65 + j]) : 0.f, 0.f) & 0xffffu); } }
    { const int s0 = 2 * (tid >> 4), v8 = tid & 15; float x0[8], x1[8]; unpack8(R.v[0], x0); unpack8(R.v[1], x1);
        const float w0 = ((c > 0) || (s0 >= LEAD)) ? 1.f : 0.f, w1 = ((c > 0) || (s0 + 1 >= LEAD)) ? 1.f : 0.f;
#pragma unroll
        for (int q = 0; q < 8; ++q) *(LAS unsigned*)(VT + tsw(v8 * 8 + q, s0)) = cvt_pk_bf16(x0[q] * w0, x1[q] * w1); }
    if (unext >= 0) load_g(p, l, unext, R, tid, false);
    LDS_BARRIER();
    { const int r = lane & 15, q = lane >> 4; bf16x8 bfr[2];
#pragma unroll
        for (int ks = 0; ks < 2; ++ks) bfr[ks] = ldfrag(VT + tfr(w * 16 + r, ks * 4 + q));
#pragma unroll
        for (int jt = 0; jt < 4; ++jt) { f32x4 acc = {0.f, 0.f, 0.f, 0.f};
#pragma unroll
            for (int ks = 0; ks < 2; ++ks) acc = mfma16(ldfrag(KHT + tfr(jt * 16 + r, ks * 4 + q)), bfr[ks], acc);
            const LAS float* bend = LA + 63 * 65 + jt * 16 + q * 4;
            Dg[jt] = (f32x4){Dg[jt][0] * fexp(bend[0]) + acc[0], Dg[jt][1] * fexp(bend[1]) + acc[1], Dg[jt][2] * fexp(bend[2]) + acc[2], Dg[jt][3] * fexp(bend[3]) + acc[3]}; }
        if (endslot >= 0) { float* ra = p.RAg(endslot);
#pragma unroll
            for (int jt = 0; jt < 4; ++jt) { *(f32x4*)(ra + (w * 16 + r) * 64 + jt * 16 + q * 4) = Dg[jt]; Dg[jt] = (f32x4){0.f, 0.f, 0.f, 0.f}; }
            if (tid < 64) { p.RBg(endslot)[tid] = bej; bej = 0.f; } } }
    LDS_BARRIER();
}

template <class LD, class FOLD> __device__ __forceinline__ void scan_stream(LD ld, FOLD fold) {
    u32x2 cur[16], nxt[16];
#pragma unroll
    for (int i = 0; i < 16; ++i) cur[i] = ld(i);
#pragma unroll 1
    for (int c0 = 0; c0 < 128; c0 += 16) {
#pragma unroll
        for (int i = 0; i < 16; ++i) nxt[i] = ld(c0 + 16 + i < NCH ? c0 + 16 + i : NCH - 1);
#pragma unroll
        for (int i = 0; i < 16; ++i) fold(c0 + i, cur[i]);
#pragma unroll
        for (int i = 0; i < 16; ++i) cur[i] = nxt[i];
    }
    fold(128, cur[0]);
}
__device__ __forceinline__ int unit_lo(int b, int G) { return (int)((long)b * NU / G); }
__device__ __forceinline__ void scan_phase(const P& p, LAS unsigned char* lds, int G, int bid, int tid) {
    asm volatile("" : "+v"(tid));
    for (int item = bid; item < 16 * 13; item += G) { const int bh = item / 13, sl = item % 13;
        if (sl < 9) { const int e = sl * 2048 + tid * 4; if (e < 16512) { const int U0 = bh * NCH, U1 = U0 + NCH;
            int b0 = (int)((long)U0 * G / NU); while (unit_lo(b0 + 1, G) <= U0) ++b0; while (unit_lo(b0, G) > U0) --b0;
            f32x4 C = {0.f, 0.f, 0.f, 0.f}; float m = 0.f;
            for (int bb = b0; bb < G && unit_lo(bb, G) < U1; ++bb) { const int slot = 2 * bb + (unit_lo(bb, G) < U0 ? 1 : 0);
                *(f32x4*)(p.RS(slot) + e) = C; if (e == 0) p.RQ(slot)[2] = m;
                const f32x4 dl = *(const f32x4*)(p.RA(slot) + e); const float mD = p.RQ(slot)[0], be = p.RQ(slot)[1], mn = fmaxf(be + m, mD), dec = fexp(be + m - mn), wg = fexp(mD - mn);
                C = C * dec + dl * wg; m = mn; } } }
        else { const int e = (sl - 9) * 2048 + tid * 4, j = e & 63; const int U0 = bh * NCH, U1 = U0 + NCH;
            int b0 = (int)((long)U0 * G / NU); while (unit_lo(b0 + 1, G) <= U0) ++b0; while (unit_lo(b0, G) > U0) --b0;
            f32x4 S = {0.f, 0.f, 0.f, 0.f};
            for (int wb = b0; wb < G && unit_lo(wb, G) < U1; ++wb) { const int slot = 2 * (G - 1 - wb) + (unit_lo(wb, G) < U0 ? 1 : 0);
                *(f32x4*)(p.RSg(slot) + e) = S;
                const f32x4 dl = *(const f32x4*)(p.RAg(slot) + e), bv = *(const f32x4*)(p.RBg(slot) + j);
                S = (f32x4){S[0] * fexp(bv[0]) + dl[0], S[1] * fexp(bv[1]) + dl[1], S[2] * fexp(bv[2]) + dl[2], S[3] * fexp(bv[3]) + dl[3]}; } }
    }
    __syncthreads();
}

__device__ __forceinline__ void mlstm_out(const P& p, int l, int u, LAS unsigned char* lds, int tid, PreO& R, int unext, f32x4 (&Cm)[9], float& mcur, int startslot) {
    asm volatile("" : "+v"(tid));
    const int lane = tid & 63, w = __builtin_amdgcn_readfirstlane(tid >> 6), c = u % NCH, hd = (u / NCH) & 3, b = u / (NCH * 4), r0 = chunk_row0(b, c);
    const bf16_t* z = p.Z();
    LAS unsigned char* QS = lds; LAS unsigned char* KS = lds + 17408; LAS unsigned char* VT = lds + 34816; LAS unsigned char* SS = lds + 55552;
    LAS float* aS = (LAS float*)(lds + 64768); LAS float* MS = aS + 64; LAS float* wiS = MS + 64; LAS float* emtS = wiS + 64; LAS float* denS = emtS + 64; LAS float* part = denS + 64; LAS float* nS = part + 128;
    const int r = lane & 15, q = lane >> 4, tt = w & 3, vh = w >> 2, t = tt * 16 + r;
    const int nvt = vh ? 4 : 5;
    LAS unsigned char* CS = lds + 69632;
    LAS unsigned char* KW = lds + 108544;
    if (startslot >= 0) { const float* rs = p.RS(startslot);
#pragma unroll
        for (int vt = 0; vt < 8; ++vt) Cm[vt] = *(const f32x4*)(rs + (vt * 16 + r) * 128 + w * 16 + q * 4);
        Cm[8] = (r == 0) ? *(const f32x4*)(rs + 16384 + w * 16 + q * 4) : (f32x4){0.f, 0.f, 0.f, 0.f};
        mcur = p.RQ(startslot)[2]; }
#pragma unroll
    for (int vt = 0; vt < 8; ++vt) { u32x2 o; o.x = cvt_pk_bf16(Cm[vt][0], Cm[vt][1]); o.y = cvt_pk_bf16(Cm[vt][2], Cm[vt][3]); *(LAS u32x2*)(CS + (vt * 16 + r) * SQ + (w * 16 + q * 4) * 2) = o; }
    if (r == 0) *(LAS f32x4*)(nS + w * 16 + q * 4) = Cm[8];
    if (w == 0) { const int s = lane; const float bb = R.g.x, aa = R.g.y, pm = R.g.z, m0 = mcur, M = fmaxf(m0, pm);
        aS[s] = aa; MS[s] = M; wiS[s] = fexp(m0 - M); emtS[s] = fexp(-(bb + M)); }
#pragma unroll
    for (int it = 0; it < 4; ++it) { const int item = tid + it * NTHR, which = item >> 10, s = (item >> 4) & 63, ch8 = item & 15; *(LAS u32x4*)((which ? KS : QS) + s * SQ + ch8 * 16) = R.qk[it]; }
    const float be = R.gw.z, mg = be + R.gw.w;
#pragma unroll
    for (int it = 0; it < 2; ++it) { const int s = (tid >> 4) + 32 * it, ch8 = tid & 15; float x[8]; unpack8(R.qk[2 + it], x); const float ws = fexp((it ? R.gw.y : R.gw.x) - R.gw.w);
#pragma unroll
        for (int e = 0; e < 8; ++e) x[e] *= ws;
        *(LAS u32x4*)(KW + s * SQ + ch8 * 16) = pack8(x); }
    { const int s0 = 2 * (tid >> 4), v8 = tid & 15; float x0[8], x1[8]; unpack8(R.v[0], x0); unpack8(R.v[1], x1);
        const float w0 = ((c > 0) || (s0 >= LEAD)) ? 1.f : 0.f, w1 = ((c > 0) || (s0 + 1 >= LEAD)) ? 1.f : 0.f;
#pragma unroll
        for (int q = 0; q < 8; ++q) *(LAS unsigned*)(VT + tsw(v8 * 8 + q, s0)) = cvt_pk_bf16(x0[q] * w0, x1[q] * w1); }
    for (int i = tid; i < 16 * 64; i += NTHR) { const int row = 128 + (i >> 6), s = i & 63; *(LAS bf16_t*)(VT + tsw(row, s)) = (row == 128) ? (bf16_t)0x3f80 : (bf16_t)0; }
    if (unext >= 0) load_o(p, unext, R, tid);
    LDS_BARRIER();
    f32x4 acc2[5];
    { bf16x8 qb[4];
#pragma unroll
        for (int ks = 0; ks < 4; ++ks) qb[ks] = ldfrag(QS + (tt * 16 + r) * SQ + (ks * 32 + q * 8) * 2);
#pragma unroll
        for (int i = 0; i < 5; ++i) { acc2[i] = (f32x4){0.f, 0.f, 0.f, 0.f}; if (i < nvt) {
#pragma unroll
            for (int ks = 0; ks < 4; ++ks) { bf16x8 afr;
                if (i < 4) afr = ldfrag(CS + ((vh * 4 + i) * 16 + r) * SQ + (ks * 32 + q * 8) * 2);
                else { const f32x4 n0 = *(const LAS f32x4*)(nS + ks * 32 + q * 8), n1 = *(const LAS f32x4*)(nS + ks * 32 + q * 8 + 4); const float mk = (r == 0) ? 1.f : 0.f;
                    const float nn[8] = {n0.x * mk, n0.y * mk, n0.z * mk, n0.w * mk, n1.x * mk, n1.y * mk, n1.z * mk, n1.w * mk};
                    afr = __builtin_bit_cast(bf16x8, pack8(nn)); }
                acc2[i] = mfma16(afr, qb[ks], acc2[i]); } } }
        const float Mt = MS[t];
#pragma unroll
        for (int cc = 0; cc < 2; ++cc) { const int st = vh * 2 + cc; f32x4 acc = {0.f, 0.f, 0.f, 0.f};
            if (st <= tt) {
#pragma unroll
                for (int ks = 0; ks < 4; ++ks) acc = mfma16(ldfrag(KS + (st * 16 + r) * SQ + (ks * 32 + q * 8) * 2), qb[ks], acc); }
            float sv[4];
#pragma unroll
            for (int j = 0; j < 4; ++j) { const int s = st * 16 + q * 4 + j; sv[j] = (s <= t) ? acc[j] * fexp(aS[s] - Mt) : 0.f; }
            u32x2 o; o.x = cvt_pk_bf16(sv[0], sv[1]); o.y = cvt_pk_bf16(sv[2], sv[3]); *(LAS u32x2*)(SS + t * ST + (st * 16 + q * 4) * 2) = o; } }
    LDS_BARRIER();
    {
        const float mn = fmaxf(be + mcur, mg), dec = fexp(be + mcur - mn), wg = fexp(mg - mn); bf16x8 ka[2];
#pragma unroll
        for (int ks = 0; ks < 2; ++ks) ka[ks] = tr_frag(KW, SQ, ks * 32, w * 16, lane);
#pragma unroll
        for (int vt = 0; vt < 9; ++vt) { f32x4 dl = {0.f, 0.f, 0.f, 0.f};
#pragma unroll
            for (int ks = 0; ks < 2; ++ks) dl = mfma16(ka[ks], ldfrag(VT + tfr(vt * 16 + r, ks * 4 + q)), dl);
            Cm[vt] = Cm[vt] * dec + dl * wg; }
        mcur = mn; }
    f32x4 hv[5];
    { bf16x8 sb[2];
#pragma unroll
        for (int ks = 0; ks < 2; ++ks) sb[ks] = ldfrag(SS + (tt * 16 + r) * ST + (ks * 32 + q * 8) * 2);
        const float wi = wiS[t];
#pragma unroll
        for (int i = 0; i < 5; ++i) { if (i < nvt) { const int vt = (i < 4) ? vh * 4 + i : 8; f32x4 a1 = {0.f, 0.f, 0.f, 0.f};
#pragma unroll
            for (int ks = 0; ks < 2; ++ks) a1 = mfma16(ldfrag(VT + tfr(vt * 16 + r, ks * 4 + q)), sb[ks], a1);
            hv[i] = a1 + acc2[i] * wi; } }
        if (vh == 0 && q == 0) denS[t] = hv[4][0]; }
    u32x2 og[4]; f32x4 gn[4];
#pragma unroll
    for (int i = 0; i < 4; ++i) { const int v0 = (vh * 4 + i) * 16 + q * 4; og[i] = *(const u32x2*)(z + (size_t)(r0 + t) * NIN + ZO_OM + hd * 128 + v0); gn[i] = *(const LAS f32x4*)((const LAS float*)(lds + 104448) + hd * 128 + v0); }
    LDS_BARRIER();
    { const float dn = frcp(fmaxf(fabsf(denS[t]), emtS[t])); float ssq = 0.f;
#pragma unroll
        for (int i = 0; i < 4; ++i) { hv[i] = hv[i] * dn; ssq += hv[i][0] * hv[i][0] + hv[i][1] * hv[i][1] + hv[i][2] * hv[i][2] + hv[i][3] * hv[i][3]; }
        ssq += __shfl_xor(ssq, 16); ssq += __shfl_xor(ssq, 32); if (q == 0) part[t * 2 + vh] = ssq; }
    LDS_BARRIER();
    { const bool valid = (c > 0) || (t >= LEAD); const float sc = frsq((part[t * 2] + part[t * 2 + 1]) * (1.f / 128.f) + EPS); bf16_t* yp = p.Z() + (size_t)(r0 + t) * NIN + ZO_OM + hd * 128;
#pragma unroll
        for (int i = 0; i < 4; ++i) { const int v0 = (vh * 4 + i) * 16 + q * 4; float y[4];
            y[0] = hv[i][0] * sc * gn[i][0] * fsigm(bflo(og[i].x)); y[1] = hv[i][1] * sc * gn[i][1] * fsigm(bfhi(og[i].x)); y[2] = hv[i][2] * sc * gn[i][2] * fsigm(bflo(og[i].y)); y[3] = hv[i][3] * sc * gn[i][3] * fsigm(bfhi(og[i].y));
            u32x2 o; o.x = valid ? cvt_pk_bf16(y[0], y[1]) : 0u; o.y = valid ? cvt_pk_bf16(y[2], y[3]) : 0u; *(u32x2*)(yp + v0) = o; } }
    LDS_BARRIER();
}

__device__ __forceinline__ void gla_out(const P& p, int l, int u, LAS unsigned char* lds, int tid, PreG& R, int unext, f32x4 (&Sm)[4], int startslot) {
    asm volatile("" : "+v"(tid));
    const int lane = tid & 63, w = __builtin_amdgcn_readfirstlane(tid >> 6), c = u % NCH, hd = (u / NCH) & 3, b = u / (NCH * 4), r0 = chunk_row0(b, c);
    const bf16_t* z = p.Z();
    LAS float* LA = (LAS float*)lds; LAS float* segtot = (LAS float*)(lds + 16640); LAS unsigned char* QT = lds + 18688; LAS unsigned char* KT2 = lds + 27904; LAS unsigned char* VT = lds + 37120; LAS unsigned char* AS = lds + 55552;
    LAS float* cod = (LAS float*)(lds + 64768); LAS float* aw = (LAS float*)(lds + 68864); LAS float* ab = (LAS float*)(lds + 72960); LAS float* part = (LAS float*)(lds + 73216);
    const int r = lane & 15, q = lane >> 4, tt = w & 3, dh = w >> 2, t = tt * 16 + r;
    LAS unsigned char* STs = lds + 73728;
    if (startslot >= 0) { const float* rs = p.RSg(startslot);
#pragma unroll
        for (int jt = 0; jt < 4; ++jt) Sm[jt] = *(const f32x4*)(rs + (w * 16 + r) * 64 + jt * 16 + q * 4); }
#pragma unroll
    for (int jt = 0; jt < 4; ++jt) { u32x2 o; o.x = cvt_pk_bf16(Sm[jt][0], Sm[jt][1]); o.y = cvt_pk_bf16(Sm[jt][2], Sm[jt][3]); *(LAS u32x2*)(STs + (w * 16 + r) * ST + (jt * 16 + q * 4) * 2) = o; }
    gla_cumdecay(p, l, hd, R, c, LA, segtot, cod, aw, ab, tid);
    { const int s = tid >> 3, j8 = tid & 7; const bool valid = (c > 0) || (s >= LEAD); float xq[8], xk[8];
        unpack8(R.q, xq); unpack8(R.k, xk);
#pragma unroll
        for (int q = 0; q < 8; ++q) { const float bb = LA[s * 65 + j8 * 8 + q]; xq[q] = valid ? xq[q] * 0.125f * fexp(bb) : 0.f; xk[q] = valid ? xk[q] * fexp(-bb) : 0.f; }
        *(LAS u32x4*)(QT + s * ST + j8 * 16) = pack8(xq); *(LAS u32x4*)(KT2 + s * ST + j8 * 16) = pack8(xk); }
    { const int s0 = 2 * (tid >> 4), v8 = tid & 15; float x0[8], x1[8]; unpack8(R.v[0], x0); unpack8(R.v[1], x1);
        const float w0 = ((c > 0) || (s0 >= LEAD)) ? 1.f : 0.f, w1 = ((c > 0) || (s0 + 1 >= LEAD)) ? 1.f : 0.f;
#pragma unroll
        for (int q = 0; q < 8; ++q) *(LAS unsigned*)(VT + tsw(v8 * 8 + q, s0)) = cvt_pk_bf16(x0[q] * w0, x1[q] * w1); }
    if (unext >= 0) load_g(p, l, unext, R, tid, true);
    LDS_BARRIER();
    f32x4 hv[4];
    { bf16x8 qb[2];
#pragma unroll
        for (int ks = 0; ks < 2; ++ks) qb[ks] = ldfrag(QT + (tt * 16 + r) * ST + (ks * 32 + q * 8) * 2);
#pragma unroll
        for (int i = 0; i < 4; ++i) { hv[i] = (f32x4){0.f, 0.f, 0.f, 0.f};
#pragma unroll
            for (int ks = 0; ks < 2; ++ks) hv[i] = mfma16(ldfrag(STs + ((dh * 4 + i) * 16 + r) * ST + (ks * 32 + q * 8) * 2), qb[ks], hv[i]); }
#pragma unroll
        for (int cc = 0; cc < 2; ++cc) { const int st = dh * 2 + cc; f32x4 acc = {0.f, 0.f, 0.f, 0.f};
            if (st <= tt) {
#pragma unroll
                for (int ks = 0; ks < 2; ++ks) acc = mfma16(ldfrag(KT2 + (st * 16 + r) * ST + (ks * 32 + q * 8) * 2), qb[ks], acc); }
            float sv[4];
#pragma unroll
            for (int j = 0; j < 4; ++j) { const int s = st * 16 + q * 4 + j; sv[j] = (s <= t) ? acc[j] : 0.f; }
            u32x2 o; o.x = cvt_pk_bf16(sv[0], sv[1]); o.y = cvt_pk_bf16(sv[2], sv[3]); *(LAS u32x2*)(AS + t * ST + (st * 16 + q * 4) * 2) = o; } }
    u32x2 og[4]; f32x4 gn[4];
#pragma unroll
    for (int i = 0; i < 4; ++i) { const int d0 = (dh * 4 + i) * 16 + q * 4; og[i] = *(const u32x2*)(z + (size_t)(r0 + t) * NIN + ZO_GG + hd * 128 + d0); gn[i] = *(const LAS f32x4*)((const LAS float*)(lds + 104448) + 512 + hd * 128 + d0); }
    LDS_BARRIER();
    {
        bf16x8 vb[2];
#pragma unroll
        for (int ks = 0; ks < 2; ++ks) vb[ks] = ldfrag(VT + tfr(w * 16 + r, ks * 4 + q));
#pragma unroll
        for (int jt = 0; jt < 4; ++jt) { f32x4 dl = {0.f, 0.f, 0.f, 0.f};
#pragma unroll
            for (int ks = 0; ks < 2; ++ks) dl = mfma16(tr_frag(KT2, ST, ks * 32, jt * 16, lane), vb[ks], dl);
            const LAS float* bend = LA + 63 * 65 + jt * 16 + q * 4;
            Sm[jt] = (f32x4){(Sm[jt][0] + dl[0]) * fexp(bend[0]), (Sm[jt][1] + dl[1]) * fexp(bend[1]), (Sm[jt][2] + dl[2]) * fexp(bend[2]), (Sm[jt][3] + dl[3]) * fexp(bend[3])}; } }
    { bf16x8 ab2[2];
#pragma unroll
        for (int ks = 0; ks < 2; ++ks) ab2[ks] = ldfrag(AS + (tt * 16 + r) * ST + (ks * 32 + q * 8) * 2);
        float ssq = 0.f;
#pragma unroll
        for (int i = 0; i < 4; ++i) { const int dt = dh * 4 + i;
#pragma unroll
            for (int ks = 0; ks < 2; ++ks) hv[i] = mfma16(ldfrag(VT + tfr(dt * 16 + r, ks * 4 + q)), ab2[ks], hv[i]);
            ssq += hv[i][0] * hv[i][0] + hv[i][1] * hv[i][1] + hv[i][2] * hv[i][2] + hv[i][3] * hv[i][3]; }
        ssq += __shfl_xor(ssq, 16); ssq += __shfl_xor(ssq, 32); if (q == 0) part[t * 2 + dh] = ssq; }
    LDS_BARRIER();
    { const bool valid = (c > 0) || (t >= LEAD); const float sc = frsq((part[t * 2] + part[t * 2 + 1]) * (1.f / 128.f) + EPS); bf16_t* yp = p.Z() + (size_t)(r0 + t) * NIN + ZO_GG + hd * 128;
#pragma unroll
        for (int i = 0; i < 4; ++i) { const int d0 = (dh * 4 + i) * 16 + q * 4; float y[4];
            y[0] = hv[i][0] * sc * gn[i][0] * fsilu(bflo(og[i].x)); y[1] = hv[i][1] * sc * gn[i][1] * fsilu(bfhi(og[i].x)); y[2] = hv[i][2] * sc * gn[i][2] * fsilu(bflo(og[i].y)); y[3] = hv[i][3] * sc * gn[i][3] * fsilu(bfhi(og[i].y));
            u32x2 o; o.x = valid ? cvt_pk_bf16(y[0], y[1]) : 0u; o.y = valid ? cvt_pk_bf16(y[2], y[3]) : 0u; *(u32x2*)(yp + d0) = o; } }
    LDS_BARRIER();
}
}

namespace pro {
#define PRO_TILE(LD4, GK, OUTROW) do { \
        f32x4 v_[8]; \
        _Pragma("unroll") for (int i = 0; i < 8; ++i) { const int kk = 8 * i + (lane >> 3); v_[i] = (LD4); } \
        _Pragma("unroll") for (int i = 0; i < 8; ++i) { const int kk = 8 * i + (lane >> 3); const float g_ = (GK); LAS float* d_ = scr + kk * 33 + (lane & 7) * 4; d_[0] = v_[i].x * g_; d_[1] = v_[i].y * g_; d_[2] = v_[i].z * g_; d_[3] = v_[i].w * g_; } \
        asm volatile("s_waitcnt lgkmcnt(0)" ::: "memory"); \
        { const int c8 = lane & 7; _Pragma("unroll") for (int j = 0; j < 4; ++j) { const int nn = (lane >> 3) + 8 * j; const LAS float* s_ = scr + (8 * c8) * 33 + nn; \
            pg8::u32x4 o_; o_.x = pg8::cvt_pk_bf16(s_[0], s_[33]); o_.y = pg8::cvt_pk_bf16(s_[66], s_[99]); o_.z = pg8::cvt_pk_bf16(s_[132], s_[165]); o_.w = pg8::cvt_pk_bf16(s_[198], s_[231]); \
            *(pg8::u32x4*)((OUTROW) + 8 * c8) = o_; } } \
        asm volatile("s_waitcnt lgkmcnt(0)" ::: "memory"); } while (0)
#define PRO_TILE8(LD4, GK, OUTROW8) do { \
        f32x4 v_[8]; \
        _Pragma("unroll") for (int i = 0; i < 8; ++i) { const int kk = 8 * i + (lane >> 3); v_[i] = (LD4); } \
        _Pragma("unroll") for (int i = 0; i < 8; ++i) { const int kk = 8 * i + (lane >> 3); const float g_ = (GK); LAS float* d_ = scr + kk * 33 + (lane & 7) * 4; d_[0] = v_[i].x * g_; d_[1] = v_[i].y * g_; d_[2] = v_[i].z * g_; d_[3] = v_[i].w * g_; } \
        asm volatile("s_waitcnt lgkmcnt(0)" ::: "memory"); \
        { const int c8 = lane & 7; _Pragma("unroll") for (int j = 0; j < 4; ++j) { const int nn = (lane >> 3) + 8 * j; const LAS float* s_ = scr + (8 * c8) * 33 + nn; \
            pg8::u32x2 o_; o_.x = pg8::pk_fp8x4(s_[0], s_[33], s_[66], s_[99]); o_.y = pg8::pk_fp8x4(s_[132], s_[165], s_[198], s_[231]); \
            *(pg8::u32x2*)((OUTROW8) + 8 * c8) = o_; } } \
        asm volatile("s_waitcnt lgkmcnt(0)" ::: "memory"); } while (0)
__device__ __forceinline__ void prologue_phase(const P& p, LAS unsigned char* lds, int G, int bid, int tid) {
    asm volatile("" : "+v"(tid));
    const int lane = tid & 63, w = __builtin_amdgcn_readfirstlane(tid >> 6), gw = bid * NWAVES + w, NGW = G * NWAVES;
    LAS float* scr = (LAS float*)(lds + w * 8448);
    constexpr int I_IN = DEPTH * 16 * (NZP / 32), I_OUT = DEPTH * 16 * (D / 32), I_GU = DEPTH * NE * 16 * (512 / 32), I_D = DEPTH * NE * (DE / 64) * (D / 32);
    const f32x4 zero4 = {0.f, 0.f, 0.f, 0.f};
    for (int it = gw; it < I_IN + I_OUT + I_GU + I_D; it += NGW) {
        int r = it;
        if (r < I_IN) { const int nb = r % (NZP / 32), kb = (r / (NZP / 32)) % 16, l = r / (16 * (NZP / 32)), k0 = kb * 64, n0 = nb * 32;
            const int n = n0 + (lane & 7) * 4; const float* src = p.w_in + ((size_t)l * D + k0) * NIN + zsrc(n); const float* g = p.norm1_g + l * D + k0;
            bf16_t* ob = (bf16_t*)(p.ws + WS_WIN) + ((size_t)l * NZP + n0) * D + k0;
            PRO_TILE((n < NIN) ? *(const f32x4*)(src + (size_t)kk * NIN) : zero4, g[kk], ob + (size_t)nn * D);
            continue; }
        r -= I_IN;
        if (r < I_OUT) { const int nb = r % 32, kb = (r / 32) % 16, l = r / 512, k0 = kb * 64, n0 = nb * 32;
            const float* src = p.w_out + ((size_t)l * D + k0) * D + n0 + (lane & 7) * 4; bf16_t* ob = (bf16_t*)(p.ws + WS_WOUT) + ((size_t)l * D + n0) * D + k0;
            PRO_TILE(*(const f32x4*)(src + (size_t)kk * D), 1.f, ob + (size_t)nn * D);
            continue; }
        r -= I_OUT;
        if (r < I_GU) { const int nb = r % 16, kb = (r / 16) % 16, bz = r / 256, k0 = kb * 64, n0 = nb * 32;
            const int i4 = (lane & 7) * 4; const float* src = ((i4 < 16) ? p.w_gate : p.w_up) + ((size_t)bz * D + k0) * DE + 16 * nb + (i4 & 15); const float* g = p.norm2_g + (bz >> 5) * D + k0;
            unsigned char* ob8 = p.ws + WS_WGU + ((size_t)bz * 512 + n0) * D + k0;
            PRO_TILE8(*(const f32x4*)(src + (size_t)kk * DE), g[kk] * 16.f, ob8 + (size_t)nn * D);
            continue; }
        r -= I_GU;
        { const int nb = r % 32, kb = (r / 32) % 4, bz = r / 128, k0 = kb * 64, n0 = nb * 32;
            const float* src = p.w_down + ((size_t)bz * DE + k0) * D + n0 + (lane & 7) * 4; unsigned char* ob8 = p.ws + WS_WD + ((size_t)bz * D + n0) * DE + k0;
            PRO_TILE8(*(const f32x4*)(src + (size_t)kk * D), 8.f, ob8 + (size_t)nn * DE); }
    }
    for (int idx = bid * NTHR + tid; idx < DEPTH * 48 * D; idx += G * NTHR) { const int k = idx % D, o = (idx / D) % 48, l = idx / (D * 48); float v = 0.f;
        if (o < 4) v = p.wr_g[((size_t)l * D + k) * 4 + o]; else if (o < 36) v = p.wr_e[((size_t)l * D + k) * 32 + (o - 4)];
        v *= p.norm2_g[l * D + k]; const bf16_t hi = f2bf(v), lo = f2bf(v - bf2f(hi));
        bf16_t* wh = (bf16_t*)(p.ws + WS_WRS); wh[idx] = hi; wh[(size_t)DEPTH * 48 * D + idx] = lo; }
    for (int r = gw; r < MP; r += NGW) { const float* src = nullptr;
        if (r < XR) src = p.x + (size_t)r * D; else if (((r - XR) & 63) >= LEAD) src = p.meta + (size_t)(((r - XR) & 63) - LEAD) * D;
        float s = 0.f; bf16_t* hr = p.H() + (size_t)r * D;
#pragma unroll
        for (int j = 0; j < 4; ++j) { f32x4 v = {0.f, 0.f, 0.f, 0.f}; if (src) v = ((const f32x4*)src)[lane + 64 * j];
            s += v.x * v.x + v.y * v.y + v.z * v.z + v.w * v.w;
            pg8::u32x2 o; o.x = pg8::cvt_pk_bf16(v.x, v.y); o.y = pg8::cvt_pk_bf16(v.z, v.w); ((pg8::u32x2*)hr)[lane + 64 * j] = o; }
        s = wave_sum(s);
        if (lane == 0) { f32x4 q = {s, 0.f, 0.f, 0.f}; *(f32x4*)(p.SS1() + (size_t)r * 4) = q; } }
}
#undef PRO_TILE
#undef PRO_TILE8
__device__ __forceinline__ void final_phase(const P& p, int G, int bid, int tid) {
    asm volatile("" : "+v"(tid));
    const int lane = tid & 63, w = tid >> 6;
    for (int t = bid * NWAVES + w; t < B * SEQ; t += G * NWAVES) { const int r = t;
        const float rs = row_rs(p.SS1(), r); const bf16_t* hr = p.H() + (size_t)r * D; float* o = p.out + (size_t)t * D;
#pragma unroll
        for (int j = 0; j < 4; ++j) { const pg8::u32x2 hv = ((const pg8::u32x2*)hr)[lane + 64 * j]; const f32x4 g = ((const f32x4*)p.final_g)[lane + 64 * j];
            f32x4 v; v.x = pg8::bflo(hv.x) * rs * g.x; v.y = pg8::bfhi(hv.x) * rs * g.y; v.z = pg8::bflo(hv.y) * rs * g.z; v.w = pg8::bfhi(hv.y) * rs * g.w;
            ((f32x4*)o)[lane + 64 * j] = v; } }
}
}

struct Args { P p; int ph_lo, ph_hi; };
__global__ void __launch_bounds__(NTHR, 2) fwd(Args a) {
    extern __shared__ __attribute__((aligned(16))) unsigned char lds_raw[];
    LAS unsigned char* lds = (LAS unsigned char*)lds_raw;
    const P& p = a.p;
    const int tid = threadIdx.x, G = gridDim.x, bid = blockIdx.x;
    unsigned* ctl = (unsigned*)(p.ws + WS_CTL);
    volatile LAS unsigned* MISC = (volatile LAS unsigned*)(lds + MISC_OFF);
    if (tid < 128) MISC[tid] = 0u;
    __syncthreads();
    XcdBarrier bar = xcd_barrier_post(ctl + CW_BAR, MISC + 8);
#define IN(k) true
#define SEAM(k) xcd_barrier(bar)
    if (IN(PH_PRO)) {
pro::prologue_phase(p, lds, G, bid, tid); }
    SEAM(PH_PRO);
    const int bid0 = bid, G0 = G;
    for (int l = 0; l < DEPTH; ++l) {
        int bid = bid0, G = G0; asm volatile("" : "+s"(bid), "+s"(G));
        const int pb = PH_LAYER0 + l * PH_PER_LAYER;
        unsigned* gcnt = ctl + CW_CNT + l * 64 * 16;
        if (IN(pb + 0)) {
{
            pg8::DenseOrderRS<D, D> S; S.init(MP, NZP, G, bid); S.lds = lds; S.ws = p.ws;
            pg8::EpiZ E{p.ws, lds};
            pg8::gemm_phase<pg8::EpiZ, pg8::DenseOrderRS<D, D>, true, D, D>(lds + RING_OFF, (const char*)(p.ws + WS_H), (const char*)(p.ws + WS_WIN) + (size_t)l * NZP * D * 2, S, E);
            }
        }
        SEAM(pb + 0);
        if (IN(pb + 1)) {
            { LAS float* cw = (LAS float*)(lds + 65536);
                for (int i = tid; i < 5 * 1024; i += NTHR) cw[i] = i < 4096 ? p.conv_w[l * 4096 + i] : p.conv_b[l * D + (i - 4096)];
                __syncthreads(); }
{ { const int ulo = (int)((long)bid * NU / G), uhi = (int)((long)(bid + 1) * NU / G);
                if (ulo < uhi) { mx::PreM<4> pre; mx::load_m<4>(p, ulo, pre, tid, ZO_VM); f32x4 Dm[9]; float mD = -INFINITY, BE = 0.f; int seg = 0;
#pragma unroll
                    for (int i = 0; i < 9; ++i) Dm[i] = (f32x4){0.f, 0.f, 0.f, 0.f};
                    for (int u = ulo; u < uhi; ++u) { const bool endrun = (u + 1 == uhi) || ((u + 1) % NCH) == 0;
                        mx::mlstm_local(p, l, u, lds, tid, pre, u + 1 < uhi ? u + 1 : -1, Dm, mD, BE, endrun ? 2 * bid + seg : -1); if (endrun) ++seg; } }
                { const int glo = (int)((long)(G - 1 - bid) * NU / G), ghi = (int)((long)(G - bid) * NU / G);
                if (glo < ghi) { mx::PreG pre; mx::load_g(p, l, glo, pre, tid, false); f32x4 Dg[4]; float bej = 0.f; int seg = 0;
#pragma unroll
                    for (int i = 0; i < 4; ++i) Dg[i] = (f32x4){0.f, 0.f, 0.f, 0.f};
                    for (int u = glo; u < ghi; ++u) { const bool endrun = (u + 1 == ghi) || ((u + 1) % NCH) == 0;
                        mx::gla_local(p, l, u, lds, tid, pre, u + 1 < ghi ? u + 1 : -1, Dg, bej, endrun ? 2 * bid + seg : -1); if (endrun) ++seg; } } } } } }
        SEAM(pb + 1);
        if (IN(pb + 2)) mx::scan_phase(p, lds, G, bid, tid);
        SEAM(pb + 2);
        if (IN(pb + 3)) {
            { LAS float* gt = (LAS float*)(lds + 104448);
                for (int i = tid; i < 1024; i += NTHR) gt[i] = i < 512 ? p.m_norm_g[l * 512 + i] : p.g_norm_g[l * 512 + (i - 512)];
                __syncthreads(); }
 { const int ulo = (int)((long)bid * NU / G), uhi = (int)((long)(bid + 1) * NU / G);
                if (ulo < uhi) { mx::PreO pre; mx::load_o(p, ulo, pre, tid); f32x4 Cm[9]; float mcur = 0.f;
#pragma unroll
                    for (int i = 0; i < 9; ++i) Cm[i] = (f32x4){0.f, 0.f, 0.f, 0.f};
                    int seg = 0;
                    for (int u = ulo; u < uhi; ++u) { const bool startrun = (u == ulo) || (u % NCH) == 0; if (startrun && u != ulo) ++seg;
                        mx::mlstm_out(p, l, u, lds, tid, pre, u + 1 < uhi ? u + 1 : -1, Cm, mcur, startrun ? 2 * bid + seg : -1); } }
                { const int glo = (int)((long)(G - 1 - bid) * NU / G), ghi = (int)((long)(G - bid) * NU / G);
                if (glo < ghi) { mx::PreG pre; mx::load_g(p, l, glo, pre, tid, true); f32x4 Sm[4]; int seg = 0;
#pragma unroll
                    for (int i = 0; i < 4; ++i) Sm[i] = (f32x4){0.f, 0.f, 0.f, 0.f};
                    for (int u = glo; u < ghi; ++u) { const bool startrun = (u == glo) || (u % NCH) == 0; if (startrun && u != glo) ++seg;
                        mx::gla_out(p, l, u, lds, tid, pre, u + 1 < ghi ? u + 1 : -1, Sm, startrun ? 2 * bid + seg : -1); } } } } }
        SEAM(pb + 3);
        if (IN(pb + 4)) {
            pg8::DenseOrder<NIN, D> S; S.init(XR, D, G, bid);
            pg8::EpiRes<false, false, WS_SS2, true> E{p.ws, lds};
            pg8::gemm_phase<pg8::EpiRes<false, false, WS_SS2, true>, pg8::DenseOrder<NIN, D>, true, NIN, D>(lds + RING_OFF, (const char*)(p.ws + WS_Z), (const char*)(p.ws + WS_WOUT) + (size_t)l * D * D * 2, S, E);
            int tl_ = tid; asm volatile("" : "+v"(tl_));
            if (tl_ < 64) { const int lane = tl_, r = lane & 15, q = lane >> 4; const bf16_t* wo = p.Wout() + (size_t)l * D * D;
                for (int tt = bid; tt < 4 * (D / 16); tt += G) { const int b4 = tt / (D / 16), ct = tt % (D / 16), row0 = XR + b4 * 64 + LEAD;
                    const bf16_t* ap = p.Z() + (size_t)(row0 + r) * NIN + q * 8; const bf16_t* bp = wo + (size_t)(ct * 16 + r) * D + q * 8; f32x4 acc = {0.f, 0.f, 0.f, 0.f};
#pragma unroll 8
                    for (int ks = 0; ks < 32; ++ks) acc = __builtin_amdgcn_mfma_f32_16x16x32_bf16(*(const pg8::bf16x8*)(ap + ks * 32), *(const pg8::bf16x8*)(bp + ks * 32), acc, 0, 0, 0);
#pragma unroll
                    for (int j = 0; j < 4; ++j) { const size_t o = (size_t)(row0 + q * 4 + j) * D + ct * 16 + r; const float v = bf2f(p.H()[o]) + acc[j];
                        p.H()[o] = (bf16_t)(pg8::cvt_pk_bf16(v, 0.f) & 0xffffu); (p.ws + WS_H8)[o] = (unsigned char)(pg8::pk_fp8x4(v, 0.f, 0.f, 0.f) & 0xffu); } } }
        }
        SEAM(pb + 4);
        if (IN(pb + 5)) route_phase(p, l, lds, G, bid, gcnt);
        SEAM(pb + 5);
        if (IN(pb + 6)) {
{
            moe_build_tab((LAS MoeTab*)(lds + TAB_OFF), gcnt);
            typedef MoeOrder<true, 2, D / 2, D / 2, 512u * D> Ord;
            Ord S; S.lds = lds; S.ws = p.ws; S.rbLo = 0; S.nwg = ((const LAS MoeTab*)(lds + TAB_OFF))->rb0[64] * 2; S.G = G; S.c = bid;
            pg8::EpiUp E{p.ws, lds};
            pg8::gemm_phase<pg8::EpiUp, Ord, true, D / 2, D / 2, true>(lds + RING_OFF, (const char*)(p.ws + WS_H8), (const char*)(p.ws + WS_WGU) + (size_t)l * NE * 512 * D, S, E);
            }
        }
        SEAM(pb + 6);
#pragma unroll
        for (int rank = 0; rank < 2; ++rank) {
            if (IN(pb + 7 + rank)) {
                moe_build_tab((LAS MoeTab*)(lds + TAB_OFF), gcnt);
                const LAS MoeTab* T = (const LAS MoeTab*)(lds + TAB_OFF);
                typedef MoeOrder<false, 4, DE / 2, DE / 2, (unsigned)D * DE> Ord;
                Ord S; S.lds = lds; S.ws = p.ws; S.rbLo = T->rb0[32 * rank]; S.nwg = (T->rb0[32 * rank + 32] - T->rb0[32 * rank]) * 4; S.G = G; S.c = bid;
                const char* Ab = (const char*)(p.ws + WS_HID); const char* Bb = (const char*)(p.ws + WS_WD) + (size_t)l * NE * D * DE;
                if (rank == 0) { pg8::EpiRes<true, false, WS_SS1> E{p.ws, lds}; pg8::gemm_phase<pg8::EpiRes<true, false, WS_SS1>, Ord, true, DE / 2, DE / 2, true>(lds + RING_OFF, Ab, Bb, S, E); }
                else { pg8::EpiRes<true, true, WS_SS1> E{p.ws, lds}; pg8::gemm_phase<pg8::EpiRes<true, true, WS_SS1>, Ord, true, DE / 2, DE / 2, true>(lds + RING_OFF, Ab, Bb, S, E); }
            }
            SEAM(pb + 7 + rank);
        }
    }
    if (IN(PH_FINAL)) pro::final_phase(p, G, bid, tid);
#undef IN
#undef SEAM
}

extern "C" void kernel_launch(void* const* d_in, const int* in_sizes, int n_in, void* d_out, int out_size, void* d_ws, size_t ws_size, hipStream_t stream) {
    if (n_in != 21 || ws_size < WS_END || out_size != B * SEQ * D) { fprintf(stderr, "kernel_launch: unexpected sizes n_in %d ws %zu (need %zu) out %d\n", n_in, ws_size, (size_t)WS_END, out_size); return; }
    P p{};
    const float** f = (const float**)&p.x;
    for (int i = 0; i < 21; ++i) f[i] = (const float*)d_in[i];
    p.out = (float*)d_out; p.ws = (unsigned char*)d_ws;
    static int grid = 0;
    if (!grid) {
        (void)hipFuncSetAttribute((const void*)fwd, hipFuncAttributeMaxDynamicSharedMemorySize, LDS_BYTES);
        int dev = 0, cus = 0, per_cu = 0;
        (void)hipGetDevice(&dev); (void)hipDeviceGetAttribute(&cus, hipDeviceAttributeMultiprocessorCount, dev);
        (void)hipOccupancyMaxActiveBlocksPerMultiprocessor(&per_cu, (const void*)fwd, NTHR, LDS_BYTES);
        (void)hipGetLastError();
        grid = cus > 0 ? cus : 256;
        if (per_cu < 1) fprintf(stderr, "kernel_launch: occupancy query reports %d blocks/CU for fwd\n", per_cu);
    }
    (void)hipMemsetAsync(d_ws, 0, CTL_BYTES, stream);
    Args a{}; a.p = p; a.ph_lo = 0; a.ph_hi = PH_COUNT;
    hipLaunchKernelGGL(fwd, dim3(grid), dim3(NTHR), LDS_BYTES, stream, a);
}
```

```cpp
#include <hip/hip_runtime.h>
#include <cstdio>
#include <cstdint>

typedef unsigned short bf16_t;
typedef float f32x4 __attribute__((ext_vector_type(4)));

namespace cfg {
constexpr int B = 4, SEQ = 8192, D = 1024, DEPTH = 2;
constexpr int CH = 64, NMETA = 16, LEAD = 48;
constexpr int TP = LEAD + NMETA + SEQ;
constexpr int NCH = TP / CH;
constexpr int MP = B * TP;
constexpr int XR = B * SEQ;
constexpr int NIN = 3608, NZP = 3840;
constexpr int ZO_OM = 0, ZO_GG = 512, ZO_QM = 1024, ZO_KM = 1536, ZO_VM = 2048, ZO_QG = 2560, ZO_KG = 2816, ZO_VG = 3072, ZO_IG = 3584, ZO_FG = 3588, ZO_CODE = 3592;
constexpr int NE = 32, DE = 256, NR = 40;
constexpr float EPS = 1e-6f;
constexpr int NU = B * 4 * NCH;

constexpr size_t al(size_t x) { return (x + 255) & ~(size_t)255; }
constexpr size_t WS_CTL = 0, CTL_BYTES = 4u << 20;
constexpr size_t WS_WIN = WS_CTL + CTL_BYTES;
constexpr size_t WS_WOUT = WS_WIN + al((size_t)DEPTH * NZP * D * 2);
constexpr size_t WS_WGU = WS_WOUT + al((size_t)DEPTH * D * D * 2);
constexpr size_t WS_H8 = WS_WGU + al((size_t)DEPTH * NE * 512 * D);
constexpr size_t WS_WD = WS_H8 + al((size_t)MP * D);
constexpr size_t WS_WR = WS_WD + al((size_t)DEPTH * NE * D * DE * 2);
constexpr size_t WS_H = WS_WR + al((size_t)DEPTH * NR * D * 4);
constexpr size_t WS_Z = WS_H + al((size_t)MP * D * 2);
constexpr size_t WS_SS1 = WS_Z + al((size_t)MP * NIN * 2);
constexpr size_t WS_SS2 = WS_SS1 + al((size_t)MP * 16);
constexpr size_t WS_TOKE = WS_SS2 + al((size_t)MP * 16);
constexpr size_t WS_TOKW = WS_TOKE + al((size_t)MP * 8);
constexpr int CAPL = MP, NBMAX = 352;
constexpr size_t WS_LTOK = WS_TOKW + al((size_t)MP * 8);
constexpr size_t WS_LRS = WS_LTOK + al((size_t)64 * CAPL * 4);
constexpr size_t WS_LW = WS_LRS + al((size_t)64 * CAPL * 4);
constexpr size_t WS_WRS = WS_LW + al((size_t)64 * CAPL * 4);
constexpr size_t WS_QKC = WS_WRS + al((size_t)2 * DEPTH * 48 * D * 2);
constexpr size_t WS_END = WS_QKC + al((size_t)MP * 1024 * 2);
constexpr size_t WS_HID = WS_QKC;
static_assert((size_t)NBMAX * 256 * 256 * 2 <= (size_t)MP * 1024 * 2, "hid fits in the q|k buffer");
constexpr size_t ST_MC = 0;
constexpr size_t ST_GS = ST_MC + al((size_t)NU * 16384 * 2);
constexpr size_t ST_MN = ST_GS + al((size_t)NU * 8192 * 2);
constexpr size_t ST_MSC = ST_MN + al((size_t)NU * 128 * 4);
constexpr size_t ST_GB = ST_MSC + al((size_t)NU * 16);
constexpr size_t ST_GA = ST_GB + al((size_t)NU * 64 * 4);
constexpr size_t ST_END = ST_GA + al((size_t)NU * 192 * 4);
static_assert(ST_END <= (size_t)B * SEQ * D * 4, "state scratch fits d_out");
}
using namespace cfg;

__device__ __forceinline__ float bf2f(bf16_t v) { return __uint_as_float(((unsigned)v) << 16); }
__device__ __forceinline__ bf16_t f2bf(float f) { unsigned u = __float_as_uint(f); u += 0x7fffu + ((u >> 16) & 1u); return (bf16_t)(u >> 16); }
__device__ __forceinline__ float wave_sum(float v) {
#pragma unroll
    for (int o = 1; o < 64; o <<= 1) v += __shfl_xor(v, o);
    return v;
}
__device__ __forceinline__ float logsig(float x) { return fminf(x, 0.f) - log1pf(__expf(-fabsf(x))); }
__device__ __forceinline__ float sigm(float x) { return 1.f / (1.f + __expf(-x)); }
__device__ __forceinline__ float silu(float x) { return x * sigm(x); }

__host__ __device__ __forceinline__ int zsrc(int n) {
    if (n < 512) return 1536 + n;
    if (n < 1024) return 3080 + (n - 512);
    if (n < 2048) return n - 1024;
    if (n < 2560) return 1024 + (n - 2048);
    if (n < 2816) return 2056 + (n - 2560);
    if (n < 3072) return 2312 + (n - 2816);
    if (n < 3584) return 2568 + (n - 3072);
    if (n < 3588) return 2048 + (n - 3584);
    if (n < 3592) return 2052 + (n - 3588);
    return n;
}

struct P {
    const float *x, *meta, *norm1_g, *w_in, *conv_w, *conv_b, *gate_b, *m_norm_g, *a_w2, *a_b, *g_norm_g, *w_out, *norm2_g, *wr_g, *br_g, *wr_e, *br_e, *w_gate, *w_up, *w_down, *final_g;
    float* out; unsigned char* ws;
    __device__ __forceinline__ bf16_t* Win() const { return (bf16_t*)(ws + WS_WIN); }
    __device__ __forceinline__ bf16_t* Wout() const { return (bf16_t*)(ws + WS_WOUT); }
    __device__ __forceinline__ bf16_t* Wgu() const { return (bf16_t*)(ws + WS_WGU); }
    __device__ __forceinline__ bf16_t* Wd() const { return (bf16_t*)(ws + WS_WD); }
    __device__ __forceinline__ bf16_t* H() const { return (bf16_t*)(ws + WS_H); }
    __device__ __forceinline__ bf16_t* Z() const { return (bf16_t*)(ws + WS_Z); }
    __device__ __forceinline__ float* SS1() const { return (float*)(ws + WS_SS1); }
    __device__ __forceinline__ float* SS2() const { return (float*)(ws + WS_SS2); }
    __device__ __forceinline__ bf16_t* MC() const { return (bf16_t*)((unsigned char*)out + ST_MC); }
    __device__ __forceinline__ float* RA(int slot) const { return (float*)((unsigned char*)out + ST_MC) + (size_t)slot * 16512; }
    __device__ __forceinline__ float* RS(int slot) const { return (float*)((unsigned char*)out + ST_MC) + (size_t)(512 + slot) * 16512; }
    __device__ __forceinline__ float* RAg(int slot) const { return (float*)((unsigned char*)out + ST_GS) + (size_t)slot * 8192; }
    __device__ __forceinline__ float* RSg(int slot) const { return (float*)((unsigned char*)out + ST_GS) + (size_t)(512 + slot) * 8192; }
    __device__ __forceinline__ float* RBg(int slot) const { return (float*)((unsigned char*)out + ST_GB) + (size_t)slot * 64; }
    __device__ __forceinline__ float* RQ(int slot) const { return (float*)((unsigned char*)out + ST_MSC) + (size_t)slot * 4; }
    __device__ __forceinline__ bf16_t* GS() const { return (bf16_t*)((unsigned char*)out + ST_GS); }
    __device__ __forceinline__ float* MN() const { return (float*)((unsigned char*)out + ST_MN); }
    __device__ __forceinline__ float* MSC() const { return (float*)((unsigned char*)out + ST_MSC); }
    __device__ __forceinline__ float* GB() const { return (float*)((unsigned char*)out + ST_GB); }
};

__host__ __device__ __forceinline__ bool is_pad_row(int r) { return r >= XR && ((r - XR) & 63) < LEAD; }
__host__ __device__ __forceinline__ int chunk_row0(int b, int c) { return c == 0 ? XR + b * 64 : b * SEQ + (c - 1) * 64; }
__device__ __forceinline__ float row_rs(const float* ss, int r) {
    if (is_pad_row(r)) return 0.f;
    const f32x4 v = *(const f32x4*)(ss + (size_t)r * 4);
    return rsqrtf((v.x + v.y + v.z + v.w) * (1.f / D) + EPS);
}

#define LAS __attribute__((address_space(3)))
constexpr int NWAVES = 8, NTHR = 512;
constexpr int RING_OFF = 0, RING_BYTES = 131072, TAB_OFF = 131072, TAB_BYTES = 24576, MISC_OFF = TAB_OFF + TAB_BYTES, LDS_BYTES = MISC_OFF + 512;
constexpr int RED_OFF = TAB_OFF + 4096;
constexpr int UROW_OFF = TAB_OFF + 8192;
constexpr int CW_BAR = 4096, CW_CNT = 16384;
constexpr int PH_PRO = 0, PH_LAYER0 = 1, PH_PER_LAYER = 9, PH_FINAL = 1 + 9 * DEPTH, PH_COUNT = PH_FINAL + 1;

#define XB_TMO      128
#define XB_XCNT(j)  (256  + 64 * (j))
#define XB_XSUB(j)  (1280 + 64 * (j))
#define XB_XGEN(j)  (2304 + 64 * (j))
#define XB_TOP      3328
#define XB_TOPGEN   3392
#define XCD_BAR_WORDS 3456
#define XB_SPIN_CAP (1u << 18)
__device__ __forceinline__ unsigned xb_ld(unsigned* p)              { return __hip_atomic_load(p, __ATOMIC_RELAXED, __HIP_MEMORY_SCOPE_AGENT); }
__device__ __forceinline__ unsigned xb_add(unsigned* p, unsigned v) { return __hip_atomic_fetch_add(p, v, __ATOMIC_RELAXED, __HIP_MEMORY_SCOPE_AGENT); }
__device__ __forceinline__ unsigned xb_xcc_id() { return (unsigned)__builtin_amdgcn_s_getreg((3 << 11) | 20) & 0xFu; }
#define XB_SPIN(cond, bar) do { unsigned _sp = 0; while (cond) { __builtin_amdgcn_s_sleep(1); \
    if ((++_sp & 255u) == 0u) { if (xb_ld(&(bar)[XB_TMO])) break; if (_sp > XB_SPIN_CAP) { atomicAdd(&(bar)[XB_TMO], 1u); break; } } } } while (0)
struct XcdBarrier { unsigned* bar; unsigned x; volatile LAS unsigned* st; };
__device__ __forceinline__ XcdBarrier xcd_barrier_post(unsigned* bar, volatile LAS unsigned* st) {
    XcdBarrier b; b.bar = bar; b.x = xb_xcc_id(); b.st = st;
    if (threadIdx.x == 0) (void)xb_add(&bar[XB_XCNT(b.x)], 1u);
    return b;
}
__device__ __forceinline__ void xcd_barrier_complete(unsigned* bar, unsigned x, unsigned& nloc, unsigned& nx) {
    const unsigned G = gridDim.x * gridDim.y * gridDim.z;
    unsigned sum, cnt, mine, sp = 0u;
    for (;;) {
        sum = 0u; cnt = 0u; mine = 0u;
#pragma unroll
        for (unsigned j = 0; j < 16; ++j) { const unsigned c = xb_ld(&bar[XB_XCNT(j)]); sum += c; cnt += (c > 0u) ? 1u : 0u; mine = (j == x) ? c : mine; }
        if (sum == G) break;
        __builtin_amdgcn_s_sleep(1);
        if ((++sp & 255u) == 0u) { if (xb_ld(&bar[XB_TMO])) break; if (sp > XB_SPIN_CAP) { atomicAdd(&bar[XB_TMO], 1u); break; } }
    }
    nloc = mine > 0u ? mine : 1u; nx = cnt > 0u ? cnt : 1u;
}
__device__ __forceinline__ void xcd_barrier(const XcdBarrier& b) {
    asm volatile("s_waitcnt vmcnt(0)" ::: "memory");
    __syncthreads();
    if (threadIdx.x == 0) {
        unsigned* bar = b.bar; unsigned bx = b.x; asm volatile("" : "+s"(bx));
        __builtin_amdgcn_s_waitcnt(0);
        unsigned nloc = b.st[0], nx = b.st[1];
        if (nloc == 0u) { xcd_barrier_complete(bar, bx, nloc, nx); b.st[0] = nloc; b.st[1] = nx; }
        const unsigned old = xb_add(&bar[XB_XSUB(bx)], 1u);
        const unsigned gen = old / nloc;
        if (old + 1u == (gen + 1u) * nloc) {
            __builtin_amdgcn_fence(__ATOMIC_RELEASE, "agent");
            asm volatile("s_waitcnt vmcnt(0)" ::: "memory");
            const unsigned og = xb_add(&bar[XB_TOP], 1u);
            const unsigned tg = og / nx;
            if (og + 1u == (tg + 1u) * nx) xb_add(&bar[XB_TOPGEN], 1u);
            else XB_SPIN(xb_ld(&bar[XB_TOPGEN]) == tg, bar);
            __builtin_amdgcn_fence(__ATOMIC_ACQUIRE, "agent");
            xb_add(&bar[XB_XGEN(bx)], 1u);
            asm volatile("s_waitcnt vmcnt(0)" ::: "memory");
        } else {
            XB_SPIN(xb_ld(&bar[XB_XGEN(bx)]) == gen, bar);
            __builtin_amdgcn_fence(__ATOMIC_ACQUIRE, "agent");
            asm volatile("s_waitcnt vmcnt(0)" ::: "memory");
        }
    }
    __syncthreads();
}

namespace pg8 {
typedef short bf16x8 __attribute__((ext_vector_type(8)));
typedef unsigned u32x4 __attribute__((ext_vector_type(4)));
typedef unsigned u32x2 __attribute__((ext_vector_type(2)));
constexpr int BM = 256, BK = 64, HALF = 128, HTB = HALF * BK * 2, STAGE_BYTES = 8 * HTB, NXCD = 8, WGM = 8;
__host__ __device__ __forceinline__ int lds_byte(int r, int c) { const int st = (r >> 4) * 2 + (c >> 5), rr = r & 15, cc = c & 31, ob = rr * 64 + cc * 2; return st * 1024 + (ob ^ (((ob >> 9) & 1) << 5)); }
__host__ __device__ __forceinline__ void stage_rc(int b, int& R, int& C) { const int st = b / 1024, sb = b % 1024, swz = sb ^ (((sb >> 9) & 1) << 5); R = (st >> 1) * 16 + swz / 64; C = (st & 1) * 32 + (swz % 64) / 2; }
__host__ __device__ __forceinline__ int perm32(int rho) { const int n = rho >> 4, i = rho & 15; return 8 * (i >> 2) + 4 * n + (i & 3); }
typedef float f32x2_ __attribute__((ext_vector_type(2))); typedef __bf16 bf16x2_ __attribute__((ext_vector_type(2)));
__device__ __forceinline__ unsigned cvt_pk_bf16(float lo, float hi) { const f32x2_ v = {lo, hi}; return __builtin_bit_cast(unsigned, __builtin_convertvector(v, bf16x2_)); }
__device__ __forceinline__ float bflo(unsigned w) { return __uint_as_float(w << 16); }
__device__ __forceinline__ float bfhi(unsigned w) { return __uint_as_float(w & 0xffff0000u); }

struct Unit { int pm, pn; unsigned bo; };

__device__ __forceinline__ int xcd_remap(int L, int nwg) { const int q = nwg / NXCD, r = nwg % NXCD, xcd = L % NXCD, off = L / NXCD; return (xcd < r ? xcd * (q + 1) : r * (q + 1) + (xcd - r) * q) + off; }

template <int LDA, int K> struct DenseOrder {
    static constexpr bool GATHER = false, LIST = false;
    typedef int Row;
    int nM, nN, nwg, G, c;
    __device__ __forceinline__ void init(int M, int N, int G_, int c_) { nM = M / BM; nN = N / BM; nwg = nM * nN; G = G_; c = c_; }
    __device__ __forceinline__ bool unit(int i, Unit& u) const {
        const int L = i * G + c; if (L >= nwg) return false;
        const int wgid = xcd_remap(L, nwg);
        const int nig = WGM * nN, gid = wgid / nig, fm = gid * WGM, gsz = (nM - fm) < WGM ? (nM - fm) : WGM;
        u.pm = fm + ((wgid % nig) % gsz); u.pn = (wgid % nig) / gsz; u.bo = (unsigned)u.pn * (unsigned)(BM * K * 2); return true;
    }
    __device__ __forceinline__ unsigned aofs(const Unit& u) const { return (unsigned)u.pm * (unsigned)(BM * LDA * 2); }
    __device__ __forceinline__ void fetch(const Unit&, int, Row&) const {}
    __device__ __forceinline__ void stash(const Unit&, const Row&, int, int) const {}
    __device__ __forceinline__ unsigned aoff(int, int rowl, int C) const { return (unsigned)(rowl * LDA + C) * 2u; }
};
template <int LDA, int K> struct DenseOrderRS : DenseOrder<LDA, K> {
    static constexpr bool GATHER = false, LIST = true;
    typedef f32x4 Row;
    LAS unsigned char* lds; unsigned char* ws;
    __device__ __forceinline__ void fetch(const Unit& u, int tid, Row& r) const { if (tid < 256) r = *(const f32x4*)((const float*)(ws + WS_SS1) + (size_t)(u.pm * BM + tid) * 4); }
    __device__ __forceinline__ void stash(const Unit& u, const Row& r, int ub, int tid) const {
        if (tid < 256) ((LAS float*)(lds + UROW_OFF))[ub * 256 + tid] = is_pad_row(u.pm * BM + tid) ? 0.f : __builtin_amdgcn_rsqf(((r.x + r.y) + (r.z + r.w)) * (1.f / D) + EPS); }
};

template <class Epi, class Sched, bool ALIGN_EPI, int LDA, int K, bool FP8 = false>
__device__ __forceinline__ void gemm_phase(LAS unsigned char* lds, const char* Abase, const char* Bbase, const Sched& S, const Epi& E) {
    int tid_ = threadIdx.x; asm volatile("" : "+v"(tid_));
    const int tid = tid_, wid = __builtin_amdgcn_readfirstlane(tid >> 6), lane = tid & 63, wr = wid >> 2, wc = wid & 3, fr = lane & 15, fq = lane >> 4;
    constexpr int nt = K / BK;
    int Rr[2], Cc[2]; unsigned voffB[2];
#pragma unroll
    for (int i = 0; i < 2; ++i) { stage_rc(tid * 16 + i * 8192, Rr[i], Cc[i]); const int Rb = Epi::PERM ? ((Rr[i] & ~31) + perm32(Rr[i] & 31)) : Rr[i]; voffB[i] = (unsigned)(Rb * K + Cc[i]) * 2u; }
    constexpr unsigned kstep = BK * 2, hstepB = HALF * K * 2;
    const unsigned ldsw = (unsigned)wid * 1024u;
    int aofs[2], bofs[2];
#pragma unroll
    for (int e = 0; e < 2; ++e) { aofs[e] = FP8 ? lds_byte(wr * 64 + fr, (2 * fq + e) * 8) : lds_byte(wr * 64 + fr, fq * 8) + e * 1024; bofs[e] = FP8 ? lds_byte(wc * 32 + fr, (2 * fq + e) * 8) : lds_byte(wc * 32 + fr, fq * 8) + e * 1024; }
#define PG8_SA(b, h) (((b) * 2 + (h)) * HTB)
#define PG8_SB(b, h) ((4 + (b) * 2 + (h)) * HTB)
#define PG8_STAGE(bufoff, gbase, uoff, voff) do { _Pragma("unroll") for (int _i = 0; _i < 2; ++_i) \
        __builtin_amdgcn_global_load_lds((const unsigned*)((gbase) + (size_t)(unsigned)((uoff) + (voff)[_i])), (LAS unsigned*)(lds + (bufoff) + ldsw + _i * 8192), 16, 0, 0); } while (0)
#define PG8_LDA(dst, b, h) do { _Pragma("unroll") for (int m = 0; m < 4; ++m) _Pragma("unroll") for (int k = 0; k < 2; ++k) dst[m][k] = *(const LAS bf16x8*)(lds + PG8_SA(b, h) + aofs[k] + m * 2048); } while (0)
#define PG8_LDB(dst, b, h) do { _Pragma("unroll") for (int n = 0; n < 2; ++n) _Pragma("unroll") for (int k = 0; k < 2; ++k) dst[n][k] = *(const LAS bf16x8*)(lds + PG8_SB(b, h) + bofs[k] + n * 2048); } while (0)
#define PG8_MMA(ai, bj, At, Bt) do { __builtin_amdgcn_s_setprio(1); _Pragma("unroll") for (int m = 0; m < 4; ++m) _Pragma("unroll") for (int n = 0; n < 2; ++n) { \
        if constexpr (FP8) { typedef int i32x4_ __attribute__((ext_vector_type(4))); typedef int i32x8_ __attribute__((ext_vector_type(8))); \
            const i32x8_ b8_ = __builtin_shufflevector(__builtin_bit_cast(i32x4_, Bt[n][0]), __builtin_bit_cast(i32x4_, Bt[n][1]), 0, 1, 2, 3, 4, 5, 6, 7), a8_ = __builtin_shufflevector(__builtin_bit_cast(i32x4_, At[m][0]), __builtin_bit_cast(i32x4_, At[m][1]), 0, 1, 2, 3, 4, 5, 6, 7); \
            acc[ai][bj][m][n] = __builtin_amdgcn_mfma_scale_f32_16x16x128_f8f6f4(b8_, a8_, acc[ai][bj][m][n], 0, 0, 0, 0x7F7F7F7F, 0, 0x7F7F7F7F); } \
        else { _Pragma("unroll") for (int k = 0; k < 2; ++k) acc[ai][bj][m][n] = __builtin_amdgcn_mfma_f32_16x16x32_bf16(Bt[n][k], At[m][k], acc[ai][bj][m][n], 0, 0, 0); } } __builtin_amdgcn_s_setprio(0); } while (0)
#define PG8_WAIT_V(n) asm volatile("s_waitcnt vmcnt(" #n ")" ::: "memory")
#define PG8_WAIT_L(n) asm volatile("s_waitcnt lgkmcnt(" #n ")" ::: "memory")
#define PG8_BAR __builtin_amdgcn_s_barrier()
#define PG8_SCHED __builtin_amdgcn_sched_barrier(0)
    Unit cur, nxt, nx2; int ui = 0, ub = 0;
    if (!S.unit(0, cur)) return;
    typename Sched::Row rowr;
    if constexpr (Sched::LIST) { S.fetch(cur, tid, rowr); S.stash(cur, rowr, 0, tid); asm volatile("s_waitcnt lgkmcnt(0)" ::: "memory"); __builtin_amdgcn_s_barrier(); asm volatile("" ::: "memory"); }
    bool has_next = S.unit(1, nxt);
    if constexpr (Sched::LIST) { if (has_next) S.fetch(nxt, tid, rowr); }
    unsigned voffA[2][2];
#pragma unroll
    for (int h = 0; h < 2; ++h)
#pragma unroll
        for (int i = 0; i < 2; ++i) voffA[h][i] = S.aoff(0, h * HALF + Rr[i], Cc[i]);
    f32x4 acc[2][2][4][2];
#pragma unroll
    for (int a = 0; a < 2; ++a)
#pragma unroll
        for (int b = 0; b < 2; ++b)
#pragma unroll
            for (int m = 0; m < 4; ++m)
#pragma unroll
                for (int n = 0; n < 2; ++n) acc[a][b][m][n] = (f32x4){0.f, 0.f, 0.f, 0.f};
    bf16x8 At[4][2], B0[2][2], B1[2][2];
    unsigned cA = S.aofs(cur), cB = cur.bo;
    PG8_STAGE(PG8_SB(0, 0), Bbase, cB, voffB); PG8_STAGE(PG8_SB(0, 1), Bbase, cB + hstepB, voffB); PG8_STAGE(PG8_SA(0, 0), Abase, cA, voffA[0]); PG8_STAGE(PG8_SA(0, 1), Abase, cA, voffA[1]);
    if (wr == 1) PG8_BAR;
    PG8_WAIT_V(2); PG8_BAR;
    PG8_STAGE(PG8_SB(1, 0), Bbase, cB + kstep, voffB); PG8_STAGE(PG8_SA(1, 0), Abase, cA + kstep, voffA[0]); PG8_STAGE(PG8_SB(1, 1), Bbase, cB + hstepB + kstep, voffB);
    PG8_WAIT_V(6); PG8_BAR;
    for (;;) {
        const int nub = (ub == 2) ? 0 : ub + 1;
        if constexpr (Sched::LIST) { if (has_next) S.stash(nxt, rowr, nub, tid); }
        const bool has_nx2 = has_next && S.unit(ui + 2, nx2);
        if constexpr (Sched::LIST) { if (has_nx2) S.fetch(nx2, tid, rowr); }
        const unsigned nA = has_next ? S.aofs(nxt) : cA, nB = has_next ? nxt.bo : cB;
#pragma unroll 1
        for (int t = 0; t < nt; t += 2) {
            const bool last = (t == nt - 2);
            const unsigned a1 = cA + (unsigned)(t + 1) * kstep;
            const unsigned a2 = last ? nA : cA + (unsigned)(t + 2) * kstep, b2 = last ? nB : cB + (unsigned)(t + 2) * kstep;
            const unsigned a3 = a2 + kstep, b3 = b2 + kstep;
            PG8_LDB(B0, 0, 0); PG8_LDB(B1, 0, 1); PG8_SCHED; PG8_LDA(At, 0, 0); PG8_STAGE(PG8_SA(1, 1), Abase, a1, voffA[1]);
            if constexpr (Sched::GATHER) { if (last && has_next) {
#pragma unroll
                for (int i = 0; i < 2; ++i) { int R2, C2; stage_rc(tid * 16 + i * 8192, R2, C2);
#pragma unroll
                    for (int h = 0; h < 2; ++h) voffA[h][i] = S.aoff(nub, h * HALF + R2, C2); } } }
            PG8_WAIT_V(8); PG8_WAIT_L(0); PG8_BAR; PG8_MMA(0, 0, At, B0); PG8_MMA(0, 1, At, B1); PG8_BAR; PG8_SCHED;
            PG8_LDA(At, 0, 1); PG8_STAGE(PG8_SB(0, 0), Bbase, b2, voffB); PG8_STAGE(PG8_SB(0, 1), Bbase, b2 + hstepB, voffB); PG8_STAGE(PG8_SA(0, 0), Abase, a2, voffA[0]);
            PG8_WAIT_V(8); PG8_WAIT_L(0); PG8_BAR; PG8_MMA(1, 0, At, B0); PG8_MMA(1, 1, At, B1); PG8_BAR; PG8_SCHED;
            PG8_LDB(B0, 1, 0); PG8_LDB(B1, 1, 1); PG8_SCHED; PG8_LDA(At, 1, 0); PG8_STAGE(PG8_SA(0, 1), Abase, a2, voffA[1]);
            PG8_WAIT_V(8); PG8_WAIT_L(0); PG8_BAR; PG8_MMA(0, 0, At, B0); PG8_MMA(0, 1, At, B1); PG8_BAR; PG8_SCHED;
            PG8_LDA(At, 1, 1); PG8_STAGE(PG8_SB(1, 0), Bbase, b3, voffB); PG8_STAGE(PG8_SB(1, 1), Bbase, b3 + hstepB, voffB); PG8_STAGE(PG8_SA(1, 0), Abase, a3, voffA[0]);
            PG8_WAIT_V(8); PG8_WAIT_L(0); PG8_BAR; PG8_MMA(1, 0, At, B0); PG8_MMA(1, 1, At, B1); PG8_BAR; PG8_SCHED;
        }
        if constexpr (ALIGN_EPI) { if (wr == 0) PG8_BAR; }
        E(acc, cur, wr, wc, fr, fq, tid, ub);
        if (!has_next) break;
#pragma unroll
        for (int a = 0; a < 2; ++a)
#pragma unroll
            for (int b = 0; b < 2; ++b)
#pragma unroll
                for (int m = 0; m < 4; ++m)
#pragma unroll
                    for (int n = 0; n < 2; ++n) acc[a][b][m][n] = (f32x4){0.f, 0.f, 0.f, 0.f};
        cur = nxt; nxt = nx2; has_next = has_nx2; cA = nA; cB = nB; ++ui; ub = nub;
        if constexpr (ALIGN_EPI) { if (wr == 1) PG8_BAR; }
    }
    PG8_WAIT_V(0);
    if constexpr (!ALIGN_EPI) { if (wr == 0) PG8_BAR; }
    PG8_BAR;
#undef PG8_SA
#undef PG8_SB
#undef PG8_STAGE
#undef PG8_LDA
#undef PG8_LDB
#undef PG8_MMA
#undef PG8_WAIT_V
#undef PG8_WAIT_L
#undef PG8_BAR
#undef PG8_SCHED
}

struct EpiZ {
    static constexpr bool PERM = true;
    unsigned char* ws; LAS unsigned char* lds;
    __device__ __forceinline__ void operator()(const f32x4 (&acc)[2][2][4][2], const Unit& u, int wr, int wc, int fr, int fq, int, int ub) const {
        const int row0 = u.pm * BM + wr * 64 + fr, col0 = u.pn * BM + wc * 32 + 8 * fq;
        bf16_t* z = (bf16_t*)(ws + WS_Z); const LAS float* rsb = (const LAS float*)(lds + UROW_OFF) + ub * 256 + wr * 64 + fr;
#pragma unroll
        for (int ai = 0; ai < 2; ++ai)
#pragma unroll
            for (int m = 0; m < 4; ++m) { const int row = row0 + ai * HALF + m * 16; const float rs = rsb[ai * HALF + m * 16]; bf16_t* rowp = z + (size_t)row * NIN + col0;
#pragma unroll
                for (int bj = 0; bj < 2; ++bj) if (col0 + bj * HALF < NIN) { const f32x4 v0 = acc[ai][bj][m][0] * rs, v1 = acc[ai][bj][m][1] * rs;
                    u32x4 w; w.x = cvt_pk_bf16(v0[0], v0[1]); w.y = cvt_pk_bf16(v0[2], v0[3]); w.z = cvt_pk_bf16(v1[0], v1[1]); w.w = cvt_pk_bf16(v1[2], v1[3]);
                    *(u32x4*)(rowp + bj * HALF) = w; } }
    }
};
__device__ __forceinline__ unsigned pk_fp8x4(float a, float b, float c, float d) { int r = __builtin_amdgcn_cvt_pk_fp8_f32(a, b, 0, false); r = __builtin_amdgcn_cvt_pk_fp8_f32(c, d, r, true); return (unsigned)r; }
template <bool LIST, bool STATS, size_t SS_OFF, bool H8OUT = false> struct EpiRes {
    static constexpr bool PERM = true;
    unsigned char* ws; LAS unsigned char* lds;
    __device__ __forceinline__ void operator()(const f32x4 (&acc)[2][2][4][2], const Unit& u, int wr, int wc, int fr, int fq, int tid, int ub) const {
        const int col0 = u.pn * BM + wc * 32 + 8 * fq;
        bf16_t* h = (bf16_t*)(ws + WS_H); float* ss = (float*)(ws + SS_OFF); LAS float* red = (LAS float*)(lds + RED_OFF); const LAS int* utok = (const LAS int*)(lds + UROW_OFF);
#pragma unroll
        for (int ai = 0; ai < 2; ++ai)
#pragma unroll
            for (int m = 0; m < 4; ++m) { const int rowl = ai * HALF + wr * 64 + m * 16 + fr; int row; bool valid = true;
                if constexpr (LIST) { row = utok[ub * 256 + rowl]; valid = row >= 0; } else row = u.pm * BM + rowl;
                float s = 0.f;
                if (valid) { bf16_t* hp = h + (size_t)row * D + col0;
#pragma unroll
                    for (int bj = 0; bj < 2; ++bj) { const u32x4 o = *(const u32x4*)(hp + bj * HALF); const f32x4 a0 = acc[ai][bj][m][0] * (LIST ? 0.0078125f : 1.f), a1 = acc[ai][bj][m][1] * (LIST ? 0.0078125f : 1.f);
                        const float v0 = bflo(o.x) + a0[0], v1 = bfhi(o.x) + a0[1], v2 = bflo(o.y) + a0[2], v3 = bfhi(o.y) + a0[3], v4 = bflo(o.z) + a1[0], v5 = bfhi(o.z) + a1[1], v6 = bflo(o.w) + a1[2], v7 = bfhi(o.w) + a1[3];
                        s += (v0 * v0 + v1 * v1) + (v2 * v2 + v3 * v3) + (v4 * v4 + v5 * v5) + (v6 * v6 + v7 * v7);
                        u32x4 w; w.x = cvt_pk_bf16(v0, v1); w.y = cvt_pk_bf16(v2, v3); w.z = cvt_pk_bf16(v4, v5); w.w = cvt_pk_bf16(v6, v7);
                        *(u32x4*)(hp + bj * HALF) = w;
                        if constexpr (H8OUT) { u32x2 q; q.x = pk_fp8x4(v0, v1, v2, v3); q.y = pk_fp8x4(v4, v5, v6, v7); *(u32x2*)(ws + WS_H8 + (size_t)row * D + col0 + bj * HALF) = q; } } }
                if constexpr (STATS) { s += __shfl_xor(s, 16); s += __shfl_xor(s, 32); if (fq == 0) red[rowl * 4 + wc] = s; }
                asm volatile("" ::: "memory"); }
        if constexpr (STATS) {
            asm volatile("s_waitcnt lgkmcnt(0)" ::: "memory"); __builtin_amdgcn_s_barrier(); asm volatile("" ::: "memory");
            if (tid < BM) { const f32x4 v = *(const LAS f32x4*)(red + tid * 4); int row; bool valid = true;
                if constexpr (LIST) { row = utok[ub * 256 + tid]; valid = row >= 0; } else row = u.pm * BM + tid;
                if (valid) ss[(size_t)row * 4 + u.pn] = (v.x + v.y) + (v.z + v.w); }
        }
    }
};
struct EpiUp {
    static constexpr bool PERM = false;
    unsigned char* ws; LAS unsigned char* lds;
    __device__ __forceinline__ void operator()(const f32x4 (&acc)[2][2][4][2], const Unit& u, int wr, int wc, int fr, int fq, int, int ub) const {
        const int col0 = u.pn * 128 + wc * 16 + 4 * fq;
        unsigned char* hid = ws + WS_HID; const LAS float* urs = (const LAS float*)(lds + UROW_OFF) + 768;
#pragma unroll
        for (int ai = 0; ai < 2; ++ai)
#pragma unroll
            for (int m = 0; m < 4; ++m) { const int rowl = ai * HALF + wr * 64 + m * 16 + fr;
                const float rs = urs[ub * 256 + rowl] * 0.0625f, gw = urs[768 + ub * 256 + rowl] * 16.f;
                unsigned char* hp = hid + ((size_t)u.pm * BM + rowl) * DE + col0;
#pragma unroll
                for (int bj = 0; bj < 2; ++bj) { const f32x4 g = acc[ai][bj][m][0] * rs, up = acc[ai][bj][m][1] * rs; float o[4];
#pragma unroll
                    for (int j = 0; j < 4; ++j) o[j] = g[j] * __builtin_amdgcn_rcpf(1.f + __builtin_amdgcn_exp2f(g[j] * -1.4426950408889634f)) * up[j] * gw;
                    *(unsigned*)(hp + bj * 64) = pk_fp8x4(o[0], o[1], o[2], o[3]); } }
    }
};
}

struct MoeTab { int cnt[64]; int rb0[65]; int pad[3]; unsigned short li[NBMAX]; unsigned short blk[NBMAX]; };
static_assert(sizeof(MoeTab) <= 4096, "MoeTab fits below RED_OFF");
__device__ __forceinline__ void moe_build_tab(LAS MoeTab* T, unsigned* gcnt) {
    int tid = threadIdx.x; asm volatile("" : "+v"(tid));
    if (tid < 64) T->cnt[tid] = (int)__hip_atomic_load(gcnt + tid * 16, __ATOMIC_RELAXED, __HIP_MEMORY_SCOPE_AGENT);
    __syncthreads();
    if (tid == 0) { int run = 0; for (int i = 0; i < 64; ++i) { T->rb0[i] = run; run += (T->cnt[i] + 255) >> 8; } T->rb0[64] = run; }
    __syncthreads();
    if (tid < 64) { const int b0 = T->rb0[tid], nb = T->rb0[tid + 1] - b0;
#pragma clang loop vectorize(disable) unroll(disable)
        for (int b = 0; b < nb; ++b) { T->li[b0 + b] = (unsigned short)tid; T->blk[b0 + b] = (unsigned short)b; } }
    __syncthreads();
}
template <bool GATHER_, int NN, int LDA, int K, unsigned ESTEP> struct MoeOrder {
    static constexpr bool GATHER = GATHER_, LIST = true;
    LAS unsigned char* lds; unsigned char* ws; int rbLo, nwg, G, c;
    typedef f32x4 Row;
    __device__ __forceinline__ bool unit(int i, pg8::Unit& u) const {
        const int L = i * G + c; if (L >= nwg) return false;
        const LAS MoeTab* T = (const LAS MoeTab*)(lds + TAB_OFF);
        const int wgid = pg8::xcd_remap(L, nwg), rb = rbLo + wgid / NN;
        u.pm = rb; u.pn = wgid % NN; u.bo = (unsigned)(T->li[rb] & 31) * ESTEP + (unsigned)u.pn * (unsigned)(256 * K * 2);
        return true;
    }
    __device__ __forceinline__ unsigned aofs(const pg8::Unit& u) const { return GATHER ? 0u : (unsigned)u.pm * (unsigned)(256 * LDA * 2); }
    __device__ __forceinline__ void fetch(const pg8::Unit& u, int tid, Row& r) const {
        const LAS MoeTab* T = (const LAS MoeTab*)(lds + TAB_OFF);
        if (tid < 256) { const int li = T->li[u.pm], slot = T->blk[u.pm] * 256 + tid; const bool valid = slot < T->cnt[li]; const size_t idx = (size_t)li * CAPL + slot;
            f32x4 v = {__int_as_float(-1), 0.f, 0.f, 0.f};
            if (valid) { v.x = __int_as_float(((const int*)(ws + WS_LTOK))[idx]); if constexpr (GATHER) { v.y = ((const float*)(ws + WS_LRS))[idx]; v.z = ((const float*)(ws + WS_LW))[idx]; } }
            r = v; }
    }
    __device__ __forceinline__ void stash(const pg8::Unit&, const Row& r, int ub, int tid) const {
        LAS int* urow = (LAS int*)(lds + UROW_OFF);
        if (tid < 256) { urow[ub * 256 + tid] = __float_as_int(r.x); if constexpr (GATHER) { ((LAS float*)urow)[768 + ub * 256 + tid] = r.y; ((LAS float*)urow)[1536 + ub * 256 + tid] = r.z; } }
    }
    __device__ __forceinline__ unsigned aoff(int ub, int rowl, int C) const {
        if constexpr (GATHER) { const int tok = ((const LAS int*)(lds + UROW_OFF))[ub * 256 + rowl]; return (unsigned)((tok < 0 ? 0 : tok) * LDA + C) * 2u; }
        else return (unsigned)(rowl * LDA + C) * 2u;
    }
};

__device__ __forceinline__ void route_phase(const P& p, int l, LAS unsigned char* lds, int G, int bid, unsigned* gcnt) {
    int tid_ = threadIdx.x; asm volatile("" : "+v"(tid_));
    const int tid = tid_, w = __builtin_amdgcn_readfirstlane(tid >> 6), lane = tid & 63, r = lane & 15, q = lane >> 4;
    const bool has_main = bid * 128 < XR, has_x = bid < B; const int r0 = bid * 128, x0 = XR + (has_x ? bid : 0) * 64 + LEAD;
    constexpr int WROW = 1040;
    LAS unsigned char* WHs = lds; LAS unsigned char* WLs = lds + 48 * WROW;
    LAS float* lg = (LAS float*)(lds + 2 * 48 * WROW);
    LAS int* lcnt = (LAS int*)(lds + TAB_OFF);
    LAS int* lbase = lcnt + 64;
    LAS int* rli = lbase + 64;
    LAS int* rpos = rli + 528;
    LAS float* rw = (LAS float*)(rpos + 528);
    LAS float* rrs = rw + 528;
    if (tid < 64) lcnt[tid] = 0;
    const bf16_t* WH = (const bf16_t*)(p.ws + WS_WRS) + (size_t)l * 48 * D; const bf16_t* WL = WH + (size_t)DEPTH * 48 * D;
    const bf16_t* ap = p.H() + (size_t)(has_main ? r0 + w * 16 + r : 0) * D + q * 8;
    const bf16_t* xp = p.H() + (size_t)(x0 + r) * D + w * 64 + q * 8;
    pg8::bf16x8 a[16], xa[2];
#pragma unroll
    for (int ks = 0; ks < 16; ++ks) a[ks] = *(const pg8::bf16x8*)(ap + ks * 32);
    if (has_x) {
#pragma unroll
        for (int ks = 0; ks < 2; ++ks) xa[ks] = *(const pg8::bf16x8*)(xp + ks * 32); }
    f32x4 acc[3], accx[3]; float ssq = 0.f, ssqx = 0.f;
#pragma unroll
    for (int tl = 0; tl < 3; ++tl) { acc[tl] = (f32x4){0.f, 0.f, 0.f, 0.f}; accx[tl] = (f32x4){0.f, 0.f, 0.f, 0.f}; }
#define ROUTE_SSQ(S, FR) do { const pg8::u32x4 w4 = __builtin_bit_cast(pg8::u32x4, FR); const float x0_ = pg8::bflo(w4.x), x1_ = pg8::bfhi(w4.x), x2_ = pg8::bflo(w4.y), x3_ = pg8::bfhi(w4.y), x4_ = pg8::bflo(w4.z), x5_ = pg8::bfhi(w4.z), x6_ = pg8::bflo(w4.w), x7_ = pg8::bfhi(w4.w); \
        S += (x0_ * x0_ + x1_ * x1_) + (x2_ * x2_ + x3_ * x3_) + (x4_ * x4_ + x5_ * x5_) + (x6_ * x6_ + x7_ * x7_); } while (0)
#define ROUTE_MMA(ACC, FR, WB, KOFS) do { _Pragma("unroll") for (int tl = 0; tl < 3; ++tl) { \
        ACC[tl] = __builtin_amdgcn_mfma_f32_16x16x32_bf16(FR, *(const LAS pg8::bf16x8*)((WB) + tl * 16 * WROW + (KOFS) * 2), ACC[tl], 0, 0, 0); \
        ACC[tl] = __builtin_amdgcn_mfma_f32_16x16x32_bf16(FR, *(const LAS pg8::bf16x8*)((WB) + 48 * WROW + tl * 16 * WROW + (KOFS) * 2), ACC[tl], 0, 0, 0); } } while (0)
    const LAS unsigned char* wb = WHs + r * WROW + q * 16; const LAS unsigned char* wbx = wb + w * 128;
#define ROUTE_STAGE(half) do { _Pragma("unroll") for (int j = 0; j < 12; ++j) { const int row = w * 12 + j; \
            const bf16_t* src_ = (row < 48 ? WH + (size_t)row * D : WL + (size_t)(row - 48) * D) + (half) * 512 + lane * 8; \
            __builtin_amdgcn_global_load_lds((const unsigned*)src_, (LAS unsigned*)(lds + row * WROW), 16, 0, 0); } \
        asm volatile("s_waitcnt vmcnt(0)" ::: "memory"); } while (0)
    __syncthreads();
    ROUTE_STAGE(0);
    __syncthreads();
    if (has_x) {
#pragma unroll
        for (int ks = 0; ks < 2; ++ks) { ROUTE_SSQ(ssqx, xa[ks]); ROUTE_MMA(accx, xa[ks], wbx, ks * 32); } }
#pragma unroll
    for (int ks = 0; ks < 16; ++ks) { ROUTE_SSQ(ssq, a[ks]); ROUTE_MMA(acc, a[ks], wb, ks * 32); a[ks] = *(const pg8::bf16x8*)(ap + 512 + ks * 32); }
    if (has_x) {
#pragma unroll
        for (int ks = 0; ks < 2; ++ks) xa[ks] = *(const pg8::bf16x8*)(xp + 512 + ks * 32); }
    __syncthreads();
    ROUTE_STAGE(1);
    __syncthreads();
    if (has_x) {
#pragma unroll
        for (int ks = 0; ks < 2; ++ks) { ROUTE_SSQ(ssqx, xa[ks]); ROUTE_MMA(accx, xa[ks], wbx, ks * 32); } }
#pragma unroll
    for (int ks = 0; ks < 16; ++ks) { ROUTE_SSQ(ssq, a[ks]); ROUTE_MMA(acc, a[ks], wb, ks * 32); }
#undef ROUTE_SSQ
#undef ROUTE_MMA
#undef ROUTE_STAGE
    auto route_row = [&](int i, const LAS float* x, float rtot) {
        const float rs = __builtin_amdgcn_rsqf(rtot * (1.f / D) + EPS); float gl[4];
#pragma unroll
        for (int j = 0; j < 4; ++j) gl[j] = x[j] * rs + p.br_g[l * 4 + j];
        int gsel = 0; float gm = gl[0];
#pragma unroll
        for (int j = 1; j < 4; ++j) if (gl[j] > gm) { gm = gl[j]; gsel = j; }
        float se = 0.f;
#pragma unroll
        for (int j = 0; j < 4; ++j) se += __expf(gl[j] - gm);
        const float psel = __builtin_amdgcn_rcpf(se);
        int i0 = 0, i1 = -1; float v0 = -INFINITY, v1 = -INFINITY;
        for (int j = 0; j < 8; ++j) { const float v = x[4 + gsel * 8 + j] * rs + p.br_e[l * 32 + gsel * 8 + j];
            if (v > v0) { v1 = v0; i1 = i0; v0 = v; i0 = j; } else if (v > v1) { v1 = v; i1 = j; } }
        const float w0 = __builtin_amdgcn_rcpf(1.f + __expf(v1 - v0));
        const int li0 = gsel * 8 + i0, li1 = 32 + gsel * 8 + i1;
        rli[2 * i] = li0; rli[2 * i + 1] = li1; rw[2 * i] = w0 * psel; rw[2 * i + 1] = (1.f - w0) * psel; rrs[i] = rs;
        rpos[2 * i] = __hip_atomic_fetch_add(&lcnt[li0], 1, __ATOMIC_RELAXED, __HIP_MEMORY_SCOPE_WORKGROUP); rpos[2 * i + 1] = __hip_atomic_fetch_add(&lcnt[li1], 1, __ATOMIC_RELAXED, __HIP_MEMORY_SCOPE_WORKGROUP); };
    float rtx = 0.f, rtot = ssq; LAS float* xsum = (LAS float*)lds + 8 * 768 + 128; LAS float* lgw = lg + w * 16 * 48;
    if (has_main) {
#pragma unroll
        for (int tl = 0; tl < 3; ++tl)
#pragma unroll
            for (int j = 0; j < 4; ++j) lgw[(q * 4 + j) * 48 + tl * 16 + r] = acc[tl][j];
        rtot += __shfl_xor(rtot, 16); rtot += __shfl_xor(rtot, 32); }
    if (has_x) {
        LAS float* xpart = (LAS float*)lds; LAS float* xss = xpart + 8 * 768;
        __syncthreads();
#pragma unroll
        for (int tl = 0; tl < 3; ++tl)
#pragma unroll
            for (int j = 0; j < 4; ++j) xpart[w * 768 + (q * 4 + j) * 48 + tl * 16 + r] = accx[tl][j];
        float rt = ssqx; rt += __shfl_xor(rt, 16); rt += __shfl_xor(rt, 32); if (lane < 16) xss[w * 16 + lane] = rt;
        __syncthreads();
        if (w == 0) {
            for (int idx = lane; idx < 768; idx += 64) { float sacc = 0.f;
#pragma unroll
                for (int ww = 0; ww < 8; ++ww) sacc += xpart[ww * 768 + idx];
                xsum[idx] = sacc; }
#pragma unroll
            for (int ww = 0; ww < 8; ++ww) rtx += xss[ww * 16 + r]; } }
    if (has_main) {
        asm volatile("s_waitcnt lgkmcnt(0)" ::: "memory");
        const bool xl = has_x && w == 0 && q == 1;
        if (q == 0 || xl) route_row(xl ? 128 + r : w * 16 + r, xl ? xsum + r * 48 : lgw + r * 48, xl ? rtx : rtot);
        asm volatile("s_waitcnt lgkmcnt(0)" ::: "memory"); }
    __syncthreads();
    if (tid < 64) { const int n = lcnt[tid]; lbase[tid] = n ? (int)__hip_atomic_fetch_add(gcnt + tid * 16, (unsigned)n, __ATOMIC_RELAXED, __HIP_MEMORY_SCOPE_AGENT) : 0; }
    __syncthreads();
    int* ltok = (int*)(p.ws + WS_LTOK); float* lrs = (float*)(p.ws + WS_LRS); float* lw = (float*)(p.ws + WS_LW);
    const int nr = has_main ? (has_x ? 144 : 128) : 0;
    for (int i = tid; i < 2 * nr; i += NTHR) { const int li = rli[i], ii = i >> 1; const size_t idx = (size_t)li * CAPL + lbase[li] + rpos[i]; ltok[idx] = ii < 128 ? r0 + ii : x0 + (ii - 128); lrs[idx] = rrs[ii]; lw[idx] = rw[i]; }
    __syncthreads();
}

namespace mx {
#define LDS_BARRIER() do { asm volatile("s_waitcnt lgkmcnt(0)" ::: "memory"); __builtin_amdgcn_s_barrier(); asm volatile("" ::: "memory"); } while (0)
using pg8::bf16x8; using pg8::u32x4; using pg8::u32x2; using pg8::cvt_pk_bf16; using pg8::bflo; using pg8::bfhi;
__device__ __forceinline__ f32x4 mfma16(bf16x8 a, bf16x8 b, f32x4 c) { return __builtin_amdgcn_mfma_f32_16x16x32_bf16(a, b, c, 0, 0, 0); }
__device__ __forceinline__ float wscan_add(float v, int lane) {
#pragma unroll
    for (int o = 1; o < 64; o <<= 1) { const float t = __shfl_up(v, o); if (lane >= o) v += t; }
    return v; }
__device__ __forceinline__ float wscan_max(float v, int lane) {
#pragma unroll
    for (int o = 1; o < 64; o <<= 1) { const float t = __shfl_up(v, o); if (lane >= o) v = fmaxf(v, t); }
    return v; }
__device__ __forceinline__ float wave_max(float v) {
#pragma unroll
    for (int o = 1; o < 64; o <<= 1) v = fmaxf(v, __shfl_xor(v, o));
    return v; }
__device__ __forceinline__ void unpack8(const u32x4 a, float (&x)[8]) { x[0] = bflo(a.x); x[1] = bfhi(a.x); x[2] = bflo(a.y); x[3] = bfhi(a.y); x[4] = bflo(a.z); x[5] = bfhi(a.z); x[6] = bflo(a.w); x[7] = bfhi(a.w); }
__device__ __forceinline__ u32x4 pack8(const float (&x)[8]) { u32x4 w; w.x = cvt_pk_bf16(x[0], x[1]); w.y = cvt_pk_bf16(x[2], x[3]); w.z = cvt_pk_bf16(x[4], x[5]); w.w = cvt_pk_bf16(x[6], x[7]); return w; }
__device__ __forceinline__ bf16x8 ldfrag(const LAS unsigned char* p) { return *(const LAS bf16x8*)p; }
__device__ __forceinline__ float fexp(float x) { return __builtin_amdgcn_exp2f(x * 1.4426950408889634f); }
__device__ __forceinline__ float frcp(float x) { return __builtin_amdgcn_rcpf(x); }
__device__ __forceinline__ float fsigm(float x) { return frcp(1.f + fexp(-x)); }
__device__ __forceinline__ float fsilu(float x) { return x * fsigm(x); }
__device__ __forceinline__ float flogsig(float x) { return fminf(x, 0.f) - __builtin_amdgcn_logf(1.f + fexp(-fabsf(x))) * 0.6931471805599453f; }
__device__ __forceinline__ float frsq(float x) { return __builtin_amdgcn_rsqf(x); }
typedef short s16x4 __attribute__((ext_vector_type(4)));
__device__ __forceinline__ s16x4 tr_read(const LAS unsigned char* p) { s16x4 r; asm volatile("ds_read_b64_tr_b16 %0, %1\n\ts_waitcnt lgkmcnt(0)" : "=&v"(r) : "v"((unsigned)(size_t)p) : "memory"); return r; }
__device__ __forceinline__ bf16x8 tr_frag(const LAS unsigned char* img, int stride, int krow0, int col0, int lane) {
    const int i16 = lane & 15, g = lane >> 4; const LAS unsigned char* a = img + (krow0 + 8 * g + (i16 >> 2)) * stride + (col0 + 4 * (i16 & 3)) * 2;
    const s16x4 lo = tr_read(a), hi = tr_read(a + 4 * stride); return __builtin_shufflevector(lo, hi, 0, 1, 2, 3, 4, 5, 6, 7); }
constexpr int SQ = 272, ST = 144;
__device__ __forceinline__ int tsw(int row, int s) { return row * ST + ((((s >> 3) ^ (row >> 3)) & 7) << 4) + ((s & 7) << 1); }
__device__ __forceinline__ int tfr(int row, int chunk) { return row * ST + (((chunk ^ (row >> 3)) & 7) << 4); }

struct UC { int c, hd, b, r0; };
__device__ __forceinline__ UC ucoord(int u) { UC k; k.c = u % NCH; k.hd = (u / NCH) & 3; k.b = u / (NCH * 4); k.r0 = chunk_row0(k.b, k.c); return k; }
template <int NS> struct PreM { u32x4 x[NS + 3]; u32x4 v[2]; pg8::f32x2_ g; };
struct PreO { u32x4 qk[4]; u32x4 v[2]; f32x4 g; f32x4 gw; };
struct PreG { u32x4 v[2]; u32x4 q, k; f32x4 ca; pg8::f32x2_ ab; };
template <int NS> __device__ __forceinline__ void load_m(const P& p, int u, PreM<NS>& R, int tid, int zvcol) {
    asm volatile("" : "+v"(tid));
    const UC k = ucoord(u); const bf16_t* z = p.Z(); const int lane = tid & 63, w = tid >> 6;
    { const size_t zr = (size_t)(k.r0 + lane) * NIN; pg8::f32x2_ g = {0.f, 0.f}; if (w == 0) { g.x = bf2f(z[zr + ZO_FG + k.hd]); g.y = bf2f(z[zr + ZO_IG + k.hd]); } R.g = g; }
    int zcol, s0;
    if (NS == 4) { const int which = tid >> 8; zcol = (which ? ZO_KM : ZO_QM) + k.hd * 128 + (tid & 15) * 8; s0 = ((tid >> 4) & 15) * 4; }
    else { zcol = ZO_KM + k.hd * 128 + (tid & 15) * 8; s0 = (tid >> 4) * 2; }
#pragma unroll
    for (int i = 0; i < NS + 3; ++i) { const int s = s0 - 3 + i, pp = k.c * 64 + s;
        const int row = (s < 0 && k.c == 1) ? XR + k.b * 64 + 64 + s : k.r0 + (pp >= 0 ? s : 0);
        const u32x4 v = *(const u32x4*)(z + (size_t)row * NIN + zcol); const unsigned m = pp >= 0 ? 0xffffffffu : 0u; R.x[i] = (u32x4){v.x & m, v.y & m, v.z & m, v.w & m}; }
#pragma unroll
    for (int it = 0; it < 2; ++it) { const int s = 2 * (tid >> 4) + it, v8 = tid & 15; R.v[it] = *(const u32x4*)(z + (size_t)(k.r0 + s) * NIN + zvcol + k.hd * 128 + v8 * 8); }
}
__device__ __forceinline__ void load_o(const P& p, int u, PreO& R, int tid) {
    asm volatile("" : "+v"(tid));
    const UC k = ucoord(u); const bf16_t* z = p.Z(); const bf16_t* qkc = (const bf16_t*)(p.ws + WS_QKC);
#pragma unroll
    for (int it = 0; it < 4; ++it) { const int item = tid + it * NTHR, which = item >> 10, s = (item >> 4) & 63, ch8 = item & 15; R.qk[it] = *(const u32x4*)(qkc + (size_t)(k.r0 + s) * 1024 + which * 512 + k.hd * 128 + ch8 * 8); }
#pragma unroll
    for (int it = 0; it < 2; ++it) { const int s = 2 * (tid >> 4) + it, v8 = tid & 15; R.v[it] = *(const u32x4*)(z + (size_t)(k.r0 + s) * NIN + ZO_VM + k.hd * 128 + v8 * 8); }
    { const float* ga = (const float*)((const unsigned char*)p.out + ST_GA) + (size_t)u * 192; f32x4 g = {0.f, 0.f, 0.f, 0.f}; if (tid < 64) { g.x = ga[tid]; g.y = ga[64 + tid]; g.z = ga[128 + tid]; } R.g = g;
      f32x4 gw; gw.x = ga[64 + (tid >> 4)]; gw.y = ga[64 + (tid >> 4) + 32]; gw.z = ga[63]; gw.w = ga[191]; R.gw = gw; }
}
__device__ __forceinline__ void load_g(const P& p, int l, int u, PreG& R, int tid, bool needq) {
    asm volatile("" : "+v"(tid));
    const UC k = ucoord(u); const bf16_t* z = p.Z();
#pragma unroll
    for (int it = 0; it < 2; ++it) { const int s = 2 * (tid >> 4) + it, v8 = tid & 15; R.v[it] = *(const u32x4*)(z + (size_t)(k.r0 + s) * NIN + ZO_VG + k.hd * 128 + v8 * 8); }
    const size_t zr = (size_t)(k.r0 + (tid >> 3)) * NIN; R.k = *(const u32x4*)(z + zr + ZO_KG + k.hd * 64 + (tid & 7) * 8); R.q = R.k;
    if (needq) R.q = *(const u32x4*)(z + zr + ZO_QG + k.hd * 64 + (tid & 7) * 8);
    { const int i0 = tid, i1 = tid + NTHR; f32x4 ca;
        ca.x = bf2f(z[(size_t)(k.r0 + (i0 >> 4)) * NIN + ZO_CODE + (i0 & 15)]); ca.y = bf2f(z[(size_t)(k.r0 + (i1 >> 4)) * NIN + ZO_CODE + (i1 & 15)]);
        ca.z = p.a_w2[(l * 16 + (i0 >> 6)) * 256 + k.hd * 64 + (i0 & 63)]; ca.w = p.a_w2[(l * 16 + (i1 >> 6)) * 256 + k.hd * 64 + (i1 & 63)]; R.ca = ca;
      pg8::f32x2_ ab = {0.f, 0.f}; if (tid < 64) ab.x = p.a_b[l * 256 + k.hd * 64 + tid]; R.ab = ab; }
}
template <int NS> __device__ __forceinline__ void conv8(const LAS float* cw, const u32x4 (&xr)[NS + 3], int c, int s0, int cch, float scale, float (&o)[NS][8]) {
    float x[NS + 3][8];
#pragma unroll
    for (int i = 0; i < NS + 3; ++i) unpack8(xr[i], x[i]);
    float bias[8];
    { const f32x4 b0 = *(const LAS f32x4*)(cw + 4096 + cch), b1 = *(const LAS f32x4*)(cw + 4096 + cch + 4); bias[0] = b0.x; bias[1] = b0.y; bias[2] = b0.z; bias[3] = b0.w; bias[4] = b1.x; bias[5] = b1.y; bias[6] = b1.z; bias[7] = b1.w; }
#pragma unroll
    for (int i = 0; i < NS; ++i)
#pragma unroll
        for (int q = 0; q < 8; ++q) o[i][q] = bias[q];
#pragma unroll
    for (int j = 0; j < 4; ++j) { float w[8];
        { const f32x4 w0 = *(const LAS f32x4*)(cw + j * 1024 + cch), w1 = *(const LAS f32x4*)(cw + j * 1024 + cch + 4); w[0] = w0.x; w[1] = w0.y; w[2] = w0.z; w[3] = w0.w; w[4] = w1.x; w[5] = w1.y; w[6] = w1.z; w[7] = w1.w; }
#pragma unroll
        for (int i = 0; i < NS; ++i)
#pragma unroll
            for (int q = 0; q < 8; ++q) o[i][q] += w[q] * x[i + j][q]; }
#pragma unroll
    for (int i = 0; i < NS; ++i) { const bool valid = (c > 0) || (s0 + i >= LEAD);
#pragma unroll
        for (int q = 0; q < 8; ++q) o[i][q] = valid ? fsilu(o[i][q]) * scale : 0.f; }
}

__device__ __forceinline__ void gla_cumdecay(const P& p, int l, int hd, const PreG& R, int c, LAS float* LA, LAS float* segtot, LAS float* cod, LAS float* aw, LAS float* ab, int tid) {
    cod[tid] = R.ca.x; cod[tid + NTHR] = R.ca.y; aw[tid] = R.ca.z; aw[tid + NTHR] = R.ca.w;
    if (tid < 64) ab[tid] = p.a_b[l * 256 + hd * 64 + tid];
    LDS_BARRIER();
    const int j = tid & 63, seg = tid >> 6; float run = 0.f, v[8];
#pragma unroll
    for (int i = 0; i < 8; ++i) { const int s = seg * 8 + i; const bool valid = (c > 0) || (s >= LEAD); float a = ab[j];
#pragma unroll
        for (int q = 0; q < 16; ++q) a += cod[s * 16 + q] * aw[q * 64 + j];
        run += valid ? flogsig(a) * (1.f / 16.f) : 0.f; v[i] = run; }
    segtot[seg * 64 + j] = run;
    LDS_BARRIER();
    float pre = 0.f;
#pragma unroll
    for (int g = 0; g < 8; ++g) pre += (g < seg) ? segtot[g * 64 + j] : 0.f;
#pragma unroll
    for (int i = 0; i < 8; ++i) LA[(seg * 8 + i) * 65 + j] = v[i] + pre;
    LDS_BARRIER();
}
__device__ __forceinline__ void mlstm_local(const P& p, int l, int u, LAS unsigned char* lds, int tid, PreM<4>& R, int unext, f32x4 (&Dm)[9], float& mD, float& BE, int endslot) {
    asm volatile("" : "+v"(tid));
    const int lane = tid & 63, w = __builtin_amdgcn_readfirstlane(tid >> 6), c = u % NCH, hd = (u / NCH) & 3, b = u / (NCH * 4), r0 = chunk_row0(b, c);
    LAS unsigned char* KT = lds; LAS unsigned char* VT = lds + 18432; LAS float* wS = (LAS float*)(lds + 39168);
    if (w == 0) { const int s = lane; const bool valid = (c > 0) || (s >= LEAD);
        const float lf = valid ? flogsig(R.g.x + p.gate_b[(l * 2 + 1) * 4 + hd]) : 0.f;
        const float ig = valid ? R.g.y + p.gate_b[(l * 2 + 0) * 4 + hd] : -INFINITY;
        const float bb = wscan_add(lf, lane), be = __shfl(bb, 63), g = be - bb + ig, mg = wave_max(g), a = ig - bb, pm = wscan_max(a, lane);
        wS[s] = fexp(g - mg);
        float* ga = (float*)((unsigned char*)p.out + ST_GA) + (size_t)u * 192; ga[s] = bb; ga[64 + s] = a; ga[128 + s] = pm;
        if (lane == 0) { wS[64] = mg; wS[65] = be; } }
    { const int which = tid >> 8, ch8 = tid & 15, s0 = ((tid >> 4) & 15) * 4; float o[4][8];
        conv8<4>((const LAS float*)(lds + 65536), R.x, c, s0, which * 512 + hd * 128 + ch8 * 8, which ? 0.08838834764831845f : 1.f, o);
        bf16_t* qkc = (bf16_t*)(p.ws + WS_QKC) + (size_t)(r0 + s0) * 1024 + which * 512 + hd * 128 + ch8 * 8;
#pragma unroll
        for (int i = 0; i < 4; ++i) *(u32x4*)(qkc + (size_t)i * 1024) = pack8(o[i]);
        if (which) {
#pragma unroll
            for (int q = 0; q < 8; ++q) { *(LAS unsigned*)(KT + tsw(ch8 * 8 + q, s0)) = cvt_pk_bf16(o[0][q], o[1][q]); *(LAS unsigned*)(KT + tsw(ch8 * 8 + q, s0 + 2)) = cvt_pk_bf16(o[2][q], o[3][q]); } } }
    LDS_BARRIER();
    { const int s0 = 2 * (tid >> 4), v8 = tid & 15; float x0[8], x1[8]; unpack8(R.v[0], x0); unpack8(R.v[1], x1);
        const float w0 = ((c > 0) || (s0 >= LEAD)) ? wS[s0] : 0.f, w1 = ((c > 0) || (s0 + 1 >= LEAD)) ? wS[s0 + 1] : 0.f;
#pragma unroll
        for (int q = 0; q < 8; ++q) *(LAS unsigned*)(VT + tsw(v8 * 8 + q, s0)) = cvt_pk_bf16(x0[q] * w0, x1[q] * w1); }
    for (int i = tid; i < 16 * 64; i += NTHR) { const int row = 128 + (i >> 6), s = i & 63; *(LAS bf16_t*)(VT + tsw(row, s)) = (row == 128) ? (bf16_t)(cvt_pk_bf16(wS[s], 0.f) & 0xffffu) : (bf16_t)0; }
    if (unext >= 0) load_m<4>(p, unext, R, tid, ZO_VM);
    LDS_BARRIER();
    { const int r = lane & 15, q = lane >> 4; bf16x8 afr[2];
#pragma unroll
        for (int ks = 0; ks < 2; ++ks) afr[ks] = ldfrag(KT + tfr(w * 16 + r, ks * 4 + q));
        const float mg = wS[64], be = wS[65], mn = fmaxf(be + mD, mg), dec = fexp(be + mD - mn), wg = fexp(mg - mn);
#pragma unroll
        for (int vt = 0; vt < 9; ++vt) { f32x4 acc = {0.f, 0.f, 0.f, 0.f};
#pragma unroll
            for (int ks = 0; ks < 2; ++ks) acc = mfma16(afr[ks], ldfrag(VT + tfr(vt * 16 + r, ks * 4 + q)), acc);
            Dm[vt] = Dm[vt] * dec + acc * wg; }
        mD = mn; BE += be;
        if (endslot >= 0) { float* ra = p.RA(endslot);
#pragma unroll
            for (int vt = 0; vt < 8; ++vt) *(f32x4*)(ra + (vt * 16 + r) * 128 + w * 16 + q * 4) = Dm[vt];
            if (r == 0) *(f32x4*)(ra + 16384 + w * 16 + q * 4) = Dm[8];
            if (tid == 0) { float* rq = p.RQ(endslot); rq[0] = mD; rq[1] = BE; }
#pragma unroll
            for (int vt = 0; vt < 9; ++vt) Dm[vt] = (f32x4){0.f, 0.f, 0.f, 0.f};
            mD = -INFINITY; BE = 0.f; } }
    LDS_BARRIER();
}

__device__ __forceinline__ void gla_local(const P& p, int l, int u, LAS unsigned char* lds, int tid, PreG& R, int unext, f32x4 (&Dg)[4], float& bej, int endslot) {
    asm volatile("" : "+v"(tid));
    const int lane = tid & 63, w = __builtin_amdgcn_readfirstlane(tid >> 6), c = u % NCH, hd = (u / NCH) & 3, b = u / (NCH * 4), r0 = chunk_row0(b, c);
    const bf16_t* z = p.Z();
    LAS float* LA = (LAS float*)lds; LAS float* segtot = (LAS float*)(lds + 16640); LAS unsigned char* KHT = lds + 18688; LAS unsigned char* VT = lds + 27904;
    LAS float* cod = (LAS float*)(lds + 46336); LAS float* aw = (LAS float*)(lds + 50432); LAS float* ab = (LAS float*)(lds + 54528);
    gla_cumdecay(p, l, hd, R, c, LA, segtot, cod, aw, ab, tid);
    if (tid < 64) bej += LA[63 * 65 + tid];
    { const int s = tid >> 3, j8 = tid & 7; const bool valid = (c > 0) || (s >= LEAD); float x[8];
        unpack8(R.k, x);
#pragma unroll
        for (int q = 0; q < 8; ++q) { const int j = j8 * 8 + q; *(LAS bf16_t*)(KHT + tsw(j, s)) = (bf16_t)(cvt_pk_bf16(valid ? x[q] * fexp(LA[63 * 65 + j] - LA[s * 65 + j]) : 0.f, 0.f) & 0xffffu); } }
    { const int s0 = 2 * (tid >> 4), v8 = tid & 15; float x0[8], x1[8]; unpack8(R.v[0], x0); unpack8(R.v[1], x1);
        const float w0 = ((c > 0) || (s0 >= LEAD)) ? 1.f : 0.f, w1 = ((c > 0) || (s0 + 1 >= LEAD)) ? 1.f : 0.f;
#pragma unroll
        for (int q = 0; q < 8; ++q) *(LAS unsigned*)(VT + tsw(v8 * 8 + q, s0)) = cvt_pk_bf16(x0[q] * w0, x1[q] * w1); }
    if (unext >= 0) load_g(p, l, unext, R, tid, false);
    LDS_BARRIER();
    { const int r = lane & 15, q = lane >> 4; bf16x8 bfr[2];
#pragma unroll
        for (int ks = 0; ks < 2; ++ks) bfr[ks] = ldfrag(VT + tfr(w * 16 + r, ks * 4 + q));
#pragma unroll
        for (int jt = 0; jt < 4; ++jt) { f32x4 acc = {0.f, 0.f, 0.f, 0.f};
#pragma unroll
            for (int ks = 0; ks < 2; ++ks) acc = mfma16(ldfrag(KHT + tfr(jt * 16 + r, ks * 4 + q)), bfr[ks], acc);
            const LAS float* bend = LA + 63 * 65 + jt * 16 + q * 4;
            Dg[jt] = (f32x4){Dg[jt][0] * fexp(bend[0]) + acc[0], Dg[jt][1] * fexp(bend[1]) + acc[1], Dg[jt][2] * fexp(bend[2]) + acc[2], Dg[jt][3] * fexp(bend[3]) + acc[3]}; }
        if (endslot >= 0) { float* ra = p.RAg(endslot);
#pragma unroll
            for (int jt = 0; jt < 4; ++jt) { *(f32x4*)(ra + (w * 16 + r) * 64 + jt * 16 + q * 4) = Dg[jt]; Dg[jt] = (f32x4){0.f, 0.f, 0.f, 0.f}; }
            if (tid < 64) { p.RBg(endslot)[tid] = bej; bej = 0.f; } } }
    LDS_BARRIER();
}

template <class LD, class FOLD> __device__ __forceinline__ void scan_stream(LD ld, FOLD fold) {
    u32x2 cur[16], nxt[16];
#pragma unroll
    for (int i = 0; i < 16; ++i) cur[i] = ld(i);
#pragma unroll 1
    for (int c0 = 0; c0 < 128; c0 += 16) {
#pragma unroll
        for (int i = 0; i < 16; ++i) nxt[i] = ld(c0 + 16 + i < NCH ? c0 + 16 + i : NCH - 1);
#pragma unroll
        for (int i = 0; i < 16; ++i) fold(c0 + i, cur[i]);
#pragma unroll
        for (int i = 0; i < 16; ++i) cur[i] = nxt[i];
    }
    fold(128, cur[0]);
}
__device__ __forceinline__ int unit_lo(int b, int G) { return (int)((long)b * NU / G); }
__device__ __forceinline__ void scan_phase(const P& p, LAS unsigned char* lds, int G, int bid, int tid) {
    asm volatile("" : "+v"(tid));
    for (int item = bid; item < 16 * 13; item += G) { const int bh = item / 13, sl = item % 13;
        if (sl < 9) { const int e = sl * 2048 + tid * 4; if (e < 16512) { const int U0 = bh * NCH, U1 = U0 + NCH;
            int b0 = (int)((long)U0 * G / NU); while (unit_lo(b0 + 1, G) <= U0) ++b0; while (unit_lo(b0, G) > U0) --b0;
            f32x4 C = {0.f, 0.f, 0.f, 0.f}; float m = 0.f;
            for (int bb = b0; bb < G && unit_lo(bb, G) < U1; ++bb) { const int slot = 2 * bb + (unit_lo(bb, G) < U0 ? 1 : 0);
                *(f32x4*)(p.RS(slot) + e) = C; if (e == 0) p.RQ(slot)[2] = m;
                const f32x4 dl = *(const f32x4*)(p.RA(slot) + e); const float mD = p.RQ(slot)[0], be = p.RQ(slot)[1], mn = fmaxf(be + m, mD), dec = fexp(be + m - mn), wg = fexp(mD - mn);
                C = C * dec + dl * wg; m = mn; } } }
        else { const int e = (sl - 9) * 2048 + tid * 4, j = e & 63; const int U0 = bh * NCH, U1 = U0 + NCH;
            int b0 = (int)((long)U0 * G / NU); while (unit_lo(b0 + 1, G) <= U0) ++b0; while (unit_lo(b0, G) > U0) --b0;
            f32x4 S = {0.f, 0.f, 0.f, 0.f};
            for (int wb = b0; wb < G && unit_lo(wb, G) < U1; ++wb) { const int slot = 2 * (G - 1 - wb) + (unit_lo(wb, G) < U0 ? 1 : 0);
                *(f32x4*)(p.RSg(slot) + e) = S;
                const f32x4 dl = *(const f32x4*)(p.RAg(slot) + e), bv = *(const f32x4*)(p.RBg(slot) + j);
                S = (f32x4){S[0] * fexp(bv[0]) + dl[0], S[1] * fexp(bv[1]) + dl[1], S[2] * fexp(bv[2]) + dl[2], S[3] * fexp(bv[3]) + dl[3]}; } }
    }
    __syncthreads();
}

__device__ __forceinline__ void mlstm_out(const P& p, int l, int u, LAS unsigned char* lds, int tid, PreO& R, int unext, f32x4 (&Cm)[9], float& mcur, int startslot) {
    asm volatile("" : "+v"(tid));
    const int lane = tid & 63, w = __builtin_amdgcn_readfirstlane(tid >> 6), c = u % NCH, hd = (u / NCH) & 3, b = u / (NCH * 4), r0 = chunk_row0(b, c);
    const bf16_t* z = p.Z();
    LAS unsigned char* QS = lds; LAS unsigned char* KS = lds + 17408; LAS unsigned char* VT = lds + 34816; LAS unsigned char* SS = lds + 55552;
    LAS float* aS = (LAS float*)(lds + 64768); LAS float* MS = aS + 64; LAS float* wiS = MS + 64; LAS float* emtS = wiS + 64; LAS float* denS = emtS + 64; LAS float* part = denS + 64; LAS float* nS = part + 128;
    const int r = lane & 15, q = lane >> 4, tt = w & 3, vh = w >> 2, t = tt * 16 + r;
    const int nvt = vh ? 4 : 5;
    LAS unsigned char* CS = lds + 69632;
    LAS unsigned char* KW = lds + 108544;
    if (startslot >= 0) { const float* rs = p.RS(startslot);
#pragma unroll
        for (int vt = 0; vt < 8; ++vt) Cm[vt] = *(const f32x4*)(rs + (vt * 16 + r) * 128 + w * 16 + q * 4);
        Cm[8] = (r == 0) ? *(const f32x4*)(rs + 16384 + w * 16 + q * 4) : (f32x4){0.f, 0.f, 0.f, 0.f};
        mcur = p.RQ(startslot)[2]; }
#pragma unroll
    for (int vt = 0; vt < 8; ++vt) { u32x2 o; o.x = cvt_pk_bf16(Cm[vt][0], Cm[vt][1]); o.y = cvt_pk_bf16(Cm[vt][2], Cm[vt][3]); *(LAS u32x2*)(CS + (vt * 16 + r) * SQ + (w * 16 + q * 4) * 2) = o; }
    if (r == 0) *(LAS f32x4*)(nS + w * 16 + q * 4) = Cm[8];
    if (w == 0) { const int s = lane; const float bb = R.g.x, aa = R.g.y, pm = R.g.z, m0 = mcur, M = fmaxf(m0, pm);
        aS[s] = aa; MS[s] = M; wiS[s] = fexp(m0 - M); emtS[s] = fexp(-(bb + M)); }
#pragma unroll
    for (int it = 0; it < 4; ++it) { const int item = tid + it * NTHR, which = item >> 10, s = (item >> 4) & 63, ch8 = item & 15; *(LAS u32x4*)((which ? KS : QS) + s * SQ + ch8 * 16) = R.qk[it]; }
    const float be = R.gw.z, mg = be + R.gw.w;
#pragma unroll
    for (int it = 0; it < 2; ++it) { const int s = (tid >> 4) + 32 * it, ch8 = tid & 15; float x[8]; unpack8(R.qk[2 + it], x); const float ws = fexp((it ? R.gw.y : R.gw.x) - R.gw.w);
#pragma unroll
        for (int e = 0; e < 8; ++e) x[e] *= ws;
        *(LAS u32x4*)(KW + s * SQ + ch8 * 16) = pack8(x); }
    { const int s0 = 2 * (tid >> 4), v8 = tid & 15; float x0[8], x1[8]; unpack8(R.v[0], x0); unpack8(R.v[1], x1);
        const float w0 = ((c > 0) || (s0 >= LEAD)) ? 1.f : 0.f, w1 = ((c > 0) || (s0 + 1 >= LEAD)) ? 1.f : 0.f;
#pragma unroll
        for (int q = 0; q < 8; ++q) *(LAS unsigned*)(VT + tsw(v8 * 8 + q, s0)) = cvt_pk_bf16(x0[q] * w0, x1[q] * w1); }
    for (int i = tid; i < 16 * 64; i += NTHR) { const int row = 128 + (i >> 6), s = i & 63; *(LAS bf16_t*)(VT + tsw(row, s)) = (row == 128) ? (bf16_t)0x3f80 : (bf16_t)0; }
    if (unext >= 0) load_o(p, unext, R, tid);
    LDS_BARRIER();
    f32x4 acc2[5];
    { bf16x8 qb[4];
#pragma unroll
        for (int ks = 0; ks < 4; ++ks) qb[ks] = ldfrag(QS + (tt * 16 + r) * SQ + (ks * 32 + q * 8) * 2);
#pragma unroll
        for (int i = 0; i < 5; ++i) { acc2[i] = (f32x4){0.f, 0.f, 0.f, 0.f}; if (i < nvt) {
#pragma unroll
            for (int ks = 0; ks < 4; ++ks) { bf16x8 afr;
                if (i < 4) afr = ldfrag(CS + ((vh * 4 + i) * 16 + r) * SQ + (ks * 32 + q * 8) * 2);
                else { const f32x4 n0 = *(const LAS f32x4*)(nS + ks * 32 + q * 8), n1 = *(const LAS f32x4*)(nS + ks * 32 + q * 8 + 4); const float mk = (r == 0) ? 1.f : 0.f;
                    const float nn[8] = {n0.x * mk, n0.y * mk, n0.z * mk, n0.w * mk, n1.x * mk, n1.y * mk, n1.z * mk, n1.w * mk};
                    afr = __builtin_bit_cast(bf16x8, pack8(nn)); }
                acc2[i] = mfma16(afr, qb[ks], acc2[i]); } } }
        const float Mt = MS[t];
#pragma unroll
        for (int cc = 0; cc < 2; ++cc) { const int st = vh * 2 + cc; f32x4 acc = {0.f, 0.f, 0.f, 0.f};
            if (st <= tt) {
#pragma unroll
                for (int ks = 0; ks < 4; ++ks) acc = mfma16(ldfrag(KS + (st * 16 + r) * SQ + (ks * 32 + q * 8) * 2), qb[ks], acc); }
            float sv[4];
#pragma unroll
            for (int j = 0; j < 4; ++j) { const int s = st * 16 + q * 4 + j; sv[j] = (s <= t) ? acc[j] * fexp(aS[s] - Mt) : 0.f; }
            u32x2 o; o.x = cvt_pk_bf16(sv[0], sv[1]); o.y = cvt_pk_bf16(sv[2], sv[3]); *(LAS u32x2*)(SS + t * ST + (st * 16 + q * 4) * 2) = o; } }
    LDS_BARRIER();
    {
        const float mn = fmaxf(be + mcur, mg), dec = fexp(be + mcur - mn), wg = fexp(mg - mn); bf16x8 ka[2];
#pragma unroll
        for (int ks = 0; ks < 2; ++ks) ka[ks] = tr_frag(KW, SQ, ks * 32, w * 16, lane);
#pragma unroll
        for (int vt = 0; vt < 9; ++vt) { f32x4 dl = {0.f, 0.f, 0.f, 0.f};
#pragma unroll
            for (int ks = 0; ks < 2; ++ks) dl = mfma16(ka[ks], ldfrag(VT + tfr(vt * 16 + r, ks * 4 + q)), dl);
            Cm[vt] = Cm[vt] * dec + dl * wg; }
        mcur = mn; }
    f32x4 hv[5];
    { bf16x8 sb[2];
#pragma unroll
        for (int ks = 0; ks < 2; ++ks) sb[ks] = ldfrag(SS + (tt * 16 + r) * ST + (ks * 32 + q * 8) * 2);
        const float wi = wiS[t];
#pragma unroll
        for (int i = 0; i < 5; ++i) { if (i < nvt) { const int vt = (i < 4) ? vh * 4 + i : 8; f32x4 a1 = {0.f, 0.f, 0.f, 0.f};
#pragma unroll
            for (int ks = 0; ks < 2; ++ks) a1 = mfma16(ldfrag(VT + tfr(vt * 16 + r, ks * 4 + q)), sb[ks], a1);
            hv[i] = a1 + acc2[i] * wi; } }
        if (vh == 0 && q == 0) denS[t] = hv[4][0]; }
    u32x2 og[4]; f32x4 gn[4];
#pragma unroll
    for (int i = 0; i < 4; ++i) { const int v0 = (vh * 4 + i) * 16 + q * 4; og[i] = *(const u32x2*)(z + (size_t)(r0 + t) * NIN + ZO_OM + hd * 128 + v0); gn[i] = *(const LAS f32x4*)((const LAS float*)(lds + 104448) + hd * 128 + v0); }
    LDS_BARRIER();
    { const float dn = frcp(fmaxf(fabsf(denS[t]), emtS[t])); float ssq = 0.f;
#pragma unroll
        for (int i = 0; i < 4; ++i) { hv[i] = hv[i] * dn; ssq += hv[i][0] * hv[i][0] + hv[i][1] * hv[i][1] + hv[i][2] * hv[i][2] + hv[i][3] * hv[i][3]; }
        ssq += __shfl_xor(ssq, 16); ssq += __shfl_xor(ssq, 32); if (q == 0) part[t * 2 + vh] = ssq; }
    LDS_BARRIER();
    { const bool valid = (c > 0) || (t >= LEAD); const float sc = frsq((part[t * 2] + part[t * 2 + 1]) * (1.f / 128.f) + EPS); bf16_t* yp = p.Z() + (size_t)(r0 + t) * NIN + ZO_OM + hd * 128;
#pragma unroll
        for (int i = 0; i < 4; ++i) { const int v0 = (vh * 4 + i) * 16 + q * 4; float y[4];
            y[0] = hv[i][0] * sc * gn[i][0] * fsigm(bflo(og[i].x)); y[1] = hv[i][1] * sc * gn[i][1] * fsigm(bfhi(og[i].x)); y[2] = hv[i][2] * sc * gn[i][2] * fsigm(bflo(og[i].y)); y[3] = hv[i][3] * sc * gn[i][3] * fsigm(bfhi(og[i].y));
            u32x2 o; o.x = valid ? cvt_pk_bf16(y[0], y[1]) : 0u; o.y = valid ? cvt_pk_bf16(y[2], y[3]) : 0u; *(u32x2*)(yp + v0) = o; } }
    LDS_BARRIER();
}

__device__ __forceinline__ void gla_out(const P& p, int l, int u, LAS unsigned char* lds, int tid, PreG& R, int unext, f32x4 (&Sm)[4], int startslot) {
    asm volatile("" : "+v"(tid));
    const int lane = tid & 63, w = __builtin_amdgcn_readfirstlane(tid >> 6), c = u % NCH, hd = (u / NCH) & 3, b = u / (NCH * 4), r0 = chunk_row0(b, c);
    const bf16_t* z = p.Z();
    LAS float* LA = (LAS float*)lds; LAS float* segtot = (LAS float*)(lds + 16640); LAS unsigned char* QT = lds + 18688; LAS unsigned char* KT2 = lds + 27904; LAS unsigned char* VT = lds + 37120; LAS unsigned char* AS = lds + 55552;
    LAS float* cod = (LAS float*)(lds + 64768); LAS float* aw = (LAS float*)(lds + 68864); LAS float* ab = (LAS float*)(lds + 72960); LAS float* part = (LAS float*)(lds + 73216);
    const int r = lane & 15, q = lane >> 4, tt = w & 3, dh = w >> 2, t = tt * 16 + r;
    LAS unsigned char* STs = lds + 73728;
    if (startslot >= 0) { const float* rs = p.RSg(startslot);
#pragma unroll
        for (int jt = 0; jt < 4; ++jt) Sm[jt] = *(const f32x4*)(rs + (w * 16 + r) * 64 + jt * 16 + q * 4); }
#pragma unroll
    for (int jt = 0; jt < 4; ++jt) { u32x2 o; o.x = cvt_pk_bf16(Sm[jt][0], Sm[jt][1]); o.y = cvt_pk_bf16(Sm[jt][2], Sm[jt][3]); *(LAS u32x2*)(STs + (w * 16 + r) * ST + (jt * 16 + q * 4) * 2) = o; }
    gla_cumdecay(p, l, hd, R, c, LA, segtot, cod, aw, ab, tid);
    { const int s = tid >> 3, j8 = tid & 7; const bool valid = (c > 0) || (s >= LEAD); float xq[8], xk[8];
        unpack8(R.q, xq); unpack8(R.k, xk);
#pragma unroll
        for (int q = 0; q < 8; ++q) { const float bb = LA[s * 65 + j8 * 8 + q]; xq[q] = valid ? xq[q] * 0.125f * fexp(bb) : 0.f; xk[q] = valid ? xk[q] * fexp(-bb) : 0.f; }
        *(LAS u32x4*)(QT + s * ST + j8 * 16) = pack8(xq); *(LAS u32x4*)(KT2 + s * ST + j8 * 16) = pack8(xk); }
    { const int s0 = 2 * (tid >> 4), v8 = tid & 15; float x0[8], x1[8]; unpack8(R.v[0], x0); unpack8(R.v[1], x1);
        const float w0 = ((c > 0) || (s0 >= LEAD)) ? 1.f : 0.f, w1 = ((c > 0) || (s0 + 1 >= LEAD)) ? 1.f : 0.f;
#pragma unroll
        for (int q = 0; q < 8; ++q) *(LAS unsigned*)(VT + tsw(v8 * 8 + q, s0)) = cvt_pk_bf16(x0[q] * w0, x1[q] * w1); }
    if (unext >= 0) load_g(p, l, unext, R, tid, true);
    LDS_BARRIER();
    f32x4 hv[4];
    { bf16x8 qb[2];
#pragma unroll
        for (int ks = 0; ks < 2; ++ks) qb[ks] = ldfrag(QT + (tt * 16 + r) * ST + (ks * 32 + q * 8) * 2);
#pragma unroll
        for (int i = 0; i < 4; ++i) { hv[i] = (f32x4){0.f, 0.f, 0.f, 0.f};
#pragma unroll
            for (int ks = 0; ks < 2; ++ks) hv[i] = mfma16(ldfrag(STs + ((dh * 4 + i) * 16 + r) * ST + (ks * 32 + q * 8) * 2), qb[ks], hv[i]); }
#pragma unroll
        for (int cc = 0; cc < 2; ++cc) { const int st = dh * 2 + cc; f32x4 acc = {0.f, 0.f, 0.f, 0.f};
            if (st <= tt) {
#pragma unroll
                for (int ks = 0; ks < 2; ++ks) acc = mfma16(ldfrag(KT2 + (st * 16 + r) * ST + (ks * 32 + q * 8) * 2), qb[ks], acc); }
            float sv[4];
#pragma unroll
            for (int j = 0; j < 4; ++j) { const int s = st * 16 + q * 4 + j; sv[j] = (s <= t) ? acc[j] : 0.f; }
            u32x2 o; o.x = cvt_pk_bf16(sv[0], sv[1]); o.y = cvt_pk_bf16(sv[2], sv[3]); *(LAS u32x2*)(AS + t * ST + (st * 16 + q * 4) * 2) = o; } }
    u32x2 og[4]; f32x4 gn[4];
#pragma unroll
    for (int i = 0; i < 4; ++i) { const int d0 = (dh * 4 + i) * 16 + q * 4; og[i] = *(const u32x2*)(z + (size_t)(r0 + t) * NIN + ZO_GG + hd * 128 + d0); gn[i] = *(const LAS f32x4*)((const LAS float*)(lds + 104448) + 512 + hd * 128 + d0); }
    LDS_BARRIER();
    {
        bf16x8 vb[2];
#pragma unroll
        for (int ks = 0; ks < 2; ++ks) vb[ks] = ldfrag(VT + tfr(w * 16 + r, ks * 4 + q));
#pragma unroll
        for (int jt = 0; jt < 4; ++jt) { f32x4 dl = {0.f, 0.f, 0.f, 0.f};
#pragma unroll
            for (int ks = 0; ks < 2; ++ks) dl = mfma16(tr_frag(KT2, ST, ks * 32, jt * 16, lane), vb[ks], dl);
            const LAS float* bend = LA + 63 * 65 + jt * 16 + q * 4;
            Sm[jt] = (f32x4){(Sm[jt][0] + dl[0]) * fexp(bend[0]), (Sm[jt][1] + dl[1]) * fexp(bend[1]), (Sm[jt][2] + dl[2]) * fexp(bend[2]), (Sm[jt][3] + dl[3]) * fexp(bend[3])}; } }
    { bf16x8 ab2[2];
#pragma unroll
        for (int ks = 0; ks < 2; ++ks) ab2[ks] = ldfrag(AS + (tt * 16 + r) * ST + (ks * 32 + q * 8) * 2);
        float ssq = 0.f;
#pragma unroll
        for (int i = 0; i < 4; ++i) { const int dt = dh * 4 + i;
#pragma unroll
            for (int ks = 0; ks < 2; ++ks) hv[i] = mfma16(ldfrag(VT + tfr(dt * 16 + r, ks * 4 + q)), ab2[ks], hv[i]);
            ssq += hv[i][0] * hv[i][0] + hv[i][1] * hv[i][1] + hv[i][2] * hv[i][2] + hv[i][3] * hv[i][3]; }
        ssq += __shfl_xor(ssq, 16); ssq += __shfl_xor(ssq, 32); if (q == 0) part[t * 2 + dh] = ssq; }
    LDS_BARRIER();
    { const bool valid = (c > 0) || (t >= LEAD); const float sc = frsq((part[t * 2] + part[t * 2 + 1]) * (1.f / 128.f) + EPS); bf16_t* yp = p.Z() + (size_t)(r0 + t) * NIN + ZO_GG + hd * 128;
#pragma unroll
        for (int i = 0; i < 4; ++i) { const int d0 = (dh * 4 + i) * 16 + q * 4; float y[4];
            y[0] = hv[i][0] * sc * gn[i][0] * fsilu(bflo(og[i].x)); y[1] = hv[i][1] * sc * gn[i][1] * fsilu(bfhi(og[i].x)); y[2] = hv[i][2] * sc * gn[i][2] * fsilu(bflo(og[i].y)); y[3] = hv[i][3] * sc * gn[i][3] * fsilu(bfhi(og[i].y));
            u32x2 o; o.x = valid ? cvt_pk_bf16(y[0], y[1]) : 0u; o.y = valid ? cvt_pk_bf16(y[2], y[3]) : 0u; *(u32x2*)(yp + d0) = o; } }
    LDS_BARRIER();
}
}

namespace pro {
#define PRO_TILE(LD4, GK, OUTROW) do { \
        f32x4 v_[8]; \
        _Pragma("unroll") for (int i = 0; i < 8; ++i) { const int kk = 8 * i + (lane >> 3); v_[i] = (LD4); } \
        _Pragma("unroll") for (int i = 0; i < 8; ++i) { const int kk = 8 * i + (lane >> 3); const float g_ = (GK); LAS float* d_ = scr + kk * 33 + (lane & 7) * 4; d_[0] = v_[i].x * g_; d_[1] = v_[i].y * g_; d_[2] = v_[i].z * g_; d_[3] = v_[i].w * g_; } \
        asm volatile("s_waitcnt lgkmcnt(0)" ::: "memory"); \
        { const int c8 = lane & 7; _Pragma("unroll") for (int j = 0; j < 4; ++j) { const int nn = (lane >> 3) + 8 * j; const LAS float* s_ = scr + (8 * c8) * 33 + nn; \
            pg8::u32x4 o_; o_.x = pg8::cvt_pk_bf16(s_[0], s_[33]); o_.y = pg8::cvt_pk_bf16(s_[66], s_[99]); o_.z = pg8::cvt_pk_bf16(s_[132], s_[165]); o_.w = pg8::cvt_pk_bf16(s_[198], s_[231]); \
            *(pg8::u32x4*)((OUTROW) + 8 * c8) = o_; } } \
        asm volatile("s_waitcnt lgkmcnt(0)" ::: "memory"); } while (0)
#define PRO_TILE8(LD4, GK, OUTROW8) do { \
        f32x4 v_[8]; \
        _Pragma("unroll") for (int i = 0; i < 8; ++i) { const int kk = 8 * i + (lane >> 3); v_[i] = (LD4); } \
        _Pragma("unroll") for (int i = 0; i < 8; ++i) { const int kk = 8 * i + (lane >> 3); const float g_ = (GK); LAS float* d_ = scr + kk * 33 + (lane & 7) * 4; d_[0] = v_[i].x * g_; d_[1] = v_[i].y * g_; d_[2] = v_[i].z * g_; d_[3] = v_[i].w * g_; } \
        asm volatile("s_waitcnt lgkmcnt(0)" ::: "memory"); \
        { const int c8 = lane & 7; _Pragma("unroll") for (int j = 0; j < 4; ++j) { const int nn = (lane >> 3) + 8 * j; const LAS float* s_ = scr + (8 * c8) * 33 + nn; \
            pg8::u32x2 o_; o_.x = pg8::pk_fp8x4(s_[0], s_[33], s_[66], s_[99]); o_.y = pg8::pk_fp8x4(s_[132], s_[165], s_[198], s_[231]); \
            *(pg8::u32x2*)((OUTROW8) + 8 * c8) = o_; } } \
        asm volatile("s_waitcnt lgkmcnt(0)" ::: "memory"); } while (0)
__device__ __forceinline__ void prologue_phase(const P& p, LAS unsigned char* lds, int G, int bid, int tid) {
    asm volatile("" : "+v"(tid));
    const int lane = tid & 63, w = __builtin_amdgcn_readfirstlane(tid >> 6), gw = bid * NWAVES + w, NGW = G * NWAVES;
    LAS float* scr = (LAS float*)(lds + w * 8448);
    constexpr int I_IN = DEPTH * 16 * (NZP / 32), I_OUT = DEPTH * 16 * (D / 32), I_GU = DEPTH * NE * 16 * (512 / 32), I_D = DEPTH * NE * (DE / 64) * (D / 32);
    const f32x4 zero4 = {0.f, 0.f, 0.f, 0.f};
    for (int it = gw; it < I_IN + I_OUT + I_GU + I_D; it += NGW) {
        int r = it;
        if (r < I_IN) { const int nb = r % (NZP / 32), kb = (r / (NZP / 32)) % 16, l = r / (16 * (NZP / 32)), k0 = kb * 64, n0 = nb * 32;
            const int n = n0 + (lane & 7) * 4; const float* src = p.w_in + ((size_t)l * D + k0) * NIN + zsrc(n); const float* g = p.norm1_g + l * D + k0;
            bf16_t* ob = (bf16_t*)(p.ws + WS_WIN) + ((size_t)l * NZP + n0) * D + k0;
            PRO_TILE((n < NIN) ? *(const f32x4*)(src + (size_t)kk * NIN) : zero4, g[kk], ob + (size_t)nn * D);
            continue; }
        r -= I_IN;
        if (r < I_OUT) { const int nb = r % 32, kb = (r / 32) % 16, l = r / 512, k0 = kb * 64, n0 = nb * 32;
            const float* src = p.w_out + ((size_t)l * D + k0) * D + n0 + (lane & 7) * 4; bf16_t* ob = (bf16_t*)(p.ws + WS_WOUT) + ((size_t)l * D + n0) * D + k0;
            PRO_TILE(*(const f32x4*)(src + (size_t)kk * D), 1.f, ob + (size_t)nn * D);
            continue; }
        r -= I_OUT;
        if (r < I_GU) { const int nb = r % 16, kb = (r / 16) % 16, bz = r / 256, k0 = kb * 64, n0 = nb * 32;
            const int i4 = (lane & 7) * 4; const float* src = ((i4 < 16) ? p.w_gate : p.w_up) + ((size_t)bz * D + k0) * DE + 16 * nb + (i4 & 15); const float* g = p.norm2_g + (bz >> 5) * D + k0;
            unsigned char* ob8 = p.ws + WS_WGU + ((size_t)bz * 512 + n0) * D + k0;
            PRO_TILE8(*(const f32x4*)(src + (size_t)kk * DE), g[kk] * 16.f, ob8 + (size_t)nn * D);
            continue; }
        r -= I_GU;
        { const int nb = r % 32, kb = (r / 32) % 4, bz = r / 128, k0 = kb * 64, n0 = nb * 32;
            const float* src = p.w_down + ((size_t)bz * DE + k0) * D + n0 + (lane & 7) * 4; unsigned char* ob8 = p.ws + WS_WD + ((size_t)bz * D + n0) * DE + k0;
            PRO_TILE8(*(const f32x4*)(src + (size_t)kk * D), 8.f, ob8 + (size_t)nn * DE); }
    }
    for (int idx = bid * NTHR + tid; idx < DEPTH * 48 * D; idx += G * NTHR) { const int k = idx % D, o = (idx / D) % 48, l = idx / (D * 48); float v = 0.f;
        if (o < 4) v = p.wr_g[((size_t)l * D + k) * 4 + o]; else if (o < 36) v = p.wr_e[((size_t)l * D + k) * 32 + (o - 4)];
        v *= p.norm2_g[l * D + k]; const bf16_t hi = f2bf(v), lo = f2bf(v - bf2f(hi));
        bf16_t* wh = (bf16_t*)(p.ws + WS_WRS); wh[idx] = hi; wh[(size_t)DEPTH * 48 * D + idx] = lo; }
    for (int r = gw; r < MP; r += NGW) { const float* src = nullptr;
        if (r < XR) src = p.x + (size_t)r * D; else if (((r - XR) & 63) >= LEAD) src = p.meta + (size_t)(((r - XR) & 63) - LEAD) * D;
        float s = 0.f; bf16_t* hr = p.H() + (size_t)r * D;
#pragma unroll
        for (int j = 0; j < 4; ++j) { f32x4 v = {0.f, 0.f, 0.f, 0.f}; if (src) v = ((const f32x4*)src)[lane + 64 * j];
            s += v.x * v.x + v.y * v.y + v.z * v.z + v.w * v.w;
            pg8::u32x2 o; o.x = pg8::cvt_pk_bf16(v.x, v.y); o.y = pg8::cvt_pk_bf16(v.z, v.w); ((pg8::u32x2*)hr)[lane + 64 * j] = o; }
        s = wave_sum(s);
        if (lane == 0) { f32x4 q = {s, 0.f, 0.f, 0.f}; *(f32x4*)(p.SS1() + (size_t)r * 4) = q; } }
}
#undef PRO_TILE
#undef PRO_TILE8
__device__ __forceinline__ void final_phase(const P& p, int G, int bid, int tid) {
    asm volatile("" : "+v"(tid));
    const int lane = tid & 63, w = tid >> 6;
    for (int t = bid * NWAVES + w; t < B * SEQ; t += G * NWAVES) { const int r = t;
        const float rs = row_rs(p.SS1(), r); const bf16_t* hr = p.H() + (size_t)r * D; float* o = p.out + (size_t)t * D;
#pragma unroll
        for (int j = 0; j < 4; ++j) { const pg8::u32x2 hv = ((const pg8::u32x2*)hr)[lane + 64 * j]; const f32x4 g = ((const f32x4*)p.final_g)[lane + 64 * j];
            f32x4 v; v.x = pg8::bflo(hv.x) * rs * g.x; v.y = pg8::bfhi(hv.x) * rs * g.y; v.z = pg8::bflo(hv.y) * rs * g.z; v.w = pg8::bfhi(hv.y) * rs * g.w;
            ((f32x4*)o)[lane + 64 * j] = v; } }
}
}

struct Args { P p; int ph_lo, ph_hi; };
__global__ void __launch_bounds__(NTHR, 2) fwd(Args a) {
    extern __shared__ __attribute__((aligned(16))) unsigned char lds_raw[];
    LAS unsigned char* lds = (LAS unsigned char*)lds_raw;
    const P& p = a.p;
    const int tid = threadIdx.x, G = gridDim.x, bid = blockIdx.x;
    unsigned* ctl = (unsigned*)(p.ws + WS_CTL);
    volatile LAS unsigned* MISC = (volatile LAS unsigned*)(lds + MISC_OFF);
    if (tid < 128) MISC[tid] = 0u;
    __syncthreads();
    XcdBarrier bar = xcd_barrier_post(ctl + CW_BAR, MISC + 8);
#define IN(k) true
#define SEAM(k) xcd_barrier(bar)
    if (IN(PH_PRO)) {
pro::prologue_phase(p, lds, G, bid, tid); }
    SEAM(PH_PRO);
    const int bid0 = bid, G0 = G;
    for (int l = 0; l < DEPTH; ++l) {
        int bid = bid0, G = G0; asm volatile("" : "+s"(bid), "+s"(G));
        const int pb = PH_LAYER0 + l * PH_PER_LAYER;
        unsigned* gcnt = ctl + CW_CNT + l * 64 * 16;
        if (IN(pb + 0)) {
{
            pg8::DenseOrderRS<D, D> S; S.init(MP, NZP, G, bid); S.lds = lds; S.ws = p.ws;
            pg8::EpiZ E{p.ws, lds};
            pg8::gemm_phase<pg8::EpiZ, pg8::DenseOrderRS<D, D>, true, D, D>(lds + RING_OFF, (const char*)(p.ws + WS_H), (const char*)(p.ws + WS_WIN) + (size_t)l * NZP * D * 2, S, E);
            }
        }
        SEAM(pb + 0);
        if (IN(pb + 1)) {
            { LAS float* cw = (LAS float*)(lds + 65536);
                int t_ = tid; asm volatile("" : "+v"(t_));
                for (int i = t_; i < 5 * 1024; i += NTHR) cw[i] = i < 4096 ? p.conv_w[l * 4096 + i] : p.conv_b[l * D + (i - 4096)];
                __syncthreads(); }
{ { const int ulo = (int)((long)bid * NU / G), uhi = (int)((long)(bid + 1) * NU / G);
                if (ulo < uhi) { mx::PreM<4> pre; mx::load_m<4>(p, ulo, pre, tid, ZO_VM); f32x4 Dm[9]; float mD = -INFINITY, BE = 0.f; int seg = 0;
#pragma unroll
                    for (int i = 0; i < 9; ++i) Dm[i] = (f32x4){0.f, 0.f, 0.f, 0.f};
                    for (int u = ulo; u < uhi; ++u) { const bool endrun = (u + 1 == uhi) || ((u + 1) % NCH) == 0;
                        mx::mlstm_local(p, l, u, lds, tid, pre, u + 1 < uhi ? u + 1 : -1, Dm, mD, BE, endrun ? 2 * bid + seg : -1); if (endrun) ++seg; } }
                { const int glo = (int)((long)(G - 1 - bid) * NU / G), ghi = (int)((long)(G - bid) * NU / G);
                if (glo < ghi) { mx::PreG pre; mx::load_g(p, l, glo, pre, tid, false); f32x4 Dg[4]; float bej = 0.f; int seg = 0;
#pragma unroll
                    for (int i = 0; i < 4; ++i) Dg[i] = (f32x4){0.f, 0.f, 0.f, 0.f};
                    for (int u = glo; u < ghi; ++u) { const bool endrun = (u + 1 == ghi) || ((u + 1) % NCH) == 0;
                        mx::gla_local(p, l, u, lds, tid, pre, u + 1 < ghi ? u + 1 : -1, Dg, bej, endrun ? 2 * bid + seg : -1); if (endrun) ++seg; } } } } } }
        SEAM(pb + 1);
        if (IN(pb + 2)) mx::scan_phase(p, lds, G, bid, tid);
        SEAM(pb + 2);
        if (IN(pb + 3)) {
            { LAS float* gt = (LAS float*)(lds + 104448);
                int t_ = tid; asm volatile("" : "+v"(t_));
                for (int i = t_; i < 1024; i += NTHR) gt[i] = i < 512 ? p.m_norm_g[l * 512 + i] : p.g_norm_g[l * 512 + (i - 512)];
                __syncthreads(); }
 { const int ulo = (int)((long)bid * NU / G), uhi = (int)((long)(bid + 1) * NU / G);
                if (ulo < uhi) { mx::PreO pre; mx::load_o(p, ulo, pre, tid); f32x4 Cm[9]; float mcur = 0.f;
#pragma unroll
                    for (int i = 0; i < 9; ++i) Cm[i] = (f32x4){0.f, 0.f, 0.f, 0.f};
                    int seg = 0;
                    for (int u = ulo; u < uhi; ++u) { const bool startrun = (u == ulo) || (u % NCH) == 0; if (startrun && u != ulo) ++seg;
                        mx::mlstm_out(p, l, u, lds, tid, pre, u + 1 < uhi ? u + 1 : -1, Cm, mcur, startrun ? 2 * bid + seg : -1); } }
                { const int glo = (int)((long)(G - 1 - bid) * NU / G), ghi = (int)((long)(G - bid) * NU / G);
                if (glo < ghi) { mx::PreG pre; mx::load_g(p, l, glo, pre, tid, true); f32x4 Sm[4]; int seg = 0;
#pragma unroll
                    for (int i = 0; i < 4; ++i) Sm[i] = (f32x4){0.f, 0.f, 0.f, 0.f};
                    for (int u = glo; u < ghi; ++u) { const bool startrun = (u == glo) || (u % NCH) == 0; if (startrun && u != glo) ++seg;
                        mx::gla_out(p, l, u, lds, tid, pre, u + 1 < ghi ? u + 1 : -1, Sm, startrun ? 2 * bid + seg : -1); } } } } }
        SEAM(pb + 3);
        if (IN(pb + 4)) {
            pg8::DenseOrder<NIN, D> S; S.init(XR, D, G, bid);
            pg8::EpiRes<false, false, WS_SS2, true> E{p.ws, lds};
            pg8::gemm_phase<pg8::EpiRes<false, false, WS_SS2, true>, pg8::DenseOrder<NIN, D>, true, NIN, D>(lds + RING_OFF, (const char*)(p.ws + WS_Z), (const char*)(p.ws + WS_WOUT) + (size_t)l * D * D * 2, S, E);
            int tl_ = tid; asm volatile("" : "+v"(tl_));
            if (tl_ < 64) { const int lane = tl_, r = lane & 15, q = lane >> 4; const bf16_t* wo = p.Wout() + (size_t)l * D * D;
                for (int tt = bid; tt < 4 * (D / 16); tt += G) { const int b4 = tt / (D / 16), ct = tt % (D / 16), row0 = XR + b4 * 64 + LEAD;
                    const bf16_t* ap = p.Z() + (size_t)(row0 + r) * NIN + q * 8; const bf16_t* bp = wo + (size_t)(ct * 16 + r) * D + q * 8; f32x4 acc = {0.f, 0.f, 0.f, 0.f};
#pragma unroll 8
                    for (int ks = 0; ks < 32; ++ks) acc = __builtin_amdgcn_mfma_f32_16x16x32_bf16(*(const pg8::bf16x8*)(ap + ks * 32), *(const pg8::bf16x8*)(bp + ks * 32), acc, 0, 0, 0);
#pragma unroll
                    for (int j = 0; j < 4; ++j) { const size_t o = (size_t)(row0 + q * 4 + j) * D + ct * 16 + r; const float v = bf2f(p.H()[o]) + acc[j];
                        p.H()[o] = (bf16_t)(pg8::cvt_pk_bf16(v, 0.f) & 0xffffu); (p.ws + WS_H8)[o] = (unsigned char)(pg8::pk_fp8x4(v, 0.f, 0.f, 0.f) & 0xffu); } } }
        }
        SEAM(pb + 4);
        if (IN(pb + 5)) route_phase(p, l, lds, G, bid, gcnt);
        SEAM(pb + 5);
        if (IN(pb + 6)) {
{
            moe_build_tab((LAS MoeTab*)(lds + TAB_OFF), gcnt);
            typedef MoeOrder<true, 2, D / 2, D / 2, 512u * D> Ord;
            Ord S; S.lds = lds; S.ws = p.ws; S.rbLo = 0; S.nwg = ((const LAS MoeTab*)(lds + TAB_OFF))->rb0[64] * 2; S.G = G; S.c = bid;
            pg8::EpiUp E{p.ws, lds};
            pg8::gemm_phase<pg8::EpiUp, Ord, true, D / 2, D / 2, true>(lds + RING_OFF, (const char*)(p.ws + WS_H8), (const char*)(p.ws + WS_WGU) + (size_t)l * NE * 512 * D, S, E);
            }
        }
        SEAM(pb + 6);
#pragma unroll
        for (int rank = 0; rank < 2; ++rank) {
            if (IN(pb + 7 + rank)) {
                moe_build_tab((LAS MoeTab*)(lds + TAB_OFF), gcnt);
                const LAS MoeTab* T = (const LAS MoeTab*)(lds + TAB_OFF);
                typedef MoeOrder<false, 4, DE / 2, DE / 2, (unsigned)D * DE> Ord;
                Ord S; S.lds = lds; S.ws = p.ws; S.rbLo = T->rb0[32 * rank]; S.nwg = (T->rb0[32 * rank + 32] - T->rb0[32 * rank]) * 4; S.G = G; S.c = bid;
                const char* Ab = (const char*)(p.ws + WS_HID); const char* Bb = (const char*)(p.ws + WS_WD) + (size_t)l * NE * D * DE;
                if (rank == 0) { pg8::EpiRes<true, false, WS_SS1> E{p.ws, lds}; pg8::gemm_phase<pg8::EpiRes<true, false, WS_SS1>, Ord, true, DE / 2, DE / 2, true>(lds + RING_OFF, Ab, Bb, S, E); }
                else { pg8::EpiRes<true, true, WS_SS1> E{p.ws, lds}; pg8::gemm_phase<pg8::EpiRes<true, true, WS_SS1>, Ord, true, DE / 2, DE / 2, true>(lds + RING_OFF, Ab, Bb, S, E); }
            }
            SEAM(pb + 7 + rank);
        }
    }
    if (IN(PH_FINAL)) pro::final_phase(p, G, bid, tid);
#undef IN
#undef SEAM
}

extern "C" void kernel_launch(void* const* d_in, const int* in_sizes, int n_in, void* d_out, int out_size, void* d_ws, size_t ws_size, hipStream_t stream) {
    if (n_in != 21 || ws_size < WS_END || out_size != B * SEQ * D) { fprintf(stderr, "kernel_launch: unexpected sizes n_in %d ws %zu (need %zu) out %d\n", n_in, ws_size, (size_t)WS_END, out_size); return; }
    P p{};
    const float** f = (const float**)&p.x;
    for (int i = 0; i < 21; ++i) f[i] = (const float*)d_in[i];
    p.out = (float*)d_out; p.ws = (unsigned char*)d_ws;
    static int grid = 0;
    if (!grid) {
        (void)hipFuncSetAttribute((const void*)fwd, hipFuncAttributeMaxDynamicSharedMemorySize, LDS_BYTES);
        int dev = 0, cus = 0, per_cu = 0;
        (void)hipGetDevice(&dev); (void)hipDeviceGetAttribute(&cus, hipDeviceAttributeMultiprocessorCount, dev);
        (void)hipOccupancyMaxActiveBlocksPerMultiprocessor(&per_cu, (const void*)fwd, NTHR, LDS_BYTES);
        (void)hipGetLastError();
        grid = cus > 0 ? cus : 256;
        if (per_cu < 1) fprintf(stderr, "kernel_launch: occupancy query reports %d blocks/CU for fwd\n", per_cu);
        if (grid * 128 < XR) fprintf(stderr, "kernel_launch: the route phase needs >= %d workgroups, the device has %d CUs\n", XR / 128, grid);
    }
    (void)hipMemsetAsync(d_ws, 0, CTL_BYTES, stream);
    Args a{}; a.p = p; a.ph_lo = 0; a.ph_hi = PH_COUNT;
    hipLaunchKernelGGL(fwd, dim3(grid), dim3(NTHR), LDS_BYTES, stream, a);
}
```

```cpp
#include <hip/hip_runtime.h>
#include <cstdio>
#include <cstdint>

typedef unsigned short bf16_t;
typedef float f32x4 __attribute__((ext_vector_type(4)));

namespace cfg {
constexpr int B = 4, SEQ = 8192, D = 1024, DEPTH = 2;
constexpr int CH = 64, NMETA = 16, LEAD = 48;
constexpr int TP = LEAD + NMETA + SEQ;
constexpr int NCH = TP / CH;
constexpr int MP = B * TP;
constexpr int XR = B * SEQ;
constexpr int NIN = 3608, NZP = 3840, ZP = 3648;
constexpr int ZO_OM = 0, ZO_GG = 512, ZO_QM = 1024, ZO_KM = 1536, ZO_VM = 2048, ZO_QG = 2560, ZO_KG = 2816, ZO_VG = 3072, ZO_IG = 3584, ZO_FG = 3588, ZO_CODE = 3592;
constexpr int NE = 32, DE = 256, NR = 40;
constexpr float EPS = 1e-6f;
constexpr int NU = B * 4 * NCH;

constexpr size_t al(size_t x) { return (x + 255) & ~(size_t)255; }
constexpr size_t WS_CTL = 0, CTL_BYTES = 4u << 20;
constexpr size_t WS_WIN = WS_CTL + CTL_BYTES;
constexpr size_t WS_WOUT = WS_WIN + al((size_t)DEPTH * NZP * D * 2);
constexpr size_t WS_WGU = WS_WOUT + al((size_t)DEPTH * D * D * 2);
constexpr size_t WS_H8 = WS_WGU + al((size_t)DEPTH * NE * 512 * D);
constexpr size_t WS_WD = WS_H8 + al((size_t)MP * D);
constexpr size_t WS_WR = WS_WD + al((size_t)DEPTH * NE * D * DE * 2);
constexpr size_t WS_H = WS_WR + al((size_t)DEPTH * NR * D * 4);
constexpr size_t WS_Z = WS_H + al((size_t)MP * D * 2);
constexpr size_t WS_SS1 = WS_Z + al((size_t)MP * ZP * 2);
constexpr size_t WS_SS2 = WS_SS1 + al((size_t)MP * 16);
constexpr size_t WS_TOKE = WS_SS2 + al((size_t)MP * 16);
constexpr size_t WS_TOKW = WS_TOKE + al((size_t)MP * 8);
constexpr int CAPL = MP, NBMAX = 352;
constexpr size_t WS_LTOK = WS_TOKW + al((size_t)MP * 8);
constexpr size_t WS_LRS = WS_LTOK + al((size_t)64 * CAPL * 4);
constexpr size_t WS_LW = WS_LRS + al((size_t)64 * CAPL * 4);
constexpr size_t WS_WRS = WS_LW + al((size_t)64 * CAPL * 4);
constexpr size_t WS_QKC = WS_WRS + al((size_t)2 * DEPTH * 48 * D * 2);
constexpr size_t WS_END = WS_QKC + al((size_t)MP * 1024 * 2);
constexpr size_t WS_HID = WS_QKC;
static_assert((size_t)NBMAX * 256 * 256 * 2 <= (size_t)MP * 1024 * 2, "hid fits in the q|k buffer");
constexpr size_t ST_MC = 0;
constexpr size_t ST_GS = ST_MC + al((size_t)NU * 16384 * 2);
constexpr size_t ST_MN = ST_GS + al((size_t)NU * 8192 * 2);
constexpr size_t ST_MSC = ST_MN + al((size_t)NU * 128 * 4);
constexpr size_t ST_GB = ST_MSC + al((size_t)NU * 16);
constexpr size_t ST_GA = ST_GB + al((size_t)NU * 64 * 4);
constexpr size_t ST_END = ST_GA + al((size_t)NU * 192 * 4);
static_assert(ST_END <= (size_t)B * SEQ * D * 4, "state scratch fits d_out");
}
using namespace cfg;

__device__ __forceinline__ float bf2f(bf16_t v) { return __uint_as_float(((unsigned)v) << 16); }
__device__ __forceinline__ bf16_t f2bf(float f) { unsigned u = __float_as_uint(f); u += 0x7fffu + ((u >> 16) & 1u); return (bf16_t)(u >> 16); }
__device__ __forceinline__ float wave_sum(float v) {
#pragma unroll
    for (int o = 1; o < 64; o <<= 1) v += __shfl_xor(v, o);
    return v;
}
__device__ __forceinline__ float logsig(float x) { return fminf(x, 0.f) - log1pf(__expf(-fabsf(x))); }
__device__ __forceinline__ float sigm(float x) { return 1.f / (1.f + __expf(-x)); }
__device__ __forceinline__ float silu(float x) { return x * sigm(x); }

__host__ __device__ __forceinline__ int zsrc(int n) {
    if (n < 512) return 1536 + n;
    if (n < 1024) return 3080 + (n - 512);
    if (n < 2048) return n - 1024;
    if (n < 2560) return 1024 + (n - 2048);
    if (n < 2816) return 2056 + (n - 2560);
    if (n < 3072) return 2312 + (n - 2816);
    if (n < 3584) return 2568 + (n - 3072);
    if (n < 3588) return 2048 + (n - 3584);
    if (n < 3592) return 2052 + (n - 3588);
    return n;
}

struct P {
    const float *x, *meta, *norm1_g, *w_in, *conv_w, *conv_b, *gate_b, *m_norm_g, *a_w2, *a_b, *g_norm_g, *w_out, *norm2_g, *wr_g, *br_g, *wr_e, *br_e, *w_gate, *w_up, *w_down, *final_g;
    float* out; unsigned char* ws;
    __device__ __forceinline__ bf16_t* Win() const { return (bf16_t*)(ws + WS_WIN); }
    __device__ __forceinline__ bf16_t* Wout() const { return (bf16_t*)(ws + WS_WOUT); }
    __device__ __forceinline__ bf16_t* Wgu() const { return (bf16_t*)(ws + WS_WGU); }
    __device__ __forceinline__ bf16_t* Wd() const { return (bf16_t*)(ws + WS_WD); }
    __device__ __forceinline__ bf16_t* H() const { return (bf16_t*)(ws + WS_H); }
    __device__ __forceinline__ bf16_t* Z() const { return (bf16_t*)(ws + WS_Z); }
    __device__ __forceinline__ float* SS1() const { return (float*)(ws + WS_SS1); }
    __device__ __forceinline__ float* SS2() const { return (float*)(ws + WS_SS2); }
    __device__ __forceinline__ bf16_t* MC() const { return (bf16_t*)((unsigned char*)out + ST_MC); }
    __device__ __forceinline__ float* RA(int slot) const { return (float*)((unsigned char*)out + ST_MC) + (size_t)slot * 16512; }
    __device__ __forceinline__ float* RS(int slot) const { return (float*)((unsigned char*)out + ST_MC) + (size_t)(512 + slot) * 16512; }
    __device__ __forceinline__ float* RAg(int slot) const { return (float*)((unsigned char*)out + ST_GS) + (size_t)slot * 8192; }
    __device__ __forceinline__ float* RSg(int slot) const { return (float*)((unsigned char*)out + ST_GS) + (size_t)(512 + slot) * 8192; }
    __device__ __forceinline__ float* RBg(int slot) const { return (float*)((unsigned char*)out + ST_GB) + (size_t)slot * 64; }
    __device__ __forceinline__ float* RQ(int slot) const { return (float*)((unsigned char*)out + ST_MSC) + (size_t)slot * 4; }
    __device__ __forceinline__ bf16_t* GS() const { return (bf16_t*)((unsigned char*)out + ST_GS); }
    __device__ __forceinline__ float* MN() const { return (float*)((unsigned char*)out + ST_MN); }
    __device__ __forceinline__ float* MSC() const { return (float*)((unsigned char*)out + ST_MSC); }
    __device__ __forceinline__ float* GB() const { return (float*)((unsigned char*)out + ST_GB); }
};

__host__ __device__ __forceinline__ bool is_pad_row(int r) { return r >= XR && ((r - XR) & 63) < LEAD; }
__host__ __device__ __forceinline__ int chunk_row0(int b, int c) { return c == 0 ? XR + b * 64 : b * SEQ + (c - 1) * 64; }
__device__ __forceinline__ float row_rs(const float* ss, int r) {
    if (is_pad_row(r)) return 0.f;
    const f32x4 v = *(const f32x4*)(ss + (size_t)r * 4);
    return rsqrtf((v.x + v.y + v.z + v.w) * (1.f / D) + EPS);
}

#define LAS __attribute__((address_space(3)))
constexpr int NWAVES = 8, NTHR = 512;
constexpr int RING_OFF = 0, RING_BYTES = 131072, TAB_OFF = 131072, TAB_BYTES = 24576, MISC_OFF = TAB_OFF + TAB_BYTES, LDS_BYTES = MISC_OFF + 512;
constexpr int GLA_TAB = TAB_OFF;
constexpr int RED_OFF = TAB_OFF + 4096;
constexpr int UROW_OFF = TAB_OFF + 8192;
constexpr int CW_BAR = 4096, CW_CNT = 16384;
constexpr int PH_PRO = 0, PH_LAYER0 = 1, PH_PER_LAYER = 9, PH_FINAL = 1 + 9 * DEPTH, PH_COUNT = PH_FINAL + 1;

#define XB_TMO      128
#define XB_XCNT(j)  (256  + 64 * (j))
#define XB_XSUB(j)  (1280 + 64 * (j))
#define XB_XGEN(j)  (2304 + 64 * (j))
#define XB_TOP      3328
#define XB_TOPGEN   3392
#define XCD_BAR_WORDS 3456
#define XB_SPIN_CAP (1u << 18)
__device__ __forceinline__ unsigned xb_ld(unsigned* p)              { return __hip_atomic_load(p, __ATOMIC_RELAXED, __HIP_MEMORY_SCOPE_AGENT); }
__device__ __forceinline__ unsigned xb_add(unsigned* p, unsigned v) { return __hip_atomic_fetch_add(p, v, __ATOMIC_RELAXED, __HIP_MEMORY_SCOPE_AGENT); }
__device__ __forceinline__ unsigned xb_xcc_id() { return (unsigned)__builtin_amdgcn_s_getreg((3 << 11) | 20) & 0xFu; }
#define XB_SPIN(cond, bar) do { unsigned _sp = 0; while (cond) { __builtin_amdgcn_s_sleep(1); \
    if ((++_sp & 255u) == 0u) { if (xb_ld(&(bar)[XB_TMO])) break; if (_sp > XB_SPIN_CAP) { atomicAdd(&(bar)[XB_TMO], 1u); break; } } } } while (0)
struct XcdBarrier { unsigned* bar; unsigned x; volatile LAS unsigned* st; };
__device__ __forceinline__ XcdBarrier xcd_barrier_post(unsigned* bar, volatile LAS unsigned* st) {
    XcdBarrier b; b.bar = bar; b.x = xb_xcc_id(); b.st = st;
    if (threadIdx.x == 0) (void)xb_add(&bar[XB_XCNT(b.x)], 1u);
    return b;
}
__device__ __forceinline__ void xcd_barrier_complete(unsigned* bar, unsigned x, unsigned& nloc, unsigned& nx) {
    const unsigned G = gridDim.x * gridDim.y * gridDim.z;
    unsigned sum, cnt, mine, sp = 0u;
    for (;;) {
        sum = 0u; cnt = 0u; mine = 0u;
#pragma unroll
        for (unsigned j = 0; j < 16; ++j) { const unsigned c = xb_ld(&bar[XB_XCNT(j)]); sum += c; cnt += (c > 0u) ? 1u : 0u; mine = (j == x) ? c : mine; }
        if (sum == G) break;
        __builtin_amdgcn_s_sleep(1);
        if ((++sp & 255u) == 0u) { if (xb_ld(&bar[XB_TMO])) break; if (sp > XB_SPIN_CAP) { atomicAdd(&bar[XB_TMO], 1u); break; } }
    }
    nloc = mine > 0u ? mine : 1u; nx = cnt > 0u ? cnt : 1u;
}
__device__ __forceinline__ void xcd_barrier(const XcdBarrier& b) {
    asm volatile("s_waitcnt vmcnt(0)" ::: "memory");
    __syncthreads();
    if (threadIdx.x == 0) {
        unsigned* bar = b.bar; unsigned bx = b.x; asm volatile("" : "+s"(bx));
        __builtin_amdgcn_s_waitcnt(0);
        unsigned nloc = b.st[0], nx = b.st[1];
        if (nloc == 0u) { xcd_barrier_complete(bar, bx, nloc, nx); b.st[0] = nloc; b.st[1] = nx; }
        const unsigned old = xb_add(&bar[XB_XSUB(bx)], 1u);
        const unsigned gen = old / nloc;
        if (old + 1u == (gen + 1u) * nloc) {
            __builtin_amdgcn_fence(__ATOMIC_RELEASE, "agent");
            asm volatile("s_waitcnt vmcnt(0)" ::: "memory");
            const unsigned og = xb_add(&bar[XB_TOP], 1u);
            const unsigned tg = og / nx;
            if (og + 1u == (tg + 1u) * nx) xb_add(&bar[XB_TOPGEN], 1u);
            else XB_SPIN(xb_ld(&bar[XB_TOPGEN]) == tg, bar);
            __builtin_amdgcn_fence(__ATOMIC_ACQUIRE, "agent");
            xb_add(&bar[XB_XGEN(bx)], 1u);
            asm volatile("s_waitcnt vmcnt(0)" ::: "memory");
        } else {
            XB_SPIN(xb_ld(&bar[XB_XGEN(bx)]) == gen, bar);
            __builtin_amdgcn_fence(__ATOMIC_ACQUIRE, "agent");
            asm volatile("s_waitcnt vmcnt(0)" ::: "memory");
        }
    }
    __syncthreads();
}

namespace pg8 {
typedef short bf16x8 __attribute__((ext_vector_type(8)));
typedef unsigned u32x4 __attribute__((ext_vector_type(4)));
typedef unsigned u32x2 __attribute__((ext_vector_type(2)));
constexpr int BM = 256, BK = 64, HALF = 128, HTB = HALF * BK * 2, STAGE_BYTES = 8 * HTB, NXCD = 8, WGM = 8;
__host__ __device__ __forceinline__ int lds_byte(int r, int c) { const int st = (r >> 4) * 2 + (c >> 5), rr = r & 15, cc = c & 31, ob = rr * 64 + cc * 2; return st * 1024 + (ob ^ (((ob >> 9) & 1) << 5)); }
__host__ __device__ __forceinline__ void stage_rc(int b, int& R, int& C) { const int st = b / 1024, sb = b % 1024, swz = sb ^ (((sb >> 9) & 1) << 5); R = (st >> 1) * 16 + swz / 64; C = (st & 1) * 32 + (swz % 64) / 2; }
__host__ __device__ __forceinline__ int perm32(int rho) { const int n = rho >> 4, i = rho & 15; return 8 * (i >> 2) + 4 * n + (i & 3); }
typedef float f32x2_ __attribute__((ext_vector_type(2))); typedef __bf16 bf16x2_ __attribute__((ext_vector_type(2)));
__device__ __forceinline__ unsigned cvt_pk_bf16(float lo, float hi) { const f32x2_ v = {lo, hi}; return __builtin_bit_cast(unsigned, __builtin_convertvector(v, bf16x2_)); }
__device__ __forceinline__ float bflo(unsigned w) { return __uint_as_float(w << 16); }
__device__ __forceinline__ float bfhi(unsigned w) { return __uint_as_float(w & 0xffff0000u); }

struct Unit { int pm, pn; unsigned bo; };

__device__ __forceinline__ int xcd_remap(int L, int nwg) { const int q = nwg / NXCD, r = nwg % NXCD, xcd = L % NXCD, off = L / NXCD; return (xcd < r ? xcd * (q + 1) : r * (q + 1) + (xcd - r) * q) + off; }

template <int LDA, int K> struct DenseOrder {
    static constexpr bool GATHER = false, LIST = false;
    typedef int Row;
    int nM, nN, nwg, G, c;
    __device__ __forceinline__ void init(int M, int N, int G_, int c_) { nM = M / BM; nN = N / BM; nwg = nM * nN; G = G_; c = c_; }
    __device__ __forceinline__ bool unit(int i, Unit& u) const {
        const int L = i * G + c; if (L >= nwg) return false;
        const int wgid = xcd_remap(L, nwg);
        const int nig = WGM * nN, gid = wgid / nig, fm = gid * WGM, gsz = (nM - fm) < WGM ? (nM - fm) : WGM;
        u.pm = fm + ((wgid % nig) % gsz); u.pn = (wgid % nig) / gsz; u.bo = (unsigned)u.pn * (unsigned)(BM * K * 2); return true;
    }
    __device__ __forceinline__ unsigned aofs(const Unit& u) const { return (unsigned)u.pm * (unsigned)(BM * LDA * 2); }
    __device__ __forceinline__ void fetch(const Unit&, int, Row&) const {}
    __device__ __forceinline__ void stash(const Unit&, const Row&, int, int) const {}
    __device__ __forceinline__ unsigned aoff(int, int rowl, int C) const { return (unsigned)(rowl * LDA + C) * 2u; }
};
template <int LDA, int K> struct DenseOrderRS : DenseOrder<LDA, K> {
    static constexpr bool GATHER = false, LIST = true;
    typedef f32x4 Row;
    LAS unsigned char* lds; unsigned char* ws;
    __device__ __forceinline__ void fetch(const Unit& u, int tid, Row& r) const { if (tid < 256) r = *(const f32x4*)((const float*)(ws + WS_SS1) + (size_t)(u.pm * BM + tid) * 4); }
    __device__ __forceinline__ void stash(const Unit& u, const Row& r, int ub, int tid) const {
        if (tid < 256) ((LAS float*)(lds + UROW_OFF))[ub * 256 + tid] = is_pad_row(u.pm * BM + tid) ? 0.f : __builtin_amdgcn_rsqf(((r.x + r.y) + (r.z + r.w)) * (1.f / D) + EPS); }
};

template <class Epi, class Sched, bool ALIGN_EPI, int LDA, int K, bool FP8 = false>
__device__ __forceinline__ void gemm_phase(LAS unsigned char* lds, const char* Abase, const char* Bbase, const Sched& S, const Epi& E) {
    int tid_ = threadIdx.x; asm volatile("" : "+v"(tid_));
    const int tid = tid_, wid = __builtin_amdgcn_readfirstlane(tid >> 6), lane = tid & 63, wr = wid >> 2, wc = wid & 3, fr = lane & 15, fq = lane >> 4;
    constexpr int nt = K / BK;
    int Rr[2], Cc[2]; unsigned voffB[2];
#pragma unroll
    for (int i = 0; i < 2; ++i) { stage_rc(tid * 16 + i * 8192, Rr[i], Cc[i]); const int Rb = Epi::PERM ? ((Rr[i] & ~31) + perm32(Rr[i] & 31)) : Rr[i]; voffB[i] = (unsigned)(Rb * K + Cc[i]) * 2u; }
    constexpr unsigned kstep = BK * 2, hstepB = HALF * K * 2;
    const unsigned ldsw = (unsigned)wid * 1024u;
    int aofs[2], bofs[2];
#pragma unroll
    for (int e = 0; e < 2; ++e) { aofs[e] = FP8 ? lds_byte(wr * 64 + fr, (2 * fq + e) * 8) : lds_byte(wr * 64 + fr, fq * 8) + e * 1024; bofs[e] = FP8 ? lds_byte(wc * 32 + fr, (2 * fq + e) * 8) : lds_byte(wc * 32 + fr, fq * 8) + e * 1024; }
#define PG8_SA(b, h) (((b) * 2 + (h)) * HTB)
#define PG8_SB(b, h) ((4 + (b) * 2 + (h)) * HTB)
#define PG8_STAGE(bufoff, gbase, uoff, voff) do { _Pragma("unroll") for (int _i = 0; _i < 2; ++_i) \
        __builtin_amdgcn_global_load_lds((const unsigned*)((gbase) + (size_t)(unsigned)((uoff) + (voff)[_i])), (LAS unsigned*)(lds + (bufoff) + ldsw + _i * 8192), 16, 0, 0); } while (0)
#define PG8_LDA(dst, b, h) do { _Pragma("unroll") for (int m = 0; m < 4; ++m) _Pragma("unroll") for (int k = 0; k < 2; ++k) dst[m][k] = *(const LAS bf16x8*)(lds + PG8_SA(b, h) + aofs[k] + m * 2048); } while (0)
#define PG8_LDB(dst, b, h) do { _Pragma("unroll") for (int n = 0; n < 2; ++n) _Pragma("unroll") for (int k = 0; k < 2; ++k) dst[n][k] = *(const LAS bf16x8*)(lds + PG8_SB(b, h) + bofs[k] + n * 2048); } while (0)
#define PG8_MMA(ai, bj, At, Bt) do { __builtin_amdgcn_s_setprio(1); _Pragma("unroll") for (int m = 0; m < 4; ++m) _Pragma("unroll") for (int n = 0; n < 2; ++n) { \
        if constexpr (FP8) { typedef int i32x4_ __attribute__((ext_vector_type(4))); typedef int i32x8_ __attribute__((ext_vector_type(8))); \
            const i32x8_ b8_ = __builtin_shufflevector(__builtin_bit_cast(i32x4_, Bt[n][0]), __builtin_bit_cast(i32x4_, Bt[n][1]), 0, 1, 2, 3, 4, 5, 6, 7), a8_ = __builtin_shufflevector(__builtin_bit_cast(i32x4_, At[m][0]), __builtin_bit_cast(i32x4_, At[m][1]), 0, 1, 2, 3, 4, 5, 6, 7); \
            acc[ai][bj][m][n] = __builtin_amdgcn_mfma_scale_f32_16x16x128_f8f6f4(b8_, a8_, acc[ai][bj][m][n], 0, 0, 0, 0x7F7F7F7F, 0, 0x7F7F7F7F); } \
        else { _Pragma("unroll") for (int k = 0; k < 2; ++k) acc[ai][bj][m][n] = __builtin_amdgcn_mfma_f32_16x16x32_bf16(Bt[n][k], At[m][k], acc[ai][bj][m][n], 0, 0, 0); } } __builtin_amdgcn_s_setprio(0); } while (0)
#define PG8_WAIT_V(n) asm volatile("s_waitcnt vmcnt(" #n ")" ::: "memory")
#define PG8_WAIT_L(n) asm volatile("s_waitcnt lgkmcnt(" #n ")" ::: "memory")
#define PG8_BAR __builtin_amdgcn_s_barrier()
#define PG8_SCHED __builtin_amdgcn_sched_barrier(0)
    Unit cur, nxt, nx2; int ui = 0, ub = 0;
    if (!S.unit(0, cur)) return;
    typename Sched::Row rowr;
    if constexpr (Sched::LIST) { S.fetch(cur, tid, rowr); S.stash(cur, rowr, 0, tid); asm volatile("s_waitcnt lgkmcnt(0)" ::: "memory"); __builtin_amdgcn_s_barrier(); asm volatile("" ::: "memory"); }
    bool has_next = S.unit(1, nxt);
    if constexpr (Sched::LIST) { if (has_next) S.fetch(nxt, tid, rowr); }
    unsigned voffA[2][2];
#pragma unroll
    for (int h = 0; h < 2; ++h)
#pragma unroll
        for (int i = 0; i < 2; ++i) voffA[h][i] = S.aoff(0, h * HALF + Rr[i], Cc[i]);
    f32x4 acc[2][2][4][2];
#pragma unroll
    for (int a = 0; a < 2; ++a)
#pragma unroll
        for (int b = 0; b < 2; ++b)
#pragma unroll
            for (int m = 0; m < 4; ++m)
#pragma unroll
                for (int n = 0; n < 2; ++n) acc[a][b][m][n] = (f32x4){0.f, 0.f, 0.f, 0.f};
    bf16x8 At[4][2], B0[2][2], B1[2][2];
    unsigned cA = S.aofs(cur), cB = cur.bo;
    PG8_STAGE(PG8_SB(0, 0), Bbase, cB, voffB); PG8_STAGE(PG8_SB(0, 1), Bbase, cB + hstepB, voffB); PG8_STAGE(PG8_SA(0, 0), Abase, cA, voffA[0]); PG8_STAGE(PG8_SA(0, 1), Abase, cA, voffA[1]);
    if (wr == 1) PG8_BAR;
    PG8_WAIT_V(2); PG8_BAR;
    PG8_STAGE(PG8_SB(1, 0), Bbase, cB + kstep, voffB); PG8_STAGE(PG8_SA(1, 0), Abase, cA + kstep, voffA[0]); PG8_STAGE(PG8_SB(1, 1), Bbase, cB + hstepB + kstep, voffB);
    PG8_WAIT_V(6); PG8_BAR;
    for (;;) {
        const int nub = (ub == 2) ? 0 : ub + 1;
        if constexpr (Sched::LIST) { if (has_next) S.stash(nxt, rowr, nub, tid); }
        const bool has_nx2 = has_next && S.unit(ui + 2, nx2);
        if constexpr (Sched::LIST) { if (has_nx2) S.fetch(nx2, tid, rowr); }
        const unsigned nA = has_next ? S.aofs(nxt) : cA, nB = has_next ? nxt.bo : cB;
#pragma unroll 1
        for (int t = 0; t < nt; t += 2) {
            const bool last = (t == nt - 2);
            const unsigned a1 = cA + (unsigned)(t + 1) * kstep;
            const unsigned a2 = last ? nA : cA + (unsigned)(t + 2) * kstep, b2 = last ? nB : cB + (unsigned)(t + 2) * kstep;
            const unsigned a3 = a2 + kstep, b3 = b2 + kstep;
            PG8_LDB(B0, 0, 0); PG8_LDB(B1, 0, 1); PG8_SCHED; PG8_LDA(At, 0, 0); PG8_STAGE(PG8_SA(1, 1), Abase, a1, voffA[1]);
            if constexpr (Sched::GATHER) { if (last && has_next) {
#pragma unroll
                for (int i = 0; i < 2; ++i) { int R2, C2; stage_rc(tid * 16 + i * 8192, R2, C2);
#pragma unroll
                    for (int h = 0; h < 2; ++h) voffA[h][i] = S.aoff(nub, h * HALF + R2, C2); } } }
            PG8_WAIT_V(8); PG8_WAIT_L(0); PG8_BAR; PG8_MMA(0, 0, At, B0); PG8_MMA(0, 1, At, B1); PG8_BAR; PG8_SCHED;
            PG8_LDA(At, 0, 1); PG8_STAGE(PG8_SB(0, 0), Bbase, b2, voffB); PG8_STAGE(PG8_SB(0, 1), Bbase, b2 + hstepB, voffB); PG8_STAGE(PG8_SA(0, 0), Abase, a2, voffA[0]);
            PG8_WAIT_V(8); PG8_WAIT_L(0); PG8_BAR; PG8_MMA(1, 0, At, B0); PG8_MMA(1, 1, At, B1); PG8_BAR; PG8_SCHED;
            PG8_LDB(B0, 1, 0); PG8_LDB(B1, 1, 1); PG8_SCHED; PG8_LDA(At, 1, 0); PG8_STAGE(PG8_SA(0, 1), Abase, a2, voffA[1]);
            PG8_WAIT_V(8); PG8_WAIT_L(0); PG8_BAR; PG8_MMA(0, 0, At, B0); PG8_MMA(0, 1, At, B1); PG8_BAR; PG8_SCHED;
            PG8_LDA(At, 1, 1); PG8_STAGE(PG8_SB(1, 0), Bbase, b3, voffB); PG8_STAGE(PG8_SB(1, 1), Bbase, b3 + hstepB, voffB); PG8_STAGE(PG8_SA(1, 0), Abase, a3, voffA[0]);
            PG8_WAIT_V(8); PG8_WAIT_L(0); PG8_BAR; PG8_MMA(1, 0, At, B0); PG8_MMA(1, 1, At, B1); PG8_BAR; PG8_SCHED;
        }
        if constexpr (ALIGN_EPI) { if (wr == 0) PG8_BAR; }
        E(acc, cur, wr, wc, fr, fq, tid, ub);
        if (!has_next) break;
#pragma unroll
        for (int a = 0; a < 2; ++a)
#pragma unroll
            for (int b = 0; b < 2; ++b)
#pragma unroll
                for (int m = 0; m < 4; ++m)
#pragma unroll
                    for (int n = 0; n < 2; ++n) acc[a][b][m][n] = (f32x4){0.f, 0.f, 0.f, 0.f};
        cur = nxt; nxt = nx2; has_next = has_nx2; cA = nA; cB = nB; ++ui; ub = nub;
        if constexpr (ALIGN_EPI) { if (wr == 1) PG8_BAR; }
    }
    PG8_WAIT_V(0);
    if constexpr (!ALIGN_EPI) { if (wr == 0) PG8_BAR; }
    PG8_BAR;
#undef PG8_SA
#undef PG8_SB
#undef PG8_STAGE
#undef PG8_LDA
#undef PG8_LDB
#undef PG8_MMA
#undef PG8_WAIT_V
#undef PG8_WAIT_L
#undef PG8_BAR
#undef PG8_SCHED
}

struct EpiZ {
    static constexpr bool PERM = true;
    unsigned char* ws; LAS unsigned char* lds;
    __device__ __forceinline__ void operator()(const f32x4 (&acc)[2][2][4][2], const Unit& u, int wr, int wc, int fr, int fq, int, int ub) const {
        const int row0 = u.pm * BM + wr * 64 + fr, col0 = u.pn * BM + wc * 32 + 8 * fq;
        bf16_t* z = (bf16_t*)(ws + WS_Z); const LAS float* rsb = (const LAS float*)(lds + UROW_OFF) + ub * 256 + wr * 64 + fr;
#pragma unroll
        for (int ai = 0; ai < 2; ++ai)
#pragma unroll
            for (int m = 0; m < 4; ++m) { const int row = row0 + ai * HALF + m * 16; const float rs = rsb[ai * HALF + m * 16]; bf16_t* rowp = z + (size_t)row * ZP + col0;
#pragma unroll
                for (int bj = 0; bj < 2; ++bj) if (col0 + bj * HALF < NIN) { const f32x4 v0 = acc[ai][bj][m][0] * rs, v1 = acc[ai][bj][m][1] * rs;
                    u32x4 w; w.x = cvt_pk_bf16(v0[0], v0[1]); w.y = cvt_pk_bf16(v0[2], v0[3]); w.z = cvt_pk_bf16(v1[0], v1[1]); w.w = cvt_pk_bf16(v1[2], v1[3]);
                    *(u32x4*)(rowp + bj * HALF) = w; } }
    }
};
__device__ __forceinline__ unsigned pk_fp8x4(float a, float b, float c, float d) { int r = __builtin_amdgcn_cvt_pk_fp8_f32(a, b, 0, false); r = __builtin_amdgcn_cvt_pk_fp8_f32(c, d, r, true); return (unsigned)r; }
template <bool LIST, bool STATS, size_t SS_OFF, bool H8OUT = false> struct EpiRes {
    static constexpr bool PERM = true;
    unsigned char* ws; LAS unsigned char* lds;
    __device__ __forceinline__ void operator()(const f32x4 (&acc)[2][2][4][2], const Unit& u, int wr, int wc, int fr, int fq, int tid, int ub) const {
        const int col0 = u.pn * BM + wc * 32 + 8 * fq;
        bf16_t* h = (bf16_t*)(ws + WS_H); float* ss = (float*)(ws + SS_OFF); LAS float* red = (LAS float*)(lds + RED_OFF); const LAS int* utok = (const LAS int*)(lds + UROW_OFF);
#pragma unroll
        for (int ai = 0; ai < 2; ++ai)
#pragma unroll
            for (int m = 0; m < 4; ++m) { const int rowl = ai * HALF + wr * 64 + m * 16 + fr; int row; bool valid = true;
                if constexpr (LIST) { row = utok[ub * 256 + rowl]; valid = row >= 0; } else row = u.pm * BM + rowl;
                float s = 0.f;
                if (valid) { bf16_t* hp = h + (size_t)row * D + col0;
#pragma unroll
                    for (int bj = 0; bj < 2; ++bj) { const u32x4 o = *(const u32x4*)(hp + bj * HALF); const f32x4 a0 = acc[ai][bj][m][0] * (LIST ? 0.0078125f : 1.f), a1 = acc[ai][bj][m][1] * (LIST ? 0.0078125f : 1.f);
                        const float v0 = bflo(o.x) + a0[0], v1 = bfhi(o.x) + a0[1], v2 = bflo(o.y) + a0[2], v3 = bfhi(o.y) + a0[3], v4 = bflo(o.z) + a1[0], v5 = bfhi(o.z) + a1[1], v6 = bflo(o.w) + a1[2], v7 = bfhi(o.w) + a1[3];
                        s += (v0 * v0 + v1 * v1) + (v2 * v2 + v3 * v3) + (v4 * v4 + v5 * v5) + (v6 * v6 + v7 * v7);
                        u32x4 w; w.x = cvt_pk_bf16(v0, v1); w.y = cvt_pk_bf16(v2, v3); w.z = cvt_pk_bf16(v4, v5); w.w = cvt_pk_bf16(v6, v7);
                        *(u32x4*)(hp + bj * HALF) = w;
                        if constexpr (H8OUT) { u32x2 q; q.x = pk_fp8x4(v0, v1, v2, v3); q.y = pk_fp8x4(v4, v5, v6, v7); *(u32x2*)(ws + WS_H8 + (size_t)row * D + col0 + bj * HALF) = q; } } }
                if constexpr (STATS) { s += __shfl_xor(s, 16); s += __shfl_xor(s, 32); if (fq == 0) red[rowl * 4 + wc] = s; }
                asm volatile("" ::: "memory"); }
        if constexpr (STATS) {
            asm volatile("s_waitcnt lgkmcnt(0)" ::: "memory"); __builtin_amdgcn_s_barrier(); asm volatile("" ::: "memory");
            if (tid < BM) { const f32x4 v = *(const LAS f32x4*)(red + tid * 4); int row; bool valid = true;
                if constexpr (LIST) { row = utok[ub * 256 + tid]; valid = row >= 0; } else row = u.pm * BM + tid;
                if (valid) ss[(size_t)row * 4 + u.pn] = (v.x + v.y) + (v.z + v.w); }
        }
    }
};
struct EpiUp {
    static constexpr bool PERM = false;
    unsigned char* ws; LAS unsigned char* lds;
    __device__ __forceinline__ void operator()(const f32x4 (&acc)[2][2][4][2], const Unit& u, int wr, int wc, int fr, int fq, int, int ub) const {
        const int col0 = u.pn * 128 + wc * 16 + 4 * fq;
        unsigned char* hid = ws + WS_HID; const LAS float* urs = (const LAS float*)(lds + UROW_OFF) + 768;
#pragma unroll
        for (int ai = 0; ai < 2; ++ai)
#pragma unroll
            for (int m = 0; m < 4; ++m) { const int rowl = ai * HALF + wr * 64 + m * 16 + fr;
                const float rs = urs[ub * 256 + rowl] * 0.0625f, gw = urs[768 + ub * 256 + rowl] * 16.f;
                unsigned char* hp = hid + ((size_t)u.pm * BM + rowl) * DE + col0;
#pragma unroll
                for (int bj = 0; bj < 2; ++bj) { const f32x4 g = acc[ai][bj][m][0] * rs, up = acc[ai][bj][m][1] * rs; float o[4];
#pragma unroll
                    for (int j = 0; j < 4; ++j) o[j] = g[j] * __builtin_amdgcn_rcpf(1.f + __builtin_amdgcn_exp2f(g[j] * -1.4426950408889634f)) * up[j] * gw;
                    *(unsigned*)(hp + bj * 64) = pk_fp8x4(o[0], o[1], o[2], o[3]); } }
    }
};
}

struct MoeTab { int cnt[64]; int rb0[65]; int pad[3]; unsigned short li[NBMAX]; unsigned short blk[NBMAX]; };
static_assert(sizeof(MoeTab) <= 4096, "MoeTab fits below RED_OFF");
__device__ __forceinline__ void moe_build_tab(LAS MoeTab* T, unsigned* gcnt) {
    int tid = threadIdx.x; asm volatile("" : "+v"(tid));
    if (tid < 64) { const int c = (int)__hip_atomic_load(gcnt + tid * 16, __ATOMIC_RELAXED, __HIP_MEMORY_SCOPE_AGENT), nb = (c + 255) >> 8;
        float inc = (float)nb;
#pragma unroll
        for (int d = 1; d < 64; d <<= 1) { const float o = __shfl_up(inc, d); if (tid >= d) inc += o; }
        const int b0 = (int)inc - nb;
        T->cnt[tid] = c; T->rb0[tid] = b0; if (tid == 63) T->rb0[64] = b0 + nb;
#pragma clang loop vectorize(disable) unroll(disable)
        for (int b = 0; b < nb; ++b) { T->li[b0 + b] = (unsigned short)tid; T->blk[b0 + b] = (unsigned short)b; } }
    __syncthreads();
}
template <bool GATHER_, int NN, int LDA, int K, unsigned ESTEP> struct MoeOrder {
    static constexpr bool GATHER = GATHER_, LIST = true;
    LAS unsigned char* lds; unsigned char* ws; int rbLo, nwg, G, c;
    typedef f32x4 Row;
    __device__ __forceinline__ bool unit(int i, pg8::Unit& u) const {
        const int L = i * G + c; if (L >= nwg) return false;
        const LAS MoeTab* T = (const LAS MoeTab*)(lds + TAB_OFF);
        const int wgid = pg8::xcd_remap(L, nwg), rb = rbLo + wgid / NN;
        u.pm = rb; u.pn = wgid % NN; u.bo = (unsigned)(T->li[rb] & 31) * ESTEP + (unsigned)u.pn * (unsigned)(256 * K * 2);
        return true;
    }
    __device__ __forceinline__ unsigned aofs(const pg8::Unit& u) const { return GATHER ? 0u : (unsigned)u.pm * (unsigned)(256 * LDA * 2); }
    __device__ __forceinline__ void fetch(const pg8::Unit& u, int tid, Row& r) const {
        const LAS MoeTab* T = (const LAS MoeTab*)(lds + TAB_OFF);
        if (tid < 256) { const int li = T->li[u.pm], slot = T->blk[u.pm] * 256 + tid; const bool valid = slot < T->cnt[li]; const size_t idx = (size_t)li * CAPL + slot;
            f32x4 v = {__int_as_float(-1), 0.f, 0.f, 0.f};
            if (valid) { v.x = __int_as_float(((const int*)(ws + WS_LTOK))[idx]); if constexpr (GATHER) { v.y = ((const float*)(ws + WS_LRS))[idx]; v.z = ((const float*)(ws + WS_LW))[idx]; } }
            r = v; }
    }
    __device__ __forceinline__ void stash(const pg8::Unit&, const Row& r, int ub, int tid) const {
        LAS int* urow = (LAS int*)(lds + UROW_OFF);
        if (tid < 256) { urow[ub * 256 + tid] = __float_as_int(r.x); if constexpr (GATHER) { ((LAS float*)urow)[768 + ub * 256 + tid] = r.y; ((LAS float*)urow)[1536 + ub * 256 + tid] = r.z; } }
    }
    __device__ __forceinline__ unsigned aoff(int ub, int rowl, int C) const {
        if constexpr (GATHER) { const int tok = ((const LAS int*)(lds + UROW_OFF))[ub * 256 + rowl]; return (unsigned)((tok < 0 ? 0 : tok) * LDA + C) * 2u; }
        else return (unsigned)(rowl * LDA + C) * 2u;
    }
};

__device__ __forceinline__ void route_phase(const P& p, int l, LAS unsigned char* lds, int G, int bid, unsigned* gcnt) {
    int tid_ = threadIdx.x; asm volatile("" : "+v"(tid_));
    const int tid = tid_, w = __builtin_amdgcn_readfirstlane(tid >> 6), lane = tid & 63, r = lane & 15, q = lane >> 4;
    const bool has_main = bid * 128 < XR, has_x = bid < B; const int r0 = bid * 128, x0 = XR + (has_x ? bid : 0) * 64 + LEAD;
    constexpr int WROW = 1040;
    LAS unsigned char* WHs = lds; LAS unsigned char* WLs = lds + 48 * WROW;
    LAS float* lg = (LAS float*)(lds + 2 * 48 * WROW);
    LAS int* lcnt = (LAS int*)(lds + TAB_OFF);
    LAS int* lbase = lcnt + 64;
    LAS int* rli = lbase + 64;
    LAS int* rpos = rli + 528;
    LAS float* rw = (LAS float*)(rpos + 528);
    LAS float* rrs = rw + 528;
    LAS float* rbias = rrs + 264;
    if (tid < 64) lcnt[tid] = 0;
    if (tid >= 64 && tid < 100) rbias[tid - 64] = tid < 68 ? p.br_g[l * 4 + (tid - 64)] : p.br_e[l * 32 + (tid - 68)];
    const bf16_t* WH = (const bf16_t*)(p.ws + WS_WRS) + (size_t)l * 48 * D; const bf16_t* WL = WH + (size_t)DEPTH * 48 * D;
    const bf16_t* ap = p.H() + (size_t)(has_main ? r0 + w * 16 + r : 0) * D + q * 8;
    const bf16_t* xp = p.H() + (size_t)(x0 + r) * D + w * 64 + q * 8;
    pg8::bf16x8 a[16], xa[2];
#pragma unroll
    for (int ks = 0; ks < 16; ++ks) a[ks] = *(const pg8::bf16x8*)(ap + ks * 32);
    if (has_x) {
#pragma unroll
        for (int ks = 0; ks < 2; ++ks) xa[ks] = *(const pg8::bf16x8*)(xp + ks * 32); }
    f32x4 acc[3], accx[3]; float ssq = 0.f, ssqx = 0.f;
#pragma unroll
    for (int tl = 0; tl < 3; ++tl) { acc[tl] = (f32x4){0.f, 0.f, 0.f, 0.f}; accx[tl] = (f32x4){0.f, 0.f, 0.f, 0.f}; }
#define ROUTE_SSQ(S, FR) do { const pg8::u32x4 w4 = __builtin_bit_cast(pg8::u32x4, FR); const float x0_ = pg8::bflo(w4.x), x1_ = pg8::bfhi(w4.x), x2_ = pg8::bflo(w4.y), x3_ = pg8::bfhi(w4.y), x4_ = pg8::bflo(w4.z), x5_ = pg8::bfhi(w4.z), x6_ = pg8::bflo(w4.w), x7_ = pg8::bfhi(w4.w); \
        S += (x0_ * x0_ + x1_ * x1_) + (x2_ * x2_ + x3_ * x3_) + (x4_ * x4_ + x5_ * x5_) + (x6_ * x6_ + x7_ * x7_); } while (0)
#define ROUTE_MMA(ACC, FR, WB, KOFS) do { _Pragma("unroll") for (int tl = 0; tl < 3; ++tl) { \
        ACC[tl] = __builtin_amdgcn_mfma_f32_16x16x32_bf16(FR, *(const LAS pg8::bf16x8*)((WB) + tl * 16 * WROW + (KOFS) * 2), ACC[tl], 0, 0, 0); \
        ACC[tl] = __builtin_amdgcn_mfma_f32_16x16x32_bf16(FR, *(const LAS pg8::bf16x8*)((WB) + 48 * WROW + tl * 16 * WROW + (KOFS) * 2), ACC[tl], 0, 0, 0); } } while (0)
    const LAS unsigned char* wb = WHs + r * WROW + q * 16; const LAS unsigned char* wbx = wb + w * 128;
#define ROUTE_STAGE(half) do { _Pragma("unroll") for (int j = 0; j < 12; ++j) { const int row = w * 12 + j; \
            const bf16_t* src_ = (row < 48 ? WH + (size_t)row * D : WL + (size_t)(row - 48) * D) + (half) * 512 + lane * 8; \
            __builtin_amdgcn_global_load_lds((const unsigned*)src_, (LAS unsigned*)(lds + row * WROW), 16, 0, 0); } \
        asm volatile("s_waitcnt vmcnt(0)" ::: "memory"); } while (0)
    __syncthreads();
    ROUTE_STAGE(0);
    __syncthreads();
    if (has_x) {
#pragma unroll
        for (int ks = 0; ks < 2; ++ks) { ROUTE_SSQ(ssqx, xa[ks]); ROUTE_MMA(accx, xa[ks], wbx, ks * 32); } }
#pragma unroll
    for (int ks = 0; ks < 16; ++ks) { ROUTE_SSQ(ssq, a[ks]); ROUTE_MMA(acc, a[ks], wb, ks * 32); a[ks] = *(const pg8::bf16x8*)(ap + 512 + ks * 32); }
    if (has_x) {
#pragma unroll
        for (int ks = 0; ks < 2; ++ks) xa[ks] = *(const pg8::bf16x8*)(xp + 512 + ks * 32); }
    __syncthreads();
    ROUTE_STAGE(1);
    __syncthreads();
    if (has_x) {
#pragma unroll
        for (int ks = 0; ks < 2; ++ks) { ROUTE_SSQ(ssqx, xa[ks]); ROUTE_MMA(accx, xa[ks], wbx, ks * 32); } }
#pragma unroll
    for (int ks = 0; ks < 16; ++ks) { ROUTE_SSQ(ssq, a[ks]); ROUTE_MMA(acc, a[ks], wb, ks * 32); }
#undef ROUTE_SSQ
#undef ROUTE_MMA
#undef ROUTE_STAGE
    auto route_row = [&](int i, const LAS float* x, float rtot) {
        const float rs = __builtin_amdgcn_rsqf(rtot * (1.f / D) + EPS); float gl[4];
#pragma unroll
        for (int j = 0; j < 4; ++j) gl[j] = x[j] * rs + rbias[j];
        int gsel = 0; float gm = gl[0];
#pragma unroll
        for (int j = 1; j < 4; ++j) if (gl[j] > gm) { gm = gl[j]; gsel = j; }
        float se = 0.f;
#pragma unroll
        for (int j = 0; j < 4; ++j) se += __expf(gl[j] - gm);
        const float psel = __builtin_amdgcn_rcpf(se);
        int i0 = 0, i1 = -1; float v0 = -INFINITY, v1 = -INFINITY;
        for (int j = 0; j < 8; ++j) { const float v = x[4 + gsel * 8 + j] * rs + rbias[4 + gsel * 8 + j];
            if (v > v0) { v1 = v0; i1 = i0; v0 = v; i0 = j; } else if (v > v1) { v1 = v; i1 = j; } }
        const float w0 = __builtin_amdgcn_rcpf(1.f + __expf(v1 - v0));
        const int li0 = gsel * 8 + i0, li1 = 32 + gsel * 8 + i1;
        rli[2 * i] = li0; rli[2 * i + 1] = li1; rw[2 * i] = w0 * psel; rw[2 * i + 1] = (1.f - w0) * psel; rrs[i] = rs;
        rpos[2 * i] = __hip_atomic_fetch_add(&lcnt[li0], 1, __ATOMIC_RELAXED, __HIP_MEMORY_SCOPE_WORKGROUP); rpos[2 * i + 1] = __hip_atomic_fetch_add(&lcnt[li1], 1, __ATOMIC_RELAXED, __HIP_MEMORY_SCOPE_WORKGROUP); };
    float rtx = 0.f, rtot = ssq; LAS float* xsum = (LAS float*)lds + 8 * 768 + 128; LAS float* lgw = lg + w * 16 * 48;
    if (has_main) {
#pragma unroll
        for (int tl = 0; tl < 3; ++tl)
#pragma unroll
            for (int j = 0; j < 4; ++j) lgw[(q * 4 + j) * 48 + tl * 16 + r] = acc[tl][j];
        rtot += __shfl_xor(rtot, 16); rtot += __shfl_xor(rtot, 32); }
    if (has_x) {
        LAS float* xpart = (LAS float*)lds; LAS float* xss = xpart + 8 * 768;
        __syncthreads();
#pragma unroll
        for (int tl = 0; tl < 3; ++tl)
#pragma unroll
            for (int j = 0; j < 4; ++j) xpart[w * 768 + (q * 4 + j) * 48 + tl * 16 + r] = accx[tl][j];
        float rt = ssqx; rt += __shfl_xor(rt, 16); rt += __shfl_xor(rt, 32); if (lane < 16) xss[w * 16 + lane] = rt;
        __syncthreads();
        if (w == 0) {
            for (int idx = lane; idx < 768; idx += 64) { float sacc = 0.f;
#pragma unroll
                for (int ww = 0; ww < 8; ++ww) sacc += xpart[ww * 768 + idx];
                xsum[idx] = sacc; }
#pragma unroll
            for (int ww = 0; ww < 8; ++ww) rtx += xss[ww * 16 + r]; } }
    if (has_main) {
        asm volatile("s_waitcnt lgkmcnt(0)" ::: "memory");
        const bool xl = has_x && w == 0 && q == 1;
        if (q == 0 || xl) route_row(xl ? 128 + r : w * 16 + r, xl ? xsum + r * 48 : lgw + r * 48, xl ? rtx : rtot);
        asm volatile("s_waitcnt lgkmcnt(0)" ::: "memory"); }
    __syncthreads();
    if (tid < 64) { const int n = lcnt[tid]; lbase[tid] = n ? (int)__hip_atomic_fetch_add(gcnt + tid * 16, (unsigned)n, __ATOMIC_RELAXED, __HIP_MEMORY_SCOPE_AGENT) : 0; }
    __syncthreads();
    int* ltok = (int*)(p.ws + WS_LTOK); float* lrs = (float*)(p.ws + WS_LRS); float* lw = (float*)(p.ws + WS_LW);
    const int nr = has_main ? (has_x ? 144 : 128) : 0;
    for (int i = tid; i < 2 * nr; i += NTHR) { const int li = rli[i], ii = i >> 1; const size_t idx = (size_t)li * CAPL + lbase[li] + rpos[i]; ltok[idx] = ii < 128 ? r0 + ii : x0 + (ii - 128); lrs[idx] = rrs[ii]; lw[idx] = rw[i]; }
    __syncthreads();
}

namespace mx {
#define LDS_BARRIER() do { asm volatile("s_waitcnt lgkmcnt(0)" ::: "memory"); __builtin_amdgcn_s_barrier(); asm volatile("" ::: "memory"); } while (0)
using pg8::bf16x8; using pg8::u32x4; using pg8::u32x2; using pg8::cvt_pk_bf16; using pg8::bflo; using pg8::bfhi;
__device__ __forceinline__ f32x4 mfma16(bf16x8 a, bf16x8 b, f32x4 c) { return __builtin_amdgcn_mfma_f32_16x16x32_bf16(a, b, c, 0, 0, 0); }
template <int CTRL> __device__ __forceinline__ float dpp_get(float v) { return __int_as_float(__builtin_amdgcn_update_dpp(__float_as_int(v), __float_as_int(v), CTRL, 0xf, 0xf, false)); }
__device__ __forceinline__ float wscan_add(float v, int lane) { float t; const int rl = lane & 15;
    t = dpp_get<0x111>(v); if (rl >= 1) v += t;
    t = dpp_get<0x112>(v); if (rl >= 2) v += t;
    t = dpp_get<0x114>(v); if (rl >= 4) v += t;
    t = dpp_get<0x118>(v); if (rl >= 8) v += t;
    t = dpp_get<0x142>(v); if ((lane & 31) >= 16) v += t;
    t = dpp_get<0x143>(v); if (lane >= 32) v += t;
    return v; }
__device__ __forceinline__ float wscan_max(float v, int lane) { float t; const int rl = lane & 15;
    t = dpp_get<0x111>(v); if (rl >= 1) v = fmaxf(v, t);
    t = dpp_get<0x112>(v); if (rl >= 2) v = fmaxf(v, t);
    t = dpp_get<0x114>(v); if (rl >= 4) v = fmaxf(v, t);
    t = dpp_get<0x118>(v); if (rl >= 8) v = fmaxf(v, t);
    t = dpp_get<0x142>(v); if ((lane & 31) >= 16) v = fmaxf(v, t);
    t = dpp_get<0x143>(v); if (lane >= 32) v = fmaxf(v, t);
    return v; }
__device__ __forceinline__ float wave_max(float v, int lane) { return __int_as_float(__builtin_amdgcn_readlane(__float_as_int(wscan_max(v, lane)), 63)); }
__device__ __forceinline__ void unpack8(const u32x4 a, float (&x)[8]) { x[0] = bflo(a.x); x[1] = bfhi(a.x); x[2] = bflo(a.y); x[3] = bfhi(a.y); x[4] = bflo(a.z); x[5] = bfhi(a.z); x[6] = bflo(a.w); x[7] = bfhi(a.w); }
__device__ __forceinline__ u32x4 pack8(const float (&x)[8]) { u32x4 w; w.x = cvt_pk_bf16(x[0], x[1]); w.y = cvt_pk_bf16(x[2], x[3]); w.z = cvt_pk_bf16(x[4], x[5]); w.w = cvt_pk_bf16(x[6], x[7]); return w; }
__device__ __forceinline__ bf16x8 ldfrag(const LAS unsigned char* p) { return *(const LAS bf16x8*)p; }
__device__ __forceinline__ float fexp(float x) { return __builtin_amdgcn_exp2f(x * 1.4426950408889634f); }
__device__ __forceinline__ float frcp(float x) { return __builtin_amdgcn_rcpf(x); }
__device__ __forceinline__ float fsigm(float x) { return frcp(1.f + fexp(-x)); }
__device__ __forceinline__ float fsilu(float x) { return x * fsigm(x); }
__device__ __forceinline__ float flogsig(float x) { return fminf(x, 0.f) - __builtin_amdgcn_logf(1.f + fexp(-fabsf(x))) * 0.6931471805599453f; }
__device__ __forceinline__ float frsq(float x) { return __builtin_amdgcn_rsqf(x); }
__device__ __forceinline__ float rawbf(float raw) { return __uint_as_float(__float_as_uint(raw) << 16); }
typedef short s16x4 __attribute__((ext_vector_type(4)));
__device__ __forceinline__ s16x4 tr_read(const LAS unsigned char* p) { return __builtin_amdgcn_ds_read_tr16_b64_v4i16((LAS s16x4*)p); }
__device__ __forceinline__ bf16x8 tr_frag(const LAS unsigned char* img, int stride, int krow0, int col0, int lane) {
    const int i16 = lane & 15, g = lane >> 4; const LAS unsigned char* a = img + (krow0 + 8 * g + (i16 >> 2)) * stride + (col0 + 4 * (i16 & 3)) * 2;
    const s16x4 lo = tr_read(a), hi = tr_read(a + 4 * stride); return __builtin_shufflevector(lo, hi, 0, 1, 2, 3, 4, 5, 6, 7); }
constexpr int SQ = 272, ST = 144;
__device__ __forceinline__ int tsw(int row, int s) { return row * ST + ((((s >> 3) ^ (row >> 3)) & 7) << 4) + ((s & 7) << 1); }
__device__ __forceinline__ int tfr(int row, int chunk) { return row * ST + (((chunk ^ (row >> 3)) & 7) << 4); }

struct UC { int c, hd, b, r0; };
__device__ __forceinline__ UC ucoord(int u) { UC k; k.c = u % NCH; k.hd = (u / NCH) & 3; k.b = u / (NCH * 4); k.r0 = chunk_row0(k.b, k.c); return k; }
template <int NS> struct PreM { u32x4 x[NS + 3]; u32x4 v[2]; f32x4 g; };
struct PreO { u32x4 qk[4]; u32x4 v[2]; f32x4 g; f32x4 gw; };
struct PreG { u32x4 v[2]; u32x4 q, k; u32x4 cd; };
template <int NS, int PARTS = 7> __device__ __forceinline__ void load_m(const P& p, int l, int u, PreM<NS>& R, int tid, int zvcol) {
    asm volatile("" : "+v"(tid));
    const UC k = ucoord(u); const bf16_t* z = p.Z(); const int lane = tid & 63, w = tid >> 6;
    if (PARTS & 1) { const size_t zr = (size_t)(k.r0 + lane) * ZP; f32x4 g = {0.f, 0.f, 0.f, 0.f}; int z0 = 0; asm volatile("" : "+v"(z0));
        if (w == 0) { g.x = __uint_as_float((unsigned)z[zr + ZO_FG + k.hd]); g.y = __uint_as_float((unsigned)z[zr + ZO_IG + k.hd]); g.z = p.gate_b[(l * 2 + 1) * 4 + k.hd + z0]; g.w = p.gate_b[(l * 2 + 0) * 4 + k.hd + z0]; } R.g = g; }
    if (PARTS & 2) {
    int zcol, s0;
    if (NS == 4) { const int which = tid >> 8; zcol = (which ? ZO_KM : ZO_QM) + k.hd * 128 + (tid & 15) * 8; s0 = ((tid >> 4) & 15) * 4; }
    else { zcol = ZO_KM + k.hd * 128 + (tid & 15) * 8; s0 = (tid >> 4) * 2; }
#pragma unroll
    for (int i = 0; i < NS + 3; ++i) { const int s = s0 - 3 + i, pp = k.c * 64 + s;
        const int row = (s < 0 && k.c == 1) ? XR + k.b * 64 + 64 + s : k.r0 + (pp >= 0 ? s : 0);
        R.x[i] = *(const u32x4*)(z + (size_t)row * ZP + zcol); } }
    if (PARTS & 4)
#pragma unroll
    for (int it = 0; it < 2; ++it) { const int s = 2 * (tid >> 4) + it, v8 = tid & 15; R.v[it] = *(const u32x4*)(z + (size_t)(k.r0 + s) * ZP + zvcol + k.hd * 128 + v8 * 8); }
}
template <int G> __device__ __forceinline__ void load_m_group(const P& p, int l, int u, PreM<4>& R, int tid) {
    const UC k = ucoord(u); const bf16_t* z = p.Z(); const int lane = tid & 63, w = tid >> 6;
    const int which = tid >> 8, zcol = (which ? ZO_KM : ZO_QM) + k.hd * 128 + (tid & 15) * 8, s0 = ((tid >> 4) & 15) * 4;
#pragma unroll
    for (int i = 2 * G; i < (G < 3 ? 2 * G + 2 : 7); ++i) { const int s = s0 - 3 + i, pp = k.c * 64 + s;
        const int row = (s < 0 && k.c == 1) ? XR + k.b * 64 + 64 + s : k.r0 + (pp >= 0 ? s : 0);
        R.x[i] = *(const u32x4*)(z + (size_t)row * ZP + zcol); }
    if (G == 0) { const size_t zr = (size_t)(k.r0 + lane) * ZP; f32x4 g = {0.f, 0.f, 0.f, 0.f}; int z0 = 0; asm volatile("" : "+v"(z0));
        if (w == 0) { g.x = __uint_as_float((unsigned)z[zr + ZO_FG + k.hd]); g.y = __uint_as_float((unsigned)z[zr + ZO_IG + k.hd]); g.z = p.gate_b[(l * 2 + 1) * 4 + k.hd + z0]; g.w = p.gate_b[(l * 2 + 0) * 4 + k.hd + z0]; } R.g = g; }
}
__device__ __forceinline__ void load_o(const P& p, int u, PreO& R, int tid) {
    asm volatile("" : "+v"(tid));
    const UC k = ucoord(u); const bf16_t* z = p.Z(); const bf16_t* qkc = (const bf16_t*)(p.ws + WS_QKC);
    { const float* ga = (const float*)((const unsigned char*)p.out + ST_GA) + (size_t)u * 192; f32x4 g = {0.f, 0.f, 0.f, 0.f}; if (tid < 64) { g.x = ga[tid]; g.y = ga[64 + tid]; g.z = ga[128 + tid]; } R.g = g;
      f32x4 gw; gw.x = ga[64 + (tid >> 4)]; gw.y = ga[64 + (tid >> 4) + 32]; gw.z = ga[63]; gw.w = ga[191]; R.gw = gw; }
#pragma unroll
    for (int it = 0; it < 4; ++it) { const int item = tid + it * NTHR, which = item >> 10, s = (item >> 4) & 63, ch8 = item & 15; R.qk[it] = *(const u32x4*)(qkc + (size_t)(k.r0 + s) * 1024 + which * 512 + k.hd * 128 + ch8 * 8); }
#pragma unroll
    for (int it = 0; it < 2; ++it) { const int s = 2 * (tid >> 4) + it, v8 = tid & 15; R.v[it] = *(const u32x4*)(z + (size_t)(k.r0 + s) * ZP + ZO_VM + k.hd * 128 + v8 * 8); }
}
__device__ __forceinline__ void load_g(const P& p, int l, int u, PreG& R, int tid, bool needq) {
    asm volatile("" : "+v"(tid));
    const UC k = ucoord(u); const bf16_t* z = p.Z();
    { u32x4 cd = {0u, 0u, 0u, 0u}; if (tid < 128) cd = *(const u32x4*)(z + (size_t)(k.r0 + (tid >> 1)) * ZP + ZO_CODE + (tid & 1) * 8); R.cd = cd; }
#pragma unroll
    for (int it = 0; it < 2; ++it) { const int s = 2 * (tid >> 4) + it, v8 = tid & 15; R.v[it] = *(const u32x4*)(z + (size_t)(k.r0 + s) * ZP + ZO_VG + k.hd * 128 + v8 * 8); }
    const size_t zr = (size_t)(k.r0 + (tid >> 3)) * ZP; R.k = *(const u32x4*)(z + zr + ZO_KG + k.hd * 64 + (tid & 7) * 8); R.q = R.k;
    if (needq) R.q = *(const u32x4*)(z + zr + ZO_QG + k.hd * 64 + (tid & 7) * 8);
}
template <int NS> __device__ __forceinline__ void conv8(const LAS float* cw, const u32x4 (&xr)[NS + 3], int c, int s0, int cch, float scale, float (&o)[NS][8]) {
    float x[NS + 3][8];
#pragma unroll
    for (int i = 0; i < NS + 3; ++i) unpack8(xr[i], x[i]);
    float bias[8];
    { const f32x4 b0 = *(const LAS f32x4*)(cw + 4096 + cch), b1 = *(const LAS f32x4*)(cw + 4096 + cch + 4); bias[0] = b0.x; bias[1] = b0.y; bias[2] = b0.z; bias[3] = b0.w; bias[4] = b1.x; bias[5] = b1.y; bias[6] = b1.z; bias[7] = b1.w; }
#pragma unroll
    for (int i = 0; i < NS; ++i)
#pragma unroll
        for (int q = 0; q < 8; ++q) o[i][q] = bias[q];
#pragma unroll
    for (int j = 0; j < 4; ++j) { float w[8];
        { const f32x4 w0 = *(const LAS f32x4*)(cw + j * 1024 + cch), w1 = *(const LAS f32x4*)(cw + j * 1024 + cch + 4); w[0] = w0.x; w[1] = w0.y; w[2] = w0.z; w[3] = w0.w; w[4] = w1.x; w[5] = w1.y; w[6] = w1.z; w[7] = w1.w; }
#pragma unroll
        for (int i = 0; i < NS; ++i)
#pragma unroll
            for (int q = 0; q < 8; ++q) o[i][q] += w[q] * x[i + j][q]; }
#pragma unroll
    for (int i = 0; i < NS; ++i) { const bool valid = (c > 0) || (s0 + i >= LEAD);
#pragma unroll
        for (int q = 0; q < 8; ++q) o[i][q] = valid ? fsilu(o[i][q]) * scale : 0.f; }
}

__device__ __forceinline__ void gla_cumdecay(const PreG& R, int c, int hd, LAS float* LA, LAS float* T0, LAS unsigned char* cod16, const LAS float* awT, const LAS float* abT, int tid) {
    if (tid < 128) *(LAS u32x4*)(cod16 + tid * 16) = R.cd;
    LDS_BARRIER();
    const int lane = tid & 63, w = __builtin_amdgcn_readfirstlane(tid >> 6), r = lane & 15, q = lane >> 4;
    { const int j = (w & 3) * 16 + r, sh = w >> 2; float wv[8];
#pragma unroll
        for (int kk = 0; kk < 8; ++kk) wv[kk] = (q < 2) ? awT[(8 * (q & 1) + kk) * 256 + hd * 64 + j] : 0.f;
        const u32x4 bh = pack8(wv); float hi[8]; unpack8(bh, hi);
#pragma unroll
        for (int kk = 0; kk < 8; ++kk) wv[kk] -= hi[kk];
        const u32x4 bl = pack8(wv); const float abj = abT[hd * 64 + j]; float run = 0.f;
#pragma unroll
        for (int t2 = 0; t2 < 2; ++t2) { const int st = 2 * sh + t2; u32x4 a = {0u, 0u, 0u, 0u}; if (q < 2) a = *(const LAS u32x4*)(cod16 + (16 * st + r) * 32 + q * 16);
            f32x4 acc = {0.f, 0.f, 0.f, 0.f};
            acc = mfma16(__builtin_bit_cast(bf16x8, a), __builtin_bit_cast(bf16x8, bh), acc); acc = mfma16(__builtin_bit_cast(bf16x8, a), __builtin_bit_cast(bf16x8, bl), acc);
            float la[4];
#pragma unroll
            for (int jj = 0; jj < 4; ++jj) { const int s = 16 * st + 4 * q + jj; const bool valid = (c > 0) || (s >= LEAD); la[jj] = valid ? flogsig(acc[jj] + abj) * (1.f / 16.f) : 0.f; }
            la[1] += la[0]; la[2] += la[1]; la[3] += la[2];
            float x = la[3], y = __shfl_up(x, 16); if (q >= 1) x += y;
            y = __shfl_up(x, 32); if (q >= 2) x += y;
            const float excl = run + (x - la[3]), tot = __shfl(x, 48 + r);
#pragma unroll
            for (int jj = 0; jj < 4; ++jj) LA[(16 * st + 4 * q + jj) * 65 + j] = excl + la[jj];
            run += tot; }
        if (sh == 0 && q == 0) T0[j] = run; }
    LDS_BARRIER();
}
__device__ __forceinline__ void mlstm_local(const P& p, int l, int u, LAS unsigned char* lds, int tid, PreM<4>& R, int unext, f32x4 (&Dm)[9], float& mD, float& BE, int endslot, int pbuf) {
    asm volatile("" : "+v"(tid));
    const int lane = tid & 63, w = __builtin_amdgcn_readfirstlane(tid >> 6), c = u % NCH, hd = (u / NCH) & 3, b = u / (NCH * 4), r0 = chunk_row0(b, c);
    LAS unsigned char* KT = lds + pbuf; LAS unsigned char* VT = lds + pbuf + 18432; LAS float* wS = (LAS float*)(lds + pbuf + 39168);
    if (w == 0) { const int s = lane; const bool valid = (c > 0) || (s >= LEAD);
        const float lf = valid ? flogsig(rawbf(R.g.x) + R.g.z) : 0.f;
        const float ig = valid ? rawbf(R.g.y) + R.g.w : -INFINITY;
        const float bb = wscan_add(lf, lane), be = __int_as_float(__builtin_amdgcn_readlane(__float_as_int(bb), 63)), g = be - bb + ig, mg = wave_max(g, lane), a = ig - bb, pm = wscan_max(a, lane);
        wS[s] = fexp(g - mg);
        float* ga = (float*)((unsigned char*)p.out + ST_GA) + (size_t)u * 192; ga[s] = bb; ga[64 + s] = a; ga[128 + s] = pm;
        if (lane == 0) { wS[64] = mg; wS[65] = be; } }
    { const int which = tid >> 8, ch8 = tid & 15, s0 = ((tid >> 4) & 15) * 4, cch = which * 512 + hd * 128 + ch8 * 8; float o[4][8];
        const float scale = which ? 0.08838834764831845f : 1.f; const LAS float* cw = (const LAS float*)(lds + 65536);
        float x[7][8];
#pragma unroll
        for (int i = 0; i < 7; ++i) unpack8(R.x[i], x[i]);
        bf16_t* qkc = (bf16_t*)(p.ws + WS_QKC) + (size_t)(r0 + s0) * 1024 + cch;
        float wt[4][8], bs[8];
        { const f32x4 b0_ = *(const LAS f32x4*)(cw + 4096 + cch), b1_ = *(const LAS f32x4*)(cw + 4096 + cch + 4); bs[0] = b0_.x; bs[1] = b0_.y; bs[2] = b0_.z; bs[3] = b0_.w; bs[4] = b1_.x; bs[5] = b1_.y; bs[6] = b1_.z; bs[7] = b1_.w; }
#pragma unroll
        for (int j = 0; j < 4; ++j) { const f32x4 w0_ = *(const LAS f32x4*)(cw + j * 1024 + cch), w1_ = *(const LAS f32x4*)(cw + j * 1024 + cch + 4); wt[j][0] = w0_.x; wt[j][1] = w0_.y; wt[j][2] = w0_.z; wt[j][3] = w0_.w; wt[j][4] = w1_.x; wt[j][5] = w1_.y; wt[j][6] = w1_.z; wt[j][7] = w1_.w; }
#define MLOCAL_POS(I) do { if (unext >= 0) load_m_group<I>(p, l, unext, R, tid); \
            __builtin_amdgcn_sched_barrier(0); \
            { float a_[8]; \
              _Pragma("unroll") for (int q = 0; q < 8; ++q) a_[q] = bs[q]; \
              _Pragma("unroll") for (int j = 0; j < 4; ++j) { _Pragma("unroll") for (int q = 0; q < 8; ++q) a_[q] += wt[j][q] * x[I + j][q]; } \
              const bool valid_ = (c > 0) || (s0 + I >= LEAD); \
              _Pragma("unroll") for (int q = 0; q < 8; ++q) o[I][q] = valid_ ? fsilu(a_[q]) * scale : 0.f; \
              *(u32x4*)(qkc + (size_t)I * 1024) = pack8(o[I]); } \
            __builtin_amdgcn_sched_barrier(0); } while (0)
        MLOCAL_POS(0); MLOCAL_POS(1); MLOCAL_POS(2); MLOCAL_POS(3);
#undef MLOCAL_POS
        if (which) {
#pragma unroll
            for (int q = 0; q < 8; ++q) { *(LAS unsigned*)(KT + tsw(ch8 * 8 + q, s0)) = cvt_pk_bf16(o[0][q], o[1][q]); *(LAS unsigned*)(KT + tsw(ch8 * 8 + q, s0 + 2)) = cvt_pk_bf16(o[2][q], o[3][q]); } } }
    LDS_BARRIER();
    { const int s0 = 2 * (tid >> 4), v8 = tid & 15; float x0[8], x1[8]; unpack8(R.v[0], x0); unpack8(R.v[1], x1);
        const float w0 = ((c > 0) || (s0 >= LEAD)) ? wS[s0] : 0.f, w1 = ((c > 0) || (s0 + 1 >= LEAD)) ? wS[s0 + 1] : 0.f;
#pragma unroll
        for (int q = 0; q < 8; ++q) *(LAS unsigned*)(VT + tsw(v8 * 8 + q, s0)) = cvt_pk_bf16(x0[q] * w0, x1[q] * w1); }
    for (int i = tid; i < 16 * 64; i += NTHR) { const int row = 128 + (i >> 6), s = i & 63; *(LAS bf16_t*)(VT + tsw(row, s)) = (row == 128) ? (bf16_t)(cvt_pk_bf16(wS[s], 0.f) & 0xffffu) : (bf16_t)0; }
    if (unext >= 0) load_m<4, 4>(p, l, unext, R, tid, ZO_VM);
    LDS_BARRIER();
    { const int r = lane & 15, q = lane >> 4; bf16x8 afr[2];
#pragma unroll
        for (int ks = 0; ks < 2; ++ks) afr[ks] = ldfrag(KT + tfr(w * 16 + r, ks * 4 + q));
        const float mg = wS[64], be = wS[65], mn = fmaxf(be + mD, mg), dec = fexp(be + mD - mn), wg = fexp(mg - mn);
#pragma unroll
        for (int vt = 0; vt < 9; ++vt) { f32x4 acc = {0.f, 0.f, 0.f, 0.f};
#pragma unroll
            for (int ks = 0; ks < 2; ++ks) acc = mfma16(afr[ks], ldfrag(VT + tfr(vt * 16 + r, ks * 4 + q)), acc);
            Dm[vt] = Dm[vt] * dec + acc * wg; }
        mD = mn; BE += be;
        if (endslot >= 0) { float* ra = p.RA(endslot);
#pragma unroll
            for (int vt = 0; vt < 8; ++vt) *(f32x4*)(ra + (vt * 16 + r) * 128 + w * 16 + q * 4) = Dm[vt];
            if (r == 0) *(f32x4*)(ra + 16384 + w * 16 + q * 4) = Dm[8];
            if (tid == 0) { float* rq = p.RQ(endslot); rq[0] = mD; rq[1] = BE; }
#pragma unroll
            for (int vt = 0; vt < 9; ++vt) Dm[vt] = (f32x4){0.f, 0.f, 0.f, 0.f};
            mD = -INFINITY; BE = 0.f; } }
    if (unext < 0) LDS_BARRIER();
}

__device__ __forceinline__ void gla_local(const P& p, int l, int u, LAS unsigned char* lds, int tid, PreG& R, int unext, f32x4 (&Dg)[4], float& bej, int endslot) {
    asm volatile("" : "+v"(tid));
    const int lane = tid & 63, w = __builtin_amdgcn_readfirstlane(tid >> 6), c = u % NCH, hd = (u / NCH) & 3, b = u / (NCH * 4), r0 = chunk_row0(b, c);
    const bf16_t* z = p.Z();
    LAS float* LA = (LAS float*)lds; LAS float* segtot = (LAS float*)(lds + 16640); LAS unsigned char* KHT = lds + 18688; LAS unsigned char* VT = lds + 27904;
    LAS float* cod = (LAS float*)(lds + 46336); LAS float* aw = (LAS float*)(lds + 50432); LAS float* ab = (LAS float*)(lds + 54528);
    gla_cumdecay(R, c, hd, LA, segtot, (LAS unsigned char*)cod, (const LAS float*)(lds + GLA_TAB), (const LAS float*)(lds + GLA_TAB) + 4096, tid);
    if (tid < 64) bej += LA[63 * 65 + tid] + segtot[tid];
    { const int s = tid >> 3, j8 = tid & 7; const bool valid = (c > 0) || (s >= LEAD); float x[8];
        unpack8(R.k, x);
#pragma unroll
        for (int q = 0; q < 8; ++q) { const int j = j8 * 8 + q; *(LAS bf16_t*)(KHT + tsw(j, s)) = (bf16_t)(cvt_pk_bf16(valid ? x[q] * fexp(LA[63 * 65 + j] - LA[s * 65 + j] + (s < 32 ? segtot[j] : 0.f)) : 0.f, 0.f) & 0xffffu); } }
    { const int s0 = 2 * (tid >> 4), v8 = tid & 15; float x0[8], x1[8]; unpack8(R.v[0], x0); unpack8(R.v[1], x1);
        const float w0 = ((c > 0) || (s0 >= LEAD)) ? 1.f : 0.f, w1 = ((c > 0) || (s0 + 1 >= LEAD)) ? 1.f : 0.f;
#pragma unroll
        for (int q = 0; q < 8; ++q) *(LAS unsigned*)(VT + tsw(v8 * 8 + q, s0)) = cvt_pk_bf16(x0[q] * w0, x1[q] * w1); }
    if (unext >= 0) load_g(p, l, unext, R, tid, false);
    LDS_BARRIER();
    { const int r = lane & 15, q = lane >> 4; bf16x8 bfr[2];
#pragma unroll
        for (int ks = 0; ks < 2; ++ks) bfr[ks] = ldfrag(VT + tfr(w * 16 + r, ks * 4 + q));
#pragma unroll
        for (int jt = 0; jt < 4; ++jt) { f32x4 acc = {0.f, 0.f, 0.f, 0.f};
#pragma unroll
            for (int ks = 0; ks < 2; ++ks) acc = mfma16(ldfrag(KHT + tfr(jt * 16 + r, ks * 4 + q)), bfr[ks], acc);
            float bend[4];
#pragma unroll
            for (int i = 0; i < 4; ++i) bend[i] = LA[63 * 65 + jt * 16 + q * 4 + i] + segtot[jt * 16 + q * 4 + i];
            Dg[jt] = (f32x4){Dg[jt][0] * fexp(bend[0]) + acc[0], Dg[jt][1] * fexp(bend[1]) + acc[1], Dg[jt][2] * fexp(bend[2]) + acc[2], Dg[jt][3] * fexp(bend[3]) + acc[3]}; }
        if (endslot >= 0) { float* ra = p.RAg(endslot);
#pragma unroll
            for (int jt = 0; jt < 4; ++jt) { *(f32x4*)(ra + (w * 16 + r) * 64 + jt * 16 + q * 4) = Dg[jt]; Dg[jt] = (f32x4){0.f, 0.f, 0.f, 0.f}; }
            if (tid < 64) { p.RBg(endslot)[tid] = bej; bej = 0.f; } } }
}

template <class LD, class FOLD> __device__ __forceinline__ void scan_stream(LD ld, FOLD fold) {
    u32x2 cur[16], nxt[16];
#pragma unroll
    for (int i = 0; i < 16; ++i) cur[i] = ld(i);
#pragma unroll 1
    for (int c0 = 0; c0 < 128; c0 += 16) {
#pragma unroll
        for (int i = 0; i < 16; ++i) nxt[i] = ld(c0 + 16 + i < NCH ? c0 + 16 + i : NCH - 1);
#pragma unroll
        for (int i = 0; i < 16; ++i) fold(c0 + i, cur[i]);
#pragma unroll
        for (int i = 0; i < 16; ++i) cur[i] = nxt[i];
    }
    fold(128, cur[0]);
}
__device__ __forceinline__ int unit_lo(int b, int G) { return (int)((long)b * NU / G); }
__device__ __forceinline__ void scan_phase(const P& p, LAS unsigned char* lds, int G, int bid, int tid) {
    asm volatile("" : "+v"(tid));
    for (int item = bid; item < 16 * 13; item += G) { const int bh = item / 13, sl = item % 13;
        if (sl < 9) { const int e = sl * 2048 + tid * 4; if (e < 16512) { const int U0 = bh * NCH, U1 = U0 + NCH;
            int b0 = (int)((long)U0 * G / NU); while (unit_lo(b0 + 1, G) <= U0) ++b0; while (unit_lo(b0, G) > U0) --b0;
            f32x4 C = {0.f, 0.f, 0.f, 0.f}; float m = 0.f;
            for (int bb = b0; bb < G && unit_lo(bb, G) < U1; ++bb) { const int slot = 2 * bb + (unit_lo(bb, G) < U0 ? 1 : 0);
                *(f32x4*)(p.RS(slot) + e) = C; if (e == 0) p.RQ(slot)[2] = m;
                const f32x4 dl = *(const f32x4*)(p.RA(slot) + e); const float mD = p.RQ(slot)[0], be = p.RQ(slot)[1], mn = fmaxf(be + m, mD), dec = fexp(be + m - mn), wg = fexp(mD - mn);
                C = C * dec + dl * wg; m = mn; } } }
        else { const int e = (sl - 9) * 2048 + tid * 4, j = e & 63; const int U0 = bh * NCH, U1 = U0 + NCH;
            int b0 = (int)((long)U0 * G / NU); while (unit_lo(b0 + 1, G) <= U0) ++b0; while (unit_lo(b0, G) > U0) --b0;
            f32x4 S = {0.f, 0.f, 0.f, 0.f};
            for (int wb = b0; wb < G && unit_lo(wb, G) < U1; ++wb) { const int slot = 2 * (G - 1 - wb) + (unit_lo(wb, G) < U0 ? 1 : 0);
                *(f32x4*)(p.RSg(slot) + e) = S;
                const f32x4 dl = *(const f32x4*)(p.RAg(slot) + e), bv = *(const f32x4*)(p.RBg(slot) + j);
                S = (f32x4){S[0] * fexp(bv[0]) + dl[0], S[1] * fexp(bv[1]) + dl[1], S[2] * fexp(bv[2]) + dl[2], S[3] * fexp(bv[3]) + dl[3]}; } }
    }
    __syncthreads();
}

__device__ __forceinline__ void mlstm_out(const P& p, int l, int u, LAS unsigned char* lds, int tid, PreO& R, int unext, f32x4 (&Cm)[9], float& mcur, int startslot) {
    asm volatile("" : "+v"(tid));
    const int lane = tid & 63, w = __builtin_amdgcn_readfirstlane(tid >> 6), c = u % NCH, hd = (u / NCH) & 3, b = u / (NCH * 4), r0 = chunk_row0(b, c);
    const bf16_t* z = p.Z();
    LAS unsigned char* QS = lds; LAS unsigned char* KS = lds + 17408; LAS unsigned char* VT = lds + 34816; LAS unsigned char* SS = lds + 55552;
    LAS float* aS = (LAS float*)(lds + 64768); LAS float* MS = aS + 64; LAS float* wiS = MS + 64; LAS float* emtS = wiS + 64; LAS float* denS = emtS + 64; LAS float* part = denS + 64; LAS float* nS = part + 128;
    const int r = lane & 15, q = lane >> 4, tt = w & 3, vh = w >> 2, t = tt * 16 + r;
    const int nvt = vh ? 4 : 5;
    LAS unsigned char* CS = lds + 69632;
    LAS unsigned char* KW = lds + 108544;
    if (startslot >= 0) { const float* rs = p.RS(startslot);
#pragma unroll
        for (int vt = 0; vt < 8; ++vt) Cm[vt] = *(const f32x4*)(rs + (vt * 16 + r) * 128 + w * 16 + q * 4);
        Cm[8] = (r == 0) ? *(const f32x4*)(rs + 16384 + w * 16 + q * 4) : (f32x4){0.f, 0.f, 0.f, 0.f};
        mcur = p.RQ(startslot)[2]; }
    if (w == 0) { const int s = lane; const float bb = R.g.x, aa = R.g.y, pm = R.g.z, m0 = mcur, M = fmaxf(m0, pm);
        aS[s] = aa; MS[s] = M; wiS[s] = fexp(m0 - M); emtS[s] = fexp(-(bb + M)); }
#pragma unroll
    for (int it = 0; it < 4; ++it) { const int item = tid + it * NTHR, which = item >> 10, s = (item >> 4) & 63, ch8 = item & 15; *(LAS u32x4*)((which ? KS : QS) + s * SQ + ch8 * 16) = R.qk[it]; }
    const float be = R.gw.z, mg = be + R.gw.w;
#pragma unroll
    for (int it = 0; it < 2; ++it) { const int s = (tid >> 4) + 32 * it, ch8 = tid & 15; float x[8]; unpack8(R.qk[2 + it], x); const float ws = fexp((it ? R.gw.y : R.gw.x) - R.gw.w);
#pragma unroll
        for (int e = 0; e < 8; ++e) x[e] *= ws;
        *(LAS u32x4*)(KW + s * SQ + ch8 * 16) = pack8(x); }
    { const int s0 = 2 * (tid >> 4), v8 = tid & 15; float x0[8], x1[8]; unpack8(R.v[0], x0); unpack8(R.v[1], x1);
        const float w0 = ((c > 0) || (s0 >= LEAD)) ? 1.f : 0.f, w1 = ((c > 0) || (s0 + 1 >= LEAD)) ? 1.f : 0.f;
#pragma unroll
        for (int q = 0; q < 8; ++q) *(LAS unsigned*)(VT + tsw(v8 * 8 + q, s0)) = cvt_pk_bf16(x0[q] * w0, x1[q] * w1); }
    if (unext >= 0) load_o(p, unext, R, tid);
#pragma unroll
    for (int vt = 0; vt < 8; ++vt) { u32x2 o; o.x = cvt_pk_bf16(Cm[vt][0], Cm[vt][1]); o.y = cvt_pk_bf16(Cm[vt][2], Cm[vt][3]); *(LAS u32x2*)(CS + (vt * 16 + r) * SQ + (w * 16 + q * 4) * 2) = o; }
    if (r == 0) *(LAS f32x4*)(nS + w * 16 + q * 4) = Cm[8];
    for (int i = tid; i < 16 * 64; i += NTHR) { const int row = 128 + (i >> 6), s = i & 63; *(LAS bf16_t*)(VT + tsw(row, s)) = (row == 128) ? (bf16_t)0x3f80 : (bf16_t)0; }
    LDS_BARRIER();
    u32x2 og[4]; f32x4 gn[4];
#pragma unroll
    for (int i = 0; i < 4; ++i) { const int v0 = (vh * 4 + i) * 16 + q * 4; og[i] = *(const u32x2*)(z + (size_t)(r0 + t) * ZP + ZO_OM + hd * 128 + v0); gn[i] = *(const LAS f32x4*)((const LAS float*)(lds + 104448) + hd * 128 + v0); }
    f32x4 acc2[5];
    { bf16x8 qb[4];
#pragma unroll
        for (int ks = 0; ks < 4; ++ks) qb[ks] = ldfrag(QS + (tt * 16 + r) * SQ + (ks * 32 + q * 8) * 2);
#pragma unroll
        for (int i = 0; i < 5; ++i) { acc2[i] = (f32x4){0.f, 0.f, 0.f, 0.f}; if (i < nvt) {
#pragma unroll
            for (int ks = 0; ks < 4; ++ks) { bf16x8 afr;
                if (i < 4) afr = ldfrag(CS + ((vh * 4 + i) * 16 + r) * SQ + (ks * 32 + q * 8) * 2);
                else { const f32x4 n0 = *(const LAS f32x4*)(nS + ks * 32 + q * 8), n1 = *(const LAS f32x4*)(nS + ks * 32 + q * 8 + 4); const float mk = (r == 0) ? 1.f : 0.f;
                    const float nn[8] = {n0.x * mk, n0.y * mk, n0.z * mk, n0.w * mk, n1.x * mk, n1.y * mk, n1.z * mk, n1.w * mk};
                    afr = __builtin_bit_cast(bf16x8, pack8(nn)); }
                acc2[i] = mfma16(afr, qb[ks], acc2[i]); } } }
        const float Mt = MS[t];
#pragma unroll
        for (int cc = 0; cc < 2; ++cc) { const int st = vh * 2 + cc; f32x4 acc = {0.f, 0.f, 0.f, 0.f};
            if (st <= tt) {
#pragma unroll
                for (int ks = 0; ks < 4; ++ks) acc = mfma16(ldfrag(KS + (st * 16 + r) * SQ + (ks * 32 + q * 8) * 2), qb[ks], acc); }
            float sv[4];
#pragma unroll
            for (int j = 0; j < 4; ++j) { const int s = st * 16 + q * 4 + j; sv[j] = (s <= t) ? acc[j] * fexp(aS[s] - Mt) : 0.f; }
            u32x2 o; o.x = cvt_pk_bf16(sv[0], sv[1]); o.y = cvt_pk_bf16(sv[2], sv[3]); *(LAS u32x2*)(SS + t * ST + (st * 16 + q * 4) * 2) = o; } }
    LDS_BARRIER();
    {
        const float mn = fmaxf(be + mcur, mg), dec = fexp(be + mcur - mn), wg = fexp(mg - mn); bf16x8 ka[2];
#pragma unroll
        for (int ks = 0; ks < 2; ++ks) ka[ks] = tr_frag(KW, SQ, ks * 32, w * 16, lane);
#pragma unroll
        for (int vt = 0; vt < 9; ++vt) { f32x4 dl = {0.f, 0.f, 0.f, 0.f};
#pragma unroll
            for (int ks = 0; ks < 2; ++ks) dl = mfma16(ka[ks], ldfrag(VT + tfr(vt * 16 + r, ks * 4 + q)), dl);
            Cm[vt] = Cm[vt] * dec + dl * wg; }
        mcur = mn; }
    f32x4 hv[5]; float emt;
    { bf16x8 sb[2];
#pragma unroll
        for (int ks = 0; ks < 2; ++ks) sb[ks] = ldfrag(SS + (tt * 16 + r) * ST + (ks * 32 + q * 8) * 2);
        const float wi = wiS[t]; emt = emtS[t];
#pragma unroll
        for (int i = 0; i < 5; ++i) { if (i < nvt) { const int vt = (i < 4) ? vh * 4 + i : 8; f32x4 a1 = {0.f, 0.f, 0.f, 0.f};
#pragma unroll
            for (int ks = 0; ks < 2; ++ks) a1 = mfma16(ldfrag(VT + tfr(vt * 16 + r, ks * 4 + q)), sb[ks], a1);
            hv[i] = a1 + acc2[i] * wi; } }
        if (vh == 0 && q == 0) denS[t] = hv[4][0];
        { float ssq = 0.f;
#pragma unroll
            for (int i = 0; i < 4; ++i) ssq += hv[i][0] * hv[i][0] + hv[i][1] * hv[i][1] + hv[i][2] * hv[i][2] + hv[i][3] * hv[i][3];
            ssq += __shfl_xor(ssq, 16); ssq += __shfl_xor(ssq, 32); if (q == 0) part[t * 2 + vh] = ssq; } }
    LDS_BARRIER();
    { const bool valid = (c > 0) || (t >= LEAD); const float dn = frcp(fmaxf(fabsf(denS[t]), emt)), sc = dn * frsq((part[t * 2] + part[t * 2 + 1]) * (dn * dn) * (1.f / 128.f) + EPS); bf16_t* yp = p.Z() + (size_t)(r0 + t) * ZP + ZO_OM + hd * 128;
#pragma unroll
        for (int i = 0; i < 4; ++i) { const int v0 = (vh * 4 + i) * 16 + q * 4; float y[4];
            y[0] = hv[i][0] * sc * gn[i][0] * fsigm(bflo(og[i].x)); y[1] = hv[i][1] * sc * gn[i][1] * fsigm(bfhi(og[i].x)); y[2] = hv[i][2] * sc * gn[i][2] * fsigm(bflo(og[i].y)); y[3] = hv[i][3] * sc * gn[i][3] * fsigm(bfhi(og[i].y));
            u32x2 o; o.x = valid ? cvt_pk_bf16(y[0], y[1]) : 0u; o.y = valid ? cvt_pk_bf16(y[2], y[3]) : 0u; *(u32x2*)(yp + v0) = o; } }
    if (unext < 0) LDS_BARRIER();
}

__device__ __forceinline__ void gla_out(const P& p, int l, int u, LAS unsigned char* lds, int tid, PreG& R, int unext, f32x4 (&Sm)[4], int startslot) {
    asm volatile("" : "+v"(tid));
    const int lane = tid & 63, w = __builtin_amdgcn_readfirstlane(tid >> 6), c = u % NCH, hd = (u / NCH) & 3, b = u / (NCH * 4), r0 = chunk_row0(b, c);
    const bf16_t* z = p.Z();
    LAS float* LA = (LAS float*)lds; LAS float* segtot = (LAS float*)(lds + 16640); LAS unsigned char* QT = lds + 18688; LAS unsigned char* KT2 = lds + 27904; LAS unsigned char* VT = lds + 37120; LAS unsigned char* AS = lds + 55552;
    LAS float* cod = (LAS float*)(lds + 64768); LAS float* aw = (LAS float*)(lds + 68864); LAS float* ab = (LAS float*)(lds + 72960); LAS float* part = (LAS float*)(lds + 73216);
    const int r = lane & 15, q = lane >> 4, tt = w & 3, dh = w >> 2, t = tt * 16 + r;
    LAS unsigned char* STs = lds + 73728;
    if (startslot >= 0) { const float* rs = p.RSg(startslot);
#pragma unroll
        for (int jt = 0; jt < 4; ++jt) Sm[jt] = *(const f32x4*)(rs + (w * 16 + r) * 64 + jt * 16 + q * 4); }
    gla_cumdecay(R, c, hd, LA, segtot, (LAS unsigned char*)cod, (const LAS float*)(lds + GLA_TAB), (const LAS float*)(lds + GLA_TAB) + 4096, tid);
    { const int s = tid >> 3, j8 = tid & 7; const bool valid = (c > 0) || (s >= LEAD); float xq[8], xk[8];
        unpack8(R.q, xq); unpack8(R.k, xk);
#pragma unroll
        for (int q = 0; q < 8; ++q) { const float bb = LA[s * 65 + j8 * 8 + q] + (s >= 32 ? segtot[j8 * 8 + q] : 0.f); xq[q] = valid ? xq[q] * 0.125f * fexp(bb) : 0.f; xk[q] = valid ? xk[q] * fexp(-bb) : 0.f; }
        *(LAS u32x4*)(QT + s * ST + j8 * 16) = pack8(xq); *(LAS u32x4*)(KT2 + s * ST + j8 * 16) = pack8(xk); }
    { const int s0 = 2 * (tid >> 4), v8 = tid & 15; float x0[8], x1[8]; unpack8(R.v[0], x0); unpack8(R.v[1], x1);
        const float w0 = ((c > 0) || (s0 >= LEAD)) ? 1.f : 0.f, w1 = ((c > 0) || (s0 + 1 >= LEAD)) ? 1.f : 0.f;
#pragma unroll
        for (int q = 0; q < 8; ++q) *(LAS unsigned*)(VT + tsw(v8 * 8 + q, s0)) = cvt_pk_bf16(x0[q] * w0, x1[q] * w1); }
    if (unext >= 0) load_g(p, l, unext, R, tid, true);
#pragma unroll
    for (int jt = 0; jt < 4; ++jt) { u32x2 o; o.x = cvt_pk_bf16(Sm[jt][0], Sm[jt][1]); o.y = cvt_pk_bf16(Sm[jt][2], Sm[jt][3]); *(LAS u32x2*)(STs + (w * 16 + r) * ST + (jt * 16 + q * 4) * 2) = o; }
    LDS_BARRIER();
    f32x4 hv[4];
    { bf16x8 qb[2];
#pragma unroll
        for (int ks = 0; ks < 2; ++ks) qb[ks] = ldfrag(QT + (tt * 16 + r) * ST + (ks * 32 + q * 8) * 2);
#pragma unroll
        for (int i = 0; i < 4; ++i) { hv[i] = (f32x4){0.f, 0.f, 0.f, 0.f};
#pragma unroll
            for (int ks = 0; ks < 2; ++ks) hv[i] = mfma16(ldfrag(STs + ((dh * 4 + i) * 16 + r) * ST + (ks * 32 + q * 8) * 2), qb[ks], hv[i]); }
#pragma unroll
        for (int cc = 0; cc < 2; ++cc) { const int st = dh * 2 + cc; f32x4 acc = {0.f, 0.f, 0.f, 0.f};
            if (st <= tt) {
#pragma unroll
                for (int ks = 0; ks < 2; ++ks) acc = mfma16(ldfrag(KT2 + (st * 16 + r) * ST + (ks * 32 + q * 8) * 2), qb[ks], acc); }
            float sv[4];
#pragma unroll
            for (int j = 0; j < 4; ++j) { const int s = st * 16 + q * 4 + j; sv[j] = (s <= t) ? acc[j] : 0.f; }
            u32x2 o; o.x = cvt_pk_bf16(sv[0], sv[1]); o.y = cvt_pk_bf16(sv[2], sv[3]); *(LAS u32x2*)(AS + t * ST + (st * 16 + q * 4) * 2) = o; } }
    u32x2 og[4]; f32x4 gn[4];
#pragma unroll
    for (int i = 0; i < 4; ++i) { const int d0 = (dh * 4 + i) * 16 + q * 4; og[i] = *(const u32x2*)(z + (size_t)(r0 + t) * ZP + ZO_GG + hd * 128 + d0); gn[i] = *(const LAS f32x4*)((const LAS float*)(lds + 104448) + 512 + hd * 128 + d0); }
    LDS_BARRIER();
    {
        bf16x8 vb[2];
#pragma unroll
        for (int ks = 0; ks < 2; ++ks) vb[ks] = ldfrag(VT + tfr(w * 16 + r, ks * 4 + q));
#pragma unroll
        for (int jt = 0; jt < 4; ++jt) { f32x4 dl = {0.f, 0.f, 0.f, 0.f};
#pragma unroll
            for (int ks = 0; ks < 2; ++ks) dl = mfma16(tr_frag(KT2, ST, ks * 32, jt * 16, lane), vb[ks], dl);
            float bend[4];
#pragma unroll
            for (int i = 0; i < 4; ++i) bend[i] = LA[63 * 65 + jt * 16 + q * 4 + i] + segtot[jt * 16 + q * 4 + i];
            Sm[jt] = (f32x4){(Sm[jt][0] + dl[0]) * fexp(bend[0]), (Sm[jt][1] + dl[1]) * fexp(bend[1]), (Sm[jt][2] + dl[2]) * fexp(bend[2]), (Sm[jt][3] + dl[3]) * fexp(bend[3])}; } }
    { bf16x8 ab2[2];
#pragma unroll
        for (int ks = 0; ks < 2; ++ks) ab2[ks] = ldfrag(AS + (tt * 16 + r) * ST + (ks * 32 + q * 8) * 2);
        float ssq = 0.f;
#pragma unroll
        for (int i = 0; i < 4; ++i) { const int dt = dh * 4 + i;
#pragma unroll
            for (int ks = 0; ks < 2; ++ks) hv[i] = mfma16(ldfrag(VT + tfr(dt * 16 + r, ks * 4 + q)), ab2[ks], hv[i]);
            ssq += hv[i][0] * hv[i][0] + hv[i][1] * hv[i][1] + hv[i][2] * hv[i][2] + hv[i][3] * hv[i][3]; }
        ssq += __shfl_xor(ssq, 16); ssq += __shfl_xor(ssq, 32); if (q == 0) part[t * 2 + dh] = ssq; }
    LDS_BARRIER();
    { const bool valid = (c > 0) || (t >= LEAD); const float sc = frsq((part[t * 2] + part[t * 2 + 1]) * (1.f / 128.f) + EPS); bf16_t* yp = p.Z() + (size_t)(r0 + t) * ZP + ZO_GG + hd * 128;
#pragma unroll
        for (int i = 0; i < 4; ++i) { const int d0 = (dh * 4 + i) * 16 + q * 4; float y[4];
            y[0] = hv[i][0] * sc * gn[i][0] * fsilu(bflo(og[i].x)); y[1] = hv[i][1] * sc * gn[i][1] * fsilu(bfhi(og[i].x)); y[2] = hv[i][2] * sc * gn[i][2] * fsilu(bflo(og[i].y)); y[3] = hv[i][3] * sc * gn[i][3] * fsilu(bfhi(og[i].y));
            u32x2 o; o.x = valid ? cvt_pk_bf16(y[0], y[1]) : 0u; o.y = valid ? cvt_pk_bf16(y[2], y[3]) : 0u; *(u32x2*)(yp + d0) = o; } }
}
}

namespace pro {
#define PRO_TILE(LD4, GK, OUTROW) do { \
        f32x4 v_[8]; \
        _Pragma("unroll") for (int i = 0; i < 8; ++i) { const int kk = 8 * i + (lane >> 3); v_[i] = (LD4); } \
        _Pragma("unroll") for (int i = 0; i < 8; ++i) { const int kk = 8 * i + (lane >> 3); const float g_ = (GK); LAS float* d_ = scr + kk * 33 + (lane & 7) * 4; d_[0] = v_[i].x * g_; d_[1] = v_[i].y * g_; d_[2] = v_[i].z * g_; d_[3] = v_[i].w * g_; } \
        asm volatile("s_waitcnt lgkmcnt(0)" ::: "memory"); \
        { const int c8 = lane & 7; _Pragma("unroll") for (int j = 0; j < 4; ++j) { const int nn = (lane >> 3) + 8 * j; const LAS float* s_ = scr + (8 * c8) * 33 + nn; \
            pg8::u32x4 o_; o_.x = pg8::cvt_pk_bf16(s_[0], s_[33]); o_.y = pg8::cvt_pk_bf16(s_[66], s_[99]); o_.z = pg8::cvt_pk_bf16(s_[132], s_[165]); o_.w = pg8::cvt_pk_bf16(s_[198], s_[231]); \
            *(pg8::u32x4*)((OUTROW) + 8 * c8) = o_; } } \
        asm volatile("s_waitcnt lgkmcnt(0)" ::: "memory"); } while (0)
#define PRO_TILE8(LD4, GK, OUTROW8) do { \
        f32x4 v_[8]; \
        _Pragma("unroll") for (int i = 0; i < 8; ++i) { const int kk = 8 * i + (lane >> 3); v_[i] = (LD4); } \
        _Pragma("unroll") for (int i = 0; i < 8; ++i) { const int kk = 8 * i + (lane >> 3); const float g_ = (GK); LAS float* d_ = scr + kk * 33 + (lane & 7) * 4; d_[0] = v_[i].x * g_; d_[1] = v_[i].y * g_; d_[2] = v_[i].z * g_; d_[3] = v_[i].w * g_; } \
        asm volatile("s_waitcnt lgkmcnt(0)" ::: "memory"); \
        { const int c8 = lane & 7; _Pragma("unroll") for (int j = 0; j < 4; ++j) { const int nn = (lane >> 3) + 8 * j; const LAS float* s_ = scr + (8 * c8) * 33 + nn; \
            pg8::u32x2 o_; o_.x = pg8::pk_fp8x4(s_[0], s_[33], s_[66], s_[99]); o_.y = pg8::pk_fp8x4(s_[132], s_[165], s_[198], s_[231]); \
            *(pg8::u32x2*)((OUTROW8) + 8 * c8) = o_; } } \
        asm volatile("s_waitcnt lgkmcnt(0)" ::: "memory"); } while (0)
constexpr int PL_IN = 16 * (NZP / 32), PL_OUT = 16 * (D / 32), PL_GU = NE * 16 * (512 / 64), PL_D = NE * (DE / 64) * (D / 32), PL_ALL = PL_IN + PL_OUT + PL_GU + PL_D;
__device__ __forceinline__ void pro_item(const P& p, LAS float* scr, int lane, int it, int l) {
    const f32x4 zero4 = {0.f, 0.f, 0.f, 0.f};
    int r = it;
    if (r < PL_IN) { const int nb = r % (NZP / 32), kb = r / (NZP / 32), k0 = kb * 64, n0 = nb * 32;
        const int n = n0 + (lane & 7) * 4; const float* src = p.w_in + ((size_t)l * D + k0) * NIN + zsrc(n); const float* g = p.norm1_g + l * D + k0;
        bf16_t* ob = (bf16_t*)(p.ws + WS_WIN) + ((size_t)l * NZP + n0) * D + k0;
        PRO_TILE((n < NIN) ? *(const f32x4*)(src + (size_t)kk * NIN) : zero4, g[kk], ob + (size_t)nn * D);
        return; }
    r -= PL_IN;
    if (r < PL_OUT) { const int nb = r % 32, kb = r / 32, k0 = kb * 64, n0 = nb * 32;
        const float* src = p.w_out + ((size_t)l * D + k0) * D + n0 + (lane & 7) * 4; bf16_t* ob = (bf16_t*)(p.ws + WS_WOUT) + ((size_t)l * D + n0) * D + k0;
        PRO_TILE(*(const f32x4*)(src + (size_t)kk * D), 1.f, ob + (size_t)nn * D);
        return; }
    r -= PL_OUT;
    if (r < PL_GU) { const int nb2 = r % 8, kb = (r / 8) % 16, bz = l * NE + r / 128, k0 = kb * 64;
        const float* g = p.norm2_g + l * D + k0; unsigned char* ob8 = p.ws + WS_WGU + ((size_t)bz * 512 + 64 * nb2) * D + k0;
        const size_t so = ((size_t)bz * D + k0) * DE + 32 * nb2 + (lane & 7) * 4;
        PRO_TILE8(*(const f32x4*)(p.w_gate + so + (size_t)kk * DE), g[kk] * 16.f, ob8 + (size_t)(32 * (nn >> 4) + (nn & 15)) * D);
        PRO_TILE8(*(const f32x4*)(p.w_up + so + (size_t)kk * DE), g[kk] * 16.f, ob8 + (size_t)(32 * (nn >> 4) + 16 + (nn & 15)) * D);
        return; }
    r -= PL_GU;
    { const int nb = r % 32, kb = (r / 32) % 4, bz = l * NE + r / 128, k0 = kb * 64, n0 = nb * 32;
        const float* src = p.w_down + ((size_t)bz * DE + k0) * D + n0 + (lane & 7) * 4; unsigned char* ob8 = p.ws + WS_WD + ((size_t)bz * D + n0) * DE + k0;
        PRO_TILE8(*(const f32x4*)(src + (size_t)kk * D), 8.f, ob8 + (size_t)nn * DE); }
}
constexpr int TE_IN = PL_IN, TE_OUT = PL_OUT, TE_GU = 2 * PL_GU, TE_D = PL_D, TE_ALL = TE_IN + TE_OUT + TE_GU + TE_D;
struct TItem { const float* src; const float* g; unsigned char* ob; int sstride, ostride, h16; float gc; bool ok, f8, gu; };
__device__ __forceinline__ TItem te_decode(const P& p, int lane, int it, int l) { TItem t; int r = it; t.ok = true; t.g = nullptr; t.gu = false; t.h16 = 0;
    if (r < TE_IN) { const int nb = r % (NZP / 32), kb = r / (NZP / 32), k0 = kb * 64, n0 = nb * 32, n = n0 + (lane & 7) * 4;
        t.ok = n < NIN; t.src = p.w_in + ((size_t)l * D + k0) * NIN + (t.ok ? zsrc(n) : 0); t.sstride = NIN; t.g = p.norm1_g + l * D + k0; t.gc = 1.f;
        t.ob = (unsigned char*)((bf16_t*)(p.ws + WS_WIN) + ((size_t)l * NZP + n0) * D + k0); t.ostride = D; t.f8 = false; return t; }
    r -= TE_IN;
    if (r < TE_OUT) { const int nb = r % 32, kb = r / 32, k0 = kb * 64, n0 = nb * 32;
        t.src = p.w_out + ((size_t)l * D + k0) * D + n0 + (lane & 7) * 4; t.sstride = D; t.gc = 1.f;
        t.ob = (unsigned char*)((bf16_t*)(p.ws + WS_WOUT) + ((size_t)l * D + n0) * D + k0); t.ostride = D; t.f8 = false; return t; }
    r -= TE_OUT;
    if (r < TE_GU) { const int h = r & 1, pr = r >> 1, nb2 = pr % 8, kb = (pr / 8) % 16, bz = l * NE + pr / 128, k0 = kb * 64;
        t.src = (h ? p.w_up : p.w_gate) + ((size_t)bz * D + k0) * DE + 32 * nb2 + (lane & 7) * 4; t.sstride = DE; t.g = p.norm2_g + l * D + k0; t.gc = 16.f;
        t.ob = p.ws + WS_WGU + ((size_t)bz * 512 + 64 * nb2) * D + k0; t.ostride = D; t.f8 = true; t.gu = true; t.h16 = 16 * h; return t; }
    r -= TE_GU;
    { const int nb = r % 32, kb = (r / 32) % 4, bz = l * NE + r / 128, k0 = kb * 64, n0 = nb * 32;
        t.src = p.w_down + ((size_t)bz * DE + k0) * D + n0 + (lane & 7) * 4; t.sstride = D; t.gc = 8.f;
        t.ob = p.ws + WS_WD + ((size_t)bz * D + n0) * DE + k0; t.ostride = DE; t.f8 = true; return t; } }
__device__ __forceinline__ void tail_convert(const P& p, LAS unsigned char* lds, int tid, int l, int lo, int hi, int j, int nj) {
    asm volatile("" : "+v"(tid));
    const int lane = tid & 63, w = __builtin_amdgcn_readfirstlane(tid >> 6); LAS float* scr = (LAS float*)(lds + w * 8448);
    auto load = [&](const TItem& t, f32x4 (&v)[8], float (&gv)[8]) {
#pragma unroll
        for (int i = 0; i < 8; ++i) { const int kk = 8 * i + (lane >> 3); v[i] = *(const f32x4*)(t.src + (size_t)kk * t.sstride); gv[i] = t.g ? t.g[kk] : 1.f; } };
    auto store = [&](const TItem& t, const f32x4 (&v)[8], const float (&gv)[8]) { const float keep = t.ok ? t.gc : 0.f;
#pragma unroll
        for (int i = 0; i < 8; ++i) { const int kk = 8 * i + (lane >> 3); const float g_ = gv[i] * keep; LAS float* d_ = scr + kk * 33 + (lane & 7) * 4; d_[0] = v[i].x * g_; d_[1] = v[i].y * g_; d_[2] = v[i].z * g_; d_[3] = v[i].w * g_; }
        asm volatile("s_waitcnt lgkmcnt(0)" ::: "memory");
        const int c8 = lane & 7;
#pragma unroll
        for (int jj = 0; jj < 4; ++jj) { const int nn = (lane >> 3) + 8 * jj, row = t.gu ? 32 * (nn >> 4) + t.h16 + (nn & 15) : nn; const LAS float* s_ = scr + (8 * c8) * 33 + nn;
            if (t.f8) { pg8::u32x2 o_; o_.x = pg8::pk_fp8x4(s_[0], s_[33], s_[66], s_[99]); o_.y = pg8::pk_fp8x4(s_[132], s_[165], s_[198], s_[231]); *(pg8::u32x2*)(t.ob + (size_t)row * t.ostride + 8 * c8) = o_; }
            else { pg8::u32x4 o_; o_.x = pg8::cvt_pk_bf16(s_[0], s_[33]); o_.y = pg8::cvt_pk_bf16(s_[66], s_[99]); o_.z = pg8::cvt_pk_bf16(s_[132], s_[165]); o_.w = pg8::cvt_pk_bf16(s_[198], s_[231]); *(pg8::u32x4*)(t.ob + ((size_t)row * t.ostride + 8 * c8) * 2) = o_; } }
        asm volatile("s_waitcnt lgkmcnt(0)" ::: "memory"); };
    const int step = nj * NWAVES; int it = lo + j * NWAVES + w; TItem cur; f32x4 v[8]; float gv[8];
    if (it < hi) { cur = te_decode(p, lane, it, l); load(cur, v, gv); }
    for (; it < hi; it += step) { const int itn = it + step; TItem nx = cur; f32x4 vn[8]; float gn[8];
        if (itn < hi) { nx = te_decode(p, lane, itn, l); load(nx, vn, gn); }
        store(cur, v, gv);
        cur = nx;
#pragma unroll
        for (int i = 0; i < 8; ++i) { v[i] = vn[i]; gv[i] = gn[i]; } }
}
constexpr int TS0 = 0, TS1 = 1200, TS2 = 5700, TS3 = 10200, TS4 = TE_ALL;
static_assert(TS1 < TS2 && TS2 < TS3 && TS3 < TS4, "tail slots");
__device__ __forceinline__ void prologue_phase(const P& p, LAS unsigned char* lds, int G, int bid, int tid) {
    asm volatile("" : "+v"(tid));
    const int lane = tid & 63, w = __builtin_amdgcn_readfirstlane(tid >> 6), gw = bid * NWAVES + w, NGW = G * NWAVES;
    LAS float* scr = (LAS float*)(lds + w * 8448);
    for (int it = gw; it < PL_ALL; it += NGW) pro_item(p, scr, lane, it, 0);
    for (int idx = bid * NTHR + tid; idx < DEPTH * 48 * D; idx += G * NTHR) { const int k = idx % D, o = (idx / D) % 48, l = idx / (D * 48); float v = 0.f;
        if (o < 4) v = p.wr_g[((size_t)l * D + k) * 4 + o]; else if (o < 36) v = p.wr_e[((size_t)l * D + k) * 32 + (o - 4)];
        v *= p.norm2_g[l * D + k]; const bf16_t hi = f2bf(v), lo = f2bf(v - bf2f(hi));
        bf16_t* wh = (bf16_t*)(p.ws + WS_WRS); wh[idx] = hi; wh[(size_t)DEPTH * 48 * D + idx] = lo; }
    { auto srcof = [&](int r) -> const float* { if (r < XR) return p.x + (size_t)r * D; if (((r - XR) & 63) >= LEAD) return p.meta + (size_t)(((r - XR) & 63) - LEAD) * D; return nullptr; };
        f32x4 cur[4], nxt[4]; int r = gw; const float* s0 = r < MP ? srcof(r) : nullptr;
        if (r < MP) { const float* sp = s0 ? s0 : p.x;
#pragma unroll
            for (int j = 0; j < 4; ++j) cur[j] = ((const f32x4*)sp)[lane + 64 * j]; }
        for (; r < MP; r += NGW) { const int rn = r + NGW; const float* sn = rn < MP ? srcof(rn) : nullptr;
            if (rn < MP) { const float* sp = sn ? sn : p.x;
#pragma unroll
                for (int j = 0; j < 4; ++j) nxt[j] = ((const f32x4*)sp)[lane + 64 * j]; }
            float s = 0.f; bf16_t* hr = p.H() + (size_t)r * D; const float keep = s0 ? 1.f : 0.f;
#pragma unroll
            for (int j = 0; j < 4; ++j) { const f32x4 v = cur[j] * keep;
                s += v.x * v.x + v.y * v.y + v.z * v.z + v.w * v.w;
                pg8::u32x2 o; o.x = pg8::cvt_pk_bf16(v.x, v.y); o.y = pg8::cvt_pk_bf16(v.z, v.w); ((pg8::u32x2*)hr)[lane + 64 * j] = o; }
            s = wave_sum(s);
            if (lane == 0) { f32x4 q = {s, 0.f, 0.f, 0.f}; *(f32x4*)(p.SS1() + (size_t)r * 4) = q; }
#pragma unroll
            for (int j = 0; j < 4; ++j) cur[j] = nxt[j];
            s0 = sn; } }
}
#undef PRO_TILE
#undef PRO_TILE8
__device__ __forceinline__ void final_phase(const P& p, int G, int bid, int tid) {
    asm volatile("" : "+v"(tid));
    const int lane = tid & 63, w = tid >> 6;
    for (int t = bid * NWAVES + w; t < B * SEQ; t += G * NWAVES) { const int r = t;
        const float rs = row_rs(p.SS1(), r); const bf16_t* hr = p.H() + (size_t)r * D; float* o = p.out + (size_t)t * D;
#pragma unroll
        for (int j = 0; j < 4; ++j) { const pg8::u32x2 hv = ((const pg8::u32x2*)hr)[lane + 64 * j]; const f32x4 g = ((const f32x4*)p.final_g)[lane + 64 * j];
            f32x4 v; v.x = pg8::bflo(hv.x) * rs * g.x; v.y = pg8::bfhi(hv.x) * rs * g.y; v.z = pg8::bflo(hv.y) * rs * g.z; v.w = pg8::bfhi(hv.y) * rs * g.w;
            ((f32x4*)o)[lane + 64 * j] = v; } }
}
}

template <int N> __device__ __forceinline__ void fill_lds(LAS float* dst, const float* src, int t) {
    constexpr int N4 = N / 4, IT = (N4 + NTHR - 1) / NTHR; f32x4 v[IT];
#pragma unroll
    for (int k = 0; k < IT; ++k) { const int i = t + k * NTHR; v[k] = (f32x4){0.f, 0.f, 0.f, 0.f}; if (i < N4) v[k] = ((const f32x4*)src)[i]; }
#pragma unroll
    for (int k = 0; k < IT; ++k) { const int i = t + k * NTHR; if (i < N4) ((LAS f32x4*)dst)[i] = v[k]; }
}
struct Args { P p; int ph_lo, ph_hi; };
__global__ void __launch_bounds__(NTHR, 2) fwd(Args a) {
    extern __shared__ __attribute__((aligned(16))) unsigned char lds_raw[];
    LAS unsigned char* lds = (LAS unsigned char*)lds_raw;
    const P& p = a.p;
    const int tid = threadIdx.x, G = gridDim.x, bid = blockIdx.x;
    unsigned* ctl = (unsigned*)(p.ws + WS_CTL);
    volatile LAS unsigned* MISC = (volatile LAS unsigned*)(lds + MISC_OFF);
    if (tid < 128) MISC[tid] = 0u;
    __syncthreads();
    XcdBarrier bar = xcd_barrier_post(ctl + CW_BAR, MISC + 8);
#define IN(k) true
#define SEAM(k) xcd_barrier(bar)
    if (IN(PH_PRO)) {
pro::prologue_phase(p, lds, G, bid, tid); }
    SEAM(PH_PRO);
    const int bid0 = bid, G0 = G;
    for (int l = 0; l < DEPTH; ++l) {
        int bid = bid0, G = G0; asm volatile("" : "+s"(bid), "+s"(G));
        const int pb = PH_LAYER0 + l * PH_PER_LAYER;
        unsigned* gcnt = ctl + CW_CNT + l * 64 * 16;
        auto tail = [&](int nwg, int lo, int hi) { if (l + 1 < DEPTH) { const int rem = nwg % G; const bool all = rem == 0; if (all || bid >= rem) pro::tail_convert(p, lds, tid, l + 1, lo, hi, all ? bid : bid - rem, all ? G : G - rem); } };
        if (IN(pb + 0)) {
{
            pg8::DenseOrderRS<D, D> S; S.init(MP, NZP, G, bid); S.lds = lds; S.ws = p.ws;
            pg8::EpiZ E{p.ws, lds};
            pg8::gemm_phase<pg8::EpiZ, pg8::DenseOrderRS<D, D>, true, D, D>(lds + RING_OFF, (const char*)(p.ws + WS_H), (const char*)(p.ws + WS_WIN) + (size_t)l * NZP * D * 2, S, E);
            tail((MP / 256) * (NZP / 256), pro::TS0, pro::TS1);
            }
        }
        SEAM(pb + 0);
        if (IN(pb + 1)) {
            { LAS float* cw = (LAS float*)(lds + 65536);
                int t_ = tid; asm volatile("" : "+v"(t_));
                fill_lds<4096>(cw, p.conv_w + l * 4096, t_); fill_lds<1024>(cw + 4096, p.conv_b + l * D, t_);
                { LAS float* gt2 = (LAS float*)(lds + GLA_TAB); fill_lds<4096>(gt2, p.a_w2 + l * 4096, t_); fill_lds<256>(gt2 + 4096, p.a_b + l * 256, t_); }
                __syncthreads(); }
{ { const int ulo = (int)((long)bid * NU / G), uhi = (int)((long)(bid + 1) * NU / G);
                if (ulo < uhi) { mx::PreM<4> pre; mx::load_m<4>(p, l, ulo, pre, tid, ZO_VM); f32x4 Dm[9]; float mD = -INFINITY, BE = 0.f; int seg = 0;
#pragma unroll
                    for (int i = 0; i < 9; ++i) Dm[i] = (f32x4){0.f, 0.f, 0.f, 0.f};
                    for (int u = ulo; u < uhi; ++u) { const bool endrun = (u + 1 == uhi) || ((u + 1) % NCH) == 0;
                        mx::mlstm_local(p, l, u, lds, tid, pre, u + 1 < uhi ? u + 1 : -1, Dm, mD, BE, endrun ? 2 * bid + seg : -1, ((u - ulo) & 1) * 86016); if (endrun) ++seg; } }
                { const int glo = (int)((long)(G - 1 - bid) * NU / G), ghi = (int)((long)(G - bid) * NU / G);
                if (glo < ghi) { mx::PreG pre; mx::load_g(p, l, glo, pre, tid, false); f32x4 Dg[4]; float bej = 0.f; int seg = 0;
#pragma unroll
                    for (int i = 0; i < 4; ++i) Dg[i] = (f32x4){0.f, 0.f, 0.f, 0.f};
                    for (int u = glo; u < ghi; ++u) { const bool endrun = (u + 1 == ghi) || ((u + 1) % NCH) == 0;
                        mx::gla_local(p, l, u, lds, tid, pre, u + 1 < ghi ? u + 1 : -1, Dg, bej, endrun ? 2 * bid + seg : -1); if (endrun) ++seg; } } } } } }
        SEAM(pb + 1);
        if (IN(pb + 2)) mx::scan_phase(p, lds, G, bid, tid);
        SEAM(pb + 2);
        if (IN(pb + 3)) {
            { LAS float* gt = (LAS float*)(lds + 104448);
                int t_ = tid; asm volatile("" : "+v"(t_));
                fill_lds<512>(gt, p.m_norm_g + l * 512, t_); fill_lds<512>(gt + 512, p.g_norm_g + l * 512, t_);
                __syncthreads(); }
 { const int ulo = (int)((long)bid * NU / G), uhi = (int)((long)(bid + 1) * NU / G);
                if (ulo < uhi) { mx::PreO pre; mx::load_o(p, ulo, pre, tid); f32x4 Cm[9]; float mcur = 0.f;
#pragma unroll
                    for (int i = 0; i < 9; ++i) Cm[i] = (f32x4){0.f, 0.f, 0.f, 0.f};
                    int seg = 0;
                    for (int u = ulo; u < uhi; ++u) { const bool startrun = (u == ulo) || (u % NCH) == 0; if (startrun && u != ulo) ++seg;
                        mx::mlstm_out(p, l, u, lds, tid, pre, u + 1 < uhi ? u + 1 : -1, Cm, mcur, startrun ? 2 * bid + seg : -1); } }
                { const int glo = (int)((long)(G - 1 - bid) * NU / G), ghi = (int)((long)(G - bid) * NU / G);
                if (glo < ghi) { mx::PreG pre; mx::load_g(p, l, glo, pre, tid, true); f32x4 Sm[4]; int seg = 0;
#pragma unroll
                    for (int i = 0; i < 4; ++i) Sm[i] = (f32x4){0.f, 0.f, 0.f, 0.f};
                    for (int u = glo; u < ghi; ++u) { const bool startrun = (u == glo) || (u % NCH) == 0; if (startrun && u != glo) ++seg;
                        mx::gla_out(p, l, u, lds, tid, pre, u + 1 < ghi ? u + 1 : -1, Sm, startrun ? 2 * bid + seg : -1); } } } } }
        SEAM(pb + 3);
        if (IN(pb + 4)) {
            pg8::DenseOrder<ZP, D> S; S.init(XR, D, G, bid);
            pg8::EpiRes<false, false, WS_SS2, true> E{p.ws, lds};
            pg8::gemm_phase<pg8::EpiRes<false, false, WS_SS2, true>, pg8::DenseOrder<ZP, D>, true, ZP, D>(lds + RING_OFF, (const char*)(p.ws + WS_Z), (const char*)(p.ws + WS_WOUT) + (size_t)l * D * D * 2, S, E);
            int tl_ = tid; asm volatile("" : "+v"(tl_));
            { const int lane = tl_ & 63, w = __builtin_amdgcn_readfirstlane(tl_ >> 6), r = lane & 15, q = lane >> 4; const bf16_t* wo = p.Wout() + (size_t)l * D * D;
                LAS f32x4* part = (LAS f32x4*)(lds + RING_OFF);
                for (int tt = bid; tt < 4 * (D / 16); tt += G) { const int b4 = tt / (D / 16), ct = tt % (D / 16), row0 = XR + b4 * 64 + LEAD;
                    const bf16_t* ap = p.Z() + (size_t)(row0 + r) * ZP + w * 128 + q * 8; const bf16_t* bp = wo + (size_t)(ct * 16 + r) * D + w * 128 + q * 8;
                    pg8::bf16x8 af[4], bfr[4];
#pragma unroll
                    for (int ks = 0; ks < 4; ++ks) { af[ks] = *(const pg8::bf16x8*)(ap + ks * 32); bfr[ks] = *(const pg8::bf16x8*)(bp + ks * 32); }
                    f32x4 acc = {0.f, 0.f, 0.f, 0.f};
#pragma unroll
                    for (int ks = 0; ks < 4; ++ks) acc = __builtin_amdgcn_mfma_f32_16x16x32_bf16(af[ks], bfr[ks], acc, 0, 0, 0);
                    part[w * 64 + lane] = acc;
                    bf16_t hold[4] = {0, 0, 0, 0};
                    if (w == 0) {
#pragma unroll
                        for (int j = 0; j < 4; ++j) hold[j] = p.H()[(size_t)(row0 + q * 4 + j) * D + ct * 16 + r]; }
                    __syncthreads();
                    if (w == 0) { f32x4 tot = part[lane];
#pragma unroll
                        for (int ww = 1; ww < 8; ++ww) tot += part[ww * 64 + lane];
#pragma unroll
                        for (int j = 0; j < 4; ++j) { const size_t o = (size_t)(row0 + q * 4 + j) * D + ct * 16 + r; const float v = bf2f(hold[j]) + tot[j];
                            p.H()[o] = (bf16_t)(pg8::cvt_pk_bf16(v, 0.f) & 0xffffu); (p.ws + WS_H8)[o] = (unsigned char)(pg8::pk_fp8x4(v, 0.f, 0.f, 0.f) & 0xffu); } }
                    __syncthreads(); } }
        }
        SEAM(pb + 4);
        if (IN(pb + 5)) route_phase(p, l, lds, G, bid, gcnt);
        SEAM(pb + 5);
        if (IN(pb + 6)) {
{
            moe_build_tab((LAS MoeTab*)(lds + TAB_OFF), gcnt);
            typedef MoeOrder<true, 2, D / 2, D / 2, 512u * D> Ord;
            Ord S; S.lds = lds; S.ws = p.ws; S.rbLo = 0; S.nwg = ((const LAS MoeTab*)(lds + TAB_OFF))->rb0[64] * 2; S.G = G; S.c = bid;
            pg8::EpiUp E{p.ws, lds};
            pg8::gemm_phase<pg8::EpiUp, Ord, true, D / 2, D / 2, true>(lds + RING_OFF, (const char*)(p.ws + WS_H8), (const char*)(p.ws + WS_WGU) + (size_t)l * NE * 512 * D, S, E);
            tail(S.nwg, pro::TS1, pro::TS2);
            }
        }
        SEAM(pb + 6);
#pragma unroll
        for (int rank = 0; rank < 2; ++rank) {
            if (IN(pb + 7 + rank)) {
                const LAS MoeTab* T = (const LAS MoeTab*)(lds + TAB_OFF);
                typedef MoeOrder<false, 4, DE / 2, DE / 2, (unsigned)D * DE> Ord;
                Ord S; S.lds = lds; S.ws = p.ws; S.rbLo = T->rb0[32 * rank]; S.nwg = (T->rb0[32 * rank + 32] - T->rb0[32 * rank]) * 4; S.G = G; S.c = bid;
                const char* Ab = (const char*)(p.ws + WS_HID); const char* Bb = (const char*)(p.ws + WS_WD) + (size_t)l * NE * D * DE;
                if (rank == 0) { pg8::EpiRes<true, false, WS_SS1> E{p.ws, lds}; pg8::gemm_phase<pg8::EpiRes<true, false, WS_SS1>, Ord, true, DE / 2, DE / 2, true>(lds + RING_OFF, Ab, Bb, S, E); }
                else { pg8::EpiRes<true, true, WS_SS1> E{p.ws, lds}; pg8::gemm_phase<pg8::EpiRes<true, true, WS_SS1>, Ord, true, DE / 2, DE / 2, true>(lds + RING_OFF, Ab, Bb, S, E); }
                tail(S.nwg, rank ? pro::TS3 : pro::TS2, rank ? pro::TS4 : pro::TS3);
            }
            SEAM(pb + 7 + rank);
        }
    }
    if (IN(PH_FINAL)) pro::final_phase(p, G, bid, tid);
#undef IN
#undef SEAM
}

extern "C" void kernel_launch(void* const* d_in, const int* in_sizes, int n_in, void* d_out, int out_size, void* d_ws, size_t ws_size, hipStream_t stream) {
    if (n_in != 21 || ws_size < WS_END || out_size != B * SEQ * D) { fprintf(stderr, "kernel_launch: unexpected sizes n_in %d ws %zu (need %zu) out %d\n", n_in, ws_size, (size_t)WS_END, out_size); return; }
    P p{};
    const float** f = (const float**)&p.x;
    for (int i = 0; i < 21; ++i) f[i] = (const float*)d_in[i];
    p.out = (float*)d_out; p.ws = (unsigned char*)d_ws;
    static int grid = 0;
    if (!grid) {
        (void)hipFuncSetAttribute((const void*)fwd, hipFuncAttributeMaxDynamicSharedMemorySize, LDS_BYTES);
        int dev = 0, cus = 0, per_cu = 0;
        (void)hipGetDevice(&dev); (void)hipDeviceGetAttribute(&cus, hipDeviceAttributeMultiprocessorCount, dev);
        (void)hipOccupancyMaxActiveBlocksPerMultiprocessor(&per_cu, (const void*)fwd, NTHR, LDS_BYTES);
        (void)hipGetLastError();
        grid = cus > 0 ? cus : 256;
        if (per_cu < 1) fprintf(stderr, "kernel_launch: occupancy query reports %d blocks/CU for fwd\n", per_cu);
        if (grid * 128 < XR) fprintf(stderr, "kernel_launch: the route phase needs >= %d workgroups, the device has %d CUs\n", XR / 128, grid);
    }
    (void)hipMemsetAsync(d_ws, 0, CTL_BYTES, stream);
    Args a{}; a.p = p; a.ph_lo = 0; a.ph_hi = PH_COUNT;
    hipLaunchKernelGGL(fwd, dim3(grid), dim3(NTHR), LDS_BYTES, stream, a);
}
```
